# Optimizing an MI355X kernel written in HIP

```python
import math
import jax, jax.numpy as jnp
from jax import lax
import numpy as np

D_MODEL = 1024
BATCH = 4
SEQ = 4096
DEPTH = 2
DEC_BATCH = 32
DEC_SEQ = 8
PAST_LEN = 8192
PAGE_SIZE = 128

N_MIXERS = 2
N_ATTN_LAYERS = (DEPTH + N_MIXERS - 1) // N_MIXERS
N_SSM_LAYERS = DEPTH // N_MIXERS

ATT_HEADS = 16
ATT_HEAD_DIM = 64
ATT_WIDTH = ATT_HEADS * ATT_HEAD_DIM
DIL_GROUPS = ((128, 1), (512, 4), (2048, 16))
N_DIL = len(DIL_GROUPS)
BAND_BLOCK = 128
ATT_IN = 3 * N_DIL * ATT_WIDTH + ATT_WIDTH

SSM_D_INNER = 2 * D_MODEL
SSM_HEAD_DIM = 64
SSM_HEADS = SSM_D_INNER // SSM_HEAD_DIM
SSM_STATE = 128
SSM_GROUPS = 4
SSM_HEADS_PER_GROUP = SSM_HEADS // SSM_GROUPS
SSM_CONV = 4
SSM_CHUNK = 128
SSM_CONV_DIM = SSM_D_INNER + 2 * SSM_GROUPS * SSM_STATE
SSM_IN = 2 * SSM_D_INNER + 2 * SSM_GROUPS * SSM_STATE + SSM_HEADS

NORM_EPS = 1e-6
GATE_NORM_EPS = 1e-5

kernel_name = "dilated_swa_mamba2_hybrid_step"


def rms_norm(x, w, eps=NORM_EPS):
    xf = x.astype(jnp.float32)
    y = xf * lax.rsqrt(jnp.mean(xf * xf, axis=-1, keepdims=True) + eps)
    return (y * w.astype(jnp.float32)).astype(x.dtype)


def attn_project(x, norm_w, w_in, q_gain, k_gain):
    b, s, _ = x.shape
    h = rms_norm(x, norm_w)
    proj = h @ w_in
    qkv = proj[..., :3 * N_DIL * ATT_WIDTH].reshape(b, s, N_DIL, 3, ATT_HEADS, ATT_HEAD_DIM)
    gate = proj[..., 3 * N_DIL * ATT_WIDTH:]
    q = rms_norm(qkv[:, :, :, 0], q_gain[:, None, :]) * (ATT_HEAD_DIM ** -0.5)
    k = rms_norm(qkv[:, :, :, 1], k_gain[:, None, :])
    v = qkv[:, :, :, 2]
    return q, k, v, gate


def dilated_band_prompt(q, k, v, window, dilation):
    b, s, nh, dh = q.shape
    wn = window // dilation
    span = dilation * BAND_BLOCK
    sp = -(-s // span) * span
    nb = sp // span
    pad = ((0, 0), (0, sp - s), (0, 0), (0, 0))

    def to_blocks(t):
        t = jnp.pad(t.astype(jnp.float32), pad).reshape(b, sp // dilation, dilation, nh, dh)
        return t.transpose(0, 2, 1, 3, 4).reshape(b, dilation, nb, BAND_BLOCK, nh, dh)

    def with_prev(t):
        prev = jnp.pad(t, ((0, 0), (0, 0), (1, 0), (0, 0), (0, 0), (0, 0)))[:, :, :-1]
        return jnp.concatenate([prev, t], axis=3)

    qb, kb, vb = to_blocks(q), to_blocks(k), to_blocks(v)
    kk, vv = with_prev(kb), with_prev(vb)
    scores = jnp.einsum('brnqhe,brnkhe->brnhqk', qb, kk)
    blk = jnp.arange(nb)[:, None, None]
    qi = jnp.arange(BAND_BLOCK)[None, :, None]
    kj = jnp.arange(2 * BAND_BLOCK)[None, None, :]
    dist = BAND_BLOCK + qi - kj
    mask = (dist >= 0) & (dist <= wn) & ((blk - 1) * BAND_BLOCK + kj >= 0)
    scores = jnp.where(mask[None, None, :, None], scores, -jnp.inf)
    m = jnp.max(scores, axis=-1, keepdims=True)
    p = jnp.exp(scores - m)
    den = jnp.sum(p, axis=-1, keepdims=True)
    o = jnp.einsum('brnhqk,brnkhe->brnqhe', p / den, vv)
    lse = (m + jnp.log(den))[..., 0]
    o = o.reshape(b, dilation, sp // dilation, nh, dh).transpose(0, 2, 1, 3, 4).reshape(b, sp, nh, dh)[:, :s]
    lse = lse.transpose(0, 1, 2, 4, 3).reshape(b, dilation, sp // dilation, nh)
    lse = lse.transpose(0, 2, 1, 3).reshape(b, sp, nh)[:, :s]
    return o, lse


def dilated_gather_sample(q, k_all, v_all, buf_len, window, dilation):
    t = q.shape[1]
    wn = window // dilation
    idx = buf_len + jnp.arange(t)[:, None] - dilation * jnp.arange(wn + 1)[None, :]
    valid = idx >= 0
    idx = jnp.maximum(idx, 0)
    kg = k_all[:, idx].astype(jnp.float32)
    vg = v_all[:, idx].astype(jnp.float32)
    scores = jnp.einsum('bthe,btkhe->bthk', q.astype(jnp.float32), kg)
    scores = jnp.where(valid[None, :, None, :], scores, -jnp.inf)
    m = jnp.max(scores, axis=-1, keepdims=True)
    p = jnp.exp(scores - m)
    den = jnp.sum(p, axis=-1, keepdims=True)
    o = jnp.einsum('bthk,btkhe->bthe', p / den, vg)
    lse = (m + jnp.log(den))[..., 0]
    return o, lse


def attn_merge(outs, lses, gate, w_out):
    wts = jax.nn.softmax(lses, axis=0)
    o = jnp.einsum('gbsh,gbshe->bshe', wts, outs)
    b, s = o.shape[:2]
    o = o.reshape(b, s, ATT_WIDTH).astype(gate.dtype) * jax.nn.silu(gate)
    return o @ w_out


def attn_layer_prompt(x, norm_w, w_in, q_gain, k_gain, w_out):
    q, k, v, gate = attn_project(x, norm_w, w_in, q_gain, k_gain)
    s = x.shape[1]
    outs, lses, new_kv = [], [], []
    for g, (window, dilation) in enumerate(DIL_GROUPS):
        o, l = dilated_band_prompt(q[:, :, g], k[:, :, g], v[:, :, g], window, dilation)
        outs.append(o)
        lses.append(l)
        keep = min(window, s)
        new_kv.append(jnp.stack([k[:, s - keep:, g], v[:, s - keep:, g]], axis=2))
    y = x + attn_merge(jnp.stack(outs), jnp.stack(lses), gate, w_out).astype(x.dtype)
    return y, new_kv


def attn_layer_sample(x, kv_bufs, norm_w, w_in, q_gain, k_gain, w_out):
    q, k, v, gate = attn_project(x, norm_w, w_in, q_gain, k_gain)
    outs, lses, new_kv = [], [], []
    for g, (window, dilation) in enumerate(DIL_GROUPS):
        buf = kv_bufs[g]
        k_all = jnp.concatenate([buf[:, :, 0], k[:, :, g].astype(buf.dtype)], axis=1)
        v_all = jnp.concatenate([buf[:, :, 1], v[:, :, g].astype(buf.dtype)], axis=1)
        o, l = dilated_gather_sample(q[:, :, g], k_all, v_all, buf.shape[1], window, dilation)
        outs.append(o)
        lses.append(l)
        new_kv.append(jnp.stack([k[:, :, g], v[:, :, g]], axis=2))
    y = x + attn_merge(jnp.stack(outs), jnp.stack(lses), gate, w_out).astype(x.dtype)
    return y, new_kv


def causal_conv(xbc, conv_state, conv_w, conv_b):
    L = xbc.shape[1]
    xpad = jnp.concatenate([conv_state.astype(xbc.dtype), xbc], axis=1)
    out = conv_b + xpad[:, 0:L] * conv_w[0]
    for j in range(1, SSM_CONV):
        out = out + xpad[:, j:j + L] * conv_w[j]
    return jax.nn.silu(out), xpad[:, L:]


def ssd_chunked(x, dt, A, Bm, Cm, h0, chunk):
    f32 = jnp.float32
    b, L, nh, p = x.shape
    c = L // chunk
    G, R, N = SSM_GROUPS, SSM_HEADS_PER_GROUP, SSM_STATE
    x = x.astype(f32).reshape(b, c, chunk, G, R, p)
    dt = dt.astype(f32).reshape(b, c, chunk, G, R)
    Bm = Bm.astype(f32).reshape(b, c, chunk, G, N)
    Cm = Cm.astype(f32).reshape(b, c, chunk, G, N)
    a_cs = jnp.cumsum(dt * A.astype(f32).reshape(G, R), axis=2)
    xdt = x * dt[..., None]
    a_t = a_cs.transpose(0, 1, 3, 4, 2)
    seg = a_t[..., :, None] - a_t[..., None, :]
    causal = jnp.tril(jnp.ones((chunk, chunk), dtype=bool))
    decay = jnp.exp(jnp.where(causal, seg, -jnp.inf))
    cb = jnp.einsum('bclgn,bcsgn->bcgls', Cm, Bm)
    y_diag = jnp.einsum('bcgls,bcgrls,bcsgrp->bclgrp', cb, decay, xdt)
    decay_to_end = jnp.exp(a_cs[:, :, -1:] - a_cs)
    states = jnp.einsum('bclgn,bclgr,bclgrp->bcgrpn', Bm, decay_to_end, xdt)
    chunk_decay = jnp.exp(a_cs[:, :, -1])

    def step(h, inp):
        s_c, d_c = inp
        return h * d_c[..., None, None] + s_c, h

    h_init = h0.astype(f32).reshape(b, G, R, p, N)
    h_final, h_prev = lax.scan(step, h_init, (states.transpose(1, 0, 2, 3, 4, 5), chunk_decay.transpose(1, 0, 2, 3)))
    h_prev = h_prev.transpose(1, 0, 2, 3, 4, 5)
    y_off = jnp.einsum('bclgn,bcgrpn,bclgr->bclgrp', Cm, h_prev, jnp.exp(a_cs))
    y = (y_diag + y_off).reshape(b, L, nh, p)
    return y, h_final.reshape(b, nh, p, N)


def ssm_layer(x, conv_state, ssm_state, chunk, norm_w, w_in, conv_w, conv_b, dt_bias, A_log, D, gate_norm, w_out):
    f32 = jnp.float32
    b, L, _ = x.shape
    h = rms_norm(x, norm_w)
    proj = h @ w_in
    z = proj[..., :SSM_D_INNER]
    xbc = proj[..., SSM_D_INNER:SSM_D_INNER + SSM_CONV_DIM]
    dt = proj[..., SSM_D_INNER + SSM_CONV_DIM:]
    xbc, new_conv = causal_conv(xbc, conv_state, conv_w, conv_b)
    gn = SSM_GROUPS * SSM_STATE
    xs = xbc[..., :SSM_D_INNER].reshape(b, L, SSM_HEADS, SSM_HEAD_DIM)
    Bm = xbc[..., SSM_D_INNER:SSM_D_INNER + gn].reshape(b, L, SSM_GROUPS, SSM_STATE)
    Cm = xbc[..., SSM_D_INNER + gn:].reshape(b, L, SSM_GROUPS, SSM_STATE)
    dt = jax.nn.softplus(dt.astype(f32) + dt_bias.astype(f32))
    A = -jnp.exp(A_log.astype(f32))
    y, new_ssm = ssd_chunked(xs, dt, A, Bm, Cm, ssm_state, chunk)
    y = y + D.astype(f32)[:, None] * xs.astype(f32)
    y = y.reshape(b, L, SSM_D_INNER) * jax.nn.silu(z.astype(f32))
    yg = y.reshape(b, L, SSM_GROUPS, SSM_D_INNER // SSM_GROUPS)
    yg = yg * lax.rsqrt(jnp.mean(yg * yg, axis=-1, keepdims=True) + GATE_NORM_EPS)
    y = yg.reshape(b, L, SSM_D_INNER) * gate_norm.astype(f32)
    out = x + (y.astype(x.dtype) @ w_out).astype(x.dtype)
    return out, new_conv, new_ssm


def setup_inputs(seed: int = 0) -> dict:
    key = jax.random.key(seed)
    ks = jax.random.split(key, 24)
    f32 = jnp.float32

    def nrm(k, shape, scale):
        return scale * jax.random.normal(k, shape, f32)

    NA, NS = N_ATTN_LAYERS, N_SSM_LAYERS
    buf = [min(w, PAST_LEN) for (w, _) in DIL_GROUPS]
    x_prompt = nrm(ks[0], (BATCH, SEQ, D_MODEL), 1.0)
    x_sample = nrm(ks[1], (DEC_BATCH, DEC_SEQ, D_MODEL), 1.0)
    cache_kv_g0 = nrm(ks[2], (NA, DEC_BATCH, buf[0], 2, ATT_HEADS, ATT_HEAD_DIM), 1.0)
    cache_kv_g1 = nrm(ks[3], (NA, DEC_BATCH, buf[1], 2, ATT_HEADS, ATT_HEAD_DIM), 1.0)
    cache_kv_g2 = nrm(ks[4], (NA, DEC_BATCH, buf[2], 2, ATT_HEADS, ATT_HEAD_DIM), 1.0)
    state_conv = nrm(ks[5], (NS, DEC_BATCH, SSM_CONV - 1, SSM_CONV_DIM), 1.0)
    state_ssm = nrm(ks[6], (NS, DEC_BATCH, SSM_HEADS, SSM_HEAD_DIM, SSM_STATE), 0.1)
    attn_norm = 1.0 + nrm(ks[7], (NA, D_MODEL), 0.02)
    attn_w_in = nrm(ks[8], (NA, D_MODEL, ATT_IN), D_MODEL ** -0.5)
    attn_q_gain = 1.0 + nrm(ks[9], (NA, N_DIL, ATT_HEAD_DIM), 0.02)
    attn_k_gain = 1.0 + nrm(ks[10], (NA, N_DIL, ATT_HEAD_DIM), 0.02)
    attn_w_out = nrm(ks[11], (NA, ATT_WIDTH, D_MODEL), ATT_WIDTH ** -0.5)
    ssm_norm = 1.0 + nrm(ks[12], (NS, D_MODEL), 0.02)
    ssm_w_in = nrm(ks[13], (NS, D_MODEL, SSM_IN), D_MODEL ** -0.5)
    ssm_conv_w = nrm(ks[14], (NS, SSM_CONV, SSM_CONV_DIM), SSM_CONV ** -0.5)
    ssm_conv_b = nrm(ks[15], (NS, SSM_CONV_DIM), 0.02)
    dt0 = jnp.exp(jax.random.uniform(ks[16], (NS, SSM_HEADS), f32, math.log(1e-3), math.log(1e-1)))
    ssm_dt_bias = dt0 + jnp.log(-jnp.expm1(-dt0))
    ssm_A_log = jnp.log(jax.random.uniform(ks[17], (NS, SSM_HEADS), f32, 1.0, 16.0))
    ssm_D = 1.0 + nrm(ks[18], (NS, SSM_HEADS), 0.02)
    ssm_gate_norm = 1.0 + nrm(ks[19], (NS, SSM_D_INNER), 0.02)
    ssm_w_out = nrm(ks[20], (NS, SSM_D_INNER, D_MODEL), SSM_D_INNER ** -0.5)
    return {
        "x_prompt": x_prompt, "x_sample": x_sample,
        "cache_kv_g0": cache_kv_g0, "cache_kv_g1": cache_kv_g1, "cache_kv_g2": cache_kv_g2,
        "state_conv": state_conv, "state_ssm": state_ssm,
        "attn_norm": attn_norm, "attn_w_in": attn_w_in, "attn_q_gain": attn_q_gain,
        "attn_k_gain": attn_k_gain, "attn_w_out": attn_w_out,
        "ssm_norm": ssm_norm, "ssm_w_in": ssm_w_in, "ssm_conv_w": ssm_conv_w, "ssm_conv_b": ssm_conv_b,
        "ssm_dt_bias": ssm_dt_bias, "ssm_A_log": ssm_A_log, "ssm_D": ssm_D,
        "ssm_gate_norm": ssm_gate_norm, "ssm_w_out": ssm_w_out,
    }


def reference(x_prompt, x_sample, cache_kv_g0, cache_kv_g1, cache_kv_g2, state_conv, state_ssm,
              attn_norm, attn_w_in, attn_q_gain, attn_k_gain, attn_w_out,
              ssm_norm, ssm_w_in, ssm_conv_w, ssm_conv_b, ssm_dt_bias, ssm_A_log, ssm_D,
              ssm_gate_norm, ssm_w_out):
    kv_caches = (cache_kv_g0, cache_kv_g1, cache_kv_g2)
    xp, xs = x_prompt, x_sample
    kv_p = [[] for _ in range(N_DIL)]
    kv_s = [[] for _ in range(N_DIL)]
    conv_p, conv_s, ssm_p, ssm_s = [], [], [], []
    for i in range(DEPTH):
        j = i // N_MIXERS
        if i % N_MIXERS == 0:
            params = (attn_norm[j], attn_w_in[j], attn_q_gain[j], attn_k_gain[j], attn_w_out[j])
            xp, new_p = attn_layer_prompt(xp, *params)
            xs, new_s = attn_layer_sample(xs, [c[j] for c in kv_caches], *params)
            for g in range(N_DIL):
                kv_p[g].append(new_p[g])
                kv_s[g].append(new_s[g])
        else:
            params = (ssm_norm[j], ssm_w_in[j], ssm_conv_w[j], ssm_conv_b[j], ssm_dt_bias[j],
                      ssm_A_log[j], ssm_D[j], ssm_gate_norm[j], ssm_w_out[j])
            b = xp.shape[0]
            zero_conv = jnp.zeros((b, SSM_CONV - 1, SSM_CONV_DIM), xp.dtype)
            zero_ssm = jnp.zeros((b, SSM_HEADS, SSM_HEAD_DIM, SSM_STATE), jnp.float32)
            xp, c_p, h_p = ssm_layer(xp, zero_conv, zero_ssm, SSM_CHUNK, *params)
            xs, c_s, h_s = ssm_layer(xs, state_conv[j], state_ssm[j], xs.shape[1], *params)
            conv_p.append(c_p)
            conv_s.append(c_s)
            ssm_p.append(h_p)
            ssm_s.append(h_s)
    new_kv_g0_prompt = jnp.stack(kv_p[0])
    new_kv_g1_prompt = jnp.stack(kv_p[1])
    new_kv_g2_prompt = jnp.stack(kv_p[2])
    new_kv_g0_sample = jnp.stack(kv_s[0])
    new_kv_g1_sample = jnp.stack(kv_s[1])
    new_kv_g2_sample = jnp.stack(kv_s[2])
    new_conv_prompt = jnp.stack(conv_p)
    new_conv_sample = jnp.stack(conv_s)
    new_ssm_prompt = jnp.stack(ssm_p)
    new_ssm_sample = jnp.stack(ssm_s)
    return (xp, xs, new_kv_g0_prompt, new_kv_g1_prompt, new_kv_g2_prompt,
            new_kv_g0_sample, new_kv_g1_sample, new_kv_g2_sample,
            new_conv_prompt, new_conv_sample, new_ssm_prompt, new_ssm_sample)
```

```cpp
#include <hip/hip_runtime.h>
#include <hip/hip_cooperative_groups.h>
#include <cstdio>
#include <cstdint>
namespace cg = cooperative_groups;

typedef unsigned short u16;
typedef short bf16x8 __attribute__((ext_vector_type(8)));
typedef short s16x4 __attribute__((ext_vector_type(4)));
typedef float f32x4 __attribute__((ext_vector_type(4)));

#define DI __device__ __forceinline__
#define MFMA16(a, b, c) __builtin_amdgcn_mfma_f32_16x16x32_bf16((a), (b), (c), 0, 0, 0)

constexpr int MROWS = 16384 + 256;
constexpr int PROWS = 16384;
constexpr int ATT_IN = 10240;
constexpr int SSM_IN = 5152;
constexpr int SSM_IN_PAD = 5248;
constexpr int LDS_BYTES = 73728;
constexpr int LDT = 72;
constexpr int LDW = 136;
constexpr int TILE_ELEMS = 128 * LDT;

constexpr size_t O_Y = 0;
constexpr size_t O_KVP0 = (size_t)MROWS * 1024;
constexpr size_t O_KVP1 = O_KVP0 + (size_t)4 * 128 * 2048;
constexpr size_t O_KVP2 = O_KVP1 + (size_t)4 * 512 * 2048;
constexpr size_t O_KVS0 = O_KVP2 + (size_t)4 * 2048 * 2048;
constexpr size_t O_KVS1 = O_KVS0 + (size_t)256 * 2048;
constexpr size_t O_KVS2 = O_KVS1 + (size_t)256 * 2048;
constexpr size_t O_CONVP = O_KVS2 + (size_t)256 * 2048;
constexpr size_t O_CONVS = O_CONVP + (size_t)4 * 3 * 3072;
constexpr size_t O_SSMP = O_CONVS + (size_t)32 * 3 * 3072;
constexpr size_t O_SSMS = O_SSMP + (size_t)4 * 32 * 64 * 128;
constexpr size_t O_END = O_SSMS + (size_t)32 * 32 * 64 * 128;

struct Params {
  const float *x_prompt, *x_sample, *cache0, *cache1, *cache2, *state_conv, *state_ssm;
  const float *attn_norm, *attn_w_in, *attn_q_gain, *attn_k_gain, *attn_w_out;
  const float *ssm_norm, *ssm_w_in, *ssm_conv_w, *ssm_conv_b, *ssm_dt_bias, *ssm_A_log, *ssm_D, *ssm_gate_norm, *ssm_w_out;
  float* out;
  u16 *Wt1, *Wt2, *Wt3, *Wt4, *H, *QKVG, *OG, *Z, *XBC, *YG;
  float *LSE, *X1, *DT, *STATES, *SSQ, *CD;
};

DI u16 f2bf(float x) { unsigned u = __float_as_uint(x); u += 0x7fffu + ((u >> 16) & 1u); return (u16)(u >> 16); }
DI float bf2f(u16 h) { return __uint_as_float(((unsigned)h) << 16); }
DI unsigned pack2(float a, float b) { return (unsigned)f2bf(a) | ((unsigned)f2bf(b) << 16); }
DI float lo_f(unsigned w) { return __uint_as_float(w << 16); }
DI float hi_f(unsigned w) { return __uint_as_float(w & 0xffff0000u); }
DI void unpack8(const uint4& v, float* f) {
  f[0] = lo_f(v.x); f[1] = hi_f(v.x); f[2] = lo_f(v.y); f[3] = hi_f(v.y);
  f[4] = lo_f(v.z); f[5] = hi_f(v.z); f[6] = lo_f(v.w); f[7] = hi_f(v.w);
}
DI uint4 pack8(const float* f) {
  uint4 v; v.x = pack2(f[0], f[1]); v.y = pack2(f[2], f[3]); v.z = pack2(f[4], f[5]); v.w = pack2(f[6], f[7]); return v;
}
DI float silu_f(float x) { return x / (1.f + __expf(-x)); }
DI s16x4 tr_read(const u16* ptr) {
  return __builtin_amdgcn_ds_read_tr16_b64_v4i16((s16x4 __attribute__((address_space(3)))*)(ptr));
}
DI bf16x8 cat4(s16x4 lo, s16x4 hi) { return __builtin_shufflevector(lo, hi, 0, 1, 2, 3, 4, 5, 6, 7); }
DI bf16x8 words_to_frag(unsigned a, unsigned b, unsigned c, unsigned d) {
  uint4 v; v.x = a; v.y = b; v.z = c; v.w = d; return __builtin_bit_cast(bf16x8, v);
}

template <class AL, class EP>
DI void gemm_tile(const AL& al, const u16* __restrict__ Bt, int K, int m0, int n0, const EP& ep, u16* smem) {
  const int tid = threadIdx.x, lane = tid & 63, w = tid >> 6, wr = w >> 1, wc = w & 1;
  const int l15 = lane & 15, G = lane >> 4;
  u16* As = smem;
  u16* Bs = smem + 2 * TILE_ELEMS;
  f32x4 acc[4][4];
#pragma unroll
  for (int m = 0; m < 4; ++m)
#pragma unroll
    for (int n = 0; n < 4; ++n) acc[m][n] = (f32x4){0.f, 0.f, 0.f, 0.f};
  uint4 ra[4], rb[4];
  const int lrow = tid >> 3, lch = tid & 7;
  const u16* bsrc = Bt + (size_t)(n0 + lrow) * K + lch * 8;
  const int nk = K >> 6;
#pragma unroll
  for (int i = 0; i < 4; ++i) {
    ra[i] = al(m0 + lrow + 32 * i, lch * 8);
    rb[i] = *(const uint4*)(bsrc + (size_t)(32 * i) * K);
  }
#pragma unroll
  for (int i = 0; i < 4; ++i) {
    *(uint4*)(As + (lrow + 32 * i) * LDT + lch * 8) = ra[i];
    *(uint4*)(Bs + (lrow + 32 * i) * LDT + lch * 8) = rb[i];
  }
  __syncthreads();
  for (int kt = 0; kt < nk; ++kt) {
    const int buf = kt & 1;
    {
      const int k0 = ((kt + 1 < nk) ? (kt + 1) : kt) << 6;
#pragma unroll
      for (int i = 0; i < 4; ++i) {
        ra[i] = al(m0 + lrow + 32 * i, k0 + lch * 8);
        rb[i] = *(const uint4*)(bsrc + (size_t)(32 * i) * K + k0);
      }
    }
    const u16* Ab = As + buf * TILE_ELEMS + (wr * 64 + l15) * LDT + G * 8;
    const u16* Bb = Bs + buf * TILE_ELEMS + (wc * 64 + l15) * LDT + G * 8;
#pragma unroll
    for (int ks = 0; ks < 2; ++ks) {
      bf16x8 a[4], b[4];
#pragma unroll
      for (int m = 0; m < 4; ++m) a[m] = *(const bf16x8*)(Ab + m * 16 * LDT + ks * 32);
#pragma unroll
      for (int n = 0; n < 4; ++n) b[n] = *(const bf16x8*)(Bb + n * 16 * LDT + ks * 32);
#pragma unroll
      for (int m = 0; m < 4; ++m)
#pragma unroll
        for (int n = 0; n < 4; ++n) acc[m][n] = MFMA16(a[m], b[n], acc[m][n]);
    }
    {
      u16* Ad = As + (buf ^ 1) * TILE_ELEMS;
      u16* Bd = Bs + (buf ^ 1) * TILE_ELEMS;
#pragma unroll
      for (int i = 0; i < 4; ++i) {
        *(uint4*)(Ad + (lrow + 32 * i) * LDT + lch * 8) = ra[i];
        *(uint4*)(Bd + (lrow + 32 * i) * LDT + lch * 8) = rb[i];
      }
    }
    __syncthreads();
  }
  ep(acc, m0 + wr * 64, n0 + wc * 64, lane);
}

template <class AL, class EP>
DI void gemm_phase(const AL& al, const u16* Bt, int K, int MT, int NT, const EP& ep, u16* smem) {
  const int x = blockIdx.x & 7, j = blockIdx.x >> 3, per = gridDim.x >> 3;
  const int SBN = (NT + 7) >> 3, SBM = (MT + 7) >> 3, total = SBN * SBM;
  for (int it = 0;; ++it) {
    const int v = it * per + j;
    const int sb = x + 8 * (v >> 6);
    if (sb >= total) break;
    const int wi = v & 63;
    const int mt = (sb / SBN) * 8 + (wi >> 3), nt = (sb % SBN) * 8 + (wi & 7);
    if (mt < MT && nt < NT) gemm_tile(al, Bt, K, mt * 128, nt * 128, ep, smem);
  }
}

struct ALPlain {
  const u16* A; int lda;
  DI uint4 operator()(int row, int k) const { return *(const uint4*)(A + (size_t)row * lda + k); }
};
DI unsigned merge_word(unsigned a, unsigned b, unsigned c, unsigned g, float e0, float e1, float e2) {
  const float lo = (e0 * lo_f(a) + e1 * lo_f(b) + e2 * lo_f(c)) * silu_f(lo_f(g));
  const float hi = (e0 * hi_f(a) + e1 * hi_f(b) + e2 * hi_f(c)) * silu_f(hi_f(g));
  return pack2(lo, hi);
}
struct ALMerge {
  const u16* OG; const u16* QKVG; const float* LSE;
  DI uint4 operator()(int row, int k) const {
    const int head = k >> 6;
    const float* lp = LSE + (size_t)row * 48 + head;
    const float l0 = lp[0], l1 = lp[16], l2 = lp[32];
    const float mx = fmaxf(l0, fmaxf(l1, l2));
    float e0 = __expf(l0 - mx), e1 = __expf(l1 - mx), e2 = __expf(l2 - mx);
    const float inv = 1.f / (e0 + e1 + e2);
    e0 *= inv; e1 *= inv; e2 *= inv;
    const u16* op = OG + (size_t)row * 3072 + k;
    const uint4 a = *(const uint4*)op, b = *(const uint4*)(op + 1024), c = *(const uint4*)(op + 2048);
    const uint4 g = *(const uint4*)(QKVG + (size_t)row * ATT_IN + 9216 + k);
    uint4 r;
    r.x = merge_word(a.x, b.x, c.x, g.x, e0, e1, e2);
    r.y = merge_word(a.y, b.y, c.y, g.y, e0, e1, e2);
    r.z = merge_word(a.z, b.z, c.z, g.z, e0, e1, e2);
    r.w = merge_word(a.w, b.w, c.w, g.w, e0, e1, e2);
    return r;
  }
};
struct ALGateNorm {
  const u16* YG; const float* SSQ; const float* gnw;
  DI uint4 operator()(int row, int k) const {
    const float* sp = SSQ + (size_t)row * 32 + (k >> 9) * 8;
    const float4 s0 = *(const float4*)sp, s1 = *(const float4*)(sp + 4);
    const float ss = (s0.x + s0.y) + (s0.z + s0.w) + (s1.x + s1.y) + (s1.z + s1.w);
    const float rstd = rsqrtf(ss * (1.f / 512.f) + 1e-5f);
    const uint4 y = *(const uint4*)(YG + (size_t)row * 2048 + k);
    const float4 g0 = *(const float4*)(gnw + k), g1 = *(const float4*)(gnw + k + 4);
    uint4 r;
    r.x = pack2(lo_f(y.x) * rstd * g0.x, hi_f(y.x) * rstd * g0.y);
    r.y = pack2(lo_f(y.y) * rstd * g0.z, hi_f(y.y) * rstd * g0.w);
    r.z = pack2(lo_f(y.z) * rstd * g1.x, hi_f(y.z) * rstd * g1.y);
    r.w = pack2(lo_f(y.w) * rstd * g1.z, hi_f(y.w) * rstd * g1.w);
    return r;
  }
};

struct Ep1 {
  const Params& p;
  DI void operator()(f32x4 (&acc)[4][4], int r0, int c0, int lane) const {
    const int l15 = lane & 15, G = lane >> 4;
    int kind, g = 0, head;
    if (c0 >= 9216) { kind = 3; head = (c0 - 9216) >> 6; }
    else { g = c0 / 3072; const int rem = c0 - g * 3072; kind = rem >> 10; head = (rem & 1023) >> 6; }
    if (kind < 2) {
      const float* gp = (kind == 0 ? p.attn_q_gain : p.attn_k_gain) + g * 64;
      float gain[4];
#pragma unroll
      for (int n = 0; n < 4; ++n) gain[n] = gp[n * 16 + l15];
      const float post = (kind == 0) ? 0.125f : 1.f;
#pragma unroll
      for (int m = 0; m < 4; ++m)
#pragma unroll
        for (int j = 0; j < 4; ++j) {
          float ss = 0.f;
#pragma unroll
          for (int n = 0; n < 4; ++n) ss += acc[m][n][j] * acc[m][n][j];
          ss += __shfl_xor(ss, 1); ss += __shfl_xor(ss, 2); ss += __shfl_xor(ss, 4); ss += __shfl_xor(ss, 8);
          const float sc = rsqrtf(ss * (1.f / 64.f) + 1e-6f) * post;
#pragma unroll
          for (int n = 0; n < 4; ++n) acc[m][n][j] *= sc * gain[n];
        }
    }
#pragma unroll
    for (int m = 0; m < 4; ++m)
#pragma unroll
      for (int j = 0; j < 4; ++j) {
        const int row = r0 + m * 16 + G * 4 + j;
        u16* dst = p.QKVG + (size_t)row * ATT_IN + c0 + l15;
#pragma unroll
        for (int n = 0; n < 4; ++n) dst[n * 16] = f2bf(acc[m][n][j]);
      }
    if (kind == 1 || kind == 2) {
      const int keep = 128 << (2 * g);
      const size_t okp = (g == 0) ? O_KVP0 : (g == 1) ? O_KVP1 : O_KVP2;
      const size_t oks = (g == 0) ? O_KVS0 : (g == 1) ? O_KVS1 : O_KVS2;
#pragma unroll
      for (int m = 0; m < 4; ++m)
#pragma unroll
        for (int j = 0; j < 4; ++j) {
          const int row = r0 + m * 16 + G * 4 + j;
          float* dst = nullptr;
          if (row < PROWS) {
            const int b = row >> 12, s = row & 4095;
            if (s >= 4096 - keep) dst = p.out + okp + ((size_t)(b * keep + s - (4096 - keep)) * 2 + (kind - 1)) * 1024 + head * 64 + l15;
          } else {
            dst = p.out + oks + ((size_t)(row - PROWS) * 2 + (kind - 1)) * 1024 + head * 64 + l15;
          }
          if (dst) {
#pragma unroll
            for (int n = 0; n < 4; ++n) dst[n * 16] = acc[m][n][j];
          }
        }
    }
  }
};
struct Ep2 {
  const Params& p;
  DI void operator()(f32x4 (&acc)[4][4], int r0, int c0, int lane) const {
    const int l15 = lane & 15, G = lane >> 4;
#pragma unroll
    for (int m = 0; m < 4; ++m)
#pragma unroll
      for (int j = 0; j < 4; ++j) {
        const int row = r0 + m * 16 + G * 4 + j;
        const float* xin = (row < PROWS) ? p.x_prompt + (size_t)row * 1024 : p.x_sample + (size_t)(row - PROWS) * 1024;
        float* dst = p.X1 + (size_t)row * 1024 + c0 + l15;
#pragma unroll
        for (int n = 0; n < 4; ++n) dst[n * 16] = xin[c0 + l15 + n * 16] + acc[m][n][j];
      }
  }
};
struct Ep3 {
  const Params& p;
  DI void operator()(f32x4 (&acc)[4][4], int r0, int c0, int lane) const {
    const int l15 = lane & 15, G = lane >> 4;
    if (c0 >= SSM_IN) return;
    if (c0 < 2048) {
#pragma unroll
      for (int m = 0; m < 4; ++m)
#pragma unroll
        for (int j = 0; j < 4; ++j) {
          const int row = r0 + m * 16 + G * 4 + j;
          u16* dst = p.Z + (size_t)row * 2048 + c0 + l15;
#pragma unroll
          for (int n = 0; n < 4; ++n) dst[n * 16] = f2bf(acc[m][n][j]);
        }
    } else if (c0 < 5120) {
      const int cc = c0 - 2048 + l15;
#pragma unroll
      for (int m = 0; m < 4; ++m)
#pragma unroll
        for (int j = 0; j < 4; ++j) {
          const int row = r0 + m * 16 + G * 4 + j;
          u16* dst = p.XBC + (size_t)row * 3072 + cc;
#pragma unroll
          for (int n = 0; n < 4; ++n) dst[n * 16] = f2bf(acc[m][n][j]);
          float* od = nullptr;
          if (row < PROWS) {
            const int b = row >> 12, s = row & 4095;
            if (s >= 4093) od = p.out + O_CONVP + (size_t)(b * 3 + s - 4093) * 3072 + cc;
          } else {
            const int rr = row - PROWS, b = rr >> 3, t = rr & 7;
            if (t >= 5) od = p.out + O_CONVS + (size_t)(b * 3 + t - 5) * 3072 + cc;
          }
          if (od) {
#pragma unroll
            for (int n = 0; n < 4; ++n) od[n * 16] = acc[m][n][j];
          }
        }
    } else {
#pragma unroll
      for (int m = 0; m < 4; ++m)
#pragma unroll
        for (int j = 0; j < 4; ++j) {
          const int row = r0 + m * 16 + G * 4 + j;
#pragma unroll
          for (int n = 0; n < 2; ++n) {
            const int h = n * 16 + l15;
            const float xv = acc[m][n][j] + p.ssm_dt_bias[h];
            p.DT[(size_t)row * 32 + h] = fmaxf(xv, 0.f) + log1pf(__expf(-fabsf(xv)));
          }
        }
    }
  }
};
struct Ep4 {
  const Params& p;
  DI void operator()(f32x4 (&acc)[4][4], int r0, int c0, int lane) const {
    const int l15 = lane & 15, G = lane >> 4;
#pragma unroll
    for (int m = 0; m < 4; ++m)
#pragma unroll
      for (int j = 0; j < 4; ++j) {
        const int row = r0 + m * 16 + G * 4 + j;
        const float* xin = p.X1 + (size_t)row * 1024 + c0 + l15;
        float* dst = p.out + O_Y + (size_t)row * 1024 + c0 + l15;
#pragma unroll
        for (int n = 0; n < 4; ++n) dst[n * 16] = xin[n * 16] + acc[m][n][j];
      }
  }
};

DI void transpose_task(const float* __restrict__ W, u16* __restrict__ Wt, int K, int N, int NTN, int tile, u16* smem) {
  const int tid = threadIdx.x;
  const int ktile = tile / NTN, ntile = tile % NTN;
  const int k0 = ktile * 64, n0 = ntile * 64;
#pragma unroll
  for (int i = 0; i < 4; ++i) {
    const int idx = tid + 256 * i;
    const int kk = idx >> 4, nq = idx & 15;
    const int n = n0 + nq * 4;
    float4 v = {0.f, 0.f, 0.f, 0.f};
    if (n < N) v = *(const float4*)(W + (size_t)(k0 + kk) * N + n);
    smem[(nq * 4 + 0) * LDT + kk] = f2bf(v.x);
    smem[(nq * 4 + 1) * LDT + kk] = f2bf(v.y);
    smem[(nq * 4 + 2) * LDT + kk] = f2bf(v.z);
    smem[(nq * 4 + 3) * LDT + kk] = f2bf(v.w);
  }
  __syncthreads();
#pragma unroll
  for (int i = 0; i < 2; ++i) {
    const int idx = tid + 256 * i;
    const int n = idx >> 3, kc = idx & 7;
    *(uint4*)(Wt + (size_t)(n0 + n) * K + k0 + kc * 8) = *(const uint4*)(smem + n * LDT + kc * 8);
  }
  __syncthreads();
}

DI void rmsnorm_row(const float* __restrict__ src, const float* __restrict__ wgt, u16* __restrict__ dst, int lane) {
  float4 v[4];
  float ss = 0.f;
#pragma unroll
  for (int i = 0; i < 4; ++i) {
    v[i] = *(const float4*)(src + lane * 4 + 256 * i);
    ss += v[i].x * v[i].x + v[i].y * v[i].y + v[i].z * v[i].z + v[i].w * v[i].w;
  }
#pragma unroll
  for (int d = 32; d >= 1; d >>= 1) ss += __shfl_xor(ss, d);
  const float rstd = rsqrtf(ss * (1.f / 1024.f) + 1e-6f);
#pragma unroll
  for (int i = 0; i < 4; ++i) {
    const float4 g = *(const float4*)(wgt + lane * 4 + 256 * i);
    uint2 o;
    o.x = pack2(v[i].x * rstd * g.x, v[i].y * rstd * g.y);
    o.y = pack2(v[i].z * rstd * g.z, v[i].w * rstd * g.w);
    *(uint2*)(dst + lane * 4 + 256 * i) = o;
  }
}

DI void phase_prep(const Params& p, u16* smem) {
  constexpr int T1 = 16 * 160, T2 = 16 * 16, T3 = 16 * 82, T4 = 32 * 16, TT = T1 + T2 + T3 + T4;
  constexpr int RT = MROWS / 4;
  for (int it = blockIdx.x; it < TT + RT; it += gridDim.x) {
    if (it < T1) transpose_task(p.attn_w_in, p.Wt1, 1024, ATT_IN, 160, it, smem);
    else if (it < T1 + T2) transpose_task(p.attn_w_out, p.Wt2, 1024, 1024, 16, it - T1, smem);
    else if (it < T1 + T2 + T3) transpose_task(p.ssm_w_in, p.Wt3, 1024, SSM_IN, 82, it - T1 - T2, smem);
    else if (it < TT) transpose_task(p.ssm_w_out, p.Wt4, 2048, 1024, 16, it - T1 - T2 - T3, smem);
    else {
      const int row = (it - TT) * 4 + (threadIdx.x >> 6);
      const float* src = (row < PROWS) ? p.x_prompt + (size_t)row * 1024 : p.x_sample + (size_t)(row - PROWS) * 1024;
      rmsnorm_row(src, p.attn_norm, p.H + (size_t)row * 1024, threadIdx.x & 63);
    }
  }
}

DI void phase_norm2(const Params& p) {
  for (int it = blockIdx.x; it < MROWS / 4; it += gridDim.x) {
    const int row = it * 4 + (threadIdx.x >> 6);
    rmsnorm_row(p.X1 + (size_t)row * 1024, p.ssm_norm, p.H + (size_t)row * 1024, threadIdx.x & 63);
  }
}

DI void attn_prompt_item(const Params& p, int item, u16* smem) {
  const int tid = threadIdx.x, lane = tid & 63, w = tid >> 6, l15 = lane & 15, G = lane >> 4;
  const int rn = item & 31, head = (item >> 5) & 15, b = (item >> 9) & 3, g = item >> 11;
  const int dsh = 2 * g, dil = 1 << dsh, nbg = 32 >> dsh;
  const int r = rn / nbg, n = rn % nbg;
  u16* Ks = smem;
  u16* Vs = smem + 256 * LDT;
  const size_t colQ = (size_t)g * 3072 + head * 64, colK = colQ + 1024, colV = colQ + 2048;
#pragma unroll
  for (int i = 0; i < 8; ++i) {
    const int c = tid + 256 * i;
    const int kj = c >> 3, ch = c & 7;
    const int u = (n - 1) * 128 + kj;
    uint4 kv = {0u, 0u, 0u, 0u}, vv = {0u, 0u, 0u, 0u};
    if (u >= 0) {
      const size_t row = (size_t)b * 4096 + (size_t)u * dil + r;
      kv = *(const uint4*)(p.QKVG + row * ATT_IN + colK + ch * 8);
      vv = *(const uint4*)(p.QKVG + row * ATT_IN + colV + ch * 8);
    }
    *(uint4*)(Ks + kj * LDT + ch * 8) = kv;
    *(uint4*)(Vs + kj * LDT + ch * 8) = vv;
  }
  __syncthreads();
#pragma unroll 1
  for (int sub = 0; sub < 2; ++sub) {
    const int q0 = w * 32 + sub * 16;
    const int qi = q0 + l15;
    const size_t rowq = (size_t)b * 4096 + (size_t)(n * 128 + qi) * dil + r;
    const u16* qp = p.QKVG + rowq * ATT_IN + colQ + G * 8;
    const bf16x8 qf0 = *(const bf16x8*)qp, qf1 = *(const bf16x8*)(qp + 32);
    f32x4 st[9];
#pragma unroll
    for (int s = 0; s < 9; ++s) {
      const u16* kp = Ks + (q0 + 16 * s + l15) * LDT + G * 8;
      const bf16x8 a0 = *(const bf16x8*)kp, a1 = *(const bf16x8*)(kp + 32);
      f32x4 z = {0.f, 0.f, 0.f, 0.f};
      z = MFMA16(a0, qf0, z);
      st[s] = MFMA16(a1, qf1, z);
    }
    float mx = -INFINITY;
#pragma unroll
    for (int s = 0; s < 9; ++s)
#pragma unroll
      for (int j = 0; j < 4; ++j) {
        const int kk = 16 * s + 4 * G + j;
        const bool valid = (kk >= l15) && (kk <= l15 + 128) && (n > 0 || q0 + kk >= 128);
        const float v = valid ? st[s][j] : -INFINITY;
        st[s][j] = v;
        mx = fmaxf(mx, v);
      }
    mx = fmaxf(mx, __shfl_xor(mx, 16));
    mx = fmaxf(mx, __shfl_xor(mx, 32));
    float sum = 0.f;
#pragma unroll
    for (int s = 0; s < 9; ++s)
#pragma unroll
      for (int j = 0; j < 4; ++j) {
        const float e = __expf(st[s][j] - mx);
        st[s][j] = e;
        sum += e;
      }
    sum += __shfl_xor(sum, 16);
    sum += __shfl_xor(sum, 32);
    const float inv = 1.f / sum;
    f32x4 o[4];
#pragma unroll
    for (int m = 0; m < 4; ++m) o[m] = (f32x4){0.f, 0.f, 0.f, 0.f};
#pragma unroll
    for (int t = 0; t < 5; ++t) {
      const int sA = 2 * t, sB = 2 * t + 1;
      bf16x8 pb;
      if (t < 4) pb = words_to_frag(pack2(st[sA][0], st[sA][1]), pack2(st[sA][2], st[sA][3]), pack2(st[sB < 9 ? sB : 8][0], st[sB < 9 ? sB : 8][1]), pack2(st[sB < 9 ? sB : 8][2], st[sB < 9 ? sB : 8][3]));
      else pb = words_to_frag(pack2(st[sA][0], st[sA][1]), pack2(st[sA][2], st[sA][3]), 0u, 0u);
      const u16* vA = Vs + (q0 + 16 * sA + 4 * G + (l15 >> 2)) * LDT + (l15 & 3) * 4;
      const u16* vB = Vs + (q0 + 16 * sB + 4 * G + (l15 >> 2)) * LDT + (l15 & 3) * 4;
#pragma unroll
      for (int m = 0; m < 4; ++m) {
        const s16x4 lo = tr_read(vA + 16 * m);
        s16x4 hi = {0, 0, 0, 0};
        if (t < 4) hi = tr_read(vB + 16 * m);
        o[m] = MFMA16(cat4(lo, hi), pb, o[m]);
      }
    }
    u16* op = p.OG + rowq * 3072 + g * 1024 + head * 64 + 4 * G;
#pragma unroll
    for (int m = 0; m < 4; ++m) {
      uint2 ov;
      ov.x = pack2(o[m][0] * inv, o[m][1] * inv);
      ov.y = pack2(o[m][2] * inv, o[m][3] * inv);
      *(uint2*)(op + 16 * m) = ov;
    }
    if (G == 0) p.LSE[rowq * 48 + g * 16 + head] = mx + __logf(sum);
  }
  __syncthreads();
}

DI void attn_sample_task(const Params& p, int id) {
  const int lane = threadIdx.x & 63, l15 = lane & 15, G = lane >> 4;
  const int t = id & 7, head = (id >> 3) & 15, b = (id >> 7) & 31, g = id >> 12;
  const int L = 128 << (2 * g), dil = 1 << (2 * g);
  const float* cache = (g == 0) ? p.cache0 : (g == 1) ? p.cache1 : p.cache2;
  const float* newkv = p.out + ((g == 0) ? O_KVS0 : (g == 1) ? O_KVS1 : O_KVS2);
  const size_t rowq = (size_t)PROWS + b * 8 + t;
  const uint2 qq = *(const uint2*)(p.QKVG + rowq * ATT_IN + g * 3072 + head * 64 + 4 * l15);
  const float q0 = lo_f(qq.x), q1 = hi_f(qq.x), q2 = lo_f(qq.y), q3 = hi_f(qq.y);
  const int coff = head * 64 + 4 * l15;
  float mx = -INFINITY, sum = 0.f, a0 = 0.f, a1 = 0.f, a2 = 0.f, a3 = 0.f;
#pragma unroll 3
  for (int i = 0; i < 33; ++i) {
    const int j = 4 * i + G;
    const int jc = j < 128 ? j : 128;
    const int idx = L + t - dil * jc;
    const float* kp = (idx < L) ? cache + ((size_t)(b * L + idx) * 2) * 1024 : newkv + ((size_t)(b * 8 + idx - L) * 2) * 1024;
    const float4 k4 = *(const float4*)(kp + coff);
    const float4 v4 = *(const float4*)(kp + 1024 + coff);
    float s = q0 * k4.x + q1 * k4.y + q2 * k4.z + q3 * k4.w;
    s += __shfl_xor(s, 1); s += __shfl_xor(s, 2); s += __shfl_xor(s, 4); s += __shfl_xor(s, 8);
    if (j > 128) s = -INFINITY;
    const float mn = fmaxf(mx, s);
    const float corr = __expf(mx - mn);
    const float pe = __expf(s - mn);
    sum = sum * corr + pe;
    a0 = a0 * corr + pe * v4.x; a1 = a1 * corr + pe * v4.y; a2 = a2 * corr + pe * v4.z; a3 = a3 * corr + pe * v4.w;
    mx = mn;
  }
  {
    float M = fmaxf(mx, __shfl_xor(mx, 16));
    M = fmaxf(M, __shfl_xor(M, 32));
    const float f = __expf(mx - M);
    sum *= f; a0 *= f; a1 *= f; a2 *= f; a3 *= f;
    mx = M;
  }
  sum += __shfl_xor(sum, 16); sum += __shfl_xor(sum, 32);
  a0 += __shfl_xor(a0, 16); a0 += __shfl_xor(a0, 32);
  a1 += __shfl_xor(a1, 16); a1 += __shfl_xor(a1, 32);
  a2 += __shfl_xor(a2, 16); a2 += __shfl_xor(a2, 32);
  a3 += __shfl_xor(a3, 16); a3 += __shfl_xor(a3, 32);
  const float inv = 1.f / sum;
  if (G == 0) {
    uint2 ov;
    ov.x = pack2(a0 * inv, a1 * inv);
    ov.y = pack2(a2 * inv, a3 * inv);
    *(uint2*)(p.OG + rowq * 3072 + g * 1024 + coff) = ov;
    if (l15 == 0) p.LSE[rowq * 48 + g * 16 + head] = mx + __logf(sum);
  }
}

DI void phase_attn(const Params& p, u16* smem) {
  constexpr int NP = 6144, NS = 3072;
  for (int it = blockIdx.x; it < NP + NS; it += gridDim.x) {
    const int tri = it / 3, rem = it - tri * 3;
    if (rem == 2) attn_sample_task(p, tri * 4 + (threadIdx.x >> 6));
    else attn_prompt_item(p, tri * 2 + rem, smem);
  }
}

DI void build_conv_tile(const Params& p, u16* dst, int ld, int nch, int colbase, int b, int c, const float* scale) {
  const int ntask = nch * 8;
  for (int task = threadIdx.x; task < ntask; task += 256) {
    const int ch = task % nch, seg = task / nch;
    const int col = colbase + ch * 8;
    float wgt[4][8], bias[8], win[3][8];
#pragma unroll
    for (int j = 0; j < 4; ++j) {
      const float4 w0 = *(const float4*)(p.ssm_conv_w + j * 3072 + col), w1 = *(const float4*)(p.ssm_conv_w + j * 3072 + col + 4);
      wgt[j][0] = w0.x; wgt[j][1] = w0.y; wgt[j][2] = w0.z; wgt[j][3] = w0.w;
      wgt[j][4] = w1.x; wgt[j][5] = w1.y; wgt[j][6] = w1.z; wgt[j][7] = w1.w;
    }
    {
      const float4 b0 = *(const float4*)(p.ssm_conv_b + col), b1 = *(const float4*)(p.ssm_conv_b + col + 4);
      bias[0] = b0.x; bias[1] = b0.y; bias[2] = b0.z; bias[3] = b0.w;
      bias[4] = b1.x; bias[5] = b1.y; bias[6] = b1.z; bias[7] = b1.w;
    }
    const int t0 = c * 128 + seg * 16;
    const u16* src = p.XBC + ((size_t)b * 4096 + t0) * 3072 + col;
#pragma unroll
    for (int j = 0; j < 3; ++j) {
      if (t0 - 3 + j >= 0) unpack8(*(const uint4*)(src + (ptrdiff_t)(j - 3) * 3072), win[j]);
      else {
#pragma unroll
        for (int e = 0; e < 8; ++e) win[j][e] = 0.f;
      }
    }
#pragma unroll 2
    for (int i = 0; i < 16; ++i) {
      float cur[8], r[8];
      unpack8(*(const uint4*)(src + (size_t)i * 3072), cur);
      const float sc = scale ? scale[seg * 16 + i] : 1.f;
#pragma unroll
      for (int e = 0; e < 8; ++e) {
        float v = bias[e] + wgt[0][e] * win[0][e] + wgt[1][e] * win[1][e] + wgt[2][e] * win[2][e] + wgt[3][e] * cur[e];
        r[e] = silu_f(v) * sc;
        win[0][e] = win[1][e]; win[1][e] = win[2][e]; win[2][e] = cur[e];
      }
      *(uint4*)(dst + (seg * 16 + i) * ld + ch * 8) = pack8(r);
    }
  }
}

DI void chunk_scan(const Params& p, int b, int c, int head, float* s_acs, float* s_dt, float* s_ws) {
  const int tid = threadIdx.x, lane = tid & 63;
  const float Aneg = -__expf(p.ssm_A_log[head]);
  if (tid < 128) {
    const float dt = p.DT[((size_t)b * 4096 + c * 128 + tid) * 32 + head];
    float v = dt * Aneg;
#pragma unroll
    for (int d = 1; d < 64; d <<= 1) {
      const float tv = __shfl_up(v, d);
      if (lane >= d) v += tv;
    }
    s_acs[tid] = v;
    s_dt[tid] = dt;
    if (lane == 63) s_ws[tid >> 6] = v;
  }
  __syncthreads();
  if (tid >= 64 && tid < 128) s_acs[tid] += s_ws[0];
  __syncthreads();
}

constexpr int SS_B = 0;
constexpr int SS_R2 = 34816;
constexpr int SS_H = 34816 + 18432;
constexpr int SS_F = 70656;

DI void ssd_states_item(const Params& p, int item, char* smem_raw) {
  const int tid = threadIdx.x, lane = tid & 63, w = tid >> 6, l15 = lane & 15, G = lane >> 4;
  const int head = item & 31, c = (item >> 5) & 31, b = item >> 10, g = head >> 3;
  u16* Bs = (u16*)(smem_raw + SS_B);
  u16* Xs = (u16*)(smem_raw + SS_R2);
  float* s_acs = (float*)(smem_raw + SS_F);
  float* s_dt = s_acs + 128;
  float* s_w = s_dt + 128;
  float* s_ws = s_w + 128;
  chunk_scan(p, b, c, head, s_acs, s_dt, s_ws);
  if (tid < 128) s_w[tid] = s_dt[tid] * __expf(s_acs[127] - s_acs[tid]);
  __syncthreads();
  build_conv_tile(p, Xs, LDT, 8, head * 64, b, c, s_w);
  build_conv_tile(p, Bs, LDW, 16, 2048 + g * 128, b, c, nullptr);
  __syncthreads();
  f32x4 acc[4][2];
#pragma unroll
  for (int m = 0; m < 4; ++m) { acc[m][0] = (f32x4){0.f, 0.f, 0.f, 0.f}; acc[m][1] = (f32x4){0.f, 0.f, 0.f, 0.f}; }
#pragma unroll
  for (int k = 0; k < 4; ++k) {
    const int rowA = 32 * k + 8 * G + (l15 >> 2);
    bf16x8 a[4], bb[2];
#pragma unroll
    for (int m = 0; m < 4; ++m) {
      const u16* ap = Xs + rowA * LDT + 16 * m + (l15 & 3) * 4;
      a[m] = cat4(tr_read(ap), tr_read(ap + 4 * LDT));
    }
#pragma unroll
    for (int nn = 0; nn < 2; ++nn) {
      const u16* bp = Bs + rowA * LDW + 32 * w + 16 * nn + (l15 & 3) * 4;
      bb[nn] = cat4(tr_read(bp), tr_read(bp + 4 * LDW));
    }
#pragma unroll
    for (int m = 0; m < 4; ++m)
#pragma unroll
      for (int nn = 0; nn < 2; ++nn) acc[m][nn] = MFMA16(a[m], bb[nn], acc[m][nn]);
  }
  float* sp = p.STATES + (size_t)item * 64 * 128;
#pragma unroll
  for (int m = 0; m < 4; ++m)
#pragma unroll
    for (int nn = 0; nn < 2; ++nn)
#pragma unroll
      for (int j = 0; j < 4; ++j) sp[(16 * m + 4 * G + j) * 128 + 32 * w + 16 * nn + l15] = acc[m][nn][j];
  if (tid == 0) p.CD[item] = __expf(s_acs[127]);
  __syncthreads();
}

DI void ssm_sample_item(const Params& p, int item, char* smem_raw) {
  const int tid = threadIdx.x;
  const int head = item & 31, b = item >> 5, g = head >> 3;
  float* sx = (float*)smem_raw;
  float* sB = sx + 512;
  float* sC = sB + 1024;
  float* sdt = sC + 1024;
  float* sdA = sdt + 8;
  float* sy2 = sdA + 8;
  const size_t row0 = (size_t)PROWS + b * 8;
  const float Aneg = -__expf(p.ssm_A_log[head]);
  for (int task = tid; task < 320; task += 256) {
    int col; float* dst;
    if (task < 64) { col = head * 64 + task; dst = sx + task; }
    else if (task < 192) { col = 2048 + g * 128 + (task - 64); dst = sB + (task - 64); }
    else { col = 2560 + g * 128 + (task - 192); dst = sC + (task - 192); }
    const int dstride = (task < 64) ? 64 : 128;
    const float w0 = p.ssm_conv_w[col], w1 = p.ssm_conv_w[3072 + col], w2 = p.ssm_conv_w[2 * 3072 + col], w3 = p.ssm_conv_w[3 * 3072 + col];
    const float bias = p.ssm_conv_b[col];
    float x0 = p.state_conv[(size_t)(b * 3 + 0) * 3072 + col];
    float x1 = p.state_conv[(size_t)(b * 3 + 1) * 3072 + col];
    float x2 = p.state_conv[(size_t)(b * 3 + 2) * 3072 + col];
#pragma unroll
    for (int t = 0; t < 8; ++t) {
      const float cur = bf2f(p.XBC[(row0 + t) * 3072 + col]);
      const float v = bias + w0 * x0 + w1 * x1 + w2 * x2 + w3 * cur;
      dst[t * dstride] = silu_f(v);
      x0 = x1; x1 = x2; x2 = cur;
    }
  }
  if (tid < 8) {
    const float dt = p.DT[(row0 + tid) * 32 + head];
    sdt[tid] = dt;
    sdA[tid] = __expf(dt * Aneg);
  }
  __syncthreads();
  const int pp = tid >> 2, nq = tid & 3;
  const size_t sbase = ((size_t)(b * 32 + head) * 64 + pp) * 128 + nq * 4;
  float4 h[8];
#pragma unroll
  for (int i = 0; i < 8; ++i) h[i] = *(const float4*)(p.state_ssm + sbase + i * 16);
  const float Dh = p.ssm_D[head];
#pragma unroll 1
  for (int t = 0; t < 8; ++t) {
    const float dA = sdA[t];
    const float xv = sx[t * 64 + pp];
    const float dtx = sdt[t] * xv;
    float y = 0.f;
#pragma unroll
    for (int i = 0; i < 8; ++i) {
      const float4 Bv = *(const float4*)(sB + t * 128 + i * 16 + nq * 4);
      const float4 Cv = *(const float4*)(sC + t * 128 + i * 16 + nq * 4);
      h[i].x = h[i].x * dA + dtx * Bv.x; h[i].y = h[i].y * dA + dtx * Bv.y;
      h[i].z = h[i].z * dA + dtx * Bv.z; h[i].w = h[i].w * dA + dtx * Bv.w;
      y += h[i].x * Cv.x + h[i].y * Cv.y + h[i].z * Cv.z + h[i].w * Cv.w;
    }
    y += __shfl_xor(y, 1);
    y += __shfl_xor(y, 2);
    if (nq == 0) {
      const float z = bf2f(p.Z[(row0 + t) * 2048 + head * 64 + pp]);
      const float yg = (y + Dh * xv) * silu_f(z);
      p.YG[(row0 + t) * 2048 + head * 64 + pp] = f2bf(yg);
      sy2[t * 64 + pp] = yg * yg;
    }
  }
  float* od = p.out + O_SSMS + sbase;
#pragma unroll
  for (int i = 0; i < 8; ++i) *(float4*)(od + i * 16) = h[i];
  __syncthreads();
  if (tid < 8) {
    float s = 0.f;
    for (int i = 0; i < 64; ++i) s += sy2[tid * 64 + i];
    p.SSQ[(row0 + tid) * 32 + head] = s;
  }
  __syncthreads();
}

DI void phase_states(const Params& p, char* smem_raw) {
  constexpr int NP = 4096, NS = 1024;
  for (int it = blockIdx.x; it < NP + NS; it += gridDim.x) {
    const int q = it / 5, rem = it - q * 5;
    if (rem == 4) ssm_sample_item(p, q, smem_raw);
    else ssd_states_item(p, q * 4 + rem, smem_raw);
  }
}

DI void phase_scan(const Params& p) {
  for (int task = blockIdx.x * 256 + threadIdx.x; task < 262144; task += gridDim.x * 256) {
    const int n4 = task & 31, pp = (task >> 5) & 63, head = (task >> 11) & 31, b = task >> 16;
    float4 h = {0.f, 0.f, 0.f, 0.f};
#pragma unroll 8
    for (int c = 0; c < 32; ++c) {
      const int item = (b * 32 + c) * 32 + head;
      float4* sp = (float4*)(p.STATES + ((size_t)item * 64 + pp) * 128 + n4 * 4);
      const float4 s = *sp;
      const float d = p.CD[item];
      *sp = h;
      h.x = h.x * d + s.x; h.y = h.y * d + s.y; h.z = h.z * d + s.z; h.w = h.w * d + s.w;
    }
    *(float4*)(p.out + O_SSMP + ((size_t)(b * 32 + head) * 64 + pp) * 128 + n4 * 4) = h;
  }
}

DI void ssd_out_item(const Params& p, int item, char* smem_raw) {
  const int tid = threadIdx.x, lane = tid & 63, w = tid >> 6, l15 = lane & 15, G = lane >> 4;
  const int head = item & 31, c = (item >> 5) & 31, b = item >> 10, g = head >> 3;
  u16* Bs = (u16*)(smem_raw + SS_B);
  u16* Xs = (u16*)(smem_raw + SS_R2);
  u16* Ct = (u16*)(smem_raw + SS_R2);
  u16* Hs = (u16*)(smem_raw + SS_H);
  float* s_acs = (float*)(smem_raw + SS_F);
  float* s_dt = s_acs + 128;
  float* s_ws = s_dt + 256;
  chunk_scan(p, b, c, head, s_acs, s_dt, s_ws);
  build_conv_tile(p, Ct, LDW, 16, 2560 + g * 128, b, c, nullptr);
  build_conv_tile(p, Bs, LDW, 16, 2048 + g * 128, b, c, nullptr);
  __syncthreads();
  bf16x8 cf[2][4];
#pragma unroll
  for (int sub = 0; sub < 2; ++sub)
#pragma unroll
    for (int ks = 0; ks < 4; ++ks) cf[sub][ks] = *(const bf16x8*)(Ct + (w * 32 + sub * 16 + l15) * LDW + ks * 32 + G * 8);
  __syncthreads();
  build_conv_tile(p, Xs, LDT, 8, head * 64, b, c, nullptr);
  {
    const float* hp = p.STATES + (size_t)item * 64 * 128;
#pragma unroll
    for (int i = 0; i < 8; ++i) {
      const int idx = tid + 256 * i;
      const int pp = idx >> 5, n4 = idx & 31;
      const float4 hv = *(const float4*)(hp + pp * 128 + n4 * 4);
      uint2 o; o.x = pack2(hv.x, hv.y); o.y = pack2(hv.z, hv.w);
      *(uint2*)(Hs + pp * LDW + n4 * 4) = o;
    }
  }
  __syncthreads();
  const float Dh = p.ssm_D[head];
#pragma unroll
  for (int sub = 0; sub < 2; ++sub) {
    const int l0 = w * 32 + sub * 16, lq = l0 + l15;
    const float acs_q = s_acs[lq];
    f32x4 yo[4];
#pragma unroll
    for (int m = 0; m < 4; ++m) {
      f32x4 z = {0.f, 0.f, 0.f, 0.f};
#pragma unroll
      for (int ks = 0; ks < 4; ++ks) z = MFMA16(*(const bf16x8*)(Hs + (16 * m + l15) * LDW + ks * 32 + G * 8), cf[sub][ks], z);
      yo[m] = z;
    }
    {
      const float ea = __expf(acs_q);
#pragma unroll
      for (int m = 0; m < 4; ++m) { yo[m][0] *= ea; yo[m][1] *= ea; yo[m][2] *= ea; yo[m][3] *= ea; }
    }
    const int ns = (l0 >> 4) + 1, nsteps = (ns + 1) >> 1;
#pragma unroll 1
    for (int step = 0; step < nsteps; ++step) {
      unsigned pw[4];
#pragma unroll
      for (int h2 = 0; h2 < 2; ++h2) {
        const int ss = 2 * step + h2;
        f32x4 st = {0.f, 0.f, 0.f, 0.f};
#pragma unroll
        for (int ks = 0; ks < 4; ++ks) st = MFMA16(*(const bf16x8*)(Bs + (16 * ss + l15) * LDW + ks * 32 + G * 8), cf[sub][ks], st);
        float mv[4];
#pragma unroll
        for (int j = 0; j < 4; ++j) {
          const int s = 16 * ss + 4 * G + j;
          const float dec = __expf(fminf(acs_q - s_acs[s], 0.f)) * s_dt[s];
          mv[j] = (s <= lq) ? st[j] * dec : 0.f;
        }
        pw[2 * h2] = pack2(mv[0], mv[1]);
        pw[2 * h2 + 1] = pack2(mv[2], mv[3]);
      }
      const bf16x8 pb = words_to_frag(pw[0], pw[1], pw[2], pw[3]);
      const u16* xa = Xs + (32 * step + 4 * G + (l15 >> 2)) * LDT + (l15 & 3) * 4;
#pragma unroll
      for (int m = 0; m < 4; ++m) yo[m] = MFMA16(cat4(tr_read(xa + 16 * m), tr_read(xa + 16 * LDT + 16 * m)), pb, yo[m]);
    }
    const size_t rowg = (size_t)b * 4096 + c * 128 + lq;
    float ssq = 0.f;
#pragma unroll
    for (int m = 0; m < 4; ++m) {
      const uint2 xv = *(const uint2*)(Xs + lq * LDT + 16 * m + 4 * G);
      const uint2 zv = *(const uint2*)(p.Z + rowg * 2048 + head * 64 + 16 * m + 4 * G);
      const float xf[4] = {lo_f(xv.x), hi_f(xv.x), lo_f(xv.y), hi_f(xv.y)};
      const float zf[4] = {lo_f(zv.x), hi_f(zv.x), lo_f(zv.y), hi_f(zv.y)};
      float y[4];
#pragma unroll
      for (int j = 0; j < 4; ++j) {
        y[j] = (yo[m][j] + Dh * xf[j]) * silu_f(zf[j]);
        ssq += y[j] * y[j];
      }
      uint2 ov; ov.x = pack2(y[0], y[1]); ov.y = pack2(y[2], y[3]);
      *(uint2*)(p.YG + rowg * 2048 + head * 64 + 16 * m + 4 * G) = ov;
    }
    ssq += __shfl_xor(ssq, 16);
    ssq += __shfl_xor(ssq, 32);
    if (G == 0) p.SSQ[rowg * 32 + head] = ssq;
  }
  __syncthreads();
}

constexpr int NPHASE = 10;
#ifndef PH_MASK
#define PH_MASK 0x3ff
#endif
#define PH_ON(k) (((PH_MASK) >> (k)) & 1)

template <bool COOP>
__global__ void __launch_bounds__(256, 2) mega(Params p, int ph0, int ph1) {
  extern __shared__ __attribute__((aligned(16))) char smem_raw[];
  u16* smem = (u16*)smem_raw;
#define PHASE_BODY(k)                                                                                                   \
  do {                                                                                                                  \
    if (k == 0) { if (PH_ON(0)) phase_prep(p, smem); }                                                                  \
    else if (k == 1) { if (PH_ON(1)) gemm_phase(ALPlain{p.H, 1024}, p.Wt1, 1024, MROWS / 128, ATT_IN / 128, Ep1{p}, smem); } \
    else if (k == 2) { if (PH_ON(2)) phase_attn(p, smem); }                                                             \
    else if (k == 3) { if (PH_ON(3)) gemm_phase(ALMerge{p.OG, p.QKVG, p.LSE}, p.Wt2, 1024, MROWS / 128, 8, Ep2{p}, smem); } \
    else if (k == 4) { if (PH_ON(4)) phase_norm2(p); }                                                                  \
    else if (k == 5) { if (PH_ON(5)) gemm_phase(ALPlain{p.H, 1024}, p.Wt3, 1024, MROWS / 128, SSM_IN_PAD / 128, Ep3{p}, smem); } \
    else if (k == 6) { if (PH_ON(6)) phase_states(p, smem_raw); }                                                       \
    else if (k == 7) { if (PH_ON(7)) phase_scan(p); }                                                                   \
    else if (k == 8) { if (PH_ON(8)) for (int it = blockIdx.x; it < 4096; it += gridDim.x) ssd_out_item(p, it, smem_raw); } \
    else if (k == 9) { if (PH_ON(9)) gemm_phase(ALGateNorm{p.YG, p.SSQ, p.ssm_gate_norm}, p.Wt4, 2048, MROWS / 128, 8, Ep4{p}, smem); } \
  } while (0)
  if constexpr (COOP) {
    cg::grid_group grid = cg::this_grid();
    PHASE_BODY(0); grid.sync();
    PHASE_BODY(1); grid.sync();
    PHASE_BODY(2); grid.sync();
    PHASE_BODY(3); grid.sync();
    PHASE_BODY(4); grid.sync();
    PHASE_BODY(5); grid.sync();
    PHASE_BODY(6); grid.sync();
    PHASE_BODY(7); grid.sync();
    PHASE_BODY(8); grid.sync();
    PHASE_BODY(9);
  } else {
    switch (ph0) {
      case 0: PHASE_BODY(0); break;
      case 1: PHASE_BODY(1); break;
      case 2: PHASE_BODY(2); break;
      case 3: PHASE_BODY(3); break;
      case 4: PHASE_BODY(4); break;
      case 5: PHASE_BODY(5); break;
      case 6: PHASE_BODY(6); break;
      case 7: PHASE_BODY(7); break;
      case 8: PHASE_BODY(8); break;
      case 9: PHASE_BODY(9); break;
    }
  }
}

#ifndef MULTI_LAUNCH
#define MULTI_LAUNCH 0
#endif

extern "C" void kernel_launch(void* const* d_in, const int* in_sizes, int n_in, void* d_out, int out_size, void* d_ws, size_t ws_size,
                              hipStream_t stream) {
  static int grid = 0;
  size_t off = 0;
  auto carve = [&](size_t bytes) { size_t o = off; off += (bytes + 255) & ~(size_t)255; return (char*)d_ws + o; };
  Params p{};
  p.x_prompt = (const float*)d_in[0]; p.x_sample = (const float*)d_in[1];
  p.cache0 = (const float*)d_in[2]; p.cache1 = (const float*)d_in[3]; p.cache2 = (const float*)d_in[4];
  p.state_conv = (const float*)d_in[5]; p.state_ssm = (const float*)d_in[6];
  p.attn_norm = (const float*)d_in[7]; p.attn_w_in = (const float*)d_in[8]; p.attn_q_gain = (const float*)d_in[9];
  p.attn_k_gain = (const float*)d_in[10]; p.attn_w_out = (const float*)d_in[11];
  p.ssm_norm = (const float*)d_in[12]; p.ssm_w_in = (const float*)d_in[13]; p.ssm_conv_w = (const float*)d_in[14];
  p.ssm_conv_b = (const float*)d_in[15]; p.ssm_dt_bias = (const float*)d_in[16]; p.ssm_A_log = (const float*)d_in[17];
  p.ssm_D = (const float*)d_in[18]; p.ssm_gate_norm = (const float*)d_in[19]; p.ssm_w_out = (const float*)d_in[20];
  p.out = (float*)d_out;
  p.Wt1 = (u16*)carve((size_t)ATT_IN * 1024 * 2);
  p.Wt2 = (u16*)carve((size_t)1024 * 1024 * 2);
  p.Wt3 = (u16*)carve((size_t)SSM_IN_PAD * 1024 * 2);
  p.Wt4 = (u16*)carve((size_t)1024 * 2048 * 2);
  p.H = (u16*)carve((size_t)MROWS * 1024 * 2);
  p.QKVG = (u16*)carve((size_t)MROWS * ATT_IN * 2);
  p.OG = (u16*)carve((size_t)MROWS * 3072 * 2);
  p.Z = (u16*)carve((size_t)MROWS * 2048 * 2);
  p.XBC = (u16*)carve((size_t)MROWS * 3072 * 2);
  p.YG = (u16*)carve((size_t)MROWS * 2048 * 2);
  p.LSE = (float*)carve((size_t)MROWS * 48 * 4);
  p.X1 = (float*)carve((size_t)MROWS * 1024 * 4);
  p.DT = (float*)carve((size_t)MROWS * 32 * 4);
  p.STATES = (float*)carve((size_t)4 * 32 * 32 * 64 * 128 * 4);
  p.SSQ = (float*)carve((size_t)MROWS * 32 * 4);
  p.CD = (float*)carve((size_t)4 * 32 * 32 * 4);
  if (grid == 0) {
    if (n_in != 21 || (size_t)out_size != O_END || ws_size < off) {
      fprintf(stderr, "kernel_launch: unexpected shapes: n_in %d out %d (want %zu) ws %zu (need %zu)\n", n_in, out_size, (size_t)O_END, ws_size, off);
      grid = -1; return;
    }
    int dev = 0, cus = 0, per_cu = 0;
    hipGetDevice(&dev);
    hipDeviceGetAttribute(&cus, hipDeviceAttributeMultiprocessorCount, dev);
    hipFuncSetAttribute((const void*)mega<true>, hipFuncAttributeMaxDynamicSharedMemorySize, LDS_BYTES);
    hipFuncSetAttribute((const void*)mega<false>, hipFuncAttributeMaxDynamicSharedMemorySize, LDS_BYTES);
    hipOccupancyMaxActiveBlocksPerMultiprocessor(&per_cu, (const void*)mega<true>, 256, LDS_BYTES);
    if (per_cu < 1) { fprintf(stderr, "kernel_launch: occupancy query returned %d\n", per_cu); grid = -1; return; }
    if (per_cu > 2) per_cu = 2;
    grid = cus * per_cu;
    grid &= ~7;
  }
  if (grid < 0) return;
#if MULTI_LAUNCH
  for (int ph = 0; ph < NPHASE; ++ph) hipLaunchKernelGGL(mega<false>, dim3(grid), dim3(256), LDS_BYTES, stream, p, ph, ph + 1);
#else
  int ph0 = 0, ph1 = NPHASE;
  void* args[] = {&p, &ph0, &ph1};
  hipError_t e = hipLaunchCooperativeKernel((const void*)mega<true>, dim3(grid), dim3(256), args, LDS_BYTES, stream);
  if (e != hipSuccess) fprintf(stderr, "cooperative launch failed: %s (grid %d)\n", hipGetErrorString(e), grid);
#endif
}
```

```cpp
#include <hip/hip_runtime.h>
#include <hip/hip_cooperative_groups.h>
#include <cstdio>
#include <cstdint>
namespace cg = cooperative_groups;

typedef unsigned short u16;
typedef short bf16x8 __attribute__((ext_vector_type(8)));
typedef short s16x4 __attribute__((ext_vector_type(4)));
typedef float f32x4 __attribute__((ext_vector_type(4)));

#define DI __device__ __forceinline__
#define MFMA16(a, b, c) __builtin_amdgcn_mfma_f32_16x16x32_bf16((a), (b), (c), 0, 0, 0)

constexpr int MROWS = 16384 + 256;
constexpr int PROWS = 16384;
constexpr int ATT_IN = 10240;
constexpr int SSM_IN = 5152;
constexpr int SSM_IN_PAD = 5248;
constexpr int LDS_MAIN = 73728;
constexpr int LDS_BYTES = LDS_MAIN + 16;
constexpr int LDT = 72;
constexpr int LDW = 136;
constexpr int TILE_ELEMS = 128 * LDT;

constexpr size_t O_Y = 0;
constexpr size_t O_KVP0 = (size_t)MROWS * 1024;
constexpr size_t O_KVP1 = O_KVP0 + (size_t)4 * 128 * 2048;
constexpr size_t O_KVP2 = O_KVP1 + (size_t)4 * 512 * 2048;
constexpr size_t O_KVS0 = O_KVP2 + (size_t)4 * 2048 * 2048;
constexpr size_t O_KVS1 = O_KVS0 + (size_t)256 * 2048;
constexpr size_t O_KVS2 = O_KVS1 + (size_t)256 * 2048;
constexpr size_t O_CONVP = O_KVS2 + (size_t)256 * 2048;
constexpr size_t O_CONVS = O_CONVP + (size_t)4 * 3 * 3072;
constexpr size_t O_SSMP = O_CONVS + (size_t)32 * 3 * 3072;
constexpr size_t O_SSMS = O_SSMP + (size_t)4 * 32 * 64 * 128;
constexpr size_t O_END = O_SSMS + (size_t)32 * 32 * 64 * 128;

struct Params {
  const float *x_prompt, *x_sample, *cache0, *cache1, *cache2, *state_conv, *state_ssm;
  const float *attn_norm, *attn_w_in, *attn_q_gain, *attn_k_gain, *attn_w_out;
  const float *ssm_norm, *ssm_w_in, *ssm_conv_w, *ssm_conv_b, *ssm_dt_bias, *ssm_A_log, *ssm_D, *ssm_gate_norm, *ssm_w_out;
  float* out;
  u16 *Wt1, *Wt2, *Wt3, *Wt4, *H, *QKVG, *OG, *Z, *XBC, *YG, *XBCC, *STATES;
  float *LSE, *X1, *DT, *SSQ, *CD, *ACS;
  unsigned* bar;
};

DI u16 f2bf(float x) { unsigned u = __float_as_uint(x); u += 0x7fffu + ((u >> 16) & 1u); return (u16)(u >> 16); }
DI float bf2f(u16 h) { return __uint_as_float(((unsigned)h) << 16); }
DI unsigned pack2(float a, float b) { return (unsigned)f2bf(a) | ((unsigned)f2bf(b) << 16); }
DI float lo_f(unsigned w) { return __uint_as_float(w << 16); }
DI float hi_f(unsigned w) { return __uint_as_float(w & 0xffff0000u); }
DI void unpack8(const uint4& v, float* f) {
  f[0] = lo_f(v.x); f[1] = hi_f(v.x); f[2] = lo_f(v.y); f[3] = hi_f(v.y);
  f[4] = lo_f(v.z); f[5] = hi_f(v.z); f[6] = lo_f(v.w); f[7] = hi_f(v.w);
}
DI uint4 pack8(const float* f) {
  uint4 v; v.x = pack2(f[0], f[1]); v.y = pack2(f[2], f[3]); v.z = pack2(f[4], f[5]); v.w = pack2(f[6], f[7]); return v;
}
DI float silu_f(float x) { return x / (1.f + __expf(-x)); }
DI s16x4 tr_read(const u16* ptr) {
  return __builtin_amdgcn_ds_read_tr16_b64_v4i16((s16x4 __attribute__((address_space(3)))*)(ptr));
}
DI bf16x8 cat4(s16x4 lo, s16x4 hi) { return __builtin_shufflevector(lo, hi, 0, 1, 2, 3, 4, 5, 6, 7); }
DI bf16x8 words_to_frag(unsigned a, unsigned b, unsigned c, unsigned d) {
  uint4 v; v.x = a; v.y = b; v.z = c; v.w = d; return __builtin_bit_cast(bf16x8, v);
}

constexpr int GT_BYTES = 16384;
template <class AL, class EP>
DI void gemm_tile(const AL& al, const u16* __restrict__ Bt, int K, int m0, int n0, const EP& ep, char* smem) {
  const int tid = threadIdx.x, lane = tid & 63, w = tid >> 6, wr = w >> 1, wc = w & 1;
  const int l15 = lane & 15, G = lane >> 4;
  char* As = smem;
  char* Bs = smem + 2 * GT_BYTES;
  f32x4 acc[4][4];
#pragma unroll
  for (int m = 0; m < 4; ++m)
#pragma unroll
    for (int n = 0; n < 4; ++n) acc[m][n] = (f32x4){0.f, 0.f, 0.f, 0.f};
  typename AL::Raw ra[4];
  uint4 rb[4];
  const int lj = tid & 3, lhalf = (tid >> 3) & 1, lrow = (tid >> 4) * 2 + ((tid >> 2) & 1);
  const int lk = (lhalf * 4 + lj) * 8;
  const int rr = lrow & 15;
  const int wofs = ((lrow >> 4) * 2 + lhalf) * 1024 + rr * 64 + ((lj ^ ((rr >> 3) << 1)) << 4);
  const int rofs = l15 * 64 + ((G ^ ((l15 >> 3) << 1)) << 4);
  const u16* bsrc = Bt + (size_t)(n0 + lrow) * K + lk;
  const int nk = K >> 6;
#pragma unroll
  for (int i = 0; i < 4; ++i) {
    ra[i] = al.load(m0 + lrow + 32 * i, lk);
    rb[i] = *(const uint4*)(bsrc + (size_t)(32 * i) * K);
  }
#pragma unroll
  for (int i = 0; i < 4; ++i) {
    *(uint4*)(As + wofs + i * 4096) = al.finish(ra[i]);
    *(uint4*)(Bs + wofs + i * 4096) = rb[i];
  }
  __syncthreads();
  for (int kt = 0; kt < nk; ++kt) {
    const int buf = kt & 1;
    {
      const int k0 = ((kt + 1 < nk) ? (kt + 1) : kt) << 6;
#pragma unroll
      for (int i = 0; i < 4; ++i) {
        ra[i] = al.load(m0 + lrow + 32 * i, k0 + lk);
        rb[i] = *(const uint4*)(bsrc + (size_t)(32 * i) * K + k0);
      }
    }
    __builtin_amdgcn_sched_barrier(0);
    const char* Ab = As + buf * GT_BYTES + wr * 8192 + rofs;
    const char* Bb = Bs + buf * GT_BYTES + wc * 8192 + rofs;
#pragma unroll
    for (int ks = 0; ks < 2; ++ks) {
      bf16x8 a[4], b[4];
#pragma unroll
      for (int m = 0; m < 4; ++m) a[m] = *(const bf16x8*)(Ab + (m * 2 + ks) * 1024);
#pragma unroll
      for (int n = 0; n < 4; ++n) b[n] = *(const bf16x8*)(Bb + (n * 2 + ks) * 1024);
#pragma unroll
      for (int m = 0; m < 4; ++m)
#pragma unroll
        for (int n = 0; n < 4; ++n) acc[m][n] = MFMA16(a[m], b[n], acc[m][n]);
    }
    __builtin_amdgcn_sched_barrier(0);
    {
      char* Ad = As + (buf ^ 1) * GT_BYTES + wofs;
      char* Bd = Bs + (buf ^ 1) * GT_BYTES + wofs;
#pragma unroll
      for (int i = 0; i < 4; ++i) {
        *(uint4*)(Ad + i * 4096) = al.finish(ra[i]);
        *(uint4*)(Bd + i * 4096) = rb[i];
      }
    }
    __syncthreads();
  }
  ep(acc, m0 + wr * 64, n0 + wc * 64, lane);
}

template <class AL, class EP>
DI void gemm_phase(const AL& al, const u16* Bt, int K, int MT, int NT, const EP& ep, char* smem) {
  const int x = blockIdx.x & 7, j = blockIdx.x >> 3, per = gridDim.x >> 3;
  const int SBN = (NT + 7) >> 3, SBM = (MT + 7) >> 3, total = SBN * SBM;
  for (int it = 0;; ++it) {
    const int v = it * per + j;
    const int sb = x + 8 * (v >> 6);
    if (sb >= total) break;
    const int wi = v & 63;
    const int mt = (sb / SBN) * 8 + (wi >> 3), nt = (sb % SBN) * 8 + (wi & 7);
    if (mt < MT && nt < NT) gemm_tile(al, Bt, K, mt * 128, nt * 128, ep, smem);
  }
}

struct ALPlain {
  typedef uint4 Raw;
  const u16* A; int lda;
  DI Raw load(int row, int k) const { return *(const uint4*)(A + (size_t)row * lda + k); }
  DI uint4 finish(const Raw& r) const { return r; }
};
DI unsigned merge_word(unsigned a, unsigned b, unsigned c, unsigned g, float e0, float e1, float e2) {
  const float lo = (e0 * lo_f(a) + e1 * lo_f(b) + e2 * lo_f(c)) * silu_f(lo_f(g));
  const float hi = (e0 * hi_f(a) + e1 * hi_f(b) + e2 * hi_f(c)) * silu_f(hi_f(g));
  return pack2(lo, hi);
}
struct ALMerge {
  struct Raw { uint4 a, b, c, g; float l0, l1, l2; };
  const u16* OG; const u16* QKVG; const float* LSE;
  DI Raw load(int row, int k) const {
    Raw r;
    const float* lp = LSE + (size_t)row * 48 + (k >> 6);
    r.l0 = lp[0]; r.l1 = lp[16]; r.l2 = lp[32];
    const u16* op = OG + (size_t)row * 3072 + k;
    r.a = *(const uint4*)op; r.b = *(const uint4*)(op + 1024); r.c = *(const uint4*)(op + 2048);
    r.g = *(const uint4*)(QKVG + (size_t)row * ATT_IN + 9216 + k);
    return r;
  }
  DI uint4 finish(const Raw& r) const {
    const float mx = fmaxf(r.l0, fmaxf(r.l1, r.l2));
    float e0 = __expf(r.l0 - mx), e1 = __expf(r.l1 - mx), e2 = __expf(r.l2 - mx);
    const float inv = 1.f / (e0 + e1 + e2);
    e0 *= inv; e1 *= inv; e2 *= inv;
    uint4 o;
    o.x = merge_word(r.a.x, r.b.x, r.c.x, r.g.x, e0, e1, e2);
    o.y = merge_word(r.a.y, r.b.y, r.c.y, r.g.y, e0, e1, e2);
    o.z = merge_word(r.a.z, r.b.z, r.c.z, r.g.z, e0, e1, e2);
    o.w = merge_word(r.a.w, r.b.w, r.c.w, r.g.w, e0, e1, e2);
    return o;
  }
};
struct ALGateNorm {
  struct Raw { uint4 y; float4 s0, s1, g0, g1; };
  const u16* YG; const float* SSQ; const float* gnw;
  DI Raw load(int row, int k) const {
    Raw r;
    const float* sp = SSQ + (size_t)row * 32 + (k >> 9) * 8;
    r.s0 = *(const float4*)sp; r.s1 = *(const float4*)(sp + 4);
    r.y = *(const uint4*)(YG + (size_t)row * 2048 + k);
    r.g0 = *(const float4*)(gnw + k); r.g1 = *(const float4*)(gnw + k + 4);
    return r;
  }
  DI uint4 finish(const Raw& r) const {
    const float ss = (r.s0.x + r.s0.y) + (r.s0.z + r.s0.w) + (r.s1.x + r.s1.y) + (r.s1.z + r.s1.w);
    const float rstd = rsqrtf(ss * (1.f / 512.f) + 1e-5f);
    uint4 o;
    o.x = pack2(lo_f(r.y.x) * rstd * r.g0.x, hi_f(r.y.x) * rstd * r.g0.y);
    o.y = pack2(lo_f(r.y.y) * rstd * r.g0.z, hi_f(r.y.y) * rstd * r.g0.w);
    o.z = pack2(lo_f(r.y.z) * rstd * r.g1.x, hi_f(r.y.z) * rstd * r.g1.y);
    o.w = pack2(lo_f(r.y.w) * rstd * r.g1.z, hi_f(r.y.w) * rstd * r.g1.w);
    return o;
  }
};

struct Ep1 {
  const Params& p;
  DI void operator()(f32x4 (&acc)[4][4], int r0, int c0, int lane) const {
    const int l15 = lane & 15, G = lane >> 4;
    int kind, g = 0, head;
    if (c0 >= 9216) { kind = 3; head = (c0 - 9216) >> 6; }
    else { g = c0 / 3072; const int rem = c0 - g * 3072; kind = rem >> 10; head = (rem & 1023) >> 6; }
    if (kind < 2) {
      const float* gp = (kind == 0 ? p.attn_q_gain : p.attn_k_gain) + g * 64;
      float gain[4];
#pragma unroll
      for (int n = 0; n < 4; ++n) gain[n] = gp[n * 16 + l15];
      const float post = (kind == 0) ? 0.125f : 1.f;
#pragma unroll
      for (int m = 0; m < 4; ++m)
#pragma unroll
        for (int j = 0; j < 4; ++j) {
          float ss = 0.f;
#pragma unroll
          for (int n = 0; n < 4; ++n) ss += acc[m][n][j] * acc[m][n][j];
          ss += __shfl_xor(ss, 1); ss += __shfl_xor(ss, 2); ss += __shfl_xor(ss, 4); ss += __shfl_xor(ss, 8);
          const float sc = rsqrtf(ss * (1.f / 64.f) + 1e-6f) * post;
#pragma unroll
          for (int n = 0; n < 4; ++n) acc[m][n][j] *= sc * gain[n];
        }
    }
#pragma unroll
    for (int m = 0; m < 4; ++m)
#pragma unroll
      for (int j = 0; j < 4; ++j) {
        const int row = r0 + m * 16 + G * 4 + j;
        u16* dst = p.QKVG + (size_t)row * ATT_IN + c0 + l15;
#pragma unroll
        for (int n = 0; n < 4; ++n) dst[n * 16] = f2bf(acc[m][n][j]);
      }
    if (kind == 1 || kind == 2) {
      const int keep = 128 << (2 * g);
      const size_t okp = (g == 0) ? O_KVP0 : (g == 1) ? O_KVP1 : O_KVP2;
      const size_t oks = (g == 0) ? O_KVS0 : (g == 1) ? O_KVS1 : O_KVS2;
#pragma unroll
      for (int m = 0; m < 4; ++m)
#pragma unroll
        for (int j = 0; j < 4; ++j) {
          const int row = r0 + m * 16 + G * 4 + j;
          float* dst = nullptr;
          if (row < PROWS) {
            const int b = row >> 12, s = row & 4095;
            if (s >= 4096 - keep) dst = p.out + okp + ((size_t)(b * keep + s - (4096 - keep)) * 2 + (kind - 1)) * 1024 + head * 64 + l15;
          } else {
            dst = p.out + oks + ((size_t)(row - PROWS) * 2 + (kind - 1)) * 1024 + head * 64 + l15;
          }
          if (dst) {
#pragma unroll
            for (int n = 0; n < 4; ++n) dst[n * 16] = acc[m][n][j];
          }
        }
    }
  }
};
struct Ep2 {
  const Params& p;
  DI void operator()(f32x4 (&acc)[4][4], int r0, int c0, int lane) const {
    const int l15 = lane & 15, G = lane >> 4;
#pragma unroll
    for (int m = 0; m < 4; ++m)
#pragma unroll
      for (int j = 0; j < 4; ++j) {
        const int row = r0 + m * 16 + G * 4 + j;
        const float* xin = (row < PROWS) ? p.x_prompt + (size_t)row * 1024 : p.x_sample + (size_t)(row - PROWS) * 1024;
        float* dst = p.X1 + (size_t)row * 1024 + c0 + l15;
#pragma unroll
        for (int n = 0; n < 4; ++n) dst[n * 16] = xin[c0 + l15 + n * 16] + acc[m][n][j];
      }
  }
};
struct Ep3 {
  const Params& p;
  DI void operator()(f32x4 (&acc)[4][4], int r0, int c0, int lane) const {
    const int l15 = lane & 15, G = lane >> 4;
    if (c0 >= SSM_IN) return;
    if (c0 < 2048) {
#pragma unroll
      for (int m = 0; m < 4; ++m)
#pragma unroll
        for (int j = 0; j < 4; ++j) {
          const int row = r0 + m * 16 + G * 4 + j;
          u16* dst = p.Z + (size_t)row * 2048 + c0 + l15;
#pragma unroll
          for (int n = 0; n < 4; ++n) dst[n * 16] = f2bf(acc[m][n][j]);
        }
    } else if (c0 < 5120) {
      const int cc = c0 - 2048 + l15;
#pragma unroll
      for (int m = 0; m < 4; ++m)
#pragma unroll
        for (int j = 0; j < 4; ++j) {
          const int row = r0 + m * 16 + G * 4 + j;
          u16* dst = p.XBC + (size_t)row * 3072 + cc;
#pragma unroll
          for (int n = 0; n < 4; ++n) dst[n * 16] = f2bf(acc[m][n][j]);
          float* od = nullptr;
          if (row < PROWS) {
            const int b = row >> 12, s = row & 4095;
            if (s >= 4093) od = p.out + O_CONVP + (size_t)(b * 3 + s - 4093) * 3072 + cc;
          } else {
            const int rr = row - PROWS, b = rr >> 3, t = rr & 7;
            if (t >= 5) od = p.out + O_CONVS + (size_t)(b * 3 + t - 5) * 3072 + cc;
          }
          if (od) {
#pragma unroll
            for (int n = 0; n < 4; ++n) od[n * 16] = acc[m][n][j];
          }
        }
    } else {
#pragma unroll
      for (int m = 0; m < 4; ++m)
#pragma unroll
        for (int j = 0; j < 4; ++j) {
          const int row = r0 + m * 16 + G * 4 + j;
#pragma unroll
          for (int n = 0; n < 2; ++n) {
            const int h = n * 16 + l15;
            const float xv = acc[m][n][j] + p.ssm_dt_bias[h];
            p.DT[(size_t)row * 32 + h] = fmaxf(xv, 0.f) + log1pf(__expf(-fabsf(xv)));
          }
        }
    }
  }
};
struct Ep4 {
  const Params& p;
  DI void operator()(f32x4 (&acc)[4][4], int r0, int c0, int lane) const {
    const int l15 = lane & 15, G = lane >> 4;
#pragma unroll
    for (int m = 0; m < 4; ++m)
#pragma unroll
      for (int j = 0; j < 4; ++j) {
        const int row = r0 + m * 16 + G * 4 + j;
        const float* xin = p.X1 + (size_t)row * 1024 + c0 + l15;
        float* dst = p.out + O_Y + (size_t)row * 1024 + c0 + l15;
#pragma unroll
        for (int n = 0; n < 4; ++n) dst[n * 16] = xin[n * 16] + acc[m][n][j];
      }
  }
};

DI void transpose_task(const float* __restrict__ W, u16* __restrict__ Wt, int K, int N, int NTN, int tile, u16* smem) {
  const int tid = threadIdx.x;
  const int ktile = tile / NTN, ntile = tile % NTN;
  const int k0 = ktile * 64, n0 = ntile * 64;
#pragma unroll
  for (int i = 0; i < 4; ++i) {
    const int idx = tid + 256 * i;
    const int kk = idx >> 4, nq = idx & 15;
    const int n = n0 + nq * 4;
    float4 v = {0.f, 0.f, 0.f, 0.f};
    if (n < N) v = *(const float4*)(W + (size_t)(k0 + kk) * N + n);
    smem[(nq * 4 + 0) * LDT + kk] = f2bf(v.x);
    smem[(nq * 4 + 1) * LDT + kk] = f2bf(v.y);
    smem[(nq * 4 + 2) * LDT + kk] = f2bf(v.z);
    smem[(nq * 4 + 3) * LDT + kk] = f2bf(v.w);
  }
  __syncthreads();
#pragma unroll
  for (int i = 0; i < 2; ++i) {
    const int idx = tid + 256 * i;
    const int n = idx >> 3, kc = idx & 7;
    *(uint4*)(Wt + (size_t)(n0 + n) * K + k0 + kc * 8) = *(const uint4*)(smem + n * LDT + kc * 8);
  }
  __syncthreads();
}

DI void rmsnorm_row(const float* __restrict__ src, const float* __restrict__ wgt, u16* __restrict__ dst, int lane) {
  float4 v[4];
  float ss = 0.f;
#pragma unroll
  for (int i = 0; i < 4; ++i) {
    v[i] = *(const float4*)(src + lane * 4 + 256 * i);
    ss += v[i].x * v[i].x + v[i].y * v[i].y + v[i].z * v[i].z + v[i].w * v[i].w;
  }
#pragma unroll
  for (int d = 32; d >= 1; d >>= 1) ss += __shfl_xor(ss, d);
  const float rstd = rsqrtf(ss * (1.f / 1024.f) + 1e-6f);
#pragma unroll
  for (int i = 0; i < 4; ++i) {
    const float4 g = *(const float4*)(wgt + lane * 4 + 256 * i);
    uint2 o;
    o.x = pack2(v[i].x * rstd * g.x, v[i].y * rstd * g.y);
    o.y = pack2(v[i].z * rstd * g.z, v[i].w * rstd * g.w);
    *(uint2*)(dst + lane * 4 + 256 * i) = o;
  }
}

DI void phase_prep(const Params& p, u16* smem) {
  constexpr int T1 = 16 * 160, T2 = 16 * 16, T3 = 16 * 82, T4 = 32 * 16, TT = T1 + T2 + T3 + T4;
  constexpr int RT = MROWS / 4;
  for (int it = blockIdx.x; it < TT + RT; it += gridDim.x) {
    if (it < T1) transpose_task(p.attn_w_in, p.Wt1, 1024, ATT_IN, 160, it, smem);
    else if (it < T1 + T2) transpose_task(p.attn_w_out, p.Wt2, 1024, 1024, 16, it - T1, smem);
    else if (it < T1 + T2 + T3) transpose_task(p.ssm_w_in, p.Wt3, 1024, SSM_IN, 82, it - T1 - T2, smem);
    else if (it < TT) transpose_task(p.ssm_w_out, p.Wt4, 2048, 1024, 16, it - T1 - T2 - T3, smem);
    else {
      const int row = (it - TT) * 4 + (threadIdx.x >> 6);
      const float* src = (row < PROWS) ? p.x_prompt + (size_t)row * 1024 : p.x_sample + (size_t)(row - PROWS) * 1024;
      rmsnorm_row(src, p.attn_norm, p.H + (size_t)row * 1024, threadIdx.x & 63);
    }
  }
}

DI void phase_norm2(const Params& p) {
  for (int it = blockIdx.x; it < MROWS / 4; it += gridDim.x) {
    const int row = it * 4 + (threadIdx.x >> 6);
    rmsnorm_row(p.X1 + (size_t)row * 1024, p.ssm_norm, p.H + (size_t)row * 1024, threadIdx.x & 63);
  }
}

DI void attn_prompt_item(const Params& p, int item, u16* smem) {
  const int tid = threadIdx.x, lane = tid & 63, w = tid >> 6, l15 = lane & 15, G = lane >> 4;
  const int rn = item & 31, head = (item >> 5) & 15, b = (item >> 9) & 3, g = item >> 11;
  const int dsh = 2 * g, dil = 1 << dsh, nbg = 32 >> dsh;
  const int r = rn / nbg, n = rn % nbg;
  u16* Ks = smem;
  u16* Vs = smem + 256 * LDT;
  const size_t colQ = (size_t)g * 3072 + head * 64, colK = colQ + 1024, colV = colQ + 2048;
#pragma unroll
  for (int i = 0; i < 8; ++i) {
    const int c = tid + 256 * i;
    const int kj = c >> 3, ch = c & 7;
    const int u = (n - 1) * 128 + kj;
    uint4 kv = {0u, 0u, 0u, 0u}, vv = {0u, 0u, 0u, 0u};
    if (u >= 0) {
      const size_t row = (size_t)b * 4096 + (size_t)u * dil + r;
      kv = *(const uint4*)(p.QKVG + row * ATT_IN + colK + ch * 8);
      vv = *(const uint4*)(p.QKVG + row * ATT_IN + colV + ch * 8);
    }
    *(uint4*)(Ks + kj * LDT + ch * 8) = kv;
    *(uint4*)(Vs + kj * LDT + ch * 8) = vv;
  }
  __syncthreads();
#pragma unroll 1
  for (int sub = 0; sub < 2; ++sub) {
    const int q0 = w * 32 + sub * 16;
    const int qi = q0 + l15;
    const size_t rowq = (size_t)b * 4096 + (size_t)(n * 128 + qi) * dil + r;
    const u16* qp = p.QKVG + rowq * ATT_IN + colQ + G * 8;
    const bf16x8 qf0 = *(const bf16x8*)qp, qf1 = *(const bf16x8*)(qp + 32);
    f32x4 st[9];
#pragma unroll
    for (int s = 0; s < 9; ++s) {
      const u16* kp = Ks + (q0 + 16 * s + l15) * LDT + G * 8;
      const bf16x8 a0 = *(const bf16x8*)kp, a1 = *(const bf16x8*)(kp + 32);
      f32x4 z = {0.f, 0.f, 0.f, 0.f};
      z = MFMA16(a0, qf0, z);
      st[s] = MFMA16(a1, qf1, z);
    }
    float mx = -INFINITY;
#pragma unroll
    for (int s = 0; s < 9; ++s)
#pragma unroll
      for (int j = 0; j < 4; ++j) {
        const int kk = 16 * s + 4 * G + j;
        const bool valid = (kk >= l15) && (kk <= l15 + 128) && (n > 0 || q0 + kk >= 128);
        const float v = valid ? st[s][j] : -INFINITY;
        st[s][j] = v;
        mx = fmaxf(mx, v);
      }
    mx = fmaxf(mx, __shfl_xor(mx, 16));
    mx = fmaxf(mx, __shfl_xor(mx, 32));
    float sum = 0.f;
#pragma unroll
    for (int s = 0; s < 9; ++s)
#pragma unroll
      for (int j = 0; j < 4; ++j) {
        const float e = __expf(st[s][j] - mx);
        st[s][j] = e;
        sum += e;
      }
    sum += __shfl_xor(sum, 16);
    sum += __shfl_xor(sum, 32);
    const float inv = 1.f / sum;
    f32x4 o[4];
#pragma unroll
    for (int m = 0; m < 4; ++m) o[m] = (f32x4){0.f, 0.f, 0.f, 0.f};
#pragma unroll
    for (int t = 0; t < 5; ++t) {
      const int sA = 2 * t, sB = 2 * t + 1;
      bf16x8 pb;
      if (t < 4) pb = words_to_frag(pack2(st[sA][0], st[sA][1]), pack2(st[sA][2], st[sA][3]), pack2(st[sB < 9 ? sB : 8][0], st[sB < 9 ? sB : 8][1]), pack2(st[sB < 9 ? sB : 8][2], st[sB < 9 ? sB : 8][3]));
      else pb = words_to_frag(pack2(st[sA][0], st[sA][1]), pack2(st[sA][2], st[sA][3]), 0u, 0u);
      const u16* vA = Vs + (q0 + 16 * sA + 4 * G + (l15 >> 2)) * LDT + (l15 & 3) * 4;
      const u16* vB = Vs + (q0 + 16 * sB + 4 * G + (l15 >> 2)) * LDT + (l15 & 3) * 4;
#pragma unroll
      for (int m = 0; m < 4; ++m) {
        const s16x4 lo = tr_read(vA + 16 * m);
        s16x4 hi = {0, 0, 0, 0};
        if (t < 4) hi = tr_read(vB + 16 * m);
        o[m] = MFMA16(cat4(lo, hi), pb, o[m]);
      }
    }
    u16* op = p.OG + rowq * 3072 + g * 1024 + head * 64 + 4 * G;
#pragma unroll
    for (int m = 0; m < 4; ++m) {
      uint2 ov;
      ov.x = pack2(o[m][0] * inv, o[m][1] * inv);
      ov.y = pack2(o[m][2] * inv, o[m][3] * inv);
      *(uint2*)(op + 16 * m) = ov;
    }
    if (G == 0) p.LSE[rowq * 48 + g * 16 + head] = mx + __logf(sum);
  }
  __syncthreads();
}

DI void attn_sample_task(const Params& p, int id) {
  const int lane = threadIdx.x & 63, l15 = lane & 15, G = lane >> 4;
  const int t = id & 7, head = (id >> 3) & 15, b = (id >> 7) & 31, g = id >> 12;
  const int L = 128 << (2 * g), dil = 1 << (2 * g);
  const float* cache = (g == 0) ? p.cache0 : (g == 1) ? p.cache1 : p.cache2;
  const float* newkv = p.out + ((g == 0) ? O_KVS0 : (g == 1) ? O_KVS1 : O_KVS2);
  const size_t rowq = (size_t)PROWS + b * 8 + t;
  const uint2 qq = *(const uint2*)(p.QKVG + rowq * ATT_IN + g * 3072 + head * 64 + 4 * l15);
  const float q0 = lo_f(qq.x), q1 = hi_f(qq.x), q2 = lo_f(qq.y), q3 = hi_f(qq.y);
  const int coff = head * 64 + 4 * l15;
  float sc[33];
#pragma unroll
  for (int bt = 0; bt < 3; ++bt) {
    float4 kb[11];
#pragma unroll
    for (int u = 0; u < 11; ++u) {
      const int j = 4 * (bt * 11 + u) + G;
      const int jc = j < 128 ? j : 128;
      const int idx = L + t - dil * jc;
      const float* kp = (idx < L) ? cache + ((size_t)(b * L + idx) * 2) * 1024 : newkv + ((size_t)(b * 8 + idx - L) * 2) * 1024;
      kb[u] = *(const float4*)(kp + coff);
    }
    __builtin_amdgcn_sched_barrier(0);
#pragma unroll
    for (int u = 0; u < 11; ++u) {
      const int j = 4 * (bt * 11 + u) + G;
      float sv = q0 * kb[u].x + q1 * kb[u].y + q2 * kb[u].z + q3 * kb[u].w;
      sv += __shfl_xor(sv, 1); sv += __shfl_xor(sv, 2); sv += __shfl_xor(sv, 4); sv += __shfl_xor(sv, 8);
      sc[bt * 11 + u] = (j <= 128) ? sv : -INFINITY;
    }
    __builtin_amdgcn_sched_barrier(0);
  }
  float mx = -INFINITY;
#pragma unroll
  for (int i = 0; i < 33; ++i) mx = fmaxf(mx, sc[i]);
  mx = fmaxf(mx, __shfl_xor(mx, 16));
  mx = fmaxf(mx, __shfl_xor(mx, 32));
  float sum = 0.f, a0 = 0.f, a1 = 0.f, a2 = 0.f, a3 = 0.f;
#pragma unroll
  for (int i = 0; i < 33; ++i) { sc[i] = __expf(sc[i] - mx); sum += sc[i]; }
#pragma unroll
  for (int bt = 0; bt < 3; ++bt) {
    float4 vb[11];
#pragma unroll
    for (int u = 0; u < 11; ++u) {
      const int j = 4 * (bt * 11 + u) + G;
      const int jc = j < 128 ? j : 128;
      const int idx = L + t - dil * jc;
      const float* vp = (idx < L) ? cache + ((size_t)(b * L + idx) * 2 + 1) * 1024 : newkv + ((size_t)(b * 8 + idx - L) * 2 + 1) * 1024;
      vb[u] = *(const float4*)(vp + coff);
    }
    __builtin_amdgcn_sched_barrier(0);
#pragma unroll
    for (int u = 0; u < 11; ++u) {
      const float pe = sc[bt * 11 + u];
      a0 += pe * vb[u].x; a1 += pe * vb[u].y; a2 += pe * vb[u].z; a3 += pe * vb[u].w;
    }
    __builtin_amdgcn_sched_barrier(0);
  }
  sum += __shfl_xor(sum, 16); sum += __shfl_xor(sum, 32);
  a0 += __shfl_xor(a0, 16); a0 += __shfl_xor(a0, 32);
  a1 += __shfl_xor(a1, 16); a1 += __shfl_xor(a1, 32);
  a2 += __shfl_xor(a2, 16); a2 += __shfl_xor(a2, 32);
  a3 += __shfl_xor(a3, 16); a3 += __shfl_xor(a3, 32);
  const float inv = 1.f / sum;
  if (G == 0) {
    uint2 ov;
    ov.x = pack2(a0 * inv, a1 * inv);
    ov.y = pack2(a2 * inv, a3 * inv);
    *(uint2*)(p.OG + rowq * 3072 + g * 1024 + coff) = ov;
    if (l15 == 0) p.LSE[rowq * 48 + g * 16 + head] = mx + __logf(sum);
  }
}

DI void phase_attn(const Params& p, u16* smem) {
  constexpr int NP = 6144, NS = 3072;
  for (int it = blockIdx.x; it < NP + NS; it += gridDim.x) {
    const int tri = it / 3, rem = it - tri * 3;
    if (rem == 2) attn_sample_task(p, tri * 4 + (threadIdx.x >> 6));
    else attn_prompt_item(p, tri * 2 + rem, smem);
  }
}

DI void conv_pass_task(const Params& p, int bt) {
  const int id = bt * 256 + threadIdx.x;
  const int ch = id % 384, seg = id / 384;
  const int col = ch * 8, row0 = seg * 8, t0 = row0 & 4095;
  const u16* src = p.XBC + (size_t)row0 * 3072 + col;
  uint4 raw[11];
#pragma unroll
  for (int j = 0; j < 3; ++j) {
    raw[j] = (uint4){0u, 0u, 0u, 0u};
    if (t0 > 0) raw[j] = *(const uint4*)(src - (ptrdiff_t)(3 - j) * 3072);
  }
#pragma unroll
  for (int j = 0; j < 8; ++j) raw[3 + j] = *(const uint4*)(src + (size_t)j * 3072);
  float wgt[4][8], bias[8];
#pragma unroll
  for (int j = 0; j < 4; ++j) {
    const float4 w0 = *(const float4*)(p.ssm_conv_w + j * 3072 + col), w1 = *(const float4*)(p.ssm_conv_w + j * 3072 + col + 4);
    wgt[j][0] = w0.x; wgt[j][1] = w0.y; wgt[j][2] = w0.z; wgt[j][3] = w0.w;
    wgt[j][4] = w1.x; wgt[j][5] = w1.y; wgt[j][6] = w1.z; wgt[j][7] = w1.w;
  }
  {
    const float4 b0 = *(const float4*)(p.ssm_conv_b + col), b1 = *(const float4*)(p.ssm_conv_b + col + 4);
    bias[0] = b0.x; bias[1] = b0.y; bias[2] = b0.z; bias[3] = b0.w;
    bias[4] = b1.x; bias[5] = b1.y; bias[6] = b1.z; bias[7] = b1.w;
  }
  float win[3][8];
  unpack8(raw[0], win[0]); unpack8(raw[1], win[1]); unpack8(raw[2], win[2]);
  u16* dst = p.XBCC + (size_t)row0 * 3072 + col;
#pragma unroll
  for (int i = 0; i < 8; ++i) {
    float cur[8], r[8];
    unpack8(raw[3 + i], cur);
#pragma unroll
    for (int e = 0; e < 8; ++e) {
      const float v = bias[e] + wgt[0][e] * win[0][e] + wgt[1][e] * win[1][e] + wgt[2][e] * win[2][e] + wgt[3][e] * cur[e];
      r[e] = silu_f(v);
      win[0][e] = win[1][e]; win[1][e] = win[2][e]; win[2][e] = cur[e];
    }
    *(uint4*)(dst + (size_t)i * 3072) = pack8(r);
  }
}

DI void acs_task(const Params& p, int bc) {
  const int lane = threadIdx.x & 63, head = lane & 31, half = lane >> 5;
  const float Aneg = -__expf(p.ssm_A_log[head]);
  const size_t rb = (size_t)bc * 128 + half * 64;
  float run = 0.f;
#pragma unroll 8
  for (int i = 0; i < 64; ++i) run += p.DT[(rb + i) * 32 + head] * Aneg;
  const float tot0 = __shfl(run, head);
  run = half ? tot0 : 0.f;
#pragma unroll 8
  for (int i = 0; i < 64; ++i) {
    run += p.DT[(rb + i) * 32 + head] * Aneg;
    p.ACS[(rb + i) * 32 + head] = run;
  }
}

DI void phase_convpass(const Params& p) {
  constexpr int NC = PROWS / 8 * 384 / 256;
  for (int it = blockIdx.x; it < NC + 32; it += gridDim.x) {
    if (it < NC) conv_pass_task(p, it);
    else acs_task(p, (it - NC) * 4 + (threadIdx.x >> 6));
  }
}

constexpr int SS_B = 0;
constexpr int SS_R2 = 34816;
constexpr int SS_H = 34816 + 18432;
constexpr int SS_F = 70656;

DI void ssd_states_item(const Params& p, int item, char* smem_raw) {
  const int tid = threadIdx.x, lane = tid & 63, w = tid >> 6, l15 = lane & 15, G = lane >> 4;
  const int head = item & 31, c = (item >> 5) & 31, b = item >> 10, g = head >> 3;
  u16* Bs = (u16*)(smem_raw + SS_B);
  u16* Xs = (u16*)(smem_raw + SS_R2);
  const size_t row0 = (size_t)b * 4096 + c * 128;
  const float a_end = p.ACS[(row0 + 127) * 32 + head];
#pragma unroll
  for (int i = 0; i < 4; ++i) {
    const int row = (tid >> 3) + 32 * i, ch = tid & 7;
    const float wl = p.DT[(row0 + row) * 32 + head] * __expf(a_end - p.ACS[(row0 + row) * 32 + head]);
    const uint4 v = *(const uint4*)(p.XBCC + (row0 + row) * 3072 + head * 64 + ch * 8);
    uint4 o;
    o.x = pack2(lo_f(v.x) * wl, hi_f(v.x) * wl); o.y = pack2(lo_f(v.y) * wl, hi_f(v.y) * wl);
    o.z = pack2(lo_f(v.z) * wl, hi_f(v.z) * wl); o.w = pack2(lo_f(v.w) * wl, hi_f(v.w) * wl);
    *(uint4*)(Xs + row * LDT + ch * 8) = o;
  }
#pragma unroll
  for (int i = 0; i < 8; ++i) {
    const int idx = tid + 256 * i, row = idx >> 4, ch = idx & 15;
    *(uint4*)(Bs + row * LDW + ch * 8) = *(const uint4*)(p.XBCC + (row0 + row) * 3072 + 2048 + g * 128 + ch * 8);
  }
  __syncthreads();
  f32x4 acc[4][2];
#pragma unroll
  for (int m = 0; m < 4; ++m) { acc[m][0] = (f32x4){0.f, 0.f, 0.f, 0.f}; acc[m][1] = (f32x4){0.f, 0.f, 0.f, 0.f}; }
#pragma unroll
  for (int k = 0; k < 4; ++k) {
    const int rowA = 32 * k + 8 * G + (l15 >> 2);
    bf16x8 a[4], bb[2];
#pragma unroll
    for (int m = 0; m < 4; ++m) {
      const u16* ap = Xs + rowA * LDT + 16 * m + (l15 & 3) * 4;
      a[m] = cat4(tr_read(ap), tr_read(ap + 4 * LDT));
    }
#pragma unroll
    for (int nn = 0; nn < 2; ++nn) {
      const u16* bp = Bs + rowA * LDW + 32 * w + 16 * nn + (l15 & 3) * 4;
      bb[nn] = cat4(tr_read(bp), tr_read(bp + 4 * LDW));
    }
#pragma unroll
    for (int m = 0; m < 4; ++m)
#pragma unroll
      for (int nn = 0; nn < 2; ++nn) acc[m][nn] = MFMA16(a[m], bb[nn], acc[m][nn]);
  }
  u16* sp = p.STATES + (size_t)item * 64 * 128;
#pragma unroll
  for (int m = 0; m < 4; ++m)
#pragma unroll
    for (int nn = 0; nn < 2; ++nn)
#pragma unroll
      for (int j = 0; j < 4; ++j) sp[(16 * m + 4 * G + j) * 128 + 32 * w + 16 * nn + l15] = f2bf(acc[m][nn][j]);
  if (tid == 0) p.CD[item] = __expf(a_end);
  __syncthreads();
}

DI void ssm_sample_item(const Params& p, int item, char* smem_raw) {
  const int tid = threadIdx.x;
  const int head = item & 31, b = item >> 5, g = head >> 3;
  float* sx = (float*)smem_raw;
  float* sB = sx + 512;
  float* sC = sB + 1024;
  float* sdt = sC + 1024;
  float* sdA = sdt + 8;
  float* sy2 = sdA + 8;
  const size_t row0 = (size_t)PROWS + b * 8;
  const float Aneg = -__expf(p.ssm_A_log[head]);
  for (int task = tid; task < 320; task += 256) {
    int col; float* dst;
    if (task < 64) { col = head * 64 + task; dst = sx + task; }
    else if (task < 192) { col = 2048 + g * 128 + (task - 64); dst = sB + (task - 64); }
    else { col = 2560 + g * 128 + (task - 192); dst = sC + (task - 192); }
    const int dstride = (task < 64) ? 64 : 128;
    const float w0 = p.ssm_conv_w[col], w1 = p.ssm_conv_w[3072 + col], w2 = p.ssm_conv_w[2 * 3072 + col], w3 = p.ssm_conv_w[3 * 3072 + col];
    const float bias = p.ssm_conv_b[col];
    float x0 = p.state_conv[(size_t)(b * 3 + 0) * 3072 + col];
    float x1 = p.state_conv[(size_t)(b * 3 + 1) * 3072 + col];
    float x2 = p.state_conv[(size_t)(b * 3 + 2) * 3072 + col];
#pragma unroll
    for (int t = 0; t < 8; ++t) {
      const float cur = bf2f(p.XBC[(row0 + t) * 3072 + col]);
      const float v = bias + w0 * x0 + w1 * x1 + w2 * x2 + w3 * cur;
      dst[t * dstride] = silu_f(v);
      x0 = x1; x1 = x2; x2 = cur;
    }
  }
  if (tid < 8) {
    const float dt = p.DT[(row0 + tid) * 32 + head];
    sdt[tid] = dt;
    sdA[tid] = __expf(dt * Aneg);
  }
  __syncthreads();
  const int pp = tid >> 2, nq = tid & 3;
  const size_t sbase = ((size_t)(b * 32 + head) * 64 + pp) * 128 + nq * 4;
  float4 h[8];
#pragma unroll
  for (int i = 0; i < 8; ++i) h[i] = *(const float4*)(p.state_ssm + sbase + i * 16);
  const float Dh = p.ssm_D[head];
#pragma unroll 1
  for (int t = 0; t < 8; ++t) {
    const float dA = sdA[t];
    const float xv = sx[t * 64 + pp];
    const float dtx = sdt[t] * xv;
    float y = 0.f;
#pragma unroll
    for (int i = 0; i < 8; ++i) {
      const float4 Bv = *(const float4*)(sB + t * 128 + i * 16 + nq * 4);
      const float4 Cv = *(const float4*)(sC + t * 128 + i * 16 + nq * 4);
      h[i].x = h[i].x * dA + dtx * Bv.x; h[i].y = h[i].y * dA + dtx * Bv.y;
      h[i].z = h[i].z * dA + dtx * Bv.z; h[i].w = h[i].w * dA + dtx * Bv.w;
      y += h[i].x * Cv.x + h[i].y * Cv.y + h[i].z * Cv.z + h[i].w * Cv.w;
    }
    y += __shfl_xor(y, 1);
    y += __shfl_xor(y, 2);
    if (nq == 0) {
      const float z = bf2f(p.Z[(row0 + t) * 2048 + head * 64 + pp]);
      const float yg = (y + Dh * xv) * silu_f(z);
      p.YG[(row0 + t) * 2048 + head * 64 + pp] = f2bf(yg);
      sy2[t * 64 + pp] = yg * yg;
    }
  }
  float* od = p.out + O_SSMS + sbase;
#pragma unroll
  for (int i = 0; i < 8; ++i) *(float4*)(od + i * 16) = h[i];
  __syncthreads();
  if (tid < 8) {
    float s = 0.f;
    for (int i = 0; i < 64; ++i) s += sy2[tid * 64 + i];
    p.SSQ[(row0 + tid) * 32 + head] = s;
  }
  __syncthreads();
}

DI void phase_states(const Params& p, char* smem_raw) {
  constexpr int NP = 4096, NS = 1024;
  for (int it = blockIdx.x; it < NP + NS; it += gridDim.x) {
    const int q = it / 5, rem = it - q * 5;
    if (rem == 4) ssm_sample_item(p, q, smem_raw);
    else ssd_states_item(p, q * 4 + rem, smem_raw);
  }
}

DI void phase_scan(const Params& p) {
  for (int task = blockIdx.x * 256 + threadIdx.x; task < 131072; task += gridDim.x * 256) {
    const int n8 = task & 15, pp = (task >> 4) & 63, head = (task >> 10) & 31, b = task >> 15;
    float h[8];
#pragma unroll
    for (int e = 0; e < 8; ++e) h[e] = 0.f;
#pragma unroll 8
    for (int c = 0; c < 32; ++c) {
      const int item = (b * 32 + c) * 32 + head;
      uint4* sp = (uint4*)(p.STATES + ((size_t)item * 64 + pp) * 128 + n8 * 8);
      const uint4 sv = *sp;
      const float d = p.CD[item];
      *sp = pack8(h);
      float sf[8];
      unpack8(sv, sf);
#pragma unroll
      for (int e = 0; e < 8; ++e) h[e] = h[e] * d + sf[e];
    }
    float* od = p.out + O_SSMP + ((size_t)(b * 32 + head) * 64 + pp) * 128 + n8 * 8;
    *(float4*)od = (float4){h[0], h[1], h[2], h[3]};
    *(float4*)(od + 4) = (float4){h[4], h[5], h[6], h[7]};
  }
}

DI void ssd_out_item(const Params& p, int item, char* smem_raw) {
  const int tid = threadIdx.x, lane = tid & 63, w = tid >> 6, l15 = lane & 15, G = lane >> 4;
  const int head = item & 31, c = (item >> 5) & 31, b = item >> 10, g = head >> 3;
  u16* Bs = (u16*)(smem_raw + SS_B);
  u16* Xs = (u16*)(smem_raw + SS_R2);
  u16* Hs = (u16*)(smem_raw + SS_H);
  float* s_acs = (float*)(smem_raw + SS_F);
  float* s_dt = s_acs + 128;
  const size_t row0 = (size_t)b * 4096 + c * 128;
  if (tid < 128) {
    s_acs[tid] = p.ACS[(row0 + tid) * 32 + head];
    s_dt[tid] = p.DT[(row0 + tid) * 32 + head];
  }
#pragma unroll
  for (int i = 0; i < 8; ++i) {
    const int idx = tid + 256 * i, row = idx >> 4, ch = idx & 15;
    *(uint4*)(Bs + row * LDW + ch * 8) = *(const uint4*)(p.XBCC + (row0 + row) * 3072 + 2048 + g * 128 + ch * 8);
  }
#pragma unroll
  for (int i = 0; i < 4; ++i) {
    const int row = (tid >> 3) + 32 * i, ch = tid & 7;
    *(uint4*)(Xs + row * LDT + ch * 8) = *(const uint4*)(p.XBCC + (row0 + row) * 3072 + head * 64 + ch * 8);
  }
  {
    const u16* hp = p.STATES + (size_t)item * 64 * 128;
#pragma unroll
    for (int i = 0; i < 4; ++i) {
      const int idx = tid + 256 * i, pp = idx >> 4, ch = idx & 15;
      *(uint4*)(Hs + pp * LDW + ch * 8) = *(const uint4*)(hp + pp * 128 + ch * 8);
    }
  }
  bf16x8 cf[2][4];
#pragma unroll
  for (int sub = 0; sub < 2; ++sub)
#pragma unroll
    for (int ks = 0; ks < 4; ++ks)
      cf[sub][ks] = *(const bf16x8*)(p.XBCC + (row0 + w * 32 + sub * 16 + l15) * 3072 + 2560 + g * 128 + ks * 32 + G * 8);
  __syncthreads();
  const float Dh = p.ssm_D[head];
#pragma unroll
  for (int sub = 0; sub < 2; ++sub) {
    const int l0 = w * 32 + sub * 16, lq = l0 + l15;
    const float acs_q = s_acs[lq];
    f32x4 yo[4];
#pragma unroll
    for (int m = 0; m < 4; ++m) {
      f32x4 z = {0.f, 0.f, 0.f, 0.f};
#pragma unroll
      for (int ks = 0; ks < 4; ++ks) z = MFMA16(*(const bf16x8*)(Hs + (16 * m + l15) * LDW + ks * 32 + G * 8), cf[sub][ks], z);
      yo[m] = z;
    }
    {
      const float ea = __expf(acs_q);
#pragma unroll
      for (int m = 0; m < 4; ++m) { yo[m][0] *= ea; yo[m][1] *= ea; yo[m][2] *= ea; yo[m][3] *= ea; }
    }
    const int ns = (l0 >> 4) + 1, nsteps = (ns + 1) >> 1;
#pragma unroll 1
    for (int step = 0; step < nsteps; ++step) {
      unsigned pw[4];
#pragma unroll
      for (int h2 = 0; h2 < 2; ++h2) {
        const int ss = 2 * step + h2;
        f32x4 st = {0.f, 0.f, 0.f, 0.f};
#pragma unroll
        for (int ks = 0; ks < 4; ++ks) st = MFMA16(*(const bf16x8*)(Bs + (16 * ss + l15) * LDW + ks * 32 + G * 8), cf[sub][ks], st);
        float mv[4];
#pragma unroll
        for (int j = 0; j < 4; ++j) {
          const int s = 16 * ss + 4 * G + j;
          const float dec = __expf(fminf(acs_q - s_acs[s], 0.f)) * s_dt[s];
          mv[j] = (s <= lq) ? st[j] * dec : 0.f;
        }
        pw[2 * h2] = pack2(mv[0], mv[1]);
        pw[2 * h2 + 1] = pack2(mv[2], mv[3]);
      }
      const bf16x8 pb = words_to_frag(pw[0], pw[1], pw[2], pw[3]);
      const u16* xa = Xs + (32 * step + 4 * G + (l15 >> 2)) * LDT + (l15 & 3) * 4;
#pragma unroll
      for (int m = 0; m < 4; ++m) yo[m] = MFMA16(cat4(tr_read(xa + 16 * m), tr_read(xa + 16 * LDT + 16 * m)), pb, yo[m]);
    }
    const size_t rowg = (size_t)b * 4096 + c * 128 + lq;
    float ssq = 0.f;
#pragma unroll
    for (int m = 0; m < 4; ++m) {
      const uint2 xv = *(const uint2*)(Xs + lq * LDT + 16 * m + 4 * G);
      const uint2 zv = *(const uint2*)(p.Z + rowg * 2048 + head * 64 + 16 * m + 4 * G);
      const float xf[4] = {lo_f(xv.x), hi_f(xv.x), lo_f(xv.y), hi_f(xv.y)};
      const float zf[4] = {lo_f(zv.x), hi_f(zv.x), lo_f(zv.y), hi_f(zv.y)};
      float y[4];
#pragma unroll
      for (int j = 0; j < 4; ++j) {
        y[j] = (yo[m][j] + Dh * xf[j]) * silu_f(zf[j]);
        ssq += y[j] * y[j];
      }
      uint2 ov; ov.x = pack2(y[0], y[1]); ov.y = pack2(y[2], y[3]);
      *(uint2*)(p.YG + rowg * 2048 + head * 64 + 16 * m + 4 * G) = ov;
    }
    ssq += __shfl_xor(ssq, 16);
    ssq += __shfl_xor(ssq, 32);
    if (G == 0) p.SSQ[rowg * 32 + head] = ssq;
  }
  __syncthreads();
}

#define XB_TMO      128
#define XB_XCNT(j)  (256  + 64 * (j))
#define XB_XSUB(j)  (1280 + 64 * (j))
#define XB_XGEN(j)  (2304 + 64 * (j))
#define XB_TOP      3328
#define XB_TOPGEN   3392
#define XCD_BAR_WORDS 3456
#define XB_SPIN_CAP (1u << 20)
#define LAS __attribute__((address_space(3)))
DI unsigned xb_ld(unsigned* p) { return __hip_atomic_load(p, __ATOMIC_RELAXED, __HIP_MEMORY_SCOPE_AGENT); }
DI unsigned xb_add(unsigned* p, unsigned v) { return __hip_atomic_fetch_add(p, v, __ATOMIC_RELAXED, __HIP_MEMORY_SCOPE_AGENT); }
DI unsigned xb_xcc_id() { return (unsigned)__builtin_amdgcn_s_getreg((3 << 11) | 20) & 0xFu; }
#define XB_SPIN(cond, bar) do { unsigned _sp = 0; while (cond) { __builtin_amdgcn_s_sleep(1); \
    if ((++_sp & 255u) == 0u) { if (xb_ld(&(bar)[XB_TMO])) break; if (_sp > XB_SPIN_CAP) { atomicAdd(&(bar)[XB_TMO], 1u); break; } } } } while (0)
struct XcdBarrier { unsigned* bar; unsigned x; volatile LAS unsigned* st; };
DI XcdBarrier xcd_barrier_post(unsigned* bar, volatile LAS unsigned* st) {
  XcdBarrier b; b.bar = bar; b.x = xb_xcc_id(); b.st = st;
  if (threadIdx.x == 0) (void)xb_add(&bar[XB_XCNT(b.x)], 1u);
  return b;
}
DI void xcd_barrier_complete(unsigned* bar, unsigned x, unsigned& nloc, unsigned& nx) {
  const unsigned Gn = gridDim.x * gridDim.y * gridDim.z;
  unsigned sum, cnt, mine, sp = 0u;
  for (;;) {
    sum = 0u; cnt = 0u; mine = 0u;
#pragma unroll
    for (unsigned j = 0; j < 16; ++j) { const unsigned c = xb_ld(&bar[XB_XCNT(j)]); sum += c; cnt += (c > 0u) ? 1u : 0u; mine = (j == x) ? c : mine; }
    if (sum == Gn) break;
    __builtin_amdgcn_s_sleep(1);
    if ((++sp & 255u) == 0u) { if (xb_ld(&bar[XB_TMO])) break; if (sp > XB_SPIN_CAP) { atomicAdd(&bar[XB_TMO], 1u); break; } }
  }
  nloc = mine > 0u ? mine : 1u; nx = cnt > 0u ? cnt : 1u;
}
DI void xcd_barrier(const XcdBarrier& b) {
  asm volatile("s_waitcnt vmcnt(0)" ::: "memory");
  __syncthreads();
  if (threadIdx.x == 0) {
    unsigned* bar = b.bar;
    __builtin_amdgcn_s_waitcnt(0);
    unsigned nloc = b.st[0], nx = b.st[1];
    if (nloc == 0u) { xcd_barrier_complete(bar, b.x, nloc, nx); b.st[0] = nloc; b.st[1] = nx; }
    const unsigned old = xb_add(&bar[XB_XSUB(b.x)], 1u);
    const unsigned gen = old / nloc;
    if (old + 1u == (gen + 1u) * nloc) {
      __builtin_amdgcn_fence(__ATOMIC_RELEASE, "agent");
      asm volatile("s_waitcnt vmcnt(0)" ::: "memory");
      const unsigned og = xb_add(&bar[XB_TOP], 1u);
      const unsigned tg = og / nx;
      if (og + 1u == (tg + 1u) * nx) xb_add(&bar[XB_TOPGEN], 1u);
      else XB_SPIN(xb_ld(&bar[XB_TOPGEN]) == tg, bar);
      __builtin_amdgcn_fence(__ATOMIC_ACQUIRE, "agent");
      xb_add(&bar[XB_XGEN(b.x)], 1u);
      asm volatile("s_waitcnt vmcnt(0)" ::: "memory");
    } else {
      XB_SPIN(xb_ld(&bar[XB_XGEN(b.x)]) == gen, bar);
      __builtin_amdgcn_fence(__ATOMIC_ACQUIRE, "agent");
      asm volatile("s_waitcnt vmcnt(0)" ::: "memory");
    }
  }
  __syncthreads();
}

constexpr int NPHASE = 11;
#ifndef PH_MASK
#define PH_MASK 0x7ff
#endif
#define PH_ON(k) (((PH_MASK) >> (k)) & 1)
#ifndef PH_REPEAT
#define PH_REPEAT 0
#endif
#define PH_REP(k) (((PH_REPEAT) >> (k)) & 1)

template <bool COOP>
__global__ void __launch_bounds__(256, 2) mega(Params p, int ph0, int ph1) {
  extern __shared__ __attribute__((aligned(16))) char smem_raw[];
  u16* smem = (u16*)smem_raw;
#define PHASE_BODY(k)                                                                                                   \
  do {                                                                                                                  \
    if (k == 0) { if (PH_ON(0)) phase_prep(p, smem); }                                                                  \
    else if (k == 1) { if (PH_ON(1)) gemm_phase(ALPlain{p.H, 1024}, p.Wt1, 1024, MROWS / 128, ATT_IN / 128, Ep1{p}, smem_raw); } \
    else if (k == 2) { if (PH_ON(2)) phase_attn(p, smem); }                                                             \
    else if (k == 3) { if (PH_ON(3)) gemm_phase(ALMerge{p.OG, p.QKVG, p.LSE}, p.Wt2, 1024, MROWS / 128, 8, Ep2{p}, smem_raw); } \
    else if (k == 4) { if (PH_ON(4)) phase_norm2(p); }                                                                  \
    else if (k == 5) { if (PH_ON(5)) gemm_phase(ALPlain{p.H, 1024}, p.Wt3, 1024, MROWS / 128, SSM_IN_PAD / 128, Ep3{p}, smem_raw); } \
    else if (k == 6) { if (PH_ON(6)) phase_convpass(p); }                                                               \
    else if (k == 7) { if (PH_ON(7)) phase_states(p, smem_raw); }                                                       \
    else if (k == 8) { if (PH_ON(8)) phase_scan(p); }                                                                   \
    else if (k == 9) { if (PH_ON(9)) for (int it = blockIdx.x; it < 4096; it += gridDim.x) ssd_out_item(p, it, smem_raw); } \
    else if (k == 10) { if (PH_ON(10)) gemm_phase(ALGateNorm{p.YG, p.SSQ, p.ssm_gate_norm}, p.Wt4, 2048, MROWS / 128, 8, Ep4{p}, smem_raw); } \
  } while (0)
#define PHASE_STEP(k) PHASE_BODY(k); if (PH_REP(k)) { xcd_barrier(xb); PHASE_BODY(k); }
  if constexpr (COOP) {
    volatile LAS unsigned* xst = (volatile LAS unsigned*)(smem_raw + LDS_MAIN);
    if (threadIdx.x == 0) { xst[0] = 0u; xst[1] = 0u; }
    __syncthreads();
    const XcdBarrier xb = xcd_barrier_post(p.bar, xst);
    if (ph0 == 0x7fffffff) cg::this_grid().sync();
    PHASE_STEP(0) xcd_barrier(xb);
    PHASE_STEP(1) xcd_barrier(xb);
    PHASE_STEP(2) xcd_barrier(xb);
    PHASE_STEP(3) xcd_barrier(xb);
    PHASE_STEP(4) xcd_barrier(xb);
    PHASE_STEP(5) xcd_barrier(xb);
    PHASE_STEP(6) xcd_barrier(xb);
    PHASE_STEP(7) xcd_barrier(xb);
    PHASE_STEP(8) xcd_barrier(xb);
    PHASE_STEP(9) xcd_barrier(xb);
    PHASE_STEP(10)
  } else {
    switch (ph0) {
      case 0: PHASE_BODY(0); break;
      case 1: PHASE_BODY(1); break;
      case 2: PHASE_BODY(2); break;
      case 3: PHASE_BODY(3); break;
      case 4: PHASE_BODY(4); break;
      case 5: PHASE_BODY(5); break;
      case 6: PHASE_BODY(6); break;
      case 7: PHASE_BODY(7); break;
      case 8: PHASE_BODY(8); break;
      case 9: PHASE_BODY(9); break;
      case 10: PHASE_BODY(10); break;
    }
  }
}

#ifndef MULTI_LAUNCH
#define MULTI_LAUNCH 0
#endif

extern "C" void kernel_launch(void* const* d_in, const int* in_sizes, int n_in, void* d_out, int out_size, void* d_ws, size_t ws_size,
                              hipStream_t stream) {
  static int grid = 0;
  size_t off = 0;
  auto carve = [&](size_t bytes) { size_t o = off; off += (bytes + 255) & ~(size_t)255; return (char*)d_ws + o; };
  Params p{};
  p.x_prompt = (const float*)d_in[0]; p.x_sample = (const float*)d_in[1];
  p.cache0 = (const float*)d_in[2]; p.cache1 = (const float*)d_in[3]; p.cache2 = (const float*)d_in[4];
  p.state_conv = (const float*)d_in[5]; p.state_ssm = (const float*)d_in[6];
  p.attn_norm = (const float*)d_in[7]; p.attn_w_in = (const float*)d_in[8]; p.attn_q_gain = (const float*)d_in[9];
  p.attn_k_gain = (const float*)d_in[10]; p.attn_w_out = (const float*)d_in[11];
  p.ssm_norm = (const float*)d_in[12]; p.ssm_w_in = (const float*)d_in[13]; p.ssm_conv_w = (const float*)d_in[14];
  p.ssm_conv_b = (const float*)d_in[15]; p.ssm_dt_bias = (const float*)d_in[16]; p.ssm_A_log = (const float*)d_in[17];
  p.ssm_D = (const float*)d_in[18]; p.ssm_gate_norm = (const float*)d_in[19]; p.ssm_w_out = (const float*)d_in[20];
  p.out = (float*)d_out;
  p.Wt1 = (u16*)carve((size_t)ATT_IN * 1024 * 2);
  p.Wt2 = (u16*)carve((size_t)1024 * 1024 * 2);
  p.Wt3 = (u16*)carve((size_t)SSM_IN_PAD * 1024 * 2);
  p.Wt4 = (u16*)carve((size_t)1024 * 2048 * 2);
  p.H = (u16*)carve((size_t)MROWS * 1024 * 2);
  p.QKVG = (u16*)carve((size_t)MROWS * ATT_IN * 2);
  p.OG = (u16*)carve((size_t)MROWS * 3072 * 2);
  p.Z = (u16*)carve((size_t)MROWS * 2048 * 2);
  p.XBC = (u16*)carve((size_t)MROWS * 3072 * 2);
  p.YG = (u16*)carve((size_t)MROWS * 2048 * 2);
  p.LSE = (float*)carve((size_t)MROWS * 48 * 4);
  p.X1 = (float*)carve((size_t)MROWS * 1024 * 4);
  p.DT = (float*)carve((size_t)MROWS * 32 * 4);
  p.STATES = (u16*)carve((size_t)4 * 32 * 32 * 64 * 128 * 2);
  p.XBCC = (u16*)carve((size_t)PROWS * 3072 * 2);
  p.ACS = (float*)carve((size_t)PROWS * 32 * 4);
  p.bar = (unsigned*)carve((size_t)XCD_BAR_WORDS * 4);
  p.SSQ = (float*)carve((size_t)MROWS * 32 * 4);
  p.CD = (float*)carve((size_t)4 * 32 * 32 * 4);
  if (grid == 0) {
    if (n_in != 21 || (size_t)out_size != O_END || ws_size < off) {
      fprintf(stderr, "kernel_launch: unexpected shapes: n_in %d out %d (want %zu) ws %zu (need %zu)\n", n_in, out_size, (size_t)O_END, ws_size, off);
      grid = -1; return;
    }
    int dev = 0, cus = 0, per_cu = 0;
    hipGetDevice(&dev);
    hipDeviceGetAttribute(&cus, hipDeviceAttributeMultiprocessorCount, dev);
    hipFuncSetAttribute((const void*)mega<true>, hipFuncAttributeMaxDynamicSharedMemorySize, LDS_BYTES);
    hipFuncSetAttribute((const void*)mega<false>, hipFuncAttributeMaxDynamicSharedMemorySize, LDS_BYTES);
    hipOccupancyMaxActiveBlocksPerMultiprocessor(&per_cu, (const void*)mega<true>, 256, LDS_BYTES);
    if (per_cu < 1) { fprintf(stderr, "kernel_launch: occupancy query returned %d\n", per_cu); grid = -1; return; }
    if (per_cu > 2) per_cu = 2;
    grid = cus * per_cu;
    grid &= ~7;
  }
  if (grid < 0) return;
#if MULTI_LAUNCH
  for (int ph = 0; ph < NPHASE; ++ph) hipLaunchKernelGGL(mega<false>, dim3(grid), dim3(256), LDS_BYTES, stream, p, ph, ph + 1);
#else
  hipMemsetAsync(p.bar, 0, (size_t)XCD_BAR_WORDS * 4, stream);
  int ph0 = 0, ph1 = NPHASE;
  void* args[] = {&p, &ph0, &ph1};
  hipError_t e = hipLaunchCooperativeKernel((const void*)mega<true>, dim3(grid), dim3(256), args, LDS_BYTES, stream);
  if (e != hipSuccess) fprintf(stderr, "cooperative launch failed: %s (grid %d)\n", hipGetErrorString(e), grid);
#endif
}
```

```cpp
#include <hip/hip_runtime.h>
#include <hip/hip_cooperative_groups.h>
#include <cstdio>
#include <cstdint>
namespace cg = cooperative_groups;

typedef unsigned short u16;
typedef short bf16x8 __attribute__((ext_vector_type(8)));
typedef short s16x4 __attribute__((ext_vector_type(4)));
typedef float f32x4 __attribute__((ext_vector_type(4)));

#define DI __device__ __forceinline__
#define MFMA16(a, b, c) __builtin_amdgcn_mfma_f32_16x16x32_bf16((a), (b), (c), 0, 0, 0)

constexpr int MROWS = 16384 + 256;
constexpr int PROWS = 16384;
constexpr int ATT_IN = 10240;
constexpr int SSM_IN = 5152;
constexpr int SSM_IN_PAD = 5248;
constexpr int LDS_MAIN = 73728;
constexpr int LDS_BYTES = LDS_MAIN + 16;
constexpr int LDT = 72;
constexpr int LDW = 136;
constexpr int TILE_ELEMS = 128 * LDT;

constexpr size_t O_Y = 0;
constexpr size_t O_KVP0 = (size_t)MROWS * 1024;
constexpr size_t O_KVP1 = O_KVP0 + (size_t)4 * 128 * 2048;
constexpr size_t O_KVP2 = O_KVP1 + (size_t)4 * 512 * 2048;
constexpr size_t O_KVS0 = O_KVP2 + (size_t)4 * 2048 * 2048;
constexpr size_t O_KVS1 = O_KVS0 + (size_t)256 * 2048;
constexpr size_t O_KVS2 = O_KVS1 + (size_t)256 * 2048;
constexpr size_t O_CONVP = O_KVS2 + (size_t)256 * 2048;
constexpr size_t O_CONVS = O_CONVP + (size_t)4 * 3 * 3072;
constexpr size_t O_SSMP = O_CONVS + (size_t)32 * 3 * 3072;
constexpr size_t O_SSMS = O_SSMP + (size_t)4 * 32 * 64 * 128;
constexpr size_t O_END = O_SSMS + (size_t)32 * 32 * 64 * 128;

struct Params {
  const float *x_prompt, *x_sample, *cache0, *cache1, *cache2, *state_conv, *state_ssm;
  const float *attn_norm, *attn_w_in, *attn_q_gain, *attn_k_gain, *attn_w_out;
  const float *ssm_norm, *ssm_w_in, *ssm_conv_w, *ssm_conv_b, *ssm_dt_bias, *ssm_A_log, *ssm_D, *ssm_gate_norm, *ssm_w_out;
  float* out;
  u16 *Wt1, *Wt2, *Wt3, *Wt4, *H, *QKVG, *OG, *Z, *XBC, *YG, *XBCC, *STATES;
  float *LSE, *X1, *DT, *SSQ, *CD, *ACS;
  unsigned* bar;
};

DI u16 f2bf(float x) { unsigned u = __float_as_uint(x); u += 0x7fffu + ((u >> 16) & 1u); return (u16)(u >> 16); }
DI float bf2f(u16 h) { return __uint_as_float(((unsigned)h) << 16); }
DI unsigned pack2(float a, float b) { return (unsigned)f2bf(a) | ((unsigned)f2bf(b) << 16); }
DI float lo_f(unsigned w) { return __uint_as_float(w << 16); }
DI float hi_f(unsigned w) { return __uint_as_float(w & 0xffff0000u); }
DI void unpack8(const uint4& v, float* f) {
  f[0] = lo_f(v.x); f[1] = hi_f(v.x); f[2] = lo_f(v.y); f[3] = hi_f(v.y);
  f[4] = lo_f(v.z); f[5] = hi_f(v.z); f[6] = lo_f(v.w); f[7] = hi_f(v.w);
}
DI uint4 pack8(const float* f) {
  uint4 v; v.x = pack2(f[0], f[1]); v.y = pack2(f[2], f[3]); v.z = pack2(f[4], f[5]); v.w = pack2(f[6], f[7]); return v;
}
DI float silu_f(float x) { return x / (1.f + __expf(-x)); }
DI s16x4 tr_read(const u16* ptr) {
  return __builtin_amdgcn_ds_read_tr16_b64_v4i16((s16x4 __attribute__((address_space(3)))*)(ptr));
}
DI bf16x8 cat4(s16x4 lo, s16x4 hi) { return __builtin_shufflevector(lo, hi, 0, 1, 2, 3, 4, 5, 6, 7); }
DI bf16x8 words_to_frag(unsigned a, unsigned b, unsigned c, unsigned d) {
  uint4 v; v.x = a; v.y = b; v.z = c; v.w = d; return __builtin_bit_cast(bf16x8, v);
}

constexpr int GT_BYTES = 16384;
template <class EP>
DI void gemm_tile_glds(const u16* __restrict__ A, const u16* __restrict__ Bt, int K, int m0, int n0, const EP& ep, char* smem) {
  const int tid = threadIdx.x, lane = tid & 63, w = tid >> 6, wr = w >> 1, wc = w & 1;
  const int l15 = lane & 15, G = lane >> 4;
  char* As = smem;
  char* Bs = smem + 2 * GT_BYTES;
  f32x4 acc[4][4];
#pragma unroll
  for (int m = 0; m < 4; ++m)
#pragma unroll
    for (int n = 0; n < 4; ++n) acc[m][n] = (f32x4){0.f, 0.f, 0.f, 0.f};
  const int srr = lane >> 3, sc = ((lane & 7) ^ srr) * 8;
  const u16* ag = A + (size_t)(m0 + w * 32 + srr) * K + sc;
  const u16* bg = Bt + (size_t)(n0 + w * 32 + srr) * K + sc;
  const int lofs = (w * 4) * 1024 + lane * 16;
  const int rofs = (l15 >> 3) * 1024 + (l15 & 7) * 128 + ((G ^ (l15 & 7)) << 4);
  const int nk = K >> 6;
#define GLDS_STAGE(buf, k0)                                                                                             \
  do {                                                                                                                  \
    _Pragma("unroll") for (int i = 0; i < 4; ++i) {                                                                     \
      __builtin_amdgcn_global_load_lds((const unsigned*)(ag + (size_t)(i * 8) * K + (k0)),                             \
                                       (unsigned*)(As + (buf) * GT_BYTES + lofs + i * 1024), 16, 0, 0);                 \
      __builtin_amdgcn_global_load_lds((const unsigned*)(bg + (size_t)(i * 8) * K + (k0)),                             \
                                       (unsigned*)(Bs + (buf) * GT_BYTES + lofs + i * 1024), 16, 0, 0);                 \
    }                                                                                                                   \
  } while (0)
  GLDS_STAGE(0, 0);
  asm volatile("s_waitcnt vmcnt(0)" ::: "memory");
  __syncthreads();
  for (int kt = 0; kt < nk; ++kt) {
    const int buf = kt & 1;
    if (kt + 1 < nk) GLDS_STAGE(buf ^ 1, (kt + 1) << 6);
    const char* Ab = As + buf * GT_BYTES + wr * 8192 + rofs;
    const char* Bb = Bs + buf * GT_BYTES + wc * 8192 + rofs;
#pragma unroll
    for (int ks = 0; ks < 2; ++ks) {
      bf16x8 a[4], b[4];
#pragma unroll
      for (int m = 0; m < 4; ++m) a[m] = *(const bf16x8*)(As + (((buf * GT_BYTES + wr * 8192 + rofs) ^ (ks * 64)) + m * 2048));
#pragma unroll
      for (int n = 0; n < 4; ++n) b[n] = *(const bf16x8*)(Bs + (((buf * GT_BYTES + wc * 8192 + rofs) ^ (ks * 64)) + n * 2048));
#pragma unroll
      for (int m = 0; m < 4; ++m)
#pragma unroll
        for (int n = 0; n < 4; ++n) acc[m][n] = MFMA16(a[m], b[n], acc[m][n]);
    }
    asm volatile("s_waitcnt vmcnt(0)" ::: "memory");
    __syncthreads();
  }
#undef GLDS_STAGE
  ep(acc, m0 + wr * 64, n0 + wc * 64, lane);
}

template <class EP>
DI void gemm_phase_glds(const u16* A, const u16* Bt, int K, int MT, int NT, const EP& ep, char* smem) {
  const int x = blockIdx.x & 7, j = blockIdx.x >> 3, per = gridDim.x >> 3;
  const int T = MT * NT, fullT = (MT >> 3) * 8 * NT, hlast = MT & 7;
  for (int it = 0;; ++it) {
    const int v = it * per + j;
    const int s = (x + 8 * (v >> 6)) * 64 + (v & 63);
    if ((x + 8 * (v >> 6)) * 64 >= T) break;
    if (s >= T) continue;
    int mt, nt;
    if (s < fullT) { const int band = s / (8 * NT), within = s - band * 8 * NT; nt = within >> 3; mt = band * 8 + (within & 7); }
    else { const int sp = s - fullT; nt = sp / hlast; mt = (MT >> 3) * 8 + (sp - nt * hlast); }
    gemm_tile_glds(A, Bt, K, mt * 128, nt * 128, ep, smem);
  }
}

DI unsigned merge_word(unsigned a, unsigned b, unsigned c, unsigned g, float e0, float e1, float e2) {
  const float lo = (e0 * lo_f(a) + e1 * lo_f(b) + e2 * lo_f(c)) * silu_f(lo_f(g));
  const float hi = (e0 * hi_f(a) + e1 * hi_f(b) + e2 * hi_f(c)) * silu_f(hi_f(g));
  return pack2(lo, hi);
}
DI void phase_merge(const Params& p) {
  const int lane = threadIdx.x & 63;
  for (int it = blockIdx.x; it < MROWS / 4; it += gridDim.x) {
    const size_t row = (size_t)it * 4 + (threadIdx.x >> 6);
    const int k = lane * 16, head = lane >> 2;
    const float* lp = p.LSE + row * 48 + head;
    const float l0 = lp[0], l1 = lp[16], l2 = lp[32];
    const u16* op = p.OG + row * 3072 + k;
    const u16* gp = p.QKVG + row * ATT_IN + 9216 + k;
    uint4 a[2], b[2], c[2], g[2];
#pragma unroll
    for (int h = 0; h < 2; ++h) {
      a[h] = *(const uint4*)(op + h * 8); b[h] = *(const uint4*)(op + 1024 + h * 8); c[h] = *(const uint4*)(op + 2048 + h * 8);
      g[h] = *(const uint4*)(gp + h * 8);
    }
    const float mx = fmaxf(l0, fmaxf(l1, l2));
    float e0 = __expf(l0 - mx), e1 = __expf(l1 - mx), e2 = __expf(l2 - mx);
    const float inv = 1.f / (e0 + e1 + e2);
    e0 *= inv; e1 *= inv; e2 *= inv;
#pragma unroll
    for (int h = 0; h < 2; ++h) {
      uint4 o;
      o.x = merge_word(a[h].x, b[h].x, c[h].x, g[h].x, e0, e1, e2);
      o.y = merge_word(a[h].y, b[h].y, c[h].y, g[h].y, e0, e1, e2);
      o.z = merge_word(a[h].z, b[h].z, c[h].z, g[h].z, e0, e1, e2);
      o.w = merge_word(a[h].w, b[h].w, c[h].w, g[h].w, e0, e1, e2);
      *(uint4*)(p.H + row * 1024 + k + h * 8) = o;
    }
  }
}
DI void phase_gatenorm(const Params& p) {
  const int lane = threadIdx.x & 63;
  for (int it = blockIdx.x; it < MROWS / 4; it += gridDim.x) {
    const size_t row = (size_t)it * 4 + (threadIdx.x >> 6);
    const int k = lane * 32;
    const float* sp = p.SSQ + row * 32 + (lane >> 4) * 8;
    const float4 s0 = *(const float4*)sp, s1 = *(const float4*)(sp + 4);
    const float ss = (s0.x + s0.y) + (s0.z + s0.w) + (s1.x + s1.y) + (s1.z + s1.w);
    const float rstd = rsqrtf(ss * (1.f / 512.f) + 1e-5f);
    u16* yp = p.YG + row * 2048 + k;
    uint4 y[4];
#pragma unroll
    for (int h = 0; h < 4; ++h) y[h] = *(const uint4*)(yp + h * 8);
#pragma unroll
    for (int h = 0; h < 4; ++h) {
      const float4 g0 = *(const float4*)(p.ssm_gate_norm + k + h * 8), g1 = *(const float4*)(p.ssm_gate_norm + k + h * 8 + 4);
      uint4 o;
      o.x = pack2(lo_f(y[h].x) * rstd * g0.x, hi_f(y[h].x) * rstd * g0.y);
      o.y = pack2(lo_f(y[h].y) * rstd * g0.z, hi_f(y[h].y) * rstd * g0.w);
      o.z = pack2(lo_f(y[h].z) * rstd * g1.x, hi_f(y[h].z) * rstd * g1.y);
      o.w = pack2(lo_f(y[h].w) * rstd * g1.z, hi_f(y[h].w) * rstd * g1.w);
      *(uint4*)(yp + h * 8) = o;
    }
  }
}

struct Ep1 {
  const Params& p;
  DI void operator()(f32x4 (&acc)[4][4], int r0, int c0, int lane) const {
    const int l15 = lane & 15, G = lane >> 4;
    int kind, g = 0, head;
    if (c0 >= 9216) { kind = 3; head = (c0 - 9216) >> 6; }
    else { g = c0 / 3072; const int rem = c0 - g * 3072; kind = rem >> 10; head = (rem & 1023) >> 6; }
    if (kind < 2) {
      const float* gp = (kind == 0 ? p.attn_q_gain : p.attn_k_gain) + g * 64;
      float gain[4];
#pragma unroll
      for (int n = 0; n < 4; ++n) gain[n] = gp[n * 16 + l15];
      const float post = (kind == 0) ? 0.125f : 1.f;
#pragma unroll
      for (int m = 0; m < 4; ++m)
#pragma unroll
        for (int j = 0; j < 4; ++j) {
          float ss = 0.f;
#pragma unroll
          for (int n = 0; n < 4; ++n) ss += acc[m][n][j] * acc[m][n][j];
          ss += __shfl_xor(ss, 1); ss += __shfl_xor(ss, 2); ss += __shfl_xor(ss, 4); ss += __shfl_xor(ss, 8);
          const float sc = rsqrtf(ss * (1.f / 64.f) + 1e-6f) * post;
#pragma unroll
          for (int n = 0; n < 4; ++n) acc[m][n][j] *= sc * gain[n];
        }
    }
#pragma unroll
    for (int m = 0; m < 4; ++m)
#pragma unroll
      for (int j = 0; j < 4; ++j) {
        const int row = r0 + m * 16 + G * 4 + j;
        u16* dst = p.QKVG + (size_t)row * ATT_IN + c0 + l15;
#pragma unroll
        for (int n = 0; n < 4; ++n) dst[n * 16] = f2bf(acc[m][n][j]);
      }
    if (kind == 1 || kind == 2) {
      const int keep = 128 << (2 * g);
      const size_t okp = (g == 0) ? O_KVP0 : (g == 1) ? O_KVP1 : O_KVP2;
      const size_t oks = (g == 0) ? O_KVS0 : (g == 1) ? O_KVS1 : O_KVS2;
#pragma unroll
      for (int m = 0; m < 4; ++m)
#pragma unroll
        for (int j = 0; j < 4; ++j) {
          const int row = r0 + m * 16 + G * 4 + j;
          float* dst = nullptr;
          if (row < PROWS) {
            const int b = row >> 12, s = row & 4095;
            if (s >= 4096 - keep) dst = p.out + okp + ((size_t)(b * keep + s - (4096 - keep)) * 2 + (kind - 1)) * 1024 + head * 64 + l15;
          } else {
            dst = p.out + oks + ((size_t)(row - PROWS) * 2 + (kind - 1)) * 1024 + head * 64 + l15;
          }
          if (dst) {
#pragma unroll
            for (int n = 0; n < 4; ++n) dst[n * 16] = acc[m][n][j];
          }
        }
    }
  }
};
struct Ep2 {
  const Params& p;
  DI void operator()(f32x4 (&acc)[4][4], int r0, int c0, int lane) const {
    const int l15 = lane & 15, G = lane >> 4;
#pragma unroll
    for (int m = 0; m < 4; ++m)
#pragma unroll
      for (int j = 0; j < 4; ++j) {
        const int row = r0 + m * 16 + G * 4 + j;
        const float* xin = (row < PROWS) ? p.x_prompt + (size_t)row * 1024 : p.x_sample + (size_t)(row - PROWS) * 1024;
        float* dst = p.X1 + (size_t)row * 1024 + c0 + l15;
#pragma unroll
        for (int n = 0; n < 4; ++n) dst[n * 16] = xin[c0 + l15 + n * 16] + acc[m][n][j];
      }
  }
};
struct Ep3 {
  const Params& p;
  DI void operator()(f32x4 (&acc)[4][4], int r0, int c0, int lane) const {
    const int l15 = lane & 15, G = lane >> 4;
    if (c0 >= SSM_IN) return;
    if (c0 < 2048) {
#pragma unroll
      for (int m = 0; m < 4; ++m)
#pragma unroll
        for (int j = 0; j < 4; ++j) {
          const int row = r0 + m * 16 + G * 4 + j;
          u16* dst = p.Z + (size_t)row * 2048 + c0 + l15;
#pragma unroll
          for (int n = 0; n < 4; ++n) dst[n * 16] = f2bf(acc[m][n][j]);
        }
    } else if (c0 < 5120) {
      const int cc = c0 - 2048 + l15;
#pragma unroll
      for (int m = 0; m < 4; ++m)
#pragma unroll
        for (int j = 0; j < 4; ++j) {
          const int row = r0 + m * 16 + G * 4 + j;
          u16* dst = p.XBC + (size_t)row * 3072 + cc;
#pragma unroll
          for (int n = 0; n < 4; ++n) dst[n * 16] = f2bf(acc[m][n][j]);
          float* od = nullptr;
          if (row < PROWS) {
            const int b = row >> 12, s = row & 4095;
            if (s >= 4093) od = p.out + O_CONVP + (size_t)(b * 3 + s - 4093) * 3072 + cc;
          } else {
            const int rr = row - PROWS, b = rr >> 3, t = rr & 7;
            if (t >= 5) od = p.out + O_CONVS + (size_t)(b * 3 + t - 5) * 3072 + cc;
          }
          if (od) {
#pragma unroll
            for (int n = 0; n < 4; ++n) od[n * 16] = acc[m][n][j];
          }
        }
    } else {
#pragma unroll
      for (int m = 0; m < 4; ++m)
#pragma unroll
        for (int j = 0; j < 4; ++j) {
          const int row = r0 + m * 16 + G * 4 + j;
#pragma unroll
          for (int n = 0; n < 2; ++n) {
            const int h = n * 16 + l15;
            const float xv = acc[m][n][j] + p.ssm_dt_bias[h];
            p.DT[(size_t)row * 32 + h] = fmaxf(xv, 0.f) + log1pf(__expf(-fabsf(xv)));
          }
        }
    }
  }
};
struct Ep4 {
  const Params& p;
  DI void operator()(f32x4 (&acc)[4][4], int r0, int c0, int lane) const {
    const int l15 = lane & 15, G = lane >> 4;
#pragma unroll
    for (int m = 0; m < 4; ++m)
#pragma unroll
      for (int j = 0; j < 4; ++j) {
        const int row = r0 + m * 16 + G * 4 + j;
        const float* xin = p.X1 + (size_t)row * 1024 + c0 + l15;
        float* dst = p.out + O_Y + (size_t)row * 1024 + c0 + l15;
#pragma unroll
        for (int n = 0; n < 4; ++n) dst[n * 16] = xin[n * 16] + acc[m][n][j];
      }
  }
};

DI void transpose_task(const float* __restrict__ W, u16* __restrict__ Wt, int K, int N, int NTN, int tile, u16* smem) {
  const int tid = threadIdx.x;
  const int ktile = tile / NTN, ntile = tile % NTN;
  const int k0 = ktile * 64, n0 = ntile * 64;
#pragma unroll
  for (int i = 0; i < 4; ++i) {
    const int idx = tid + 256 * i;
    const int kk = idx >> 4, nq = idx & 15;
    const int n = n0 + nq * 4;
    float4 v = {0.f, 0.f, 0.f, 0.f};
    if (n < N) v = *(const float4*)(W + (size_t)(k0 + kk) * N + n);
    smem[(nq * 4 + 0) * LDT + kk] = f2bf(v.x);
    smem[(nq * 4 + 1) * LDT + kk] = f2bf(v.y);
    smem[(nq * 4 + 2) * LDT + kk] = f2bf(v.z);
    smem[(nq * 4 + 3) * LDT + kk] = f2bf(v.w);
  }
  __syncthreads();
#pragma unroll
  for (int i = 0; i < 2; ++i) {
    const int idx = tid + 256 * i;
    const int n = idx >> 3, kc = idx & 7;
    *(uint4*)(Wt + (size_t)(n0 + n) * K + k0 + kc * 8) = *(const uint4*)(smem + n * LDT + kc * 8);
  }
  __syncthreads();
}

DI void rmsnorm_row(const float* __restrict__ src, const float* __restrict__ wgt, u16* __restrict__ dst, int lane) {
  float4 v[4];
  float ss = 0.f;
#pragma unroll
  for (int i = 0; i < 4; ++i) {
    v[i] = *(const float4*)(src + lane * 4 + 256 * i);
    ss += v[i].x * v[i].x + v[i].y * v[i].y + v[i].z * v[i].z + v[i].w * v[i].w;
  }
#pragma unroll
  for (int d = 32; d >= 1; d >>= 1) ss += __shfl_xor(ss, d);
  const float rstd = rsqrtf(ss * (1.f / 1024.f) + 1e-6f);
#pragma unroll
  for (int i = 0; i < 4; ++i) {
    const float4 g = *(const float4*)(wgt + lane * 4 + 256 * i);
    uint2 o;
    o.x = pack2(v[i].x * rstd * g.x, v[i].y * rstd * g.y);
    o.y = pack2(v[i].z * rstd * g.z, v[i].w * rstd * g.w);
    *(uint2*)(dst + lane * 4 + 256 * i) = o;
  }
}

DI void phase_prep(const Params& p, u16* smem) {
  constexpr int T1 = 16 * 160, T2 = 16 * 16, T3 = 16 * 82, T4 = 32 * 16, TT = T1 + T2 + T3 + T4;
  constexpr int RT = MROWS / 4;
  for (int it = blockIdx.x; it < TT + RT; it += gridDim.x) {
    if (it < T1) transpose_task(p.attn_w_in, p.Wt1, 1024, ATT_IN, 160, it, smem);
    else if (it < T1 + T2) transpose_task(p.attn_w_out, p.Wt2, 1024, 1024, 16, it - T1, smem);
    else if (it < T1 + T2 + T3) transpose_task(p.ssm_w_in, p.Wt3, 1024, SSM_IN, 82, it - T1 - T2, smem);
    else if (it < TT) transpose_task(p.ssm_w_out, p.Wt4, 2048, 1024, 16, it - T1 - T2 - T3, smem);
    else {
      const int row = (it - TT) * 4 + (threadIdx.x >> 6);
      const float* src = (row < PROWS) ? p.x_prompt + (size_t)row * 1024 : p.x_sample + (size_t)(row - PROWS) * 1024;
      rmsnorm_row(src, p.attn_norm, p.H + (size_t)row * 1024, threadIdx.x & 63);
    }
  }
}

DI void phase_norm2(const Params& p) {
  for (int it = blockIdx.x; it < MROWS / 4; it += gridDim.x) {
    const int row = it * 4 + (threadIdx.x >> 6);
    rmsnorm_row(p.X1 + (size_t)row * 1024, p.ssm_norm, p.H + (size_t)row * 1024, threadIdx.x & 63);
  }
}

DI void attn_prompt_item(const Params& p, int item, u16* smem) {
  const int tid = threadIdx.x, lane = tid & 63, w = tid >> 6, l15 = lane & 15, G = lane >> 4;
  const int rn = item & 31, head = (item >> 5) & 15, b = (item >> 9) & 3, g = item >> 11;
  const int dsh = 2 * g, dil = 1 << dsh, nbg = 32 >> dsh;
  const int r = rn / nbg, n = rn % nbg;
  u16* Ks = smem;
  u16* Vs = smem + 256 * LDT;
  const size_t colQ = (size_t)g * 3072 + head * 64, colK = colQ + 1024, colV = colQ + 2048;
#pragma unroll
  for (int i = 0; i < 8; ++i) {
    const int c = tid + 256 * i;
    const int kj = c >> 3, ch = c & 7;
    const int u = (n - 1) * 128 + kj;
    uint4 kv = {0u, 0u, 0u, 0u}, vv = {0u, 0u, 0u, 0u};
    if (u >= 0) {
      const size_t row = (size_t)b * 4096 + (size_t)u * dil + r;
      kv = *(const uint4*)(p.QKVG + row * ATT_IN + colK + ch * 8);
      vv = *(const uint4*)(p.QKVG + row * ATT_IN + colV + ch * 8);
    }
    *(uint4*)(Ks + kj * LDT + ch * 8) = kv;
    *(uint4*)(Vs + kj * LDT + ch * 8) = vv;
  }
  __syncthreads();
#pragma unroll 1
  for (int sub = 0; sub < 2; ++sub) {
    const int q0 = w * 32 + sub * 16;
    const int qi = q0 + l15;
    const size_t rowq = (size_t)b * 4096 + (size_t)(n * 128 + qi) * dil + r;
    const u16* qp = p.QKVG + rowq * ATT_IN + colQ + G * 8;
    const bf16x8 qf0 = *(const bf16x8*)qp, qf1 = *(const bf16x8*)(qp + 32);
    f32x4 st[9];
#pragma unroll
    for (int s = 0; s < 9; ++s) {
      const u16* kp = Ks + (q0 + 16 * s + l15) * LDT + G * 8;
      const bf16x8 a0 = *(const bf16x8*)kp, a1 = *(const bf16x8*)(kp + 32);
      f32x4 z = {0.f, 0.f, 0.f, 0.f};
      z = MFMA16(a0, qf0, z);
      st[s] = MFMA16(a1, qf1, z);
    }
    float mx = -INFINITY;
#pragma unroll
    for (int s = 0; s < 9; ++s)
#pragma unroll
      for (int j = 0; j < 4; ++j) {
        const int kk = 16 * s + 4 * G + j;
        const bool valid = (kk >= l15) && (kk <= l15 + 128) && (n > 0 || q0 + kk >= 128);
        const float v = valid ? st[s][j] : -INFINITY;
        st[s][j] = v;
        mx = fmaxf(mx, v);
      }
    mx = fmaxf(mx, __shfl_xor(mx, 16));
    mx = fmaxf(mx, __shfl_xor(mx, 32));
    float sum = 0.f;
#pragma unroll
    for (int s = 0; s < 9; ++s)
#pragma unroll
      for (int j = 0; j < 4; ++j) {
        const float e = __expf(st[s][j] - mx);
        st[s][j] = e;
        sum += e;
      }
    sum += __shfl_xor(sum, 16);
    sum += __shfl_xor(sum, 32);
    const float inv = 1.f / sum;
    f32x4 o[4];
#pragma unroll
    for (int m = 0; m < 4; ++m) o[m] = (f32x4){0.f, 0.f, 0.f, 0.f};
#pragma unroll
    for (int t = 0; t < 5; ++t) {
      const int sA = 2 * t, sB = 2 * t + 1;
      bf16x8 pb;
      if (t < 4) pb = words_to_frag(pack2(st[sA][0], st[sA][1]), pack2(st[sA][2], st[sA][3]), pack2(st[sB < 9 ? sB : 8][0], st[sB < 9 ? sB : 8][1]), pack2(st[sB < 9 ? sB : 8][2], st[sB < 9 ? sB : 8][3]));
      else pb = words_to_frag(pack2(st[sA][0], st[sA][1]), pack2(st[sA][2], st[sA][3]), 0u, 0u);
      const u16* vA = Vs + (q0 + 16 * sA + 4 * G + (l15 >> 2)) * LDT + (l15 & 3) * 4;
      const u16* vB = Vs + (q0 + 16 * sB + 4 * G + (l15 >> 2)) * LDT + (l15 & 3) * 4;
#pragma unroll
      for (int m = 0; m < 4; ++m) {
        const s16x4 lo = tr_read(vA + 16 * m);
        s16x4 hi = {0, 0, 0, 0};
        if (t < 4) hi = tr_read(vB + 16 * m);
        o[m] = MFMA16(cat4(lo, hi), pb, o[m]);
      }
    }
    u16* op = p.OG + rowq * 3072 + g * 1024 + head * 64 + 4 * G;
#pragma unroll
    for (int m = 0; m < 4; ++m) {
      uint2 ov;
      ov.x = pack2(o[m][0] * inv, o[m][1] * inv);
      ov.y = pack2(o[m][2] * inv, o[m][3] * inv);
      *(uint2*)(op + 16 * m) = ov;
    }
    if (G == 0) p.LSE[rowq * 48 + g * 16 + head] = mx + __logf(sum);
  }
  __syncthreads();
}

DI void attn_sample_task(const Params& p, int id) {
  const int lane = threadIdx.x & 63, l15 = lane & 15, G = lane >> 4;
  const int t = id & 7, head = (id >> 3) & 15, b = (id >> 7) & 31, g = id >> 12;
  const int L = 128 << (2 * g), dil = 1 << (2 * g);
  const float* cache = (g == 0) ? p.cache0 : (g == 1) ? p.cache1 : p.cache2;
  const float* newkv = p.out + ((g == 0) ? O_KVS0 : (g == 1) ? O_KVS1 : O_KVS2);
  const size_t rowq = (size_t)PROWS + b * 8 + t;
  const uint2 qq = *(const uint2*)(p.QKVG + rowq * ATT_IN + g * 3072 + head * 64 + 4 * l15);
  const float q0 = lo_f(qq.x), q1 = hi_f(qq.x), q2 = lo_f(qq.y), q3 = hi_f(qq.y);
  const int coff = head * 64 + 4 * l15;
  float sc[33];
#pragma unroll
  for (int bt = 0; bt < 3; ++bt) {
    float4 kb[11];
#pragma unroll
    for (int u = 0; u < 11; ++u) {
      const int j = 4 * (bt * 11 + u) + G;
      const int jc = j < 128 ? j : 128;
      const int idx = L + t - dil * jc;
      const float* kp = (idx < L) ? cache + ((size_t)(b * L + idx) * 2) * 1024 : newkv + ((size_t)(b * 8 + idx - L) * 2) * 1024;
      kb[u] = *(const float4*)(kp + coff);
    }
    __builtin_amdgcn_sched_barrier(0);
#pragma unroll
    for (int u = 0; u < 11; ++u) {
      const int j = 4 * (bt * 11 + u) + G;
      float sv = q0 * kb[u].x + q1 * kb[u].y + q2 * kb[u].z + q3 * kb[u].w;
      sv += __shfl_xor(sv, 1); sv += __shfl_xor(sv, 2); sv += __shfl_xor(sv, 4); sv += __shfl_xor(sv, 8);
      sc[bt * 11 + u] = (j <= 128) ? sv : -INFINITY;
    }
    __builtin_amdgcn_sched_barrier(0);
  }
  float mx = -INFINITY;
#pragma unroll
  for (int i = 0; i < 33; ++i) mx = fmaxf(mx, sc[i]);
  mx = fmaxf(mx, __shfl_xor(mx, 16));
  mx = fmaxf(mx, __shfl_xor(mx, 32));
  float sum = 0.f, a0 = 0.f, a1 = 0.f, a2 = 0.f, a3 = 0.f;
#pragma unroll
  for (int i = 0; i < 33; ++i) { sc[i] = __expf(sc[i] - mx); sum += sc[i]; }
#pragma unroll
  for (int bt = 0; bt < 3; ++bt) {
    float4 vb[11];
#pragma unroll
    for (int u = 0; u < 11; ++u) {
      const int j = 4 * (bt * 11 + u) + G;
      const int jc = j < 128 ? j : 128;
      const int idx = L + t - dil * jc;
      const float* vp = (idx < L) ? cache + ((size_t)(b * L + idx) * 2 + 1) * 1024 : newkv + ((size_t)(b * 8 + idx - L) * 2 + 1) * 1024;
      vb[u] = *(const float4*)(vp + coff);
    }
    __builtin_amdgcn_sched_barrier(0);
#pragma unroll
    for (int u = 0; u < 11; ++u) {
      const float pe = sc[bt * 11 + u];
      a0 += pe * vb[u].x; a1 += pe * vb[u].y; a2 += pe * vb[u].z; a3 += pe * vb[u].w;
    }
    __builtin_amdgcn_sched_barrier(0);
  }
  sum += __shfl_xor(sum, 16); sum += __shfl_xor(sum, 32);
  a0 += __shfl_xor(a0, 16); a0 += __shfl_xor(a0, 32);
  a1 += __shfl_xor(a1, 16); a1 += __shfl_xor(a1, 32);
  a2 += __shfl_xor(a2, 16); a2 += __shfl_xor(a2, 32);
  a3 += __shfl_xor(a3, 16); a3 += __shfl_xor(a3, 32);
  const float inv = 1.f / sum;
  if (G == 0) {
    uint2 ov;
    ov.x = pack2(a0 * inv, a1 * inv);
    ov.y = pack2(a2 * inv, a3 * inv);
    *(uint2*)(p.OG + rowq * 3072 + g * 1024 + coff) = ov;
    if (l15 == 0) p.LSE[rowq * 48 + g * 16 + head] = mx + __logf(sum);
  }
}

DI void phase_attn(const Params& p, u16* smem) {
  constexpr int NP = 6144, NS = 3072;
  for (int it = blockIdx.x; it < NP + NS; it += gridDim.x) {
    const int tri = it / 3, rem = it - tri * 3;
    if (rem == 2) attn_sample_task(p, tri * 4 + (threadIdx.x >> 6));
    else attn_prompt_item(p, tri * 2 + rem, smem);
  }
}

DI void conv_pass_task(const Params& p, int bt) {
  const int id = bt * 256 + threadIdx.x;
  const int ch = id % 384, seg = id / 384;
  const int col = ch * 8, row0 = seg * 8, t0 = row0 & 4095;
  const u16* src = p.XBC + (size_t)row0 * 3072 + col;
  uint4 raw[11];
#pragma unroll
  for (int j = 0; j < 3; ++j) {
    raw[j] = (uint4){0u, 0u, 0u, 0u};
    if (t0 > 0) raw[j] = *(const uint4*)(src - (ptrdiff_t)(3 - j) * 3072);
  }
#pragma unroll
  for (int j = 0; j < 8; ++j) raw[3 + j] = *(const uint4*)(src + (size_t)j * 3072);
  float wgt[4][8], bias[8];
#pragma unroll
  for (int j = 0; j < 4; ++j) {
    const float4 w0 = *(const float4*)(p.ssm_conv_w + j * 3072 + col), w1 = *(const float4*)(p.ssm_conv_w + j * 3072 + col + 4);
    wgt[j][0] = w0.x; wgt[j][1] = w0.y; wgt[j][2] = w0.z; wgt[j][3] = w0.w;
    wgt[j][4] = w1.x; wgt[j][5] = w1.y; wgt[j][6] = w1.z; wgt[j][7] = w1.w;
  }
  {
    const float4 b0 = *(const float4*)(p.ssm_conv_b + col), b1 = *(const float4*)(p.ssm_conv_b + col + 4);
    bias[0] = b0.x; bias[1] = b0.y; bias[2] = b0.z; bias[3] = b0.w;
    bias[4] = b1.x; bias[5] = b1.y; bias[6] = b1.z; bias[7] = b1.w;
  }
  float win[3][8];
  unpack8(raw[0], win[0]); unpack8(raw[1], win[1]); unpack8(raw[2], win[2]);
  u16* dst = p.XBCC + (size_t)row0 * 3072 + col;
#pragma unroll
  for (int i = 0; i < 8; ++i) {
    float cur[8], r[8];
    unpack8(raw[3 + i], cur);
#pragma unroll
    for (int e = 0; e < 8; ++e) {
      const float v = bias[e] + wgt[0][e] * win[0][e] + wgt[1][e] * win[1][e] + wgt[2][e] * win[2][e] + wgt[3][e] * cur[e];
      r[e] = silu_f(v);
      win[0][e] = win[1][e]; win[1][e] = win[2][e]; win[2][e] = cur[e];
    }
    *(uint4*)(dst + (size_t)i * 3072) = pack8(r);
  }
}

DI void acs_task(const Params& p, int bc) {
  const int lane = threadIdx.x & 63, head = lane & 31, half = lane >> 5;
  const float Aneg = -__expf(p.ssm_A_log[head]);
  const size_t rb = (size_t)bc * 128 + half * 64;
  float run = 0.f;
#pragma unroll 8
  for (int i = 0; i < 64; ++i) run += p.DT[(rb + i) * 32 + head] * Aneg;
  const float tot0 = __shfl(run, head);
  run = half ? tot0 : 0.f;
#pragma unroll 8
  for (int i = 0; i < 64; ++i) {
    run += p.DT[(rb + i) * 32 + head] * Aneg;
    p.ACS[(rb + i) * 32 + head] = run;
  }
}

DI void phase_convpass(const Params& p) {
  constexpr int NC = PROWS / 8 * 384 / 256;
  for (int it = blockIdx.x; it < NC + 32; it += gridDim.x) {
    if (it < NC) conv_pass_task(p, it);
    else acs_task(p, (it - NC) * 4 + (threadIdx.x >> 6));
  }
}

constexpr int SS_B = 0;
constexpr int SS_R2 = 34816;
constexpr int SS_H = 34816 + 18432;
constexpr int SS_F = 70656;

DI void ssd_states_item(const Params& p, int item, char* smem_raw) {
  const int tid = threadIdx.x, lane = tid & 63, w = tid >> 6, l15 = lane & 15, G = lane >> 4;
  const int head = item & 31, c = (item >> 5) & 31, b = item >> 10, g = head >> 3;
  u16* Bs = (u16*)(smem_raw + SS_B);
  u16* Xs = (u16*)(smem_raw + SS_R2);
  const size_t row0 = (size_t)b * 4096 + c * 128;
  const float a_end = p.ACS[(row0 + 127) * 32 + head];
#pragma unroll
  for (int i = 0; i < 4; ++i) {
    const int row = (tid >> 3) + 32 * i, ch = tid & 7;
    const float wl = p.DT[(row0 + row) * 32 + head] * __expf(a_end - p.ACS[(row0 + row) * 32 + head]);
    const uint4 v = *(const uint4*)(p.XBCC + (row0 + row) * 3072 + head * 64 + ch * 8);
    uint4 o;
    o.x = pack2(lo_f(v.x) * wl, hi_f(v.x) * wl); o.y = pack2(lo_f(v.y) * wl, hi_f(v.y) * wl);
    o.z = pack2(lo_f(v.z) * wl, hi_f(v.z) * wl); o.w = pack2(lo_f(v.w) * wl, hi_f(v.w) * wl);
    *(uint4*)(Xs + row * LDT + ch * 8) = o;
  }
#pragma unroll
  for (int i = 0; i < 8; ++i) {
    const int idx = tid + 256 * i, row = idx >> 4, ch = idx & 15;
    *(uint4*)(Bs + row * LDW + ch * 8) = *(const uint4*)(p.XBCC + (row0 + row) * 3072 + 2048 + g * 128 + ch * 8);
  }
  __syncthreads();
  f32x4 acc[4][2];
#pragma unroll
  for (int m = 0; m < 4; ++m) { acc[m][0] = (f32x4){0.f, 0.f, 0.f, 0.f}; acc[m][1] = (f32x4){0.f, 0.f, 0.f, 0.f}; }
#pragma unroll
  for (int k = 0; k < 4; ++k) {
    const int rowA = 32 * k + 8 * G + (l15 >> 2);
    bf16x8 a[4], bb[2];
#pragma unroll
    for (int m = 0; m < 4; ++m) {
      const u16* ap = Xs + rowA * LDT + 16 * m + (l15 & 3) * 4;
      a[m] = cat4(tr_read(ap), tr_read(ap + 4 * LDT));
    }
#pragma unroll
    for (int nn = 0; nn < 2; ++nn) {
      const u16* bp = Bs + rowA * LDW + 32 * w + 16 * nn + (l15 & 3) * 4;
      bb[nn] = cat4(tr_read(bp), tr_read(bp + 4 * LDW));
    }
#pragma unroll
    for (int m = 0; m < 4; ++m)
#pragma unroll
      for (int nn = 0; nn < 2; ++nn) acc[m][nn] = MFMA16(a[m], bb[nn], acc[m][nn]);
  }
  u16* sp = p.STATES + (size_t)item * 64 * 128;
#pragma unroll
  for (int m = 0; m < 4; ++m)
#pragma unroll
    for (int nn = 0; nn < 2; ++nn)
#pragma unroll
      for (int j = 0; j < 4; ++j) sp[(16 * m + 4 * G + j) * 128 + 32 * w + 16 * nn + l15] = f2bf(acc[m][nn][j]);
  if (tid == 0) p.CD[item] = __expf(a_end);
  __syncthreads();
}

DI void ssm_sample_item(const Params& p, int item, char* smem_raw) {
  const int tid = threadIdx.x;
  const int head = item & 31, b = item >> 5, g = head >> 3;
  float* sx = (float*)smem_raw;
  float* sB = sx + 512;
  float* sC = sB + 1024;
  float* sdt = sC + 1024;
  float* sdA = sdt + 8;
  float* sy2 = sdA + 8;
  const size_t row0 = (size_t)PROWS + b * 8;
  const float Aneg = -__expf(p.ssm_A_log[head]);
  for (int task = tid; task < 320; task += 256) {
    int col; float* dst;
    if (task < 64) { col = head * 64 + task; dst = sx + task; }
    else if (task < 192) { col = 2048 + g * 128 + (task - 64); dst = sB + (task - 64); }
    else { col = 2560 + g * 128 + (task - 192); dst = sC + (task - 192); }
    const int dstride = (task < 64) ? 64 : 128;
    const float w0 = p.ssm_conv_w[col], w1 = p.ssm_conv_w[3072 + col], w2 = p.ssm_conv_w[2 * 3072 + col], w3 = p.ssm_conv_w[3 * 3072 + col];
    const float bias = p.ssm_conv_b[col];
    float x0 = p.state_conv[(size_t)(b * 3 + 0) * 3072 + col];
    float x1 = p.state_conv[(size_t)(b * 3 + 1) * 3072 + col];
    float x2 = p.state_conv[(size_t)(b * 3 + 2) * 3072 + col];
#pragma unroll
    for (int t = 0; t < 8; ++t) {
      const float cur = bf2f(p.XBC[(row0 + t) * 3072 + col]);
      const float v = bias + w0 * x0 + w1 * x1 + w2 * x2 + w3 * cur;
      dst[t * dstride] = silu_f(v);
      x0 = x1; x1 = x2; x2 = cur;
    }
  }
  if (tid < 8) {
    const float dt = p.DT[(row0 + tid) * 32 + head];
    sdt[tid] = dt;
    sdA[tid] = __expf(dt * Aneg);
  }
  __syncthreads();
  const int pp = tid >> 2, nq = tid & 3;
  const size_t sbase = ((size_t)(b * 32 + head) * 64 + pp) * 128 + nq * 4;
  float4 h[8];
#pragma unroll
  for (int i = 0; i < 8; ++i) h[i] = *(const float4*)(p.state_ssm + sbase + i * 16);
  const float Dh = p.ssm_D[head];
#pragma unroll 1
  for (int t = 0; t < 8; ++t) {
    const float dA = sdA[t];
    const float xv = sx[t * 64 + pp];
    const float dtx = sdt[t] * xv;
    float y = 0.f;
#pragma unroll
    for (int i = 0; i < 8; ++i) {
      const float4 Bv = *(const float4*)(sB + t * 128 + i * 16 + nq * 4);
      const float4 Cv = *(const float4*)(sC + t * 128 + i * 16 + nq * 4);
      h[i].x = h[i].x * dA + dtx * Bv.x; h[i].y = h[i].y * dA + dtx * Bv.y;
      h[i].z = h[i].z * dA + dtx * Bv.z; h[i].w = h[i].w * dA + dtx * Bv.w;
      y += h[i].x * Cv.x + h[i].y * Cv.y + h[i].z * Cv.z + h[i].w * Cv.w;
    }
    y += __shfl_xor(y, 1);
    y += __shfl_xor(y, 2);
    if (nq == 0) {
      const float z = bf2f(p.Z[(row0 + t) * 2048 + head * 64 + pp]);
      const float yg = (y + Dh * xv) * silu_f(z);
      p.YG[(row0 + t) * 2048 + head * 64 + pp] = f2bf(yg);
      sy2[t * 64 + pp] = yg * yg;
    }
  }
  float* od = p.out + O_SSMS + sbase;
#pragma unroll
  for (int i = 0; i < 8; ++i) *(float4*)(od + i * 16) = h[i];
  __syncthreads();
  if (tid < 8) {
    float s = 0.f;
    for (int i = 0; i < 64; ++i) s += sy2[tid * 64 + i];
    p.SSQ[(row0 + tid) * 32 + head] = s;
  }
  __syncthreads();
}

DI void phase_states(const Params& p, char* smem_raw) {
  constexpr int NP = 4096, NS = 1024;
  for (int it = blockIdx.x; it < NP + NS; it += gridDim.x) {
    const int q = it / 5, rem = it - q * 5;
    if (rem == 4) ssm_sample_item(p, q, smem_raw);
    else ssd_states_item(p, q * 4 + rem, smem_raw);
  }
}

DI void phase_scan(const Params& p) {
  for (int task = blockIdx.x * 256 + threadIdx.x; task < 131072; task += gridDim.x * 256) {
    const int n8 = task & 15, pp = (task >> 4) & 63, head = (task >> 10) & 31, b = task >> 15;
    float h[8];
#pragma unroll
    for (int e = 0; e < 8; ++e) h[e] = 0.f;
#pragma unroll 8
    for (int c = 0; c < 32; ++c) {
      const int item = (b * 32 + c) * 32 + head;
      uint4* sp = (uint4*)(p.STATES + ((size_t)item * 64 + pp) * 128 + n8 * 8);
      const uint4 sv = *sp;
      const float d = p.CD[item];
      *sp = pack8(h);
      float sf[8];
      unpack8(sv, sf);
#pragma unroll
      for (int e = 0; e < 8; ++e) h[e] = h[e] * d + sf[e];
    }
    float* od = p.out + O_SSMP + ((size_t)(b * 32 + head) * 64 + pp) * 128 + n8 * 8;
    *(float4*)od = (float4){h[0], h[1], h[2], h[3]};
    *(float4*)(od + 4) = (float4){h[4], h[5], h[6], h[7]};
  }
}

DI void ssd_out_item(const Params& p, int item, char* smem_raw) {
  const int tid = threadIdx.x, lane = tid & 63, w = tid >> 6, l15 = lane & 15, G = lane >> 4;
  const int head = item & 31, c = (item >> 5) & 31, b = item >> 10, g = head >> 3;
  u16* Bs = (u16*)(smem_raw + SS_B);
  u16* Xs = (u16*)(smem_raw + SS_R2);
  u16* Hs = (u16*)(smem_raw + SS_H);
  float* s_acs = (float*)(smem_raw + SS_F);
  float* s_dt = s_acs + 128;
  const size_t row0 = (size_t)b * 4096 + c * 128;
  if (tid < 128) {
    s_acs[tid] = p.ACS[(row0 + tid) * 32 + head];
    s_dt[tid] = p.DT[(row0 + tid) * 32 + head];
  }
#pragma unroll
  for (int i = 0; i < 8; ++i) {
    const int idx = tid + 256 * i, row = idx >> 4, ch = idx & 15;
    *(uint4*)(Bs + row * LDW + ch * 8) = *(const uint4*)(p.XBCC + (row0 + row) * 3072 + 2048 + g * 128 + ch * 8);
  }
#pragma unroll
  for (int i = 0; i < 4; ++i) {
    const int row = (tid >> 3) + 32 * i, ch = tid & 7;
    *(uint4*)(Xs + row * LDT + ch * 8) = *(const uint4*)(p.XBCC + (row0 + row) * 3072 + head * 64 + ch * 8);
  }
  {
    const u16* hp = p.STATES + (size_t)item * 64 * 128;
#pragma unroll
    for (int i = 0; i < 4; ++i) {
      const int idx = tid + 256 * i, pp = idx >> 4, ch = idx & 15;
      *(uint4*)(Hs + pp * LDW + ch * 8) = *(const uint4*)(hp + pp * 128 + ch * 8);
    }
  }
  bf16x8 cf[2][4];
#pragma unroll
  for (int sub = 0; sub < 2; ++sub)
#pragma unroll
    for (int ks = 0; ks < 4; ++ks)
      cf[sub][ks] = *(const bf16x8*)(p.XBCC + (row0 + w * 32 + sub * 16 + l15) * 3072 + 2560 + g * 128 + ks * 32 + G * 8);
  __syncthreads();
  const float Dh = p.ssm_D[head];
#pragma unroll
  for (int sub = 0; sub < 2; ++sub) {
    const int l0 = w * 32 + sub * 16, lq = l0 + l15;
    const float acs_q = s_acs[lq];
    f32x4 yo[4];
#pragma unroll
    for (int m = 0; m < 4; ++m) {
      f32x4 z = {0.f, 0.f, 0.f, 0.f};
#pragma unroll
      for (int ks = 0; ks < 4; ++ks) z = MFMA16(*(const bf16x8*)(Hs + (16 * m + l15) * LDW + ks * 32 + G * 8), cf[sub][ks], z);
      yo[m] = z;
    }
    {
      const float ea = __expf(acs_q);
#pragma unroll
      for (int m = 0; m < 4; ++m) { yo[m][0] *= ea; yo[m][1] *= ea; yo[m][2] *= ea; yo[m][3] *= ea; }
    }
    const int ns = (l0 >> 4) + 1, nsteps = (ns + 1) >> 1;
#pragma unroll 1
    for (int step = 0; step < nsteps; ++step) {
      unsigned pw[4];
#pragma unroll
      for (int h2 = 0; h2 < 2; ++h2) {
        const int ss = 2 * step + h2;
        f32x4 st = {0.f, 0.f, 0.f, 0.f};
#pragma unroll
        for (int ks = 0; ks < 4; ++ks) st = MFMA16(*(const bf16x8*)(Bs + (16 * ss + l15) * LDW + ks * 32 + G * 8), cf[sub][ks], st);
        float mv[4];
#pragma unroll
        for (int j = 0; j < 4; ++j) {
          const int s = 16 * ss + 4 * G + j;
          const float dec = __expf(fminf(acs_q - s_acs[s], 0.f)) * s_dt[s];
          mv[j] = (s <= lq) ? st[j] * dec : 0.f;
        }
        pw[2 * h2] = pack2(mv[0], mv[1]);
        pw[2 * h2 + 1] = pack2(mv[2], mv[3]);
      }
      const bf16x8 pb = words_to_frag(pw[0], pw[1], pw[2], pw[3]);
      const u16* xa = Xs + (32 * step + 4 * G + (l15 >> 2)) * LDT + (l15 & 3) * 4;
#pragma unroll
      for (int m = 0; m < 4; ++m) yo[m] = MFMA16(cat4(tr_read(xa + 16 * m), tr_read(xa + 16 * LDT + 16 * m)), pb, yo[m]);
    }
    const size_t rowg = (size_t)b * 4096 + c * 128 + lq;
    float ssq = 0.f;
#pragma unroll
    for (int m = 0; m < 4; ++m) {
      const uint2 xv = *(const uint2*)(Xs + lq * LDT + 16 * m + 4 * G);
      const uint2 zv = *(const uint2*)(p.Z + rowg * 2048 + head * 64 + 16 * m + 4 * G);
      const float xf[4] = {lo_f(xv.x), hi_f(xv.x), lo_f(xv.y), hi_f(xv.y)};
      const float zf[4] = {lo_f(zv.x), hi_f(zv.x), lo_f(zv.y), hi_f(zv.y)};
      float y[4];
#pragma unroll
      for (int j = 0; j < 4; ++j) {
        y[j] = (yo[m][j] + Dh * xf[j]) * silu_f(zf[j]);
        ssq += y[j] * y[j];
      }
      uint2 ov; ov.x = pack2(y[0], y[1]); ov.y = pack2(y[2], y[3]);
      *(uint2*)(p.YG + rowg * 2048 + head * 64 + 16 * m + 4 * G) = ov;
    }
    ssq += __shfl_xor(ssq, 16);
    ssq += __shfl_xor(ssq, 32);
    if (G == 0) p.SSQ[rowg * 32 + head] = ssq;
  }
  __syncthreads();
}

#define XB_TMO      128
#define XB_XCNT(j)  (256  + 64 * (j))
#define XB_XSUB(j)  (1280 + 64 * (j))
#define XB_XGEN(j)  (2304 + 64 * (j))
#define XB_TOP      3328
#define XB_TOPGEN   3392
#define XCD_BAR_WORDS 3456
#define XB_SPIN_CAP (1u << 20)
#define LAS __attribute__((address_space(3)))
DI unsigned xb_ld(unsigned* p) { return __hip_atomic_load(p, __ATOMIC_RELAXED, __HIP_MEMORY_SCOPE_AGENT); }
DI unsigned xb_add(unsigned* p, unsigned v) { return __hip_atomic_fetch_add(p, v, __ATOMIC_RELAXED, __HIP_MEMORY_SCOPE_AGENT); }
DI unsigned xb_xcc_id() { return (unsigned)__builtin_amdgcn_s_getreg((3 << 11) | 20) & 0xFu; }
#define XB_SPIN(cond, bar) do { unsigned _sp = 0; while (cond) { __builtin_amdgcn_s_sleep(1); \
    if ((++_sp & 255u) == 0u) { if (xb_ld(&(bar)[XB_TMO])) break; if (_sp > XB_SPIN_CAP) { atomicAdd(&(bar)[XB_TMO], 1u); break; } } } } while (0)
struct XcdBarrier { unsigned* bar; unsigned x; volatile LAS unsigned* st; };
DI XcdBarrier xcd_barrier_post(unsigned* bar, volatile LAS unsigned* st) {
  XcdBarrier b; b.bar = bar; b.x = xb_xcc_id(); b.st = st;
  if (threadIdx.x == 0) (void)xb_add(&bar[XB_XCNT(b.x)], 1u);
  return b;
}
DI void xcd_barrier_complete(unsigned* bar, unsigned x, unsigned& nloc, unsigned& nx) {
  const unsigned Gn = gridDim.x * gridDim.y * gridDim.z;
  unsigned sum, cnt, mine, sp = 0u;
  for (;;) {
    sum = 0u; cnt = 0u; mine = 0u;
#pragma unroll
    for (unsigned j = 0; j < 16; ++j) { const unsigned c = xb_ld(&bar[XB_XCNT(j)]); sum += c; cnt += (c > 0u) ? 1u : 0u; mine = (j == x) ? c : mine; }
    if (sum == Gn) break;
    __builtin_amdgcn_s_sleep(1);
    if ((++sp & 255u) == 0u) { if (xb_ld(&bar[XB_TMO])) break; if (sp > XB_SPIN_CAP) { atomicAdd(&bar[XB_TMO], 1u); break; } }
  }
  nloc = mine > 0u ? mine : 1u; nx = cnt > 0u ? cnt : 1u;
}
DI void xcd_barrier(const XcdBarrier& b) {
  asm volatile("s_waitcnt vmcnt(0)" ::: "memory");
  __syncthreads();
  if (threadIdx.x == 0) {
    unsigned* bar = b.bar;
    __builtin_amdgcn_s_waitcnt(0);
    unsigned nloc = b.st[0], nx = b.st[1];
    if (nloc == 0u) { xcd_barrier_complete(bar, b.x, nloc, nx); b.st[0] = nloc; b.st[1] = nx; }
    const unsigned old = xb_add(&bar[XB_XSUB(b.x)], 1u);
    const unsigned gen = old / nloc;
    if (old + 1u == (gen + 1u) * nloc) {
      __builtin_amdgcn_fence(__ATOMIC_RELEASE, "agent");
      asm volatile("s_waitcnt vmcnt(0)" ::: "memory");
      const unsigned og = xb_add(&bar[XB_TOP], 1u);
      const unsigned tg = og / nx;
      if (og + 1u == (tg + 1u) * nx) xb_add(&bar[XB_TOPGEN], 1u);
      else XB_SPIN(xb_ld(&bar[XB_TOPGEN]) == tg, bar);
      __builtin_amdgcn_fence(__ATOMIC_ACQUIRE, "agent");
      xb_add(&bar[XB_XGEN(b.x)], 1u);
      asm volatile("s_waitcnt vmcnt(0)" ::: "memory");
    } else {
      XB_SPIN(xb_ld(&bar[XB_XGEN(b.x)]) == gen, bar);
      __builtin_amdgcn_fence(__ATOMIC_ACQUIRE, "agent");
      asm volatile("s_waitcnt vmcnt(0)" ::: "memory");
    }
  }
  __syncthreads();
}

constexpr int NPHASE = 13;
#ifndef PH_MASK
#define PH_MASK 0x1fff
#endif
#define PH_ON(k) (((PH_MASK) >> (k)) & 1)
#ifndef PH_REPEAT
#define PH_REPEAT 0
#endif
#define PH_REP(k) (((PH_REPEAT) >> (k)) & 1)

template <bool COOP>
__global__ void __launch_bounds__(256, 2) mega(Params p, int ph0, int ph1) {
  extern __shared__ __attribute__((aligned(16))) char smem_raw[];
  u16* smem = (u16*)smem_raw;
#define PHASE_BODY(k)                                                                                                   \
  do {                                                                                                                  \
    if (k == 0) { if (PH_ON(0)) phase_prep(p, smem); }                                                                  \
    else if (k == 1) { if (PH_ON(1)) gemm_phase_glds(p.H, p.Wt1, 1024, MROWS / 128, ATT_IN / 128, Ep1{p}, smem_raw); }  \
    else if (k == 2) { if (PH_ON(2)) phase_attn(p, smem); }                                                             \
    else if (k == 3) { if (PH_ON(3)) phase_merge(p); }                                                                  \
    else if (k == 4) { if (PH_ON(4)) gemm_phase_glds(p.H, p.Wt2, 1024, MROWS / 128, 8, Ep2{p}, smem_raw); }             \
    else if (k == 5) { if (PH_ON(5)) phase_norm2(p); }                                                                  \
    else if (k == 6) { if (PH_ON(6)) gemm_phase_glds(p.H, p.Wt3, 1024, MROWS / 128, SSM_IN_PAD / 128, Ep3{p}, smem_raw); } \
    else if (k == 7) { if (PH_ON(7)) phase_convpass(p); }                                                               \
    else if (k == 8) { if (PH_ON(8)) phase_states(p, smem_raw); }                                                       \
    else if (k == 9) { if (PH_ON(9)) phase_scan(p); }                                                                   \
    else if (k == 10) { if (PH_ON(10)) for (int it = blockIdx.x; it < 4096; it += gridDim.x) ssd_out_item(p, it, smem_raw); } \
    else if (k == 11) { if (PH_ON(11)) phase_gatenorm(p); }                                                             \
    else if (k == 12) { if (PH_ON(12)) gemm_phase_glds(p.YG, p.Wt4, 2048, MROWS / 128, 8, Ep4{p}, smem_raw); }          \
  } while (0)
#define PHASE_STEP(k) PHASE_BODY(k); if (PH_REP(k)) { xcd_barrier(xb); PHASE_BODY(k); }
  if constexpr (COOP) {
    volatile LAS unsigned* xst = (volatile LAS unsigned*)(smem_raw + LDS_MAIN);
    if (threadIdx.x == 0) { xst[0] = 0u; xst[1] = 0u; }
    __syncthreads();
    const XcdBarrier xb = xcd_barrier_post(p.bar, xst);
    if (ph0 == 0x7fffffff) cg::this_grid().sync();
    PHASE_STEP(0) xcd_barrier(xb);
    PHASE_STEP(1) xcd_barrier(xb);
    PHASE_STEP(2) xcd_barrier(xb);
    PHASE_STEP(3) xcd_barrier(xb);
    PHASE_STEP(4) xcd_barrier(xb);
    PHASE_STEP(5) xcd_barrier(xb);
    PHASE_STEP(6) xcd_barrier(xb);
    PHASE_STEP(7) xcd_barrier(xb);
    PHASE_STEP(8) xcd_barrier(xb);
    PHASE_STEP(9) xcd_barrier(xb);
    PHASE_STEP(10) xcd_barrier(xb);
    PHASE_STEP(11) xcd_barrier(xb);
    PHASE_STEP(12)
  } else {
    switch (ph0) {
      case 0: PHASE_BODY(0); break;
      case 1: PHASE_BODY(1); break;
      case 2: PHASE_BODY(2); break;
      case 3: PHASE_BODY(3); break;
      case 4: PHASE_BODY(4); break;
      case 5: PHASE_BODY(5); break;
      case 6: PHASE_BODY(6); break;
      case 7: PHASE_BODY(7); break;
      case 8: PHASE_BODY(8); break;
      case 9: PHASE_BODY(9); break;
      case 10: PHASE_BODY(10); break;
      case 11: PHASE_BODY(11); break;
      case 12: PHASE_BODY(12); break;
    }
  }
}

#ifndef MULTI_LAUNCH
#define MULTI_LAUNCH 0
#endif

extern "C" void kernel_launch(void* const* d_in, const int* in_sizes, int n_in, void* d_out, int out_size, void* d_ws, size_t ws_size,
                              hipStream_t stream) {
  static int grid = 0;
  size_t off = 0;
  auto carve = [&](size_t bytes) { size_t o = off; off += (bytes + 255) & ~(size_t)255; return (char*)d_ws + o; };
  Params p{};
  p.x_prompt = (const float*)d_in[0]; p.x_sample = (const float*)d_in[1];
  p.cache0 = (const float*)d_in[2]; p.cache1 = (const float*)d_in[3]; p.cache2 = (const float*)d_in[4];
  p.state_conv = (const float*)d_in[5]; p.state_ssm = (const float*)d_in[6];
  p.attn_norm = (const float*)d_in[7]; p.attn_w_in = (const float*)d_in[8]; p.attn_q_gain = (const float*)d_in[9];
  p.attn_k_gain = (const float*)d_in[10]; p.attn_w_out = (const float*)d_in[11];
  p.ssm_norm = (const float*)d_in[12]; p.ssm_w_in = (const float*)d_in[13]; p.ssm_conv_w = (const float*)d_in[14];
  p.ssm_conv_b = (const float*)d_in[15]; p.ssm_dt_bias = (const float*)d_in[16]; p.ssm_A_log = (const float*)d_in[17];
  p.ssm_D = (const float*)d_in[18]; p.ssm_gate_norm = (const float*)d_in[19]; p.ssm_w_out = (const float*)d_in[20];
  p.out = (float*)d_out;
  p.Wt1 = (u16*)carve((size_t)ATT_IN * 1024 * 2);
  p.Wt2 = (u16*)carve((size_t)1024 * 1024 * 2);
  p.Wt3 = (u16*)carve((size_t)SSM_IN_PAD * 1024 * 2);
  p.Wt4 = (u16*)carve((size_t)1024 * 2048 * 2);
  p.H = (u16*)carve((size_t)MROWS * 1024 * 2);
  p.QKVG = (u16*)carve((size_t)MROWS * ATT_IN * 2);
  p.OG = (u16*)carve((size_t)MROWS * 3072 * 2);
  p.Z = (u16*)carve((size_t)MROWS * 2048 * 2);
  p.XBC = (u16*)carve((size_t)MROWS * 3072 * 2);
  p.YG = (u16*)carve((size_t)MROWS * 2048 * 2);
  p.LSE = (float*)carve((size_t)MROWS * 48 * 4);
  p.X1 = (float*)carve((size_t)MROWS * 1024 * 4);
  p.DT = (float*)carve((size_t)MROWS * 32 * 4);
  p.STATES = (u16*)carve((size_t)4 * 32 * 32 * 64 * 128 * 2);
  p.XBCC = (u16*)carve((size_t)PROWS * 3072 * 2);
  p.ACS = (float*)carve((size_t)PROWS * 32 * 4);
  p.bar = (unsigned*)carve((size_t)XCD_BAR_WORDS * 4);
  p.SSQ = (float*)carve((size_t)MROWS * 32 * 4);
  p.CD = (float*)carve((size_t)4 * 32 * 32 * 4);
  if (grid == 0) {
    if (n_in != 21 || (size_t)out_size != O_END || ws_size < off) {
      fprintf(stderr, "kernel_launch: unexpected shapes: n_in %d out %d (want %zu) ws %zu (need %zu)\n", n_in, out_size, (size_t)O_END, ws_size, off);
      grid = -1; return;
    }
    int dev = 0, cus = 0, per_cu = 0;
    hipGetDevice(&dev);
    hipDeviceGetAttribute(&cus, hipDeviceAttributeMultiprocessorCount, dev);
    hipFuncSetAttribute((const void*)mega<true>, hipFuncAttributeMaxDynamicSharedMemorySize, LDS_BYTES);
    hipFuncSetAttribute((const void*)mega<false>, hipFuncAttributeMaxDynamicSharedMemorySize, LDS_BYTES);
    hipOccupancyMaxActiveBlocksPerMultiprocessor(&per_cu, (const void*)mega<true>, 256, LDS_BYTES);
    if (per_cu < 1) { fprintf(stderr, "kernel_launch: occupancy query returned %d\n", per_cu); grid = -1; return; }
    if (per_cu > 2) per_cu = 2;
    grid = cus * per_cu;
    grid &= ~7;
  }
  if (grid < 0) return;
#if MULTI_LAUNCH
  for (int ph = 0; ph < NPHASE; ++ph) hipLaunchKernelGGL(mega<false>, dim3(grid), dim3(256), LDS_BYTES, stream, p, ph, ph + 1);
#else
  hipMemsetAsync(p.bar, 0, (size_t)XCD_BAR_WORDS * 4, stream);
  int ph0 = 0, ph1 = NPHASE;
  void* args[] = {&p, &ph0, &ph1};
  hipError_t e = hipLaunchCooperativeKernel((const void*)mega<true>, dim3(grid), dim3(256), args, LDS_BYTES, stream);
  if (e != hipSuccess) fprintf(stderr, "cooperative launch failed: %s (grid %d)\n", hipGetErrorString(e), grid);
#endif
}
```

```cpp
#include <hip/hip_runtime.h>
#include <hip/hip_cooperative_groups.h>
#include <cstdio>
#include <cstdint>
namespace cg = cooperative_groups;

typedef unsigned short u16;
typedef short bf16x8 __attribute__((ext_vector_type(8)));
typedef short s16x4 __attribute__((ext_vector_type(4)));
typedef float f32x4 __attribute__((ext_vector_type(4)));

#define DI __device__ __forceinline__
#define MFMA16(a, b, c) __builtin_amdgcn_mfma_f32_16x16x32_bf16((a), (b), (c), 0, 0, 0)

constexpr int MROWS = 16384 + 256;
constexpr int PROWS = 16384;
constexpr int ATT_IN = 10240;
constexpr int SSM_IN = 5152;
constexpr int SSM_IN_PAD = 5248;
constexpr int LDS_MAIN = 73728;
constexpr int LDS_BYTES = LDS_MAIN + 16;
constexpr int LDT = 72;
constexpr int LDW = 136;
constexpr int TILE_ELEMS = 128 * LDT;

constexpr size_t O_Y = 0;
constexpr size_t O_KVP0 = (size_t)MROWS * 1024;
constexpr size_t O_KVP1 = O_KVP0 + (size_t)4 * 128 * 2048;
constexpr size_t O_KVP2 = O_KVP1 + (size_t)4 * 512 * 2048;
constexpr size_t O_KVS0 = O_KVP2 + (size_t)4 * 2048 * 2048;
constexpr size_t O_KVS1 = O_KVS0 + (size_t)256 * 2048;
constexpr size_t O_KVS2 = O_KVS1 + (size_t)256 * 2048;
constexpr size_t O_CONVP = O_KVS2 + (size_t)256 * 2048;
constexpr size_t O_CONVS = O_CONVP + (size_t)4 * 3 * 3072;
constexpr size_t O_SSMP = O_CONVS + (size_t)32 * 3 * 3072;
constexpr size_t O_SSMS = O_SSMP + (size_t)4 * 32 * 64 * 128;
constexpr size_t O_END = O_SSMS + (size_t)32 * 32 * 64 * 128;

struct Params {
  const float *x_prompt, *x_sample, *cache0, *cache1, *cache2, *state_conv, *state_ssm;
  const float *attn_norm, *attn_w_in, *attn_q_gain, *attn_k_gain, *attn_w_out;
  const float *ssm_norm, *ssm_w_in, *ssm_conv_w, *ssm_conv_b, *ssm_dt_bias, *ssm_A_log, *ssm_D, *ssm_gate_norm, *ssm_w_out;
  float* out;
  u16 *Wt1, *Wt2, *Wt3, *Wt4, *H, *QKVG, *OG, *Z, *XBC, *YG, *XBCC, *STATES;
  float *LSE, *X1, *DT, *SSQ, *CD, *ACS;
  unsigned* bar;
};

typedef __bf16 bf16v2 __attribute__((ext_vector_type(2)));
DI u16 f2bf(float x) { return __builtin_bit_cast(u16, (__bf16)x); }
DI float bf2f(u16 h) { return __uint_as_float(((unsigned)h) << 16); }
DI unsigned pack2(float a, float b) { bf16v2 v; v[0] = (__bf16)a; v[1] = (__bf16)b; return __builtin_bit_cast(unsigned, v); }
DI float lo_f(unsigned w) { return __uint_as_float(w << 16); }
DI float hi_f(unsigned w) { return __uint_as_float(w & 0xffff0000u); }
DI void unpack8(const uint4& v, float* f) {
  f[0] = lo_f(v.x); f[1] = hi_f(v.x); f[2] = lo_f(v.y); f[3] = hi_f(v.y);
  f[4] = lo_f(v.z); f[5] = hi_f(v.z); f[6] = lo_f(v.w); f[7] = hi_f(v.w);
}
DI uint4 pack8(const float* f) {
  uint4 v; v.x = pack2(f[0], f[1]); v.y = pack2(f[2], f[3]); v.z = pack2(f[4], f[5]); v.w = pack2(f[6], f[7]); return v;
}
DI float silu_f(float x) { return x / (1.f + __expf(-x)); }
DI s16x4 tr_read(const u16* ptr) {
  return __builtin_amdgcn_ds_read_tr16_b64_v4i16((s16x4 __attribute__((address_space(3)))*)(ptr));
}
DI bf16x8 cat4(s16x4 lo, s16x4 hi) { return __builtin_shufflevector(lo, hi, 0, 1, 2, 3, 4, 5, 6, 7); }
DI bf16x8 words_to_frag(unsigned a, unsigned b, unsigned c, unsigned d) {
  uint4 v; v.x = a; v.y = b; v.z = c; v.w = d; return __builtin_bit_cast(bf16x8, v);
}

constexpr int GT_BYTES = 16384;
template <class EP>
DI void gemm_tile_glds(const u16* __restrict__ A, const u16* __restrict__ Bt, int K, int m0, int n0, const EP& ep, char* smem) {
  const int tid = threadIdx.x, lane = tid & 63, w = tid >> 6, wr = w >> 1, wc = w & 1;
  const int l15 = lane & 15, G = lane >> 4;
  char* As = smem;
  char* Bs = smem + 2 * GT_BYTES;
  f32x4 acc[4][4];
#pragma unroll
  for (int m = 0; m < 4; ++m)
#pragma unroll
    for (int n = 0; n < 4; ++n) acc[m][n] = (f32x4){0.f, 0.f, 0.f, 0.f};
  const int srr = lane >> 3, sc = ((lane & 7) ^ srr) * 8;
  const u16* ag = A + (size_t)(m0 + w * 32 + srr) * K + sc;
  const u16* bg = Bt + (size_t)(n0 + w * 32 + srr) * K + sc;
  const int lofs = (w * 4) * 1024 + lane * 16;
  const int rofs = (l15 >> 3) * 1024 + (l15 & 7) * 128 + ((G ^ (l15 & 7)) << 4);
  const int nk = K >> 6;
#define GLDS_STAGE(buf, k0)                                                                                             \
  do {                                                                                                                  \
    _Pragma("unroll") for (int i = 0; i < 4; ++i) {                                                                     \
      __builtin_amdgcn_global_load_lds((const unsigned*)(ag + (size_t)(i * 8) * K + (k0)),                             \
                                       (unsigned*)(As + (buf) * GT_BYTES + lofs + i * 1024), 16, 0, 0);                 \
      __builtin_amdgcn_global_load_lds((const unsigned*)(bg + (size_t)(i * 8) * K + (k0)),                             \
                                       (unsigned*)(Bs + (buf) * GT_BYTES + lofs + i * 1024), 16, 0, 0);                 \
    }                                                                                                                   \
  } while (0)
  GLDS_STAGE(0, 0);
  asm volatile("s_waitcnt vmcnt(0)" ::: "memory");
  __syncthreads();
  for (int kt = 0; kt < nk; ++kt) {
    const int buf = kt & 1;
    if (kt + 1 < nk) GLDS_STAGE(buf ^ 1, (kt + 1) << 6);
    const char* Ab = As + buf * GT_BYTES + wr * 8192 + rofs;
    const char* Bb = Bs + buf * GT_BYTES + wc * 8192 + rofs;
#pragma unroll
    for (int ks = 0; ks < 2; ++ks) {
      bf16x8 a[4], b[4];
#pragma unroll
      for (int m = 0; m < 4; ++m) a[m] = *(const bf16x8*)(As + (((buf * GT_BYTES + wr * 8192 + rofs) ^ (ks * 64)) + m * 2048));
#pragma unroll
      for (int n = 0; n < 4; ++n) b[n] = *(const bf16x8*)(Bs + (((buf * GT_BYTES + wc * 8192 + rofs) ^ (ks * 64)) + n * 2048));
#pragma unroll
      for (int m = 0; m < 4; ++m)
#pragma unroll
        for (int n = 0; n < 4; ++n) acc[m][n] = MFMA16(a[m], b[n], acc[m][n]);
    }
    asm volatile("s_waitcnt vmcnt(0)" ::: "memory");
    __syncthreads();
  }
#undef GLDS_STAGE
  ep(acc, m0 + wr * 64, n0 + wc * 64, lane);
}

template <class EP>
DI void gemm_phase_glds(const u16* A, const u16* Bt, int K, int MT, int NT, const EP& ep, char* smem) {
  const int x = blockIdx.x & 7, j = blockIdx.x >> 3, per = gridDim.x >> 3;
  const int T = MT * NT, fullT = (MT >> 3) * 8 * NT, hlast = MT & 7;
  for (int it = 0;; ++it) {
    const int v = it * per + j;
    const int s = (x + 8 * (v >> 6)) * 64 + (v & 63);
    if ((x + 8 * (v >> 6)) * 64 >= T) break;
    if (s >= T) continue;
    int mt, nt;
    if (s < fullT) { const int band = s / (8 * NT), within = s - band * 8 * NT; nt = within >> 3; mt = band * 8 + (within & 7); }
    else { const int sp = s - fullT; nt = sp / hlast; mt = (MT >> 3) * 8 + (sp - nt * hlast); }
    gemm_tile_glds(A, Bt, K, mt * 128, nt * 128, ep, smem);
  }
}

DI unsigned merge_word(unsigned a, unsigned b, unsigned c, unsigned g, float e0, float e1, float e2) {
  const float lo = (e0 * lo_f(a) + e1 * lo_f(b) + e2 * lo_f(c)) * silu_f(lo_f(g));
  const float hi = (e0 * hi_f(a) + e1 * hi_f(b) + e2 * hi_f(c)) * silu_f(hi_f(g));
  return pack2(lo, hi);
}
DI void phase_merge(const Params& p) {
  const int lane = threadIdx.x & 63;
  for (int it = blockIdx.x; it < MROWS / 4; it += gridDim.x) {
    const size_t row = (size_t)it * 4 + (threadIdx.x >> 6);
    const int k = lane * 16, head = lane >> 2;
    const float* lp = p.LSE + row * 48 + head;
    const float l0 = lp[0], l1 = lp[16], l2 = lp[32];
    const u16* op = p.OG + row * 3072 + k;
    const u16* gp = p.QKVG + row * ATT_IN + 9216 + k;
    uint4 a[2], b[2], c[2], g[2];
#pragma unroll
    for (int h = 0; h < 2; ++h) {
      a[h] = *(const uint4*)(op + h * 8); b[h] = *(const uint4*)(op + 1024 + h * 8); c[h] = *(const uint4*)(op + 2048 + h * 8);
      g[h] = *(const uint4*)(gp + h * 8);
    }
    const float mx = fmaxf(l0, fmaxf(l1, l2));
    float e0 = __expf(l0 - mx), e1 = __expf(l1 - mx), e2 = __expf(l2 - mx);
    const float inv = 1.f / (e0 + e1 + e2);
    e0 *= inv; e1 *= inv; e2 *= inv;
#pragma unroll
    for (int h = 0; h < 2; ++h) {
      uint4 o;
      o.x = merge_word(a[h].x, b[h].x, c[h].x, g[h].x, e0, e1, e2);
      o.y = merge_word(a[h].y, b[h].y, c[h].y, g[h].y, e0, e1, e2);
      o.z = merge_word(a[h].z, b[h].z, c[h].z, g[h].z, e0, e1, e2);
      o.w = merge_word(a[h].w, b[h].w, c[h].w, g[h].w, e0, e1, e2);
      *(uint4*)(p.H + row * 1024 + k + h * 8) = o;
    }
  }
}
DI void phase_gatenorm(const Params& p) {
  const int lane = threadIdx.x & 63;
  for (int it = blockIdx.x; it < MROWS / 4; it += gridDim.x) {
    const size_t row = (size_t)it * 4 + (threadIdx.x >> 6);
    const int k = lane * 32;
    const float* sp = p.SSQ + row * 32 + (lane >> 4) * 8;
    const float4 s0 = *(const float4*)sp, s1 = *(const float4*)(sp + 4);
    const float ss = (s0.x + s0.y) + (s0.z + s0.w) + (s1.x + s1.y) + (s1.z + s1.w);
    const float rstd = rsqrtf(ss * (1.f / 512.f) + 1e-5f);
    u16* yp = p.YG + row * 2048 + k;
    uint4 y[4];
#pragma unroll
    for (int h = 0; h < 4; ++h) y[h] = *(const uint4*)(yp + h * 8);
#pragma unroll
    for (int h = 0; h < 4; ++h) {
      const float4 g0 = *(const float4*)(p.ssm_gate_norm + k + h * 8), g1 = *(const float4*)(p.ssm_gate_norm + k + h * 8 + 4);
      uint4 o;
      o.x = pack2(lo_f(y[h].x) * rstd * g0.x, hi_f(y[h].x) * rstd * g0.y);
      o.y = pack2(lo_f(y[h].y) * rstd * g0.z, hi_f(y[h].y) * rstd * g0.w);
      o.z = pack2(lo_f(y[h].z) * rstd * g1.x, hi_f(y[h].z) * rstd * g1.y);
      o.w = pack2(lo_f(y[h].w) * rstd * g1.z, hi_f(y[h].w) * rstd * g1.w);
      *(uint4*)(yp + h * 8) = o;
    }
  }
}

struct Ep1 {
  const Params& p;
  DI void operator()(f32x4 (&acc)[4][4], int r0, int c0, int lane) const {
    const int l15 = lane & 15, G = lane >> 4;
    int kind, g = 0, head;
    if (c0 >= 9216) { kind = 3; head = (c0 - 9216) >> 6; }
    else { g = c0 / 3072; const int rem = c0 - g * 3072; kind = rem >> 10; head = (rem & 1023) >> 6; }
    if (kind < 2) {
      const float* gp = (kind == 0 ? p.attn_q_gain : p.attn_k_gain) + g * 64;
      float gain[4];
#pragma unroll
      for (int n = 0; n < 4; ++n) gain[n] = gp[n * 16 + l15];
      const float post = (kind == 0) ? 0.125f : 1.f;
#pragma unroll
      for (int m = 0; m < 4; ++m)
#pragma unroll
        for (int j = 0; j < 4; ++j) {
          float ss = 0.f;
#pragma unroll
          for (int n = 0; n < 4; ++n) ss += acc[m][n][j] * acc[m][n][j];
          ss += __shfl_xor(ss, 1); ss += __shfl_xor(ss, 2); ss += __shfl_xor(ss, 4); ss += __shfl_xor(ss, 8);
          const float sc = rsqrtf(ss * (1.f / 64.f) + 1e-6f) * post;
#pragma unroll
          for (int n = 0; n < 4; ++n) acc[m][n][j] *= sc * gain[n];
        }
    }
#pragma unroll
    for (int m = 0; m < 4; ++m)
#pragma unroll
      for (int j = 0; j < 4; ++j) {
        const int row = r0 + m * 16 + G * 4 + j;
        u16* dst = p.QKVG + (size_t)row * ATT_IN + c0 + l15;
#pragma unroll
        for (int n = 0; n < 4; ++n) dst[n * 16] = f2bf(acc[m][n][j]);
      }
    if (kind == 1 || kind == 2) {
      const int keep = 128 << (2 * g);
      const size_t okp = (g == 0) ? O_KVP0 : (g == 1) ? O_KVP1 : O_KVP2;
      const size_t oks = (g == 0) ? O_KVS0 : (g == 1) ? O_KVS1 : O_KVS2;
#pragma unroll
      for (int m = 0; m < 4; ++m)
#pragma unroll
        for (int j = 0; j < 4; ++j) {
          const int row = r0 + m * 16 + G * 4 + j;
          float* dst = nullptr;
          if (row < PROWS) {
            const int b = row >> 12, s = row & 4095;
            if (s >= 4096 - keep) dst = p.out + okp + ((size_t)(b * keep + s - (4096 - keep)) * 2 + (kind - 1)) * 1024 + head * 64 + l15;
          } else {
            dst = p.out + oks + ((size_t)(row - PROWS) * 2 + (kind - 1)) * 1024 + head * 64 + l15;
          }
          if (dst) {
#pragma unroll
            for (int n = 0; n < 4; ++n) dst[n * 16] = acc[m][n][j];
          }
        }
    }
  }
};
struct Ep2 {
  const Params& p;
  DI void operator()(f32x4 (&acc)[4][4], int r0, int c0, int lane) const {
    const int l15 = lane & 15, G = lane >> 4;
#pragma unroll
    for (int m = 0; m < 4; ++m)
#pragma unroll
      for (int j = 0; j < 4; ++j) {
        const int row = r0 + m * 16 + G * 4 + j;
        const float* xin = (row < PROWS) ? p.x_prompt + (size_t)row * 1024 : p.x_sample + (size_t)(row - PROWS) * 1024;
        float* dst = p.X1 + (size_t)row * 1024 + c0 + l15;
#pragma unroll
        for (int n = 0; n < 4; ++n) dst[n * 16] = xin[c0 + l15 + n * 16] + acc[m][n][j];
      }
  }
};
struct Ep3 {
  const Params& p;
  DI void operator()(f32x4 (&acc)[4][4], int r0, int c0, int lane) const {
    const int l15 = lane & 15, G = lane >> 4;
    if (c0 >= SSM_IN) return;
    if (c0 < 2048) {
#pragma unroll
      for (int m = 0; m < 4; ++m)
#pragma unroll
        for (int j = 0; j < 4; ++j) {
          const int row = r0 + m * 16 + G * 4 + j;
          u16* dst = p.Z + (size_t)row * 2048 + c0 + l15;
#pragma unroll
          for (int n = 0; n < 4; ++n) dst[n * 16] = f2bf(acc[m][n][j]);
        }
    } else if (c0 < 5120) {
      const int cc = c0 - 2048 + l15;
#pragma unroll
      for (int m = 0; m < 4; ++m)
#pragma unroll
        for (int j = 0; j < 4; ++j) {
          const int row = r0 + m * 16 + G * 4 + j;
          u16* dst = p.XBC + (size_t)row * 3072 + cc;
#pragma unroll
          for (int n = 0; n < 4; ++n) dst[n * 16] = f2bf(acc[m][n][j]);
          float* od = nullptr;
          if (row < PROWS) {
            const int b = row >> 12, s = row & 4095;
            if (s >= 4093) od = p.out + O_CONVP + (size_t)(b * 3 + s - 4093) * 3072 + cc;
          } else {
            const int rr = row - PROWS, b = rr >> 3, t = rr & 7;
            if (t >= 5) od = p.out + O_CONVS + (size_t)(b * 3 + t - 5) * 3072 + cc;
          }
          if (od) {
#pragma unroll
            for (int n = 0; n < 4; ++n) od[n * 16] = acc[m][n][j];
          }
        }
    } else {
#pragma unroll
      for (int m = 0; m < 4; ++m)
#pragma unroll
        for (int j = 0; j < 4; ++j) {
          const int row = r0 + m * 16 + G * 4 + j;
#pragma unroll
          for (int n = 0; n < 2; ++n) {
            const int h = n * 16 + l15;
            const float xv = acc[m][n][j] + p.ssm_dt_bias[h];
            p.DT[(size_t)row * 32 + h] = fmaxf(xv, 0.f) + log1pf(__expf(-fabsf(xv)));
          }
        }
    }
  }
};
struct Ep4 {
  const Params& p;
  DI void operator()(f32x4 (&acc)[4][4], int r0, int c0, int lane) const {
    const int l15 = lane & 15, G = lane >> 4;
#pragma unroll
    for (int m = 0; m < 4; ++m)
#pragma unroll
      for (int j = 0; j < 4; ++j) {
        const int row = r0 + m * 16 + G * 4 + j;
        const float* xin = p.X1 + (size_t)row * 1024 + c0 + l15;
        float* dst = p.out + O_Y + (size_t)row * 1024 + c0 + l15;
#pragma unroll
        for (int n = 0; n < 4; ++n) dst[n * 16] = xin[n * 16] + acc[m][n][j];
      }
  }
};

DI void transpose_task(const float* __restrict__ W, u16* __restrict__ Wt, int K, int N, int NTN, int tile, u16* smem) {
  const int tid = threadIdx.x;
  const int ktile = tile / NTN, ntile = tile % NTN;
  const int k0 = ktile * 64, n0 = ntile * 64;
#pragma unroll
  for (int i = 0; i < 4; ++i) {
    const int idx = tid + 256 * i;
    const int kk = idx >> 4, nq = idx & 15;
    const int n = n0 + nq * 4;
    float4 v = {0.f, 0.f, 0.f, 0.f};
    if (n < N) v = *(const float4*)(W + (size_t)(k0 + kk) * N + n);
    smem[(nq * 4 + 0) * LDT + kk] = f2bf(v.x);
    smem[(nq * 4 + 1) * LDT + kk] = f2bf(v.y);
    smem[(nq * 4 + 2) * LDT + kk] = f2bf(v.z);
    smem[(nq * 4 + 3) * LDT + kk] = f2bf(v.w);
  }
  __syncthreads();
#pragma unroll
  for (int i = 0; i < 2; ++i) {
    const int idx = tid + 256 * i;
    const int n = idx >> 3, kc = idx & 7;
    *(uint4*)(Wt + (size_t)(n0 + n) * K + k0 + kc * 8) = *(const uint4*)(smem + n * LDT + kc * 8);
  }
  __syncthreads();
}

DI void rmsnorm_row(const float* __restrict__ src, const float* __restrict__ wgt, u16* __restrict__ dst, int lane) {
  float4 v[4];
  float ss = 0.f;
#pragma unroll
  for (int i = 0; i < 4; ++i) {
    v[i] = *(const float4*)(src + lane * 4 + 256 * i);
    ss += v[i].x * v[i].x + v[i].y * v[i].y + v[i].z * v[i].z + v[i].w * v[i].w;
  }
#pragma unroll
  for (int d = 32; d >= 1; d >>= 1) ss += __shfl_xor(ss, d);
  const float rstd = rsqrtf(ss * (1.f / 1024.f) + 1e-6f);
#pragma unroll
  for (int i = 0; i < 4; ++i) {
    const float4 g = *(const float4*)(wgt + lane * 4 + 256 * i);
    uint2 o;
    o.x = pack2(v[i].x * rstd * g.x, v[i].y * rstd * g.y);
    o.y = pack2(v[i].z * rstd * g.z, v[i].w * rstd * g.w);
    *(uint2*)(dst + lane * 4 + 256 * i) = o;
  }
}

DI void phase_prep(const Params& p, u16* smem) {
  constexpr int T1 = 16 * 160, T2 = 16 * 16, T3 = 16 * 82, T4 = 32 * 16, TT = T1 + T2 + T3 + T4;
  constexpr int RT = MROWS / 4;
  for (int it = blockIdx.x; it < TT + RT; it += gridDim.x) {
    if (it < T1) transpose_task(p.attn_w_in, p.Wt1, 1024, ATT_IN, 160, it, smem);
    else if (it < T1 + T2) transpose_task(p.attn_w_out, p.Wt2, 1024, 1024, 16, it - T1, smem);
    else if (it < T1 + T2 + T3) transpose_task(p.ssm_w_in, p.Wt3, 1024, SSM_IN, 82, it - T1 - T2, smem);
    else if (it < TT) transpose_task(p.ssm_w_out, p.Wt4, 2048, 1024, 16, it - T1 - T2 - T3, smem);
    else {
      const int row = (it - TT) * 4 + (threadIdx.x >> 6);
      const float* src = (row < PROWS) ? p.x_prompt + (size_t)row * 1024 : p.x_sample + (size_t)(row - PROWS) * 1024;
      rmsnorm_row(src, p.attn_norm, p.H + (size_t)row * 1024, threadIdx.x & 63);
    }
  }
}

DI void phase_norm2(const Params& p) {
  for (int it = blockIdx.x; it < MROWS / 4; it += gridDim.x) {
    const int row = it * 4 + (threadIdx.x >> 6);
    rmsnorm_row(p.X1 + (size_t)row * 1024, p.ssm_norm, p.H + (size_t)row * 1024, threadIdx.x & 63);
  }
}

DI void attn_prompt_item(const Params& p, int item, u16* smem) {
  const int tid = threadIdx.x, lane = tid & 63, w = tid >> 6, l15 = lane & 15, G = lane >> 4;
  const int rn = item & 31, head = (item >> 5) & 15, b = (item >> 9) & 3, g = item >> 11;
  const int dsh = 2 * g, dil = 1 << dsh, nbg = 32 >> dsh;
  const int r = rn / nbg, n = rn % nbg;
  u16* Ks = smem;
  u16* Vs = smem + 256 * LDT;
  const size_t colQ = (size_t)g * 3072 + head * 64, colK = colQ + 1024, colV = colQ + 2048;
#pragma unroll
  for (int i = 0; i < 8; ++i) {
    const int c = tid + 256 * i;
    const int kj = c >> 3, ch = c & 7;
    const int u = (n - 1) * 128 + kj;
    uint4 kv = {0u, 0u, 0u, 0u}, vv = {0u, 0u, 0u, 0u};
    if (u >= 0) {
      const size_t row = (size_t)b * 4096 + (size_t)u * dil + r;
      kv = *(const uint4*)(p.QKVG + row * ATT_IN + colK + ch * 8);
      vv = *(const uint4*)(p.QKVG + row * ATT_IN + colV + ch * 8);
    }
    *(uint4*)(Ks + kj * LDT + ch * 8) = kv;
    *(uint4*)(Vs + kj * LDT + ch * 8) = vv;
  }
  bf16x8 qpre[2][2];
#pragma unroll
  for (int sub = 0; sub < 2; ++sub) {
    const size_t rowq = (size_t)b * 4096 + (size_t)(n * 128 + w * 32 + sub * 16 + l15) * dil + r;
    const u16* qp = p.QKVG + rowq * ATT_IN + colQ + G * 8;
    qpre[sub][0] = *(const bf16x8*)qp;
    qpre[sub][1] = *(const bf16x8*)(qp + 32);
  }
  __syncthreads();
#pragma unroll 1
  for (int sub = 0; sub < 2; ++sub) {
    const int q0 = w * 32 + sub * 16;
    const int qi = q0 + l15;
    const size_t rowq = (size_t)b * 4096 + (size_t)(n * 128 + qi) * dil + r;
    const bf16x8 qf0 = sub ? qpre[1][0] : qpre[0][0], qf1 = sub ? qpre[1][1] : qpre[0][1];
    f32x4 st[9];
#pragma unroll
    for (int s = 0; s < 9; ++s) {
      const u16* kp = Ks + (q0 + 16 * s + l15) * LDT + G * 8;
      const bf16x8 a0 = *(const bf16x8*)kp, a1 = *(const bf16x8*)(kp + 32);
      f32x4 z = {0.f, 0.f, 0.f, 0.f};
      z = MFMA16(a0, qf0, z);
      st[s] = MFMA16(a1, qf1, z);
    }
    float mx = -INFINITY;
#pragma unroll
    for (int s = 0; s < 9; ++s)
#pragma unroll
      for (int j = 0; j < 4; ++j) {
        const int kk = 16 * s + 4 * G + j;
        const bool valid = (kk >= l15) && (kk <= l15 + 128) && (n > 0 || q0 + kk >= 128);
        const float v = valid ? st[s][j] : -INFINITY;
        st[s][j] = v;
        mx = fmaxf(mx, v);
      }
    mx = fmaxf(mx, __shfl_xor(mx, 16));
    mx = fmaxf(mx, __shfl_xor(mx, 32));
    float sum = 0.f;
#pragma unroll
    for (int s = 0; s < 9; ++s)
#pragma unroll
      for (int j = 0; j < 4; ++j) {
        const float e = __expf(st[s][j] - mx);
        st[s][j] = e;
        sum += e;
      }
    sum += __shfl_xor(sum, 16);
    sum += __shfl_xor(sum, 32);
    const float inv = 1.f / sum;
    f32x4 o[4];
#pragma unroll
    for (int m = 0; m < 4; ++m) o[m] = (f32x4){0.f, 0.f, 0.f, 0.f};
#pragma unroll
    for (int t = 0; t < 5; ++t) {
      const int sA = 2 * t, sB = 2 * t + 1;
      bf16x8 pb;
      if (t < 4) pb = words_to_frag(pack2(st[sA][0], st[sA][1]), pack2(st[sA][2], st[sA][3]), pack2(st[sB < 9 ? sB : 8][0], st[sB < 9 ? sB : 8][1]), pack2(st[sB < 9 ? sB : 8][2], st[sB < 9 ? sB : 8][3]));
      else pb = words_to_frag(pack2(st[sA][0], st[sA][1]), pack2(st[sA][2], st[sA][3]), 0u, 0u);
      const u16* vA = Vs + (q0 + 16 * sA + 4 * G + (l15 >> 2)) * LDT + (l15 & 3) * 4;
      const u16* vB = Vs + (q0 + 16 * sB + 4 * G + (l15 >> 2)) * LDT + (l15 & 3) * 4;
#pragma unroll
      for (int m = 0; m < 4; ++m) {
        const s16x4 lo = tr_read(vA + 16 * m);
        s16x4 hi = {0, 0, 0, 0};
        if (t < 4) hi = tr_read(vB + 16 * m);
        o[m] = MFMA16(cat4(lo, hi), pb, o[m]);
      }
    }
    u16* op = p.OG + rowq * 3072 + g * 1024 + head * 64 + 4 * G;
#pragma unroll
    for (int m = 0; m < 4; ++m) {
      uint2 ov;
      ov.x = pack2(o[m][0] * inv, o[m][1] * inv);
      ov.y = pack2(o[m][2] * inv, o[m][3] * inv);
      *(uint2*)(op + 16 * m) = ov;
    }
    if (G == 0) p.LSE[rowq * 48 + g * 16 + head] = mx + __logf(sum);
  }
  __syncthreads();
}

DI void attn_sample_task(const Params& p, int id) {
  const int lane = threadIdx.x & 63, l15 = lane & 15, G = lane >> 4;
  const int t = id & 7, head = (id >> 3) & 15, b = (id >> 7) & 31, g = id >> 12;
  const int L = 128 << (2 * g), dil = 1 << (2 * g);
  const float* cache = (g == 0) ? p.cache0 : (g == 1) ? p.cache1 : p.cache2;
  const float* newkv = p.out + ((g == 0) ? O_KVS0 : (g == 1) ? O_KVS1 : O_KVS2);
  const size_t rowq = (size_t)PROWS + b * 8 + t;
  const uint2 qq = *(const uint2*)(p.QKVG + rowq * ATT_IN + g * 3072 + head * 64 + 4 * l15);
  const float q0 = lo_f(qq.x), q1 = hi_f(qq.x), q2 = lo_f(qq.y), q3 = hi_f(qq.y);
  const int coff = head * 64 + 4 * l15;
  float sc[33];
#pragma unroll
  for (int bt = 0; bt < 3; ++bt) {
    float4 kb[11];
#pragma unroll
    for (int u = 0; u < 11; ++u) {
      const int j = 4 * (bt * 11 + u) + G;
      const int jc = j < 128 ? j : 128;
      const int idx = L + t - dil * jc;
      const float* kp = (idx < L) ? cache + ((size_t)(b * L + idx) * 2) * 1024 : newkv + ((size_t)(b * 8 + idx - L) * 2) * 1024;
      kb[u] = *(const float4*)(kp + coff);
    }
    __builtin_amdgcn_sched_barrier(0);
#pragma unroll
    for (int u = 0; u < 11; ++u) {
      const int j = 4 * (bt * 11 + u) + G;
      float sv = q0 * kb[u].x + q1 * kb[u].y + q2 * kb[u].z + q3 * kb[u].w;
      sv += __shfl_xor(sv, 1); sv += __shfl_xor(sv, 2); sv += __shfl_xor(sv, 4); sv += __shfl_xor(sv, 8);
      sc[bt * 11 + u] = (j <= 128) ? sv : -INFINITY;
    }
    __builtin_amdgcn_sched_barrier(0);
  }
  float mx = -INFINITY;
#pragma unroll
  for (int i = 0; i < 33; ++i) mx = fmaxf(mx, sc[i]);
  mx = fmaxf(mx, __shfl_xor(mx, 16));
  mx = fmaxf(mx, __shfl_xor(mx, 32));
  float sum = 0.f, a0 = 0.f, a1 = 0.f, a2 = 0.f, a3 = 0.f;
#pragma unroll
  for (int i = 0; i < 33; ++i) { sc[i] = __expf(sc[i] - mx); sum += sc[i]; }
#pragma unroll
  for (int bt = 0; bt < 3; ++bt) {
    float4 vb[11];
#pragma unroll
    for (int u = 0; u < 11; ++u) {
      const int j = 4 * (bt * 11 + u) + G;
      const int jc = j < 128 ? j : 128;
      const int idx = L + t - dil * jc;
      const float* vp = (idx < L) ? cache + ((size_t)(b * L + idx) * 2 + 1) * 1024 : newkv + ((size_t)(b * 8 + idx - L) * 2 + 1) * 1024;
      vb[u] = *(const float4*)(vp + coff);
    }
    __builtin_amdgcn_sched_barrier(0);
#pragma unroll
    for (int u = 0; u < 11; ++u) {
      const float pe = sc[bt * 11 + u];
      a0 += pe * vb[u].x; a1 += pe * vb[u].y; a2 += pe * vb[u].z; a3 += pe * vb[u].w;
    }
    __builtin_amdgcn_sched_barrier(0);
  }
  sum += __shfl_xor(sum, 16); sum += __shfl_xor(sum, 32);
  a0 += __shfl_xor(a0, 16); a0 += __shfl_xor(a0, 32);
  a1 += __shfl_xor(a1, 16); a1 += __shfl_xor(a1, 32);
  a2 += __shfl_xor(a2, 16); a2 += __shfl_xor(a2, 32);
  a3 += __shfl_xor(a3, 16); a3 += __shfl_xor(a3, 32);
  const float inv = 1.f / sum;
  if (G == 0) {
    uint2 ov;
    ov.x = pack2(a0 * inv, a1 * inv);
    ov.y = pack2(a2 * inv, a3 * inv);
    *(uint2*)(p.OG + rowq * 3072 + g * 1024 + coff) = ov;
    if (l15 == 0) p.LSE[rowq * 48 + g * 16 + head] = mx + __logf(sum);
  }
}

DI void phase_attn(const Params& p, u16* smem) {
  constexpr int NP = 6144, NS = 3072;
  for (int it = blockIdx.x; it < NP + NS; it += gridDim.x) {
    const int tri = it / 3, rem = it - tri * 3;
    if (rem == 2) attn_sample_task(p, tri * 4 + (threadIdx.x >> 6));
    else attn_prompt_item(p, tri * 2 + rem, smem);
  }
}

DI void conv_pass_task(const Params& p, int bt) {
  const int id = bt * 256 + threadIdx.x;
  const int ch = id % 384, seg = id / 384;
  const int col = ch * 8, row0 = seg * 8, t0 = row0 & 4095;
  const u16* src = p.XBC + (size_t)row0 * 3072 + col;
  uint4 raw[11];
#pragma unroll
  for (int j = 0; j < 3; ++j) {
    raw[j] = (uint4){0u, 0u, 0u, 0u};
    if (t0 > 0) raw[j] = *(const uint4*)(src - (ptrdiff_t)(3 - j) * 3072);
  }
#pragma unroll
  for (int j = 0; j < 8; ++j) raw[3 + j] = *(const uint4*)(src + (size_t)j * 3072);
  float wgt[4][8], bias[8];
#pragma unroll
  for (int j = 0; j < 4; ++j) {
    const float4 w0 = *(const float4*)(p.ssm_conv_w + j * 3072 + col), w1 = *(const float4*)(p.ssm_conv_w + j * 3072 + col + 4);
    wgt[j][0] = w0.x; wgt[j][1] = w0.y; wgt[j][2] = w0.z; wgt[j][3] = w0.w;
    wgt[j][4] = w1.x; wgt[j][5] = w1.y; wgt[j][6] = w1.z; wgt[j][7] = w1.w;
  }
  {
    const float4 b0 = *(const float4*)(p.ssm_conv_b + col), b1 = *(const float4*)(p.ssm_conv_b + col + 4);
    bias[0] = b0.x; bias[1] = b0.y; bias[2] = b0.z; bias[3] = b0.w;
    bias[4] = b1.x; bias[5] = b1.y; bias[6] = b1.z; bias[7] = b1.w;
  }
  float win[3][8];
  unpack8(raw[0], win[0]); unpack8(raw[1], win[1]); unpack8(raw[2], win[2]);
  u16* dst = p.XBCC + (size_t)row0 * 3072 + col;
#pragma unroll
  for (int i = 0; i < 8; ++i) {
    float cur[8], r[8];
    unpack8(raw[3 + i], cur);
#pragma unroll
    for (int e = 0; e < 8; ++e) {
      const float v = bias[e] + wgt[0][e] * win[0][e] + wgt[1][e] * win[1][e] + wgt[2][e] * win[2][e] + wgt[3][e] * cur[e];
      r[e] = silu_f(v);
      win[0][e] = win[1][e]; win[1][e] = win[2][e]; win[2][e] = cur[e];
    }
    *(uint4*)(dst + (size_t)i * 3072) = pack8(r);
  }
}

DI void acs_task(const Params& p, int bc) {
  const int lane = threadIdx.x & 63, head = lane & 31, half = lane >> 5;
  const float Aneg = -__expf(p.ssm_A_log[head]);
  const size_t rb = (size_t)bc * 128 + half * 64;
  float run = 0.f;
#pragma unroll 8
  for (int i = 0; i < 64; ++i) run += p.DT[(rb + i) * 32 + head] * Aneg;
  const float tot0 = __shfl(run, head);
  run = half ? tot0 : 0.f;
#pragma unroll 8
  for (int i = 0; i < 64; ++i) {
    run += p.DT[(rb + i) * 32 + head] * Aneg;
    p.ACS[(rb + i) * 32 + head] = run;
  }
}

DI void phase_convpass(const Params& p) {
  constexpr int NC = PROWS / 8 * 384 / 256;
  for (int it = blockIdx.x; it < NC + 32; it += gridDim.x) {
    if (it < NC) conv_pass_task(p, it);
    else acs_task(p, (it - NC) * 4 + (threadIdx.x >> 6));
  }
}

constexpr int SS_B = 0;
constexpr int SS_R2 = 34816;
constexpr int SS_H = 34816 + 18432;
constexpr int SS_F = 70656;

DI void ssd_states_item(const Params& p, int item, char* smem_raw) {
  const int tid = threadIdx.x, lane = tid & 63, w = tid >> 6, l15 = lane & 15, G = lane >> 4;
  const int head = item & 31, c = (item >> 5) & 31, b = item >> 10, g = head >> 3;
  u16* Bs = (u16*)(smem_raw + SS_B);
  u16* Xs = (u16*)(smem_raw + SS_R2);
  const size_t row0 = (size_t)b * 4096 + c * 128;
  const float a_end = p.ACS[(row0 + 127) * 32 + head];
#pragma unroll
  for (int i = 0; i < 4; ++i) {
    const int row = (tid >> 3) + 32 * i, ch = tid & 7;
    const float wl = p.DT[(row0 + row) * 32 + head] * __expf(a_end - p.ACS[(row0 + row) * 32 + head]);
    const uint4 v = *(const uint4*)(p.XBCC + (row0 + row) * 3072 + head * 64 + ch * 8);
    uint4 o;
    o.x = pack2(lo_f(v.x) * wl, hi_f(v.x) * wl); o.y = pack2(lo_f(v.y) * wl, hi_f(v.y) * wl);
    o.z = pack2(lo_f(v.z) * wl, hi_f(v.z) * wl); o.w = pack2(lo_f(v.w) * wl, hi_f(v.w) * wl);
    *(uint4*)(Xs + row * LDT + ch * 8) = o;
  }
#pragma unroll
  for (int i = 0; i < 8; ++i) {
    const int idx = tid + 256 * i, row = idx >> 4, ch = idx & 15;
    *(uint4*)(Bs + row * LDW + ch * 8) = *(const uint4*)(p.XBCC + (row0 + row) * 3072 + 2048 + g * 128 + ch * 8);
  }
  __syncthreads();
  f32x4 acc[4][2];
#pragma unroll
  for (int m = 0; m < 4; ++m) { acc[m][0] = (f32x4){0.f, 0.f, 0.f, 0.f}; acc[m][1] = (f32x4){0.f, 0.f, 0.f, 0.f}; }
#pragma unroll
  for (int k = 0; k < 4; ++k) {
    const int rowA = 32 * k + 8 * G + (l15 >> 2);
    bf16x8 a[4], bb[2];
#pragma unroll
    for (int m = 0; m < 4; ++m) {
      const u16* ap = Xs + rowA * LDT + 16 * m + (l15 & 3) * 4;
      a[m] = cat4(tr_read(ap), tr_read(ap + 4 * LDT));
    }
#pragma unroll
    for (int nn = 0; nn < 2; ++nn) {
      const u16* bp = Bs + rowA * LDW + 32 * w + 16 * nn + (l15 & 3) * 4;
      bb[nn] = cat4(tr_read(bp), tr_read(bp + 4 * LDW));
    }
#pragma unroll
    for (int m = 0; m < 4; ++m)
#pragma unroll
      for (int nn = 0; nn < 2; ++nn) acc[m][nn] = MFMA16(a[m], bb[nn], acc[m][nn]);
  }
  u16* sp = p.STATES + (size_t)item * 64 * 128;
#pragma unroll
  for (int m = 0; m < 4; ++m)
#pragma unroll
    for (int nn = 0; nn < 2; ++nn)
#pragma unroll
      for (int j = 0; j < 4; ++j) sp[(16 * m + 4 * G + j) * 128 + 32 * w + 16 * nn + l15] = f2bf(acc[m][nn][j]);
  if (tid == 0) p.CD[item] = __expf(a_end);
  __syncthreads();
}

DI void ssm_sample_item(const Params& p, int item, char* smem_raw) {
  const int tid = threadIdx.x;
  const int head = item & 31, b = item >> 5, g = head >> 3;
  float* sx = (float*)smem_raw;
  float* sB = sx + 512;
  float* sC = sB + 1024;
  float* sdt = sC + 1024;
  float* sdA = sdt + 8;
  float* sy2 = sdA + 8;
  const size_t row0 = (size_t)PROWS + b * 8;
  const float Aneg = -__expf(p.ssm_A_log[head]);
  for (int task = tid; task < 320; task += 256) {
    int col; float* dst;
    if (task < 64) { col = head * 64 + task; dst = sx + task; }
    else if (task < 192) { col = 2048 + g * 128 + (task - 64); dst = sB + (task - 64); }
    else { col = 2560 + g * 128 + (task - 192); dst = sC + (task - 192); }
    const int dstride = (task < 64) ? 64 : 128;
    const float w0 = p.ssm_conv_w[col], w1 = p.ssm_conv_w[3072 + col], w2 = p.ssm_conv_w[2 * 3072 + col], w3 = p.ssm_conv_w[3 * 3072 + col];
    const float bias = p.ssm_conv_b[col];
    float x0 = p.state_conv[(size_t)(b * 3 + 0) * 3072 + col];
    float x1 = p.state_conv[(size_t)(b * 3 + 1) * 3072 + col];
    float x2 = p.state_conv[(size_t)(b * 3 + 2) * 3072 + col];
#pragma unroll
    for (int t = 0; t < 8; ++t) {
      const float cur = bf2f(p.XBC[(row0 + t) * 3072 + col]);
      const float v = bias + w0 * x0 + w1 * x1 + w2 * x2 + w3 * cur;
      dst[t * dstride] = silu_f(v);
      x0 = x1; x1 = x2; x2 = cur;
    }
  }
  if (tid < 8) {
    const float dt = p.DT[(row0 + tid) * 32 + head];
    sdt[tid] = dt;
    sdA[tid] = __expf(dt * Aneg);
  }
  __syncthreads();
  const int pp = tid >> 2, nq = tid & 3;
  const size_t sbase = ((size_t)(b * 32 + head) * 64 + pp) * 128 + nq * 4;
  float4 h[8];
#pragma unroll
  for (int i = 0; i < 8; ++i) h[i] = *(const float4*)(p.state_ssm + sbase + i * 16);
  const float Dh = p.ssm_D[head];
#pragma unroll 1
  for (int t = 0; t < 8; ++t) {
    const float dA = sdA[t];
    const float xv = sx[t * 64 + pp];
    const float dtx = sdt[t] * xv;
    float y = 0.f;
#pragma unroll
    for (int i = 0; i < 8; ++i) {
      const float4 Bv = *(const float4*)(sB + t * 128 + i * 16 + nq * 4);
      const float4 Cv = *(const float4*)(sC + t * 128 + i * 16 + nq * 4);
      h[i].x = h[i].x * dA + dtx * Bv.x; h[i].y = h[i].y * dA + dtx * Bv.y;
      h[i].z = h[i].z * dA + dtx * Bv.z; h[i].w = h[i].w * dA + dtx * Bv.w;
      y += h[i].x * Cv.x + h[i].y * Cv.y + h[i].z * Cv.z + h[i].w * Cv.w;
    }
    y += __shfl_xor(y, 1);
    y += __shfl_xor(y, 2);
    if (nq == 0) {
      const float z = bf2f(p.Z[(row0 + t) * 2048 + head * 64 + pp]);
      const float yg = (y + Dh * xv) * silu_f(z);
      p.YG[(row0 + t) * 2048 + head * 64 + pp] = f2bf(yg);
      sy2[t * 64 + pp] = yg * yg;
    }
  }
  float* od = p.out + O_SSMS + sbase;
#pragma unroll
  for (int i = 0; i < 8; ++i) *(float4*)(od + i * 16) = h[i];
  __syncthreads();
  if (tid < 8) {
    float s = 0.f;
    for (int i = 0; i < 64; ++i) s += sy2[tid * 64 + i];
    p.SSQ[(row0 + tid) * 32 + head] = s;
  }
  __syncthreads();
}

DI void phase_states(const Params& p, char* smem_raw) {
  constexpr int NP = 4096, NS = 1024;
  for (int it = blockIdx.x; it < NP + NS; it += gridDim.x) {
    const int q = it / 5, rem = it - q * 5;
    if (rem == 4) ssm_sample_item(p, q, smem_raw);
    else ssd_states_item(p, q * 4 + rem, smem_raw);
  }
}

DI void phase_scan(const Params& p) {
  for (int task = blockIdx.x * 256 + threadIdx.x; task < 131072; task += gridDim.x * 256) {
    const int n8 = task & 15, pp = (task >> 4) & 63, head = (task >> 10) & 31, b = task >> 15;
    float h[8];
#pragma unroll
    for (int e = 0; e < 8; ++e) h[e] = 0.f;
#pragma unroll 8
    for (int c = 0; c < 32; ++c) {
      const int item = (b * 32 + c) * 32 + head;
      uint4* sp = (uint4*)(p.STATES + ((size_t)item * 64 + pp) * 128 + n8 * 8);
      const uint4 sv = *sp;
      const float d = p.CD[item];
      *sp = pack8(h);
      float sf[8];
      unpack8(sv, sf);
#pragma unroll
      for (int e = 0; e < 8; ++e) h[e] = h[e] * d + sf[e];
    }
    float* od = p.out + O_SSMP + ((size_t)(b * 32 + head) * 64 + pp) * 128 + n8 * 8;
    *(float4*)od = (float4){h[0], h[1], h[2], h[3]};
    *(float4*)(od + 4) = (float4){h[4], h[5], h[6], h[7]};
  }
}

DI void ssd_out_item(const Params& p, int item, char* smem_raw) {
  const int tid = threadIdx.x, lane = tid & 63, w = tid >> 6, l15 = lane & 15, G = lane >> 4;
  const int head = item & 31, c = (item >> 5) & 31, b = item >> 10, g = head >> 3;
  u16* Bs = (u16*)(smem_raw + SS_B);
  u16* Xs = (u16*)(smem_raw + SS_R2);
  u16* Hs = (u16*)(smem_raw + SS_H);
  float* s_acs = (float*)(smem_raw + SS_F);
  float* s_dt = s_acs + 128;
  const size_t row0 = (size_t)b * 4096 + c * 128;
  if (tid < 128) {
    s_acs[tid] = p.ACS[(row0 + tid) * 32 + head];
    s_dt[tid] = p.DT[(row0 + tid) * 32 + head];
  }
#pragma unroll
  for (int i = 0; i < 8; ++i) {
    const int idx = tid + 256 * i, row = idx >> 4, ch = idx & 15;
    *(uint4*)(Bs + row * LDW + ch * 8) = *(const uint4*)(p.XBCC + (row0 + row) * 3072 + 2048 + g * 128 + ch * 8);
  }
#pragma unroll
  for (int i = 0; i < 4; ++i) {
    const int row = (tid >> 3) + 32 * i, ch = tid & 7;
    *(uint4*)(Xs + row * LDT + ch * 8) = *(const uint4*)(p.XBCC + (row0 + row) * 3072 + head * 64 + ch * 8);
  }
  {
    const u16* hp = p.STATES + (size_t)item * 64 * 128;
#pragma unroll
    for (int i = 0; i < 4; ++i) {
      const int idx = tid + 256 * i, pp = idx >> 4, ch = idx & 15;
      *(uint4*)(Hs + pp * LDW + ch * 8) = *(const uint4*)(hp + pp * 128 + ch * 8);
    }
  }
  bf16x8 cf[2][4];
#pragma unroll
  for (int sub = 0; sub < 2; ++sub)
#pragma unroll
    for (int ks = 0; ks < 4; ++ks)
      cf[sub][ks] = *(const bf16x8*)(p.XBCC + (row0 + w * 32 + sub * 16 + l15) * 3072 + 2560 + g * 128 + ks * 32 + G * 8);
  uint2 zpre[2][4];
#pragma unroll
  for (int sub = 0; sub < 2; ++sub)
#pragma unroll
    for (int m = 0; m < 4; ++m)
      zpre[sub][m] = *(const uint2*)(p.Z + (row0 + w * 32 + sub * 16 + l15) * 2048 + head * 64 + 16 * m + 4 * G);
  __syncthreads();
  const float Dh = p.ssm_D[head];
#pragma unroll
  for (int sub = 0; sub < 2; ++sub) {
    const int l0 = w * 32 + sub * 16, lq = l0 + l15;
    const float acs_q = s_acs[lq];
    f32x4 yo[4];
#pragma unroll
    for (int m = 0; m < 4; ++m) {
      f32x4 z = {0.f, 0.f, 0.f, 0.f};
#pragma unroll
      for (int ks = 0; ks < 4; ++ks) z = MFMA16(*(const bf16x8*)(Hs + (16 * m + l15) * LDW + ks * 32 + G * 8), cf[sub][ks], z);
      yo[m] = z;
    }
    {
      const float ea = __expf(acs_q);
#pragma unroll
      for (int m = 0; m < 4; ++m) { yo[m][0] *= ea; yo[m][1] *= ea; yo[m][2] *= ea; yo[m][3] *= ea; }
    }
    const int ns = (l0 >> 4) + 1, nsteps = (ns + 1) >> 1;
#pragma unroll 1
    for (int step = 0; step < nsteps; ++step) {
      unsigned pw[4];
#pragma unroll
      for (int h2 = 0; h2 < 2; ++h2) {
        const int ss = 2 * step + h2;
        f32x4 st = {0.f, 0.f, 0.f, 0.f};
#pragma unroll
        for (int ks = 0; ks < 4; ++ks) st = MFMA16(*(const bf16x8*)(Bs + (16 * ss + l15) * LDW + ks * 32 + G * 8), cf[sub][ks], st);
        float mv[4];
#pragma unroll
        for (int j = 0; j < 4; ++j) {
          const int s = 16 * ss + 4 * G + j;
          const float dec = __expf(fminf(acs_q - s_acs[s], 0.f)) * s_dt[s];
          mv[j] = (s <= lq) ? st[j] * dec : 0.f;
        }
        pw[2 * h2] = pack2(mv[0], mv[1]);
        pw[2 * h2 + 1] = pack2(mv[2], mv[3]);
      }
      const bf16x8 pb = words_to_frag(pw[0], pw[1], pw[2], pw[3]);
      const u16* xa = Xs + (32 * step + 4 * G + (l15 >> 2)) * LDT + (l15 & 3) * 4;
#pragma unroll
      for (int m = 0; m < 4; ++m) yo[m] = MFMA16(cat4(tr_read(xa + 16 * m), tr_read(xa + 16 * LDT + 16 * m)), pb, yo[m]);
    }
    const size_t rowg = (size_t)b * 4096 + c * 128 + lq;
    float ssq = 0.f;
#pragma unroll
    for (int m = 0; m < 4; ++m) {
      const uint2 xv = *(const uint2*)(Xs + lq * LDT + 16 * m + 4 * G);
      const uint2 zv = zpre[sub][m];
      const float xf[4] = {lo_f(xv.x), hi_f(xv.x), lo_f(xv.y), hi_f(xv.y)};
      const float zf[4] = {lo_f(zv.x), hi_f(zv.x), lo_f(zv.y), hi_f(zv.y)};
      float y[4];
#pragma unroll
      for (int j = 0; j < 4; ++j) {
        y[j] = (yo[m][j] + Dh * xf[j]) * silu_f(zf[j]);
        ssq += y[j] * y[j];
      }
      uint2 ov; ov.x = pack2(y[0], y[1]); ov.y = pack2(y[2], y[3]);
      *(uint2*)(p.YG + rowg * 2048 + head * 64 + 16 * m + 4 * G) = ov;
    }
    ssq += __shfl_xor(ssq, 16);
    ssq += __shfl_xor(ssq, 32);
    if (G == 0) p.SSQ[rowg * 32 + head] = ssq;
  }
  __syncthreads();
}

#define XB_TMO      128
#define XB_XCNT(j)  (256  + 64 * (j))
#define XB_XSUB(j)  (1280 + 64 * (j))
#define XB_XGEN(j)  (2304 + 64 * (j))
#define XB_TOP      3328
#define XB_TOPGEN   3392
#define XCD_BAR_WORDS 3456
#define XB_SPIN_CAP (1u << 20)
#define LAS __attribute__((address_space(3)))
DI unsigned xb_ld(unsigned* p) { return __hip_atomic_load(p, __ATOMIC_RELAXED, __HIP_MEMORY_SCOPE_AGENT); }
DI unsigned xb_add(unsigned* p, unsigned v) { return __hip_atomic_fetch_add(p, v, __ATOMIC_RELAXED, __HIP_MEMORY_SCOPE_AGENT); }
DI unsigned xb_xcc_id() { return (unsigned)__builtin_amdgcn_s_getreg((3 << 11) | 20) & 0xFu; }
#define XB_SPIN(cond, bar) do { unsigned _sp = 0; while (cond) { __builtin_amdgcn_s_sleep(1); \
    if ((++_sp & 255u) == 0u) { if (xb_ld(&(bar)[XB_TMO])) break; if (_sp > XB_SPIN_CAP) { atomicAdd(&(bar)[XB_TMO], 1u); break; } } } } while (0)
struct XcdBarrier { unsigned* bar; unsigned x; volatile LAS unsigned* st; };
DI XcdBarrier xcd_barrier_post(unsigned* bar, volatile LAS unsigned* st) {
  XcdBarrier b; b.bar = bar; b.x = xb_xcc_id(); b.st = st;
  if (threadIdx.x == 0) (void)xb_add(&bar[XB_XCNT(b.x)], 1u);
  return b;
}
DI void xcd_barrier_complete(unsigned* bar, unsigned x, unsigned& nloc, unsigned& nx) {
  const unsigned Gn = gridDim.x * gridDim.y * gridDim.z;
  unsigned sum, cnt, mine, sp = 0u;
  for (;;) {
    sum = 0u; cnt = 0u; mine = 0u;
#pragma unroll
    for (unsigned j = 0; j < 16; ++j) { const unsigned c = xb_ld(&bar[XB_XCNT(j)]); sum += c; cnt += (c > 0u) ? 1u : 0u; mine = (j == x) ? c : mine; }
    if (sum == Gn) break;
    __builtin_amdgcn_s_sleep(1);
    if ((++sp & 255u) == 0u) { if (xb_ld(&bar[XB_TMO])) break; if (sp > XB_SPIN_CAP) { atomicAdd(&bar[XB_TMO], 1u); break; } }
  }
  nloc = mine > 0u ? mine : 1u; nx = cnt > 0u ? cnt : 1u;
}
DI void xcd_barrier(const XcdBarrier& b) {
  asm volatile("s_waitcnt vmcnt(0)" ::: "memory");
  __syncthreads();
  if (threadIdx.x == 0) {
    unsigned* bar = b.bar;
    __builtin_amdgcn_s_waitcnt(0);
    unsigned nloc = b.st[0], nx = b.st[1];
    if (nloc == 0u) { xcd_barrier_complete(bar, b.x, nloc, nx); b.st[0] = nloc; b.st[1] = nx; }
    const unsigned old = xb_add(&bar[XB_XSUB(b.x)], 1u);
    const unsigned gen = old / nloc;
    if (old + 1u == (gen + 1u) * nloc) {
      __builtin_amdgcn_fence(__ATOMIC_RELEASE, "agent");
      asm volatile("s_waitcnt vmcnt(0)" ::: "memory");
      const unsigned og = xb_add(&bar[XB_TOP], 1u);
      const unsigned tg = og / nx;
      if (og + 1u == (tg + 1u) * nx) xb_add(&bar[XB_TOPGEN], 1u);
      else XB_SPIN(xb_ld(&bar[XB_TOPGEN]) == tg, bar);
      __builtin_amdgcn_fence(__ATOMIC_ACQUIRE, "agent");
      xb_add(&bar[XB_XGEN(b.x)], 1u);
      asm volatile("s_waitcnt vmcnt(0)" ::: "memory");
    } else {
      XB_SPIN(xb_ld(&bar[XB_XGEN(b.x)]) == gen, bar);
      __builtin_amdgcn_fence(__ATOMIC_ACQUIRE, "agent");
      asm volatile("s_waitcnt vmcnt(0)" ::: "memory");
    }
  }
  __syncthreads();
}

constexpr int NPHASE = 13;
#ifndef PH_MASK
#define PH_MASK 0x1fff
#endif
#define PH_ON(k) (((PH_MASK) >> (k)) & 1)
#ifndef PH_REPEAT
#define PH_REPEAT 0
#endif
#define PH_REP(k) (((PH_REPEAT) >> (k)) & 1)

template <bool COOP>
__global__ void __launch_bounds__(256, 2) mega(Params p, int ph0, int ph1) {
  extern __shared__ __attribute__((aligned(16))) char smem_raw[];
  u16* smem = (u16*)smem_raw;
#define PHASE_BODY(k)                                                                                                   \
  do {                                                                                                                  \
    if (k == 0) { if (PH_ON(0)) phase_prep(p, smem); }                                                                  \
    else if (k == 1) { if (PH_ON(1)) gemm_phase_glds(p.H, p.Wt1, 1024, MROWS / 128, ATT_IN / 128, Ep1{p}, smem_raw); }  \
    else if (k == 2) { if (PH_ON(2)) phase_attn(p, smem); }                                                             \
    else if (k == 3) { if (PH_ON(3)) phase_merge(p); }                                                                  \
    else if (k == 4) { if (PH_ON(4)) gemm_phase_glds(p.H, p.Wt2, 1024, MROWS / 128, 8, Ep2{p}, smem_raw); }             \
    else if (k == 5) { if (PH_ON(5)) phase_norm2(p); }                                                                  \
    else if (k == 6) { if (PH_ON(6)) gemm_phase_glds(p.H, p.Wt3, 1024, MROWS / 128, SSM_IN_PAD / 128, Ep3{p}, smem_raw); } \
    else if (k == 7) { if (PH_ON(7)) phase_convpass(p); }                                                               \
    else if (k == 8) { if (PH_ON(8)) phase_states(p, smem_raw); }                                                       \
    else if (k == 9) { if (PH_ON(9)) phase_scan(p); }                                                                   \
    else if (k == 10) { if (PH_ON(10)) for (int it = blockIdx.x; it < 4096; it += gridDim.x) ssd_out_item(p, it, smem_raw); } \
    else if (k == 11) { if (PH_ON(11)) phase_gatenorm(p); }                                                             \
    else if (k == 12) { if (PH_ON(12)) gemm_phase_glds(p.YG, p.Wt4, 2048, MROWS / 128, 8, Ep4{p}, smem_raw); }          \
  } while (0)
#define PHASE_STEP(k) PHASE_BODY(k); if (PH_REP(k)) { xcd_barrier(xb); PHASE_BODY(k); }
  if constexpr (COOP) {
    volatile LAS unsigned* xst = (volatile LAS unsigned*)(smem_raw + LDS_MAIN);
    if (threadIdx.x == 0) { xst[0] = 0u; xst[1] = 0u; }
    __syncthreads();
    const XcdBarrier xb = xcd_barrier_post(p.bar, xst);
    if (ph0 == 0x7fffffff) cg::this_grid().sync();
    PHASE_STEP(0) xcd_barrier(xb);
    PHASE_STEP(1) xcd_barrier(xb);
    PHASE_STEP(2) xcd_barrier(xb);
    PHASE_STEP(3) xcd_barrier(xb);
    PHASE_STEP(4) xcd_barrier(xb);
    PHASE_STEP(5) xcd_barrier(xb);
    PHASE_STEP(6) xcd_barrier(xb);
    PHASE_STEP(7) xcd_barrier(xb);
    PHASE_STEP(8) xcd_barrier(xb);
    PHASE_STEP(9) xcd_barrier(xb);
    PHASE_STEP(10) xcd_barrier(xb);
    PHASE_STEP(11) xcd_barrier(xb);
    PHASE_STEP(12)
  } else {
    switch (ph0) {
      case 0: PHASE_BODY(0); break;
      case 1: PHASE_BODY(1); break;
      case 2: PHASE_BODY(2); break;
      case 3: PHASE_BODY(3); break;
      case 4: PHASE_BODY(4); break;
      case 5: PHASE_BODY(5); break;
      case 6: PHASE_BODY(6); break;
      case 7: PHASE_BODY(7); break;
      case 8: PHASE_BODY(8); break;
      case 9: PHASE_BODY(9); break;
      case 10: PHASE_BODY(10); break;
      case 11: PHASE_BODY(11); break;
      case 12: PHASE_BODY(12); break;
    }
  }
}

#ifndef MULTI_LAUNCH
#define MULTI_LAUNCH 0
#endif

extern "C" void kernel_launch(void* const* d_in, const int* in_sizes, int n_in, void* d_out, int out_size, void* d_ws, size_t ws_size,
                              hipStream_t stream) {
  static int grid = 0;
  size_t off = 0;
  auto carve = [&](size_t bytes) { size_t o = off; off += (bytes + 255) & ~(size_t)255; return (char*)d_ws + o; };
  Params p{};
  p.x_prompt = (const float*)d_in[0]; p.x_sample = (const float*)d_in[1];
  p.cache0 = (const float*)d_in[2]; p.cache1 = (const float*)d_in[3]; p.cache2 = (const float*)d_in[4];
  p.state_conv = (const float*)d_in[5]; p.state_ssm = (const float*)d_in[6];
  p.attn_norm = (const float*)d_in[7]; p.attn_w_in = (const float*)d_in[8]; p.attn_q_gain = (const float*)d_in[9];
  p.attn_k_gain = (const float*)d_in[10]; p.attn_w_out = (const float*)d_in[11];
  p.ssm_norm = (const float*)d_in[12]; p.ssm_w_in = (const float*)d_in[13]; p.ssm_conv_w = (const float*)d_in[14];
  p.ssm_conv_b = (const float*)d_in[15]; p.ssm_dt_bias = (const float*)d_in[16]; p.ssm_A_log = (const float*)d_in[17];
  p.ssm_D = (const float*)d_in[18]; p.ssm_gate_norm = (const float*)d_in[19]; p.ssm_w_out = (const float*)d_in[20];
  p.out = (float*)d_out;
  p.Wt1 = (u16*)carve((size_t)ATT_IN * 1024 * 2);
  p.Wt2 = (u16*)carve((size_t)1024 * 1024 * 2);
  p.Wt3 = (u16*)carve((size_t)SSM_IN_PAD * 1024 * 2);
  p.Wt4 = (u16*)carve((size_t)1024 * 2048 * 2);
  p.H = (u16*)carve((size_t)MROWS * 1024 * 2);
  p.QKVG = (u16*)carve((size_t)MROWS * ATT_IN * 2);
  p.OG = (u16*)carve((size_t)MROWS * 3072 * 2);
  p.Z = (u16*)carve((size_t)MROWS * 2048 * 2);
  p.XBC = (u16*)carve((size_t)MROWS * 3072 * 2);
  p.YG = (u16*)carve((size_t)MROWS * 2048 * 2);
  p.LSE = (float*)carve((size_t)MROWS * 48 * 4);
  p.X1 = (float*)carve((size_t)MROWS * 1024 * 4);
  p.DT = (float*)carve((size_t)MROWS * 32 * 4);
  p.STATES = (u16*)carve((size_t)4 * 32 * 32 * 64 * 128 * 2);
  p.XBCC = (u16*)carve((size_t)PROWS * 3072 * 2);
  p.ACS = (float*)carve((size_t)PROWS * 32 * 4);
  p.bar = (unsigned*)carve((size_t)XCD_BAR_WORDS * 4);
  p.SSQ = (float*)carve((size_t)MROWS * 32 * 4);
  p.CD = (float*)carve((size_t)4 * 32 * 32 * 4);
  if (grid == 0) {
    if (n_in != 21 || (size_t)out_size != O_END || ws_size < off) {
      fprintf(stderr, "kernel_launch: unexpected shapes: n_in %d out %d (want %zu) ws %zu (need %zu)\n", n_in, out_size, (size_t)O_END, ws_size, off);
      grid = -1; return;
    }
    int dev = 0, cus = 0, per_cu = 0;
    hipGetDevice(&dev);
    hipDeviceGetAttribute(&cus, hipDeviceAttributeMultiprocessorCount, dev);
    hipFuncSetAttribute((const void*)mega<true>, hipFuncAttributeMaxDynamicSharedMemorySize, LDS_BYTES);
    hipFuncSetAttribute((const void*)mega<false>, hipFuncAttributeMaxDynamicSharedMemorySize, LDS_BYTES);
    hipOccupancyMaxActiveBlocksPerMultiprocessor(&per_cu, (const void*)mega<true>, 256, LDS_BYTES);
    if (per_cu < 1) { fprintf(stderr, "kernel_launch: occupancy query returned %d\n", per_cu); grid = -1; return; }
    if (per_cu > 2) per_cu = 2;
    grid = cus * per_cu;
    grid &= ~7;
  }
  if (grid < 0) return;
#if MULTI_LAUNCH
  for (int ph = 0; ph < NPHASE; ++ph) hipLaunchKernelGGL(mega<false>, dim3(grid), dim3(256), LDS_BYTES, stream, p, ph, ph + 1);
#else
  hipMemsetAsync(p.bar, 0, (size_t)XCD_BAR_WORDS * 4, stream);
  int ph0 = 0, ph1 = NPHASE;
  void* args[] = {&p, &ph0, &ph1};
  hipError_t e = hipLaunchCooperativeKernel((const void*)mega<true>, dim3(grid), dim3(256), args, LDS_BYTES, stream);
  if (e != hipSuccess) fprintf(stderr, "cooperative launch failed: %s (grid %d)\n", hipGetErrorString(e), grid);
#endif
}
```

```cpp
#include <hip/hip_runtime.h>
#include <hip/hip_cooperative_groups.h>
#include <cstdio>
#include <cstdint>
namespace cg = cooperative_groups;

typedef unsigned short u16;
typedef short bf16x8 __attribute__((ext_vector_type(8)));
typedef short s16x4 __attribute__((ext_vector_type(4)));
typedef float f32x4 __attribute__((ext_vector_type(4)));

#define DI __device__ __forceinline__
#define MFMA16(a, b, c) __builtin_amdgcn_mfma_f32_16x16x32_bf16((a), (b), (c), 0, 0, 0)

constexpr int MROWS = 16384 + 256;
constexpr int PROWS = 16384;
constexpr int ATT_IN = 10240;
constexpr int SSM_IN = 5152;
constexpr int SSM_IN_PAD = 5248;
constexpr int LDS_MAIN = 73728;
constexpr int LDS_BYTES = LDS_MAIN + 16;
constexpr int LDT = 72;
constexpr int LDW = 136;
constexpr int TILE_ELEMS = 128 * LDT;

constexpr size_t O_Y = 0;
constexpr size_t O_KVP0 = (size_t)MROWS * 1024;
constexpr size_t O_KVP1 = O_KVP0 + (size_t)4 * 128 * 2048;
constexpr size_t O_KVP2 = O_KVP1 + (size_t)4 * 512 * 2048;
constexpr size_t O_KVS0 = O_KVP2 + (size_t)4 * 2048 * 2048;
constexpr size_t O_KVS1 = O_KVS0 + (size_t)256 * 2048;
constexpr size_t O_KVS2 = O_KVS1 + (size_t)256 * 2048;
constexpr size_t O_CONVP = O_KVS2 + (size_t)256 * 2048;
constexpr size_t O_CONVS = O_CONVP + (size_t)4 * 3 * 3072;
constexpr size_t O_SSMP = O_CONVS + (size_t)32 * 3 * 3072;
constexpr size_t O_SSMS = O_SSMP + (size_t)4 * 32 * 64 * 128;
constexpr size_t O_END = O_SSMS + (size_t)32 * 32 * 64 * 128;

struct Params {
  const float *x_prompt, *x_sample, *cache0, *cache1, *cache2, *state_conv, *state_ssm;
  const float *attn_norm, *attn_w_in, *attn_q_gain, *attn_k_gain, *attn_w_out;
  const float *ssm_norm, *ssm_w_in, *ssm_conv_w, *ssm_conv_b, *ssm_dt_bias, *ssm_A_log, *ssm_D, *ssm_gate_norm, *ssm_w_out;
  float* out;
  u16 *Wt1, *Wt2, *Wt3, *Wt4, *H, *QKVG, *OG, *Z, *XBC, *YG, *XBCC, *STATES, *QKVH;
  float *LSE, *X1, *DT, *SSQ, *CD, *ACS;
  unsigned* bar;
};

typedef __bf16 bf16v2 __attribute__((ext_vector_type(2)));
DI u16 f2bf(float x) { return __builtin_bit_cast(u16, (__bf16)x); }
DI float bf2f(u16 h) { return __uint_as_float(((unsigned)h) << 16); }
DI unsigned pack2(float a, float b) { bf16v2 v; v[0] = (__bf16)a; v[1] = (__bf16)b; return __builtin_bit_cast(unsigned, v); }
DI float lo_f(unsigned w) { return __uint_as_float(w << 16); }
DI float hi_f(unsigned w) { return __uint_as_float(w & 0xffff0000u); }
DI void unpack8(const uint4& v, float* f) {
  f[0] = lo_f(v.x); f[1] = hi_f(v.x); f[2] = lo_f(v.y); f[3] = hi_f(v.y);
  f[4] = lo_f(v.z); f[5] = hi_f(v.z); f[6] = lo_f(v.w); f[7] = hi_f(v.w);
}
DI uint4 pack8(const float* f) {
  uint4 v; v.x = pack2(f[0], f[1]); v.y = pack2(f[2], f[3]); v.z = pack2(f[4], f[5]); v.w = pack2(f[6], f[7]); return v;
}
DI float sum16(float v) {
  v += __builtin_bit_cast(float, __builtin_amdgcn_update_dpp(0, __builtin_bit_cast(int, v), 0xB1, 0xf, 0xf, true));
  v += __builtin_bit_cast(float, __builtin_amdgcn_update_dpp(0, __builtin_bit_cast(int, v), 0x4E, 0xf, 0xf, true));
  v += __builtin_bit_cast(float, __builtin_amdgcn_update_dpp(0, __builtin_bit_cast(int, v), 0x141, 0xf, 0xf, true));
  v += __builtin_bit_cast(float, __builtin_amdgcn_update_dpp(0, __builtin_bit_cast(int, v), 0x140, 0xf, 0xf, true));
  return v;
}
DI float sum4(float v) {
  v += __builtin_bit_cast(float, __builtin_amdgcn_update_dpp(0, __builtin_bit_cast(int, v), 0xB1, 0xf, 0xf, true));
  v += __builtin_bit_cast(float, __builtin_amdgcn_update_dpp(0, __builtin_bit_cast(int, v), 0x4E, 0xf, 0xf, true));
  return v;
}
DI float silu_f(float x) { return x / (1.f + __expf(-x)); }
DI s16x4 tr_read(const u16* ptr) {
  return __builtin_amdgcn_ds_read_tr16_b64_v4i16((s16x4 __attribute__((address_space(3)))*)(ptr));
}
DI bf16x8 cat4(s16x4 lo, s16x4 hi) { return __builtin_shufflevector(lo, hi, 0, 1, 2, 3, 4, 5, 6, 7); }
DI bf16x8 words_to_frag(unsigned a, unsigned b, unsigned c, unsigned d) {
  uint4 v; v.x = a; v.y = b; v.z = c; v.w = d; return __builtin_bit_cast(bf16x8, v);
}

constexpr int GT_BYTES = 16384;
template <class EP>
DI void gemm_tile_glds(const u16* __restrict__ A, const u16* __restrict__ Bt, int K, int m0, int n0, const EP& ep, char* smem) {
  const int tid = threadIdx.x, lane = tid & 63, w = tid >> 6, wr = w >> 1, wc = w & 1;
  const int l15 = lane & 15, G = lane >> 4;
  char* As = smem;
  char* Bs = smem + 2 * GT_BYTES;
  f32x4 acc[4][4];
#pragma unroll
  for (int m = 0; m < 4; ++m)
#pragma unroll
    for (int n = 0; n < 4; ++n) acc[m][n] = (f32x4){0.f, 0.f, 0.f, 0.f};
  const int srr = lane >> 3, sc = ((lane & 7) ^ srr) * 8;
  const u16* ag = A + (size_t)(m0 + w * 32 + srr) * K + sc;
  const u16* bg = Bt + (size_t)(n0 + w * 32 + srr) * K + sc;
  const int lofs = (w * 4) * 1024 + lane * 16;
  const int rofs = (l15 >> 3) * 1024 + (l15 & 7) * 128 + ((G ^ (l15 & 7)) << 4);
  const int nk = K >> 6;
#define GLDS_STAGE(buf, k0)                                                                                             \
  do {                                                                                                                  \
    _Pragma("unroll") for (int i = 0; i < 4; ++i) {                                                                     \
      __builtin_amdgcn_global_load_lds((const unsigned*)(ag + (size_t)(i * 8) * K + (k0)),                             \
                                       (unsigned*)(As + (buf) * GT_BYTES + lofs + i * 1024), 16, 0, 0);                 \
      __builtin_amdgcn_global_load_lds((const unsigned*)(bg + (size_t)(i * 8) * K + (k0)),                             \
                                       (unsigned*)(Bs + (buf) * GT_BYTES + lofs + i * 1024), 16, 0, 0);                 \
    }                                                                                                                   \
  } while (0)
  GLDS_STAGE(0, 0);
  asm volatile("s_waitcnt vmcnt(0)" ::: "memory");
  __syncthreads();
  for (int kt = 0; kt < nk; ++kt) {
    const int buf = kt & 1;
    if (kt + 1 < nk) GLDS_STAGE(buf ^ 1, (kt + 1) << 6);
    const char* Ab = As + buf * GT_BYTES + wr * 8192 + rofs;
    const char* Bb = Bs + buf * GT_BYTES + wc * 8192 + rofs;
#pragma unroll
    for (int ks = 0; ks < 2; ++ks) {
      bf16x8 a[4], b[4];
#pragma unroll
      for (int m = 0; m < 4; ++m) a[m] = *(const bf16x8*)(As + (((buf * GT_BYTES + wr * 8192 + rofs) ^ (ks * 64)) + m * 2048));
#pragma unroll
      for (int n = 0; n < 4; ++n) b[n] = *(const bf16x8*)(Bs + (((buf * GT_BYTES + wc * 8192 + rofs) ^ (ks * 64)) + n * 2048));
#pragma unroll
      for (int m = 0; m < 4; ++m)
#pragma unroll
        for (int n = 0; n < 4; ++n) acc[m][n] = MFMA16(a[m], b[n], acc[m][n]);
    }
    asm volatile("s_waitcnt vmcnt(0)" ::: "memory");
    __syncthreads();
  }
#undef GLDS_STAGE
  ep(acc, m0 + wr * 64, n0 + wc * 64, lane);
}

template <class EP>
DI void gemm_phase_glds(const u16* A, const u16* Bt, int K, int MT, int NT, const EP& ep, char* smem) {
  const int x = blockIdx.x & 7, j = blockIdx.x >> 3, per = gridDim.x >> 3;
  const int T = MT * NT, fullT = (MT >> 3) * 8 * NT, hlast = MT & 7;
  for (int it = 0;; ++it) {
    const int v = it * per + j;
    const int s = (x + 8 * (v >> 6)) * 64 + (v & 63);
    if ((x + 8 * (v >> 6)) * 64 >= T) break;
    if (s >= T) continue;
    int mt, nt;
    if (s < fullT) { const int band = s / (8 * NT), within = s - band * 8 * NT; nt = within >> 3; mt = band * 8 + (within & 7); }
    else { const int sp = s - fullT; nt = sp / hlast; mt = (MT >> 3) * 8 + (sp - nt * hlast); }
    gemm_tile_glds(A, Bt, K, mt * 128, nt * 128, ep, smem);
  }
}

DI unsigned merge_word(unsigned a, unsigned b, unsigned c, unsigned g, float e0, float e1, float e2) {
  const float lo = (e0 * lo_f(a) + e1 * lo_f(b) + e2 * lo_f(c)) * silu_f(lo_f(g));
  const float hi = (e0 * hi_f(a) + e1 * hi_f(b) + e2 * hi_f(c)) * silu_f(hi_f(g));
  return pack2(lo, hi);
}
DI void phase_merge(const Params& p) {
  const int lane = threadIdx.x & 63;
  for (int it = blockIdx.x; it < MROWS / 4; it += gridDim.x) {
    const size_t row = (size_t)it * 4 + (threadIdx.x >> 6);
    const int k = lane * 16, head = lane >> 2;
    const float* lp = p.LSE + row * 48 + head;
    const float l0 = lp[0], l1 = lp[16], l2 = lp[32];
    const u16* op = p.OG + row * 3072 + k;
    const u16* gp = p.QKVG + row * ATT_IN + 9216 + k;
    uint4 a[2], b[2], c[2], g[2];
#pragma unroll
    for (int h = 0; h < 2; ++h) {
      a[h] = *(const uint4*)(op + h * 8); b[h] = *(const uint4*)(op + 1024 + h * 8); c[h] = *(const uint4*)(op + 2048 + h * 8);
      g[h] = *(const uint4*)(gp + h * 8);
    }
    const float mx = fmaxf(l0, fmaxf(l1, l2));
    float e0 = __expf(l0 - mx), e1 = __expf(l1 - mx), e2 = __expf(l2 - mx);
    const float inv = 1.f / (e0 + e1 + e2);
    e0 *= inv; e1 *= inv; e2 *= inv;
#pragma unroll
    for (int h = 0; h < 2; ++h) {
      uint4 o;
      o.x = merge_word(a[h].x, b[h].x, c[h].x, g[h].x, e0, e1, e2);
      o.y = merge_word(a[h].y, b[h].y, c[h].y, g[h].y, e0, e1, e2);
      o.z = merge_word(a[h].z, b[h].z, c[h].z, g[h].z, e0, e1, e2);
      o.w = merge_word(a[h].w, b[h].w, c[h].w, g[h].w, e0, e1, e2);
      *(uint4*)(p.H + row * 1024 + k + h * 8) = o;
    }
  }
}
DI void phase_gatenorm(const Params& p) {
  const int lane = threadIdx.x & 63;
  for (int it = blockIdx.x; it < MROWS / 4; it += gridDim.x) {
    const size_t row = (size_t)it * 4 + (threadIdx.x >> 6);
    const int k = lane * 32;
    const float* sp = p.SSQ + row * 32 + (lane >> 4) * 8;
    const float4 s0 = *(const float4*)sp, s1 = *(const float4*)(sp + 4);
    const float ss = (s0.x + s0.y) + (s0.z + s0.w) + (s1.x + s1.y) + (s1.z + s1.w);
    const float rstd = rsqrtf(ss * (1.f / 512.f) + 1e-5f);
    u16* yp = p.YG + row * 2048 + k;
    uint4 y[4];
#pragma unroll
    for (int h = 0; h < 4; ++h) y[h] = *(const uint4*)(yp + h * 8);
#pragma unroll
    for (int h = 0; h < 4; ++h) {
      const float4 g0 = *(const float4*)(p.ssm_gate_norm + k + h * 8), g1 = *(const float4*)(p.ssm_gate_norm + k + h * 8 + 4);
      uint4 o;
      o.x = pack2(lo_f(y[h].x) * rstd * g0.x, hi_f(y[h].x) * rstd * g0.y);
      o.y = pack2(lo_f(y[h].y) * rstd * g0.z, hi_f(y[h].y) * rstd * g0.w);
      o.z = pack2(lo_f(y[h].z) * rstd * g1.x, hi_f(y[h].z) * rstd * g1.y);
      o.w = pack2(lo_f(y[h].w) * rstd * g1.z, hi_f(y[h].w) * rstd * g1.w);
      *(uint4*)(yp + h * 8) = o;
    }
  }
}

struct Ep1 {
  const Params& p;
  DI void operator()(f32x4 (&acc)[4][4], int r0, int c0, int lane) const {
    const int l15 = lane & 15, G = lane >> 4;
    int kind, g = 0, head;
    if (c0 >= 9216) { kind = 3; head = (c0 - 9216) >> 6; }
    else { g = c0 / 3072; const int rem = c0 - g * 3072; kind = rem >> 10; head = (rem & 1023) >> 6; }
    if (kind < 2) {
      const float* gp = (kind == 0 ? p.attn_q_gain : p.attn_k_gain) + g * 64;
      float gain[4];
#pragma unroll
      for (int n = 0; n < 4; ++n) gain[n] = gp[n * 16 + l15];
      const float post = (kind == 0) ? 0.125f : 1.f;
#pragma unroll
      for (int m = 0; m < 4; ++m)
#pragma unroll
        for (int j = 0; j < 4; ++j) {
          float ss = 0.f;
#pragma unroll
          for (int n = 0; n < 4; ++n) ss += acc[m][n][j] * acc[m][n][j];
          ss = sum16(ss);
          const float sc = rsqrtf(ss * (1.f / 64.f) + 1e-6f) * post;
#pragma unroll
          for (int n = 0; n < 4; ++n) acc[m][n][j] *= sc * gain[n];
        }
    }
    if (kind < 3 && r0 < PROWS) {
      const int dsh = 2 * g;
      const size_t hb = ((size_t)(((r0 >> 12) * 3 + g) * 3 + kind) * 16 + head) * 4096;
#pragma unroll
      for (int m = 0; m < 4; ++m)
#pragma unroll
        for (int j = 0; j < 4; ++j) {
          const int t = (r0 + m * 16 + G * 4 + j) & 4095;
          const int pos = (t & ((1 << dsh) - 1)) * (4096 >> dsh) + (t >> dsh);
          u16* dst = p.QKVH + (hb + pos) * 64 + l15;
#pragma unroll
          for (int n = 0; n < 4; ++n) dst[n * 16] = f2bf(acc[m][n][j]);
        }
    } else {
#pragma unroll
      for (int m = 0; m < 4; ++m)
#pragma unroll
        for (int j = 0; j < 4; ++j) {
          const int row = r0 + m * 16 + G * 4 + j;
          u16* dst = p.QKVG + (size_t)row * ATT_IN + c0 + l15;
#pragma unroll
          for (int n = 0; n < 4; ++n) dst[n * 16] = f2bf(acc[m][n][j]);
        }
    }
    if (kind == 1 || kind == 2) {
      const int keep = 128 << (2 * g);
      const size_t okp = (g == 0) ? O_KVP0 : (g == 1) ? O_KVP1 : O_KVP2;
      const size_t oks = (g == 0) ? O_KVS0 : (g == 1) ? O_KVS1 : O_KVS2;
#pragma unroll
      for (int m = 0; m < 4; ++m)
#pragma unroll
        for (int j = 0; j < 4; ++j) {
          const int row = r0 + m * 16 + G * 4 + j;
          float* dst = nullptr;
          if (row < PROWS) {
            const int b = row >> 12, s = row & 4095;
            if (s >= 4096 - keep) dst = p.out + okp + ((size_t)(b * keep + s - (4096 - keep)) * 2 + (kind - 1)) * 1024 + head * 64 + l15;
          } else {
            dst = p.out + oks + ((size_t)(row - PROWS) * 2 + (kind - 1)) * 1024 + head * 64 + l15;
          }
          if (dst) {
#pragma unroll
            for (int n = 0; n < 4; ++n) dst[n * 16] = acc[m][n][j];
          }
        }
    }
  }
};
struct Ep2 {
  const Params& p;
  DI void operator()(f32x4 (&acc)[4][4], int r0, int c0, int lane) const {
    const int l15 = lane & 15, G = lane >> 4;
#pragma unroll
    for (int m = 0; m < 4; ++m)
#pragma unroll
      for (int j = 0; j < 4; ++j) {
        const int row = r0 + m * 16 + G * 4 + j;
        const float* xin = (row < PROWS) ? p.x_prompt + (size_t)row * 1024 : p.x_sample + (size_t)(row - PROWS) * 1024;
        float* dst = p.X1 + (size_t)row * 1024 + c0 + l15;
#pragma unroll
        for (int n = 0; n < 4; ++n) dst[n * 16] = xin[c0 + l15 + n * 16] + acc[m][n][j];
      }
  }
};
struct Ep3 {
  const Params& p;
  DI void operator()(f32x4 (&acc)[4][4], int r0, int c0, int lane) const {
    const int l15 = lane & 15, G = lane >> 4;
    if (c0 >= SSM_IN) return;
    if (c0 < 2048) {
#pragma unroll
      for (int m = 0; m < 4; ++m)
#pragma unroll
        for (int j = 0; j < 4; ++j) {
          const int row = r0 + m * 16 + G * 4 + j;
          u16* dst = p.Z + (size_t)row * 2048 + c0 + l15;
#pragma unroll
          for (int n = 0; n < 4; ++n) dst[n * 16] = f2bf(acc[m][n][j]);
        }
    } else if (c0 < 5120) {
      const int cc = c0 - 2048 + l15;
#pragma unroll
      for (int m = 0; m < 4; ++m)
#pragma unroll
        for (int j = 0; j < 4; ++j) {
          const int row = r0 + m * 16 + G * 4 + j;
          u16* dst = p.XBC + (size_t)row * 3072 + cc;
#pragma unroll
          for (int n = 0; n < 4; ++n) dst[n * 16] = f2bf(acc[m][n][j]);
          float* od = nullptr;
          if (row < PROWS) {
            const int b = row >> 12, s = row & 4095;
            if (s >= 4093) od = p.out + O_CONVP + (size_t)(b * 3 + s - 4093) * 3072 + cc;
          } else {
            const int rr = row - PROWS, b = rr >> 3, t = rr & 7;
            if (t >= 5) od = p.out + O_CONVS + (size_t)(b * 3 + t - 5) * 3072 + cc;
          }
          if (od) {
#pragma unroll
            for (int n = 0; n < 4; ++n) od[n * 16] = acc[m][n][j];
          }
        }
    } else {
#pragma unroll
      for (int m = 0; m < 4; ++m)
#pragma unroll
        for (int j = 0; j < 4; ++j) {
          const int row = r0 + m * 16 + G * 4 + j;
#pragma unroll
          for (int n = 0; n < 2; ++n) {
            const int h = n * 16 + l15;
            const float xv = acc[m][n][j] + p.ssm_dt_bias[h];
            p.DT[(size_t)row * 32 + h] = fmaxf(xv, 0.f) + log1pf(__expf(-fabsf(xv)));
          }
        }
    }
  }
};
struct Ep4 {
  const Params& p;
  DI void operator()(f32x4 (&acc)[4][4], int r0, int c0, int lane) const {
    const int l15 = lane & 15, G = lane >> 4;
#pragma unroll
    for (int m = 0; m < 4; ++m)
#pragma unroll
      for (int j = 0; j < 4; ++j) {
        const int row = r0 + m * 16 + G * 4 + j;
        const float* xin = p.X1 + (size_t)row * 1024 + c0 + l15;
        float* dst = p.out + O_Y + (size_t)row * 1024 + c0 + l15;
#pragma unroll
        for (int n = 0; n < 4; ++n) dst[n * 16] = xin[n * 16] + acc[m][n][j];
      }
  }
};

DI void transpose_task(const float* __restrict__ W, u16* __restrict__ Wt, int K, int N, int NTN, int tile, u16* smem) {
  const int tid = threadIdx.x;
  const int ktile = tile / NTN, ntile = tile % NTN;
  const int k0 = ktile * 64, n0 = ntile * 64;
#pragma unroll
  for (int i = 0; i < 4; ++i) {
    const int idx = tid + 256 * i;
    const int kk = idx >> 4, nq = idx & 15;
    const int n = n0 + nq * 4;
    float4 v = {0.f, 0.f, 0.f, 0.f};
    if (n < N) v = *(const float4*)(W + (size_t)(k0 + kk) * N + n);
    smem[(nq * 4 + 0) * LDT + kk] = f2bf(v.x);
    smem[(nq * 4 + 1) * LDT + kk] = f2bf(v.y);
    smem[(nq * 4 + 2) * LDT + kk] = f2bf(v.z);
    smem[(nq * 4 + 3) * LDT + kk] = f2bf(v.w);
  }
  __syncthreads();
#pragma unroll
  for (int i = 0; i < 2; ++i) {
    const int idx = tid + 256 * i;
    const int n = idx >> 3, kc = idx & 7;
    *(uint4*)(Wt + (size_t)(n0 + n) * K + k0 + kc * 8) = *(const uint4*)(smem + n * LDT + kc * 8);
  }
  __syncthreads();
}

DI void rmsnorm_row(const float* __restrict__ src, const float* __restrict__ wgt, u16* __restrict__ dst, int lane) {
  float4 v[4];
  float ss = 0.f;
#pragma unroll
  for (int i = 0; i < 4; ++i) {
    v[i] = *(const float4*)(src + lane * 4 + 256 * i);
    ss += v[i].x * v[i].x + v[i].y * v[i].y + v[i].z * v[i].z + v[i].w * v[i].w;
  }
  ss = sum16(ss);
  ss += __shfl_xor(ss, 16);
  ss += __shfl_xor(ss, 32);
  const float rstd = rsqrtf(ss * (1.f / 1024.f) + 1e-6f);
#pragma unroll
  for (int i = 0; i < 4; ++i) {
    const float4 g = *(const float4*)(wgt + lane * 4 + 256 * i);
    uint2 o;
    o.x = pack2(v[i].x * rstd * g.x, v[i].y * rstd * g.y);
    o.y = pack2(v[i].z * rstd * g.z, v[i].w * rstd * g.w);
    *(uint2*)(dst + lane * 4 + 256 * i) = o;
  }
}

constexpr int TR1 = 16 * 160, TR2 = 16 * 16, TR3 = 16 * 82, TR4 = 32 * 16;
DI void phase_prep(const Params& p, u16* smem) {
  constexpr int RT = MROWS / 4;
  for (int it = blockIdx.x; it < TR1 + RT; it += gridDim.x) {
    if (it < TR1) transpose_task(p.attn_w_in, p.Wt1, 1024, ATT_IN, 160, it, smem);
    else {
      const int row = (it - TR1) * 4 + (threadIdx.x >> 6);
      const float* src = (row < PROWS) ? p.x_prompt + (size_t)row * 1024 : p.x_sample + (size_t)(row - PROWS) * 1024;
      rmsnorm_row(src, p.attn_norm, p.H + (size_t)row * 1024, threadIdx.x & 63);
    }
  }
}
DI void late_transpose_task(const Params& p, int it, u16* smem) {
  if (it < TR2) transpose_task(p.attn_w_out, p.Wt2, 1024, 1024, 16, it, smem);
  else if (it < TR2 + TR3) transpose_task(p.ssm_w_in, p.Wt3, 1024, SSM_IN, 82, it - TR2, smem);
  else transpose_task(p.ssm_w_out, p.Wt4, 2048, 1024, 16, it - TR2 - TR3, smem);
}

DI void phase_norm2(const Params& p) {
  for (int it = blockIdx.x; it < MROWS / 4; it += gridDim.x) {
    const int row = it * 4 + (threadIdx.x >> 6);
    rmsnorm_row(p.X1 + (size_t)row * 1024, p.ssm_norm, p.H + (size_t)row * 1024, threadIdx.x & 63);
  }
}

struct PromptRegs { uint4 k[8], v[8]; bf16x8 q[2][2]; };
DI void attn_prompt_load(const Params& p, int item, PromptRegs& R) {
  const int tid = threadIdx.x, lane = tid & 63, w = tid >> 6, l15 = lane & 15, G = lane >> 4;
  const int rn = item & 31, head = (item >> 5) & 15, b = (item >> 9) & 3, g = item >> 11;
  const int dsh = 2 * g, dil = 1 << dsh, nbg = 32 >> dsh;
  const int r = rn / nbg, n = rn % nbg;
  const size_t hq = ((size_t)((b * 3 + g) * 3 + 0) * 16 + head) * 4096 + (size_t)r * (4096 >> dsh);
  const size_t hk = hq + (size_t)16 * 4096, hv = hq + (size_t)32 * 4096;
  (void)dil;
#pragma unroll
  for (int i = 0; i < 8; ++i) {
    const int c = tid + 256 * i;
    const int kj = c >> 3, ch = c & 7;
    const int u = (n - 1) * 128 + kj;
    R.k[i] = (uint4){0u, 0u, 0u, 0u}; R.v[i] = (uint4){0u, 0u, 0u, 0u};
    if (u >= 0) {
      R.k[i] = *(const uint4*)(p.QKVH + (hk + u) * 64 + ch * 8);
      R.v[i] = *(const uint4*)(p.QKVH + (hv + u) * 64 + ch * 8);
    }
  }
#pragma unroll
  for (int sub = 0; sub < 2; ++sub) {
    const u16* qp = p.QKVH + (hq + n * 128 + w * 32 + sub * 16 + l15) * 64 + G * 8;
    R.q[sub][0] = *(const bf16x8*)qp;
    R.q[sub][1] = *(const bf16x8*)(qp + 32);
  }
}
DI void attn_prompt_stage(const PromptRegs& R, u16* smem) {
  const int tid = threadIdx.x;
  u16* Ks = smem;
  u16* Vs = smem + 256 * LDT;
#pragma unroll
  for (int i = 0; i < 8; ++i) {
    const int c = tid + 256 * i;
    const int kj = c >> 3, ch = c & 7;
    *(uint4*)(Ks + kj * LDT + ch * 8) = R.k[i];
    *(uint4*)(Vs + kj * LDT + ch * 8) = R.v[i];
  }
}
DI void attn_prompt_compute(const Params& p, int item, const bf16x8 (&qpre)[2][2], u16* smem) {
  const int tid = threadIdx.x, lane = tid & 63, w = tid >> 6, l15 = lane & 15, G = lane >> 4;
  const int rn = item & 31, head = (item >> 5) & 15, b = (item >> 9) & 3, g = item >> 11;
  const int dsh = 2 * g, dil = 1 << dsh, nbg = 32 >> dsh;
  const int r = rn / nbg, n = rn % nbg;
  u16* Ks = smem;
  u16* Vs = smem + 256 * LDT;
#pragma unroll 1
  for (int sub = 0; sub < 2; ++sub) {
    const int q0 = w * 32 + sub * 16;
    const int qi = q0 + l15;
    const size_t rowq = (size_t)b * 4096 + (size_t)(n * 128 + qi) * dil + r;
    const bf16x8 qf0 = sub ? qpre[1][0] : qpre[0][0], qf1 = sub ? qpre[1][1] : qpre[0][1];
    f32x4 st[9];
#pragma unroll
    for (int s = 0; s < 9; ++s) {
      const u16* kp = Ks + (q0 + 16 * s + l15) * LDT + G * 8;
      const bf16x8 a0 = *(const bf16x8*)kp, a1 = *(const bf16x8*)(kp + 32);
      f32x4 z = {0.f, 0.f, 0.f, 0.f};
      z = MFMA16(a0, qf0, z);
      st[s] = MFMA16(a1, qf1, z);
    }
    float mx = -INFINITY;
#pragma unroll
    for (int s = 0; s < 9; ++s)
#pragma unroll
      for (int j = 0; j < 4; ++j) {
        const int kk = 16 * s + 4 * G + j;
        const bool valid = (kk >= l15) && (kk <= l15 + 128) && (n > 0 || q0 + kk >= 128);
        const float v = valid ? st[s][j] : -INFINITY;
        st[s][j] = v;
        mx = fmaxf(mx, v);
      }
    mx = fmaxf(mx, __shfl_xor(mx, 16));
    mx = fmaxf(mx, __shfl_xor(mx, 32));
    float sum = 0.f;
#pragma unroll
    for (int s = 0; s < 9; ++s)
#pragma unroll
      for (int j = 0; j < 4; ++j) {
        const float e = __expf(st[s][j] - mx);
        st[s][j] = e;
        sum += e;
      }
    sum += __shfl_xor(sum, 16);
    sum += __shfl_xor(sum, 32);
    const float inv = 1.f / sum;
    f32x4 o[4];
#pragma unroll
    for (int m = 0; m < 4; ++m) o[m] = (f32x4){0.f, 0.f, 0.f, 0.f};
#pragma unroll
    for (int t = 0; t < 5; ++t) {
      const int sA = 2 * t, sB = 2 * t + 1;
      bf16x8 pb;
      if (t < 4) pb = words_to_frag(pack2(st[sA][0], st[sA][1]), pack2(st[sA][2], st[sA][3]), pack2(st[sB < 9 ? sB : 8][0], st[sB < 9 ? sB : 8][1]), pack2(st[sB < 9 ? sB : 8][2], st[sB < 9 ? sB : 8][3]));
      else pb = words_to_frag(pack2(st[sA][0], st[sA][1]), pack2(st[sA][2], st[sA][3]), 0u, 0u);
      const u16* vA = Vs + (q0 + 16 * sA + 4 * G + (l15 >> 2)) * LDT + (l15 & 3) * 4;
      const u16* vB = Vs + (q0 + 16 * sB + 4 * G + (l15 >> 2)) * LDT + (l15 & 3) * 4;
#pragma unroll
      for (int m = 0; m < 4; ++m) {
        const s16x4 lo = tr_read(vA + 16 * m);
        s16x4 hi = {0, 0, 0, 0};
        if (t < 4) hi = tr_read(vB + 16 * m);
        o[m] = MFMA16(cat4(lo, hi), pb, o[m]);
      }
    }
    u16* op = p.OG + rowq * 3072 + g * 1024 + head * 64 + 4 * G;
#pragma unroll
    for (int m = 0; m < 4; ++m) {
      uint2 ov;
      ov.x = pack2(o[m][0] * inv, o[m][1] * inv);
      ov.y = pack2(o[m][2] * inv, o[m][3] * inv);
      *(uint2*)(op + 16 * m) = ov;
    }
    if (G == 0) p.LSE[rowq * 48 + g * 16 + head] = mx + __logf(sum);
  }
}

DI void attn_sample_task(const Params& p, int id) {
  const int lane = threadIdx.x & 63, l15 = lane & 15, G = lane >> 4;
  const int t = id & 7, head = (id >> 3) & 15, b = (id >> 7) & 31, g = id >> 12;
  const int L = 128 << (2 * g), dil = 1 << (2 * g);
  const float* cache = (g == 0) ? p.cache0 : (g == 1) ? p.cache1 : p.cache2;
  const float* newkv = p.out + ((g == 0) ? O_KVS0 : (g == 1) ? O_KVS1 : O_KVS2);
  const size_t rowq = (size_t)PROWS + b * 8 + t;
  const uint2 qq = *(const uint2*)(p.QKVG + rowq * ATT_IN + g * 3072 + head * 64 + 4 * l15);
  const float q0 = lo_f(qq.x), q1 = hi_f(qq.x), q2 = lo_f(qq.y), q3 = hi_f(qq.y);
  const int coff = head * 64 + 4 * l15;
  float mx = -INFINITY, sum = 0.f, a0 = 0.f, a1 = 0.f, a2 = 0.f, a3 = 0.f;
#pragma unroll 1
  for (int bt = 0; bt < 2; ++bt) {
    float4 kb[17], vb[17];
#pragma unroll
    for (int u = 0; u < 17; ++u) {
      const int j = 4 * (bt * 17 + u) + G;
      const int jc = j < 128 ? j : 128;
      const int idx = L + t - dil * jc;
      const float* kp = ((idx < L) ? cache + (size_t)(b * L + idx) * 2048 : newkv + (size_t)(b * 8 + idx - L) * 2048) + coff + 512;
      kb[u] = *(const float4*)(kp - 512);
      vb[u] = *(const float4*)(kp + 512);
    }
    float scb[17];
    float bm = -INFINITY;
#pragma unroll
    for (int u = 0; u < 17; ++u) {
      const int j = 4 * (bt * 17 + u) + G;
      float sv = q0 * kb[u].x + q1 * kb[u].y + q2 * kb[u].z + q3 * kb[u].w;
      sv = sum16(sv);
      sv = (j <= 128) ? sv : -INFINITY;
      scb[u] = sv;
      bm = fmaxf(bm, sv);
    }
    const float mn = fmaxf(mx, bm);
    const float corr = __expf(mx - mn);
    sum *= corr; a0 *= corr; a1 *= corr; a2 *= corr; a3 *= corr;
#pragma unroll
    for (int u = 0; u < 17; ++u) {
      const float pe = __expf(scb[u] - mn);
      sum += pe;
      a0 += pe * vb[u].x; a1 += pe * vb[u].y; a2 += pe * vb[u].z; a3 += pe * vb[u].w;
    }
    mx = mn;
  }
  {
    float M = fmaxf(mx, __shfl_xor(mx, 16));
    M = fmaxf(M, __shfl_xor(M, 32));
    const float f = __expf(mx - M);
    sum *= f; a0 *= f; a1 *= f; a2 *= f; a3 *= f;
    mx = M;
  }
  sum += __shfl_xor(sum, 16); sum += __shfl_xor(sum, 32);
  a0 += __shfl_xor(a0, 16); a0 += __shfl_xor(a0, 32);
  a1 += __shfl_xor(a1, 16); a1 += __shfl_xor(a1, 32);
  a2 += __shfl_xor(a2, 16); a2 += __shfl_xor(a2, 32);
  a3 += __shfl_xor(a3, 16); a3 += __shfl_xor(a3, 32);
  const float inv = 1.f / sum;
  if (G == 0) {
    uint2 ov;
    ov.x = pack2(a0 * inv, a1 * inv);
    ov.y = pack2(a2 * inv, a3 * inv);
    *(uint2*)(p.OG + rowq * 3072 + g * 1024 + coff) = ov;
    if (l15 == 0) p.LSE[rowq * 48 + g * 16 + head] = mx + __logf(sum);
  }
}

DI void attn_prompt_stream(const Params& p, u16* smem) {
  constexpr int NP = 6144;
  int item = blockIdx.x;
  PromptRegs R;
  if (item < NP) attn_prompt_load(p, item, R);
  while (item < NP) {
    attn_prompt_stage(R, smem);
    bf16x8 qc[2][2];
    qc[0][0] = R.q[0][0]; qc[0][1] = R.q[0][1]; qc[1][0] = R.q[1][0]; qc[1][1] = R.q[1][1];
    __syncthreads();
    const int next = item + gridDim.x;
    if (next < NP) attn_prompt_load(p, next, R);
    attn_prompt_compute(p, item, qc, smem);
    __syncthreads();
    item = next;
  }
}
DI void phase_attn(const Params& p, u16* smem) {
  constexpr int NS = 3072;
  const bool sample_first = ((blockIdx.x >> 3) & 1) != 0;
  if (!sample_first) attn_prompt_stream(p, smem);
  for (int it = blockIdx.x; it < NS; it += gridDim.x) attn_sample_task(p, it * 4 + (threadIdx.x >> 6));
  if (sample_first) attn_prompt_stream(p, smem);
  for (int it = blockIdx.x; it < TR2 + TR3 + TR4; it += gridDim.x) late_transpose_task(p, it, smem);
}

DI void conv_pass_task(const Params& p, int bt) {
  const int id = bt * 256 + threadIdx.x;
  const int ch = id % 384, seg = id / 384;
  const int col = ch * 8, row0 = seg * 8, t0 = row0 & 4095;
  const u16* src = p.XBC + (size_t)row0 * 3072 + col;
  uint4 raw[11];
#pragma unroll
  for (int j = 0; j < 3; ++j) {
    raw[j] = (uint4){0u, 0u, 0u, 0u};
    if (t0 > 0) raw[j] = *(const uint4*)(src - (ptrdiff_t)(3 - j) * 3072);
  }
#pragma unroll
  for (int j = 0; j < 8; ++j) raw[3 + j] = *(const uint4*)(src + (size_t)j * 3072);
  float wgt[4][8], bias[8];
#pragma unroll
  for (int j = 0; j < 4; ++j) {
    const float4 w0 = *(const float4*)(p.ssm_conv_w + j * 3072 + col), w1 = *(const float4*)(p.ssm_conv_w + j * 3072 + col + 4);
    wgt[j][0] = w0.x; wgt[j][1] = w0.y; wgt[j][2] = w0.z; wgt[j][3] = w0.w;
    wgt[j][4] = w1.x; wgt[j][5] = w1.y; wgt[j][6] = w1.z; wgt[j][7] = w1.w;
  }
  {
    const float4 b0 = *(const float4*)(p.ssm_conv_b + col), b1 = *(const float4*)(p.ssm_conv_b + col + 4);
    bias[0] = b0.x; bias[1] = b0.y; bias[2] = b0.z; bias[3] = b0.w;
    bias[4] = b1.x; bias[5] = b1.y; bias[6] = b1.z; bias[7] = b1.w;
  }
  float win[3][8];
  unpack8(raw[0], win[0]); unpack8(raw[1], win[1]); unpack8(raw[2], win[2]);
  u16* dst = p.XBCC + (size_t)row0 * 3072 + col;
#pragma unroll
  for (int i = 0; i < 8; ++i) {
    float cur[8], r[8];
    unpack8(raw[3 + i], cur);
#pragma unroll
    for (int e = 0; e < 8; ++e) {
      const float v = bias[e] + wgt[0][e] * win[0][e] + wgt[1][e] * win[1][e] + wgt[2][e] * win[2][e] + wgt[3][e] * cur[e];
      r[e] = silu_f(v);
      win[0][e] = win[1][e]; win[1][e] = win[2][e]; win[2][e] = cur[e];
    }
    *(uint4*)(dst + (size_t)i * 3072) = pack8(r);
  }
}

DI void acs_task(const Params& p, int bc) {
  const int lane = threadIdx.x & 63, head = lane & 31, half = lane >> 5;
  const float Aneg = -__expf(p.ssm_A_log[head]);
  const size_t rb = (size_t)bc * 128 + half * 64;
  float run = 0.f;
#pragma unroll 8
  for (int i = 0; i < 64; ++i) run += p.DT[(rb + i) * 32 + head] * Aneg;
  const float tot0 = __shfl(run, head);
  run = half ? tot0 : 0.f;
#pragma unroll 8
  for (int i = 0; i < 64; ++i) {
    run += p.DT[(rb + i) * 32 + head] * Aneg;
    p.ACS[(rb + i) * 32 + head] = run;
  }
}

DI void phase_convpass(const Params& p) {
  constexpr int NC = PROWS / 8 * 384 / 256;
  for (int it = blockIdx.x; it < NC + 32; it += gridDim.x) {
    if (it < NC) conv_pass_task(p, it);
    else acs_task(p, (it - NC) * 4 + (threadIdx.x >> 6));
  }
}

constexpr int SS_B = 0;
constexpr int SS_R2 = 34816;
constexpr int SS_H = 34816 + 18432;
constexpr int SS_F = 70656;

DI void ssd_states_item(const Params& p, int item, char* smem_raw) {
  const int tid = threadIdx.x, lane = tid & 63, w = tid >> 6, l15 = lane & 15, G = lane >> 4;
  const int head = item & 31, c = (item >> 5) & 31, b = item >> 10, g = head >> 3;
  u16* Bs = (u16*)(smem_raw + SS_B);
  u16* Xs = (u16*)(smem_raw + SS_R2);
  const size_t row0 = (size_t)b * 4096 + c * 128;
  const float a_end = p.ACS[(row0 + 127) * 32 + head];
#pragma unroll
  for (int i = 0; i < 4; ++i) {
    const int row = (tid >> 3) + 32 * i, ch = tid & 7;
    const float wl = p.DT[(row0 + row) * 32 + head] * __expf(a_end - p.ACS[(row0 + row) * 32 + head]);
    const uint4 v = *(const uint4*)(p.XBCC + (row0 + row) * 3072 + head * 64 + ch * 8);
    uint4 o;
    o.x = pack2(lo_f(v.x) * wl, hi_f(v.x) * wl); o.y = pack2(lo_f(v.y) * wl, hi_f(v.y) * wl);
    o.z = pack2(lo_f(v.z) * wl, hi_f(v.z) * wl); o.w = pack2(lo_f(v.w) * wl, hi_f(v.w) * wl);
    *(uint4*)(Xs + row * LDT + ch * 8) = o;
  }
#pragma unroll
  for (int i = 0; i < 8; ++i) {
    const int idx = tid + 256 * i, row = idx >> 4, ch = idx & 15;
    *(uint4*)(Bs + row * LDW + ch * 8) = *(const uint4*)(p.XBCC + (row0 + row) * 3072 + 2048 + g * 128 + ch * 8);
  }
  __syncthreads();
  f32x4 acc[4][2];
#pragma unroll
  for (int m = 0; m < 4; ++m) { acc[m][0] = (f32x4){0.f, 0.f, 0.f, 0.f}; acc[m][1] = (f32x4){0.f, 0.f, 0.f, 0.f}; }
#pragma unroll
  for (int k = 0; k < 4; ++k) {
    const int rowA = 32 * k + 8 * G + (l15 >> 2);
    bf16x8 a[4], bb[2];
#pragma unroll
    for (int m = 0; m < 4; ++m) {
      const u16* ap = Xs + rowA * LDT + 16 * m + (l15 & 3) * 4;
      a[m] = cat4(tr_read(ap), tr_read(ap + 4 * LDT));
    }
#pragma unroll
    for (int nn = 0; nn < 2; ++nn) {
      const u16* bp = Bs + rowA * LDW + 32 * w + 16 * nn + (l15 & 3) * 4;
      bb[nn] = cat4(tr_read(bp), tr_read(bp + 4 * LDW));
    }
#pragma unroll
    for (int m = 0; m < 4; ++m)
#pragma unroll
      for (int nn = 0; nn < 2; ++nn) acc[m][nn] = MFMA16(a[m], bb[nn], acc[m][nn]);
  }
  u16* sp = p.STATES + (size_t)item * 64 * 128;
#pragma unroll
  for (int m = 0; m < 4; ++m)
#pragma unroll
    for (int nn = 0; nn < 2; ++nn)
#pragma unroll
      for (int j = 0; j < 4; ++j) sp[(16 * m + 4 * G + j) * 128 + 32 * w + 16 * nn + l15] = f2bf(acc[m][nn][j]);
  if (tid == 0) p.CD[item] = __expf(a_end);
  __syncthreads();
}

DI void ssm_sample_item(const Params& p, int item, char* smem_raw) {
  const int tid = threadIdx.x;
  const int head = item & 31, b = item >> 5, g = head >> 3;
  float* sx = (float*)smem_raw;
  float* sB = sx + 512;
  float* sC = sB + 1024;
  float* sdt = sC + 1024;
  float* sdA = sdt + 8;
  float* sy2 = sdA + 8;
  const size_t row0 = (size_t)PROWS + b * 8;
  const float Aneg = -__expf(p.ssm_A_log[head]);
  for (int task = tid; task < 320; task += 256) {
    int col; float* dst;
    if (task < 64) { col = head * 64 + task; dst = sx + task; }
    else if (task < 192) { col = 2048 + g * 128 + (task - 64); dst = sB + (task - 64); }
    else { col = 2560 + g * 128 + (task - 192); dst = sC + (task - 192); }
    const int dstride = (task < 64) ? 64 : 128;
    const float w0 = p.ssm_conv_w[col], w1 = p.ssm_conv_w[3072 + col], w2 = p.ssm_conv_w[2 * 3072 + col], w3 = p.ssm_conv_w[3 * 3072 + col];
    const float bias = p.ssm_conv_b[col];
    float x0 = p.state_conv[(size_t)(b * 3 + 0) * 3072 + col];
    float x1 = p.state_conv[(size_t)(b * 3 + 1) * 3072 + col];
    float x2 = p.state_conv[(size_t)(b * 3 + 2) * 3072 + col];
#pragma unroll
    for (int t = 0; t < 8; ++t) {
      const float cur = bf2f(p.XBC[(row0 + t) * 3072 + col]);
      const float v = bias + w0 * x0 + w1 * x1 + w2 * x2 + w3 * cur;
      dst[t * dstride] = silu_f(v);
      x0 = x1; x1 = x2; x2 = cur;
    }
  }
  if (tid < 8) {
    const float dt = p.DT[(row0 + tid) * 32 + head];
    sdt[tid] = dt;
    sdA[tid] = __expf(dt * Aneg);
  }
  __syncthreads();
  const int pp = tid >> 2, nq = tid & 3;
  const size_t sbase = ((size_t)(b * 32 + head) * 64 + pp) * 128 + nq * 4;
  float4 h[8];
#pragma unroll
  for (int i = 0; i < 8; ++i) h[i] = *(const float4*)(p.state_ssm + sbase + i * 16);
  const float Dh = p.ssm_D[head];
#pragma unroll 1
  for (int t = 0; t < 8; ++t) {
    const float dA = sdA[t];
    const float xv = sx[t * 64 + pp];
    const float dtx = sdt[t] * xv;
    float y = 0.f;
#pragma unroll
    for (int i = 0; i < 8; ++i) {
      const float4 Bv = *(const float4*)(sB + t * 128 + i * 16 + nq * 4);
      const float4 Cv = *(const float4*)(sC + t * 128 + i * 16 + nq * 4);
      h[i].x = h[i].x * dA + dtx * Bv.x; h[i].y = h[i].y * dA + dtx * Bv.y;
      h[i].z = h[i].z * dA + dtx * Bv.z; h[i].w = h[i].w * dA + dtx * Bv.w;
      y += h[i].x * Cv.x + h[i].y * Cv.y + h[i].z * Cv.z + h[i].w * Cv.w;
    }
    y = sum4(y);
    if (nq == 0) {
      const float z = bf2f(p.Z[(row0 + t) * 2048 + head * 64 + pp]);
      const float yg = (y + Dh * xv) * silu_f(z);
      p.YG[(row0 + t) * 2048 + head * 64 + pp] = f2bf(yg);
      sy2[t * 64 + pp] = yg * yg;
    }
  }
  float* od = p.out + O_SSMS + sbase;
#pragma unroll
  for (int i = 0; i < 8; ++i) *(float4*)(od + i * 16) = h[i];
  __syncthreads();
  if (tid < 8) {
    float s = 0.f;
    for (int i = 0; i < 64; ++i) s += sy2[tid * 64 + i];
    p.SSQ[(row0 + tid) * 32 + head] = s;
  }
  __syncthreads();
}

DI void phase_states(const Params& p, char* smem_raw) {
  constexpr int NP = 4096, NS = 1024;
  for (int it = blockIdx.x; it < NP + NS; it += gridDim.x) {
    const int q = it / 5, rem = it - q * 5;
    if (rem == 4) ssm_sample_item(p, q, smem_raw);
    else ssd_states_item(p, q * 4 + rem, smem_raw);
  }
}

DI void phase_scan(const Params& p) {
  for (int task = blockIdx.x * 256 + threadIdx.x; task < 131072; task += gridDim.x * 256) {
    const int n8 = task & 15, pp = (task >> 4) & 63, head = (task >> 10) & 31, b = task >> 15;
    float h[8];
#pragma unroll
    for (int e = 0; e < 8; ++e) h[e] = 0.f;
#pragma unroll 8
    for (int c = 0; c < 32; ++c) {
      const int item = (b * 32 + c) * 32 + head;
      uint4* sp = (uint4*)(p.STATES + ((size_t)item * 64 + pp) * 128 + n8 * 8);
      const uint4 sv = *sp;
      const float d = p.CD[item];
      *sp = pack8(h);
      float sf[8];
      unpack8(sv, sf);
#pragma unroll
      for (int e = 0; e < 8; ++e) h[e] = h[e] * d + sf[e];
    }
    float* od = p.out + O_SSMP + ((size_t)(b * 32 + head) * 64 + pp) * 128 + n8 * 8;
    *(float4*)od = (float4){h[0], h[1], h[2], h[3]};
    *(float4*)(od + 4) = (float4){h[4], h[5], h[6], h[7]};
  }
}

DI void ssd_out_item(const Params& p, int item, char* smem_raw) {
  const int tid = threadIdx.x, lane = tid & 63, w = tid >> 6, l15 = lane & 15, G = lane >> 4;
  const int head = item & 31, c = (item >> 5) & 31, b = item >> 10, g = head >> 3;
  u16* Bs = (u16*)(smem_raw + SS_B);
  u16* Xs = (u16*)(smem_raw + SS_R2);
  u16* Hs = (u16*)(smem_raw + SS_H);
  float* s_acs = (float*)(smem_raw + SS_F);
  float* s_dt = s_acs + 128;
  const size_t row0 = (size_t)b * 4096 + c * 128;
  if (tid < 128) {
    s_acs[tid] = p.ACS[(row0 + tid) * 32 + head];
    s_dt[tid] = p.DT[(row0 + tid) * 32 + head];
  }
#pragma unroll
  for (int i = 0; i < 8; ++i) {
    const int idx = tid + 256 * i, row = idx >> 4, ch = idx & 15;
    *(uint4*)(Bs + row * LDW + ch * 8) = *(const uint4*)(p.XBCC + (row0 + row) * 3072 + 2048 + g * 128 + ch * 8);
  }
#pragma unroll
  for (int i = 0; i < 4; ++i) {
    const int row = (tid >> 3) + 32 * i, ch = tid & 7;
    *(uint4*)(Xs + row * LDT + ch * 8) = *(const uint4*)(p.XBCC + (row0 + row) * 3072 + head * 64 + ch * 8);
  }
  {
    const u16* hp = p.STATES + (size_t)item * 64 * 128;
#pragma unroll
    for (int i = 0; i < 4; ++i) {
      const int idx = tid + 256 * i, pp = idx >> 4, ch = idx & 15;
      *(uint4*)(Hs + pp * LDW + ch * 8) = *(const uint4*)(hp + pp * 128 + ch * 8);
    }
  }
  bf16x8 cf[2][4];
#pragma unroll
  for (int sub = 0; sub < 2; ++sub)
#pragma unroll
    for (int ks = 0; ks < 4; ++ks)
      cf[sub][ks] = *(const bf16x8*)(p.XBCC + (row0 + w * 32 + sub * 16 + l15) * 3072 + 2560 + g * 128 + ks * 32 + G * 8);
  uint2 zpre[2][4];
#pragma unroll
  for (int sub = 0; sub < 2; ++sub)
#pragma unroll
    for (int m = 0; m < 4; ++m)
      zpre[sub][m] = *(const uint2*)(p.Z + (row0 + w * 32 + sub * 16 + l15) * 2048 + head * 64 + 16 * m + 4 * G);
  __syncthreads();
  const float Dh = p.ssm_D[head];
#pragma unroll
  for (int sub = 0; sub < 2; ++sub) {
    const int l0 = w * 32 + sub * 16, lq = l0 + l15;
    const float acs_q = s_acs[lq];
    f32x4 yo[4];
#pragma unroll
    for (int m = 0; m < 4; ++m) {
      f32x4 z = {0.f, 0.f, 0.f, 0.f};
#pragma unroll
      for (int ks = 0; ks < 4; ++ks) z = MFMA16(*(const bf16x8*)(Hs + (16 * m + l15) * LDW + ks * 32 + G * 8), cf[sub][ks], z);
      yo[m] = z;
    }
    {
      const float ea = __expf(acs_q);
#pragma unroll
      for (int m = 0; m < 4; ++m) { yo[m][0] *= ea; yo[m][1] *= ea; yo[m][2] *= ea; yo[m][3] *= ea; }
    }
    const int ns = (l0 >> 4) + 1, nsteps = (ns + 1) >> 1;
#pragma unroll 1
    for (int step = 0; step < nsteps; ++step) {
      unsigned pw[4];
#pragma unroll
      for (int h2 = 0; h2 < 2; ++h2) {
        const int ss = 2 * step + h2;
        f32x4 st = {0.f, 0.f, 0.f, 0.f};
#pragma unroll
        for (int ks = 0; ks < 4; ++ks) st = MFMA16(*(const bf16x8*)(Bs + (16 * ss + l15) * LDW + ks * 32 + G * 8), cf[sub][ks], st);
        float mv[4];
#pragma unroll
        for (int j = 0; j < 4; ++j) {
          const int s = 16 * ss + 4 * G + j;
          const float dec = __expf(fminf(acs_q - s_acs[s], 0.f)) * s_dt[s];
          mv[j] = (s <= lq) ? st[j] * dec : 0.f;
        }
        pw[2 * h2] = pack2(mv[0], mv[1]);
        pw[2 * h2 + 1] = pack2(mv[2], mv[3]);
      }
      const bf16x8 pb = words_to_frag(pw[0], pw[1], pw[2], pw[3]);
      const u16* xa = Xs + (32 * step + 4 * G + (l15 >> 2)) * LDT + (l15 & 3) * 4;
#pragma unroll
      for (int m = 0; m < 4; ++m) yo[m] = MFMA16(cat4(tr_read(xa + 16 * m), tr_read(xa + 16 * LDT + 16 * m)), pb, yo[m]);
    }
    const size_t rowg = (size_t)b * 4096 + c * 128 + lq;
    float ssq = 0.f;
#pragma unroll
    for (int m = 0; m < 4; ++m) {
      const uint2 xv = *(const uint2*)(Xs + lq * LDT + 16 * m + 4 * G);
      const uint2 zv = zpre[sub][m];
      const float xf[4] = {lo_f(xv.x), hi_f(xv.x), lo_f(xv.y), hi_f(xv.y)};
      const float zf[4] = {lo_f(zv.x), hi_f(zv.x), lo_f(zv.y), hi_f(zv.y)};
      float y[4];
#pragma unroll
      for (int j = 0; j < 4; ++j) {
        y[j] = (yo[m][j] + Dh * xf[j]) * silu_f(zf[j]);
        ssq += y[j] * y[j];
      }
      uint2 ov; ov.x = pack2(y[0], y[1]); ov.y = pack2(y[2], y[3]);
      *(uint2*)(p.YG + rowg * 2048 + head * 64 + 16 * m + 4 * G) = ov;
    }
    ssq += __shfl_xor(ssq, 16);
    ssq += __shfl_xor(ssq, 32);
    if (G == 0) p.SSQ[rowg * 32 + head] = ssq;
  }
  __syncthreads();
}

#define XB_TMO      128
#define XB_XCNT(j)  (256  + 64 * (j))
#define XB_XSUB(j)  (1280 + 64 * (j))
#define XB_XGEN(j)  (2304 + 64 * (j))
#define XB_TOP      3328
#define XB_TOPGEN   3392
#define XCD_BAR_WORDS 3456
#define XB_SPIN_CAP (1u << 20)
#define LAS __attribute__((address_space(3)))
DI unsigned xb_ld(unsigned* p) { return __hip_atomic_load(p, __ATOMIC_RELAXED, __HIP_MEMORY_SCOPE_AGENT); }
DI unsigned xb_add(unsigned* p, unsigned v) { return __hip_atomic_fetch_add(p, v, __ATOMIC_RELAXED, __HIP_MEMORY_SCOPE_AGENT); }
DI unsigned xb_xcc_id() { return (unsigned)__builtin_amdgcn_s_getreg((3 << 11) | 20) & 0xFu; }
#define XB_SPIN(cond, bar) do { unsigned _sp = 0; while (cond) { __builtin_amdgcn_s_sleep(1); \
    if ((++_sp & 255u) == 0u) { if (xb_ld(&(bar)[XB_TMO])) break; if (_sp > XB_SPIN_CAP) { atomicAdd(&(bar)[XB_TMO], 1u); break; } } } } while (0)
struct XcdBarrier { unsigned* bar; unsigned x; volatile LAS unsigned* st; };
DI XcdBarrier xcd_barrier_post(unsigned* bar, volatile LAS unsigned* st) {
  XcdBarrier b; b.bar = bar; b.x = xb_xcc_id(); b.st = st;
  if (threadIdx.x == 0) (void)xb_add(&bar[XB_XCNT(b.x)], 1u);
  return b;
}
DI void xcd_barrier_complete(unsigned* bar, unsigned x, unsigned& nloc, unsigned& nx) {
  const unsigned Gn = gridDim.x * gridDim.y * gridDim.z;
  unsigned sum, cnt, mine, sp = 0u;
  for (;;) {
    sum = 0u; cnt = 0u; mine = 0u;
#pragma unroll
    for (unsigned j = 0; j < 16; ++j) { const unsigned c = xb_ld(&bar[XB_XCNT(j)]); sum += c; cnt += (c > 0u) ? 1u : 0u; mine = (j == x) ? c : mine; }
    if (sum == Gn) break;
    __builtin_amdgcn_s_sleep(1);
    if ((++sp & 255u) == 0u) { if (xb_ld(&bar[XB_TMO])) break; if (sp > XB_SPIN_CAP) { atomicAdd(&bar[XB_TMO], 1u); break; } }
  }
  nloc = mine > 0u ? mine : 1u; nx = cnt > 0u ? cnt : 1u;
}
DI void xcd_barrier(const XcdBarrier& b) {
  asm volatile("s_waitcnt vmcnt(0)" ::: "memory");
  __syncthreads();
  if (threadIdx.x == 0) {
    unsigned* bar = b.bar;
    __builtin_amdgcn_s_waitcnt(0);
    unsigned nloc = b.st[0], nx = b.st[1];
    if (nloc == 0u) { xcd_barrier_complete(bar, b.x, nloc, nx); b.st[0] = nloc; b.st[1] = nx; }
    const unsigned old = xb_add(&bar[XB_XSUB(b.x)], 1u);
    const unsigned gen = old / nloc;
    if (old + 1u == (gen + 1u) * nloc) {
      __builtin_amdgcn_fence(__ATOMIC_RELEASE, "agent");
      asm volatile("s_waitcnt vmcnt(0)" ::: "memory");
      const unsigned og = xb_add(&bar[XB_TOP], 1u);
      const unsigned tg = og / nx;
      if (og + 1u == (tg + 1u) * nx) xb_add(&bar[XB_TOPGEN], 1u);
      else XB_SPIN(xb_ld(&bar[XB_TOPGEN]) == tg, bar);
      __builtin_amdgcn_fence(__ATOMIC_ACQUIRE, "agent");
      xb_add(&bar[XB_XGEN(b.x)], 1u);
      asm volatile("s_waitcnt vmcnt(0)" ::: "memory");
    } else {
      XB_SPIN(xb_ld(&bar[XB_XGEN(b.x)]) == gen, bar);
      __builtin_amdgcn_fence(__ATOMIC_ACQUIRE, "agent");
      asm volatile("s_waitcnt vmcnt(0)" ::: "memory");
    }
  }
  __syncthreads();
}

constexpr int NPHASE = 13;
#ifndef PH_MASK
#define PH_MASK 0x1fff
#endif
#define PH_ON(k) (((PH_MASK) >> (k)) & 1)
#ifndef PH_REPEAT
#define PH_REPEAT 0
#endif
#define PH_REP(k) (((PH_REPEAT) >> (k)) & 1)

template <bool COOP>
__global__ void __launch_bounds__(256, 2) mega(Params p, int ph0, int ph1) {
  extern __shared__ __attribute__((aligned(16))) char smem_raw[];
  u16* smem = (u16*)smem_raw;
#define PHASE_BODY(k)                                                                                                   \
  do {                                                                                                                  \
    if (k == 0) { if (PH_ON(0)) phase_prep(p, smem); }                                                                  \
    else if (k == 1) { if (PH_ON(1)) gemm_phase_glds(p.H, p.Wt1, 1024, MROWS / 128, ATT_IN / 128, Ep1{p}, smem_raw); }  \
    else if (k == 2) { if (PH_ON(2)) phase_attn(p, smem); }                                                             \
    else if (k == 3) { if (PH_ON(3)) phase_merge(p); }                                                                  \
    else if (k == 4) { if (PH_ON(4)) gemm_phase_glds(p.H, p.Wt2, 1024, MROWS / 128, 8, Ep2{p}, smem_raw); }             \
    else if (k == 5) { if (PH_ON(5)) phase_norm2(p); }                                                                  \
    else if (k == 6) { if (PH_ON(6)) gemm_phase_glds(p.H, p.Wt3, 1024, MROWS / 128, SSM_IN_PAD / 128, Ep3{p}, smem_raw); } \
    else if (k == 7) { if (PH_ON(7)) phase_convpass(p); }                                                               \
    else if (k == 8) { if (PH_ON(8)) phase_states(p, smem_raw); }                                                       \
    else if (k == 9) { if (PH_ON(9)) phase_scan(p); }                                                                   \
    else if (k == 10) { if (PH_ON(10)) for (int it = blockIdx.x; it < 4096; it += gridDim.x) ssd_out_item(p, it, smem_raw); } \
    else if (k == 11) { if (PH_ON(11)) phase_gatenorm(p); }                                                             \
    else if (k == 12) { if (PH_ON(12)) gemm_phase_glds(p.YG, p.Wt4, 2048, MROWS / 128, 8, Ep4{p}, smem_raw); }          \
  } while (0)
#define PHASE_STEP(k) PHASE_BODY(k); if (PH_REP(k)) { xcd_barrier(xb); PHASE_BODY(k); }
  if constexpr (COOP) {
    volatile LAS unsigned* xst = (volatile LAS unsigned*)(smem_raw + LDS_MAIN);
    if (threadIdx.x == 0) { xst[0] = 0u; xst[1] = 0u; }
    __syncthreads();
    const XcdBarrier xb = xcd_barrier_post(p.bar, xst);
    if (ph0 == 0x7fffffff) cg::this_grid().sync();
    PHASE_STEP(0) xcd_barrier(xb);
    PHASE_STEP(1) xcd_barrier(xb);
    PHASE_STEP(2) xcd_barrier(xb);
    PHASE_STEP(3) xcd_barrier(xb);
    PHASE_STEP(4) xcd_barrier(xb);
    PHASE_STEP(5) xcd_barrier(xb);
    PHASE_STEP(6) xcd_barrier(xb);
    PHASE_STEP(7) xcd_barrier(xb);
    PHASE_STEP(8) xcd_barrier(xb);
    PHASE_STEP(9) xcd_barrier(xb);
    PHASE_STEP(10) xcd_barrier(xb);
    PHASE_STEP(11) xcd_barrier(xb);
    PHASE_STEP(12)
  } else {
    switch (ph0) {
      case 0: PHASE_BODY(0); break;
      case 1: PHASE_BODY(1); break;
      case 2: PHASE_BODY(2); break;
      case 3: PHASE_BODY(3); break;
      case 4: PHASE_BODY(4); break;
      case 5: PHASE_BODY(5); break;
      case 6: PHASE_BODY(6); break;
      case 7: PHASE_BODY(7); break;
      case 8: PHASE_BODY(8); break;
      case 9: PHASE_BODY(9); break;
      case 10: PHASE_BODY(10); break;
      case 11: PHASE_BODY(11); break;
      case 12: PHASE_BODY(12); break;
    }
  }
}

#ifndef MULTI_LAUNCH
#define MULTI_LAUNCH 0
#endif

extern "C" void kernel_launch(void* const* d_in, const int* in_sizes, int n_in, void* d_out, int out_size, void* d_ws, size_t ws_size,
                              hipStream_t stream) {
  static int grid = 0;
  size_t off = 0;
  auto carve = [&](size_t bytes) { size_t o = off; off += (bytes + 255) & ~(size_t)255; return (char*)d_ws + o; };
  Params p{};
  p.x_prompt = (const float*)d_in[0]; p.x_sample = (const float*)d_in[1];
  p.cache0 = (const float*)d_in[2]; p.cache1 = (const float*)d_in[3]; p.cache2 = (const float*)d_in[4];
  p.state_conv = (const float*)d_in[5]; p.state_ssm = (const float*)d_in[6];
  p.attn_norm = (const float*)d_in[7]; p.attn_w_in = (const float*)d_in[8]; p.attn_q_gain = (const float*)d_in[9];
  p.attn_k_gain = (const float*)d_in[10]; p.attn_w_out = (const float*)d_in[11];
  p.ssm_norm = (const float*)d_in[12]; p.ssm_w_in = (const float*)d_in[13]; p.ssm_conv_w = (const float*)d_in[14];
  p.ssm_conv_b = (const float*)d_in[15]; p.ssm_dt_bias = (const float*)d_in[16]; p.ssm_A_log = (const float*)d_in[17];
  p.ssm_D = (const float*)d_in[18]; p.ssm_gate_norm = (const float*)d_in[19]; p.ssm_w_out = (const float*)d_in[20];
  p.out = (float*)d_out;
  p.Wt1 = (u16*)carve((size_t)ATT_IN * 1024 * 2);
  p.Wt2 = (u16*)carve((size_t)1024 * 1024 * 2);
  p.Wt3 = (u16*)carve((size_t)SSM_IN_PAD * 1024 * 2);
  p.Wt4 = (u16*)carve((size_t)1024 * 2048 * 2);
  p.H = (u16*)carve((size_t)MROWS * 1024 * 2);
  p.QKVG = (u16*)carve((size_t)MROWS * ATT_IN * 2);
  p.OG = (u16*)carve((size_t)MROWS * 3072 * 2);
  p.Z = (u16*)carve((size_t)MROWS * 2048 * 2);
  p.XBC = (u16*)carve((size_t)MROWS * 3072 * 2);
  p.YG = (u16*)carve((size_t)MROWS * 2048 * 2);
  p.LSE = (float*)carve((size_t)MROWS * 48 * 4);
  p.X1 = (float*)carve((size_t)MROWS * 1024 * 4);
  p.DT = (float*)carve((size_t)MROWS * 32 * 4);
  p.STATES = (u16*)carve((size_t)4 * 32 * 32 * 64 * 128 * 2);
  p.XBCC = (u16*)carve((size_t)PROWS * 3072 * 2);
  p.ACS = (float*)carve((size_t)PROWS * 32 * 4);
  p.bar = (unsigned*)carve((size_t)XCD_BAR_WORDS * 4);
  p.QKVH = (u16*)carve((size_t)4 * 3 * 3 * 16 * 4096 * 64 * 2);
  p.SSQ = (float*)carve((size_t)MROWS * 32 * 4);
  p.CD = (float*)carve((size_t)4 * 32 * 32 * 4);
  if (grid == 0) {
    if (n_in != 21 || (size_t)out_size != O_END || ws_size < off) {
      fprintf(stderr, "kernel_launch: unexpected shapes: n_in %d out %d (want %zu) ws %zu (need %zu)\n", n_in, out_size, (size_t)O_END, ws_size, off);
      grid = -1; return;
    }
    int dev = 0, cus = 0, per_cu = 0;
    hipGetDevice(&dev);
    hipDeviceGetAttribute(&cus, hipDeviceAttributeMultiprocessorCount, dev);
    hipFuncSetAttribute((const void*)mega<true>, hipFuncAttributeMaxDynamicSharedMemorySize, LDS_BYTES);
    hipFuncSetAttribute((const void*)mega<false>, hipFuncAttributeMaxDynamicSharedMemorySize, LDS_BYTES);
    hipOccupancyMaxActiveBlocksPerMultiprocessor(&per_cu, (const void*)mega<true>, 256, LDS_BYTES);
    if (per_cu < 1) { fprintf(stderr, "kernel_launch: occupancy query returned %d\n", per_cu); grid = -1; return; }
    if (per_cu > 2) per_cu = 2;
    grid = cus * per_cu;
    grid &= ~7;
  }
  if (grid < 0) return;
#if MULTI_LAUNCH
  for (int ph = 0; ph < NPHASE; ++ph) hipLaunchKernelGGL(mega<false>, dim3(grid), dim3(256), LDS_BYTES, stream, p, ph, ph + 1);
#else
  hipMemsetAsync(p.bar, 0, (size_t)XCD_BAR_WORDS * 4, stream);
  int ph0 = 0, ph1 = NPHASE;
  void* args[] = {&p, &ph0, &ph1};
  hipError_t e = hipLaunchCooperativeKernel((const void*)mega<true>, dim3(grid), dim3(256), args, LDS_BYTES, stream);
  if (e != hipSuccess) fprintf(stderr, "cooperative launch failed: %s (grid %d)\n", hipGetErrorString(e), grid);
#endif
}
```

```cpp
#include <hip/hip_runtime.h>
#include <hip/hip_cooperative_groups.h>
#include <cstdio>
#include <cstdint>
namespace cg = cooperative_groups;

typedef unsigned short u16;
typedef short bf16x8 __attribute__((ext_vector_type(8)));
typedef short s16x4 __attribute__((ext_vector_type(4)));
typedef float f32x4 __attribute__((ext_vector_type(4)));

#define DI __device__ __forceinline__
__device__ __forceinline__ int opaque_tid() { int t = threadIdx.x; asm volatile("" : "+v"(t)); return t; }
#define VTID (opaque_tid() & 255)
#define VBID ((int)(blockIdx.x * 2 + (opaque_tid() >> 8)))
#define VGRID ((int)(gridDim.x * 2))
#define MFMA16(a, b, c) __builtin_amdgcn_mfma_f32_16x16x32_bf16((a), (b), (c), 0, 0, 0)

constexpr int MROWS = 16384 + 256;
constexpr int PROWS = 16384;
constexpr int ATT_IN = 10240;
constexpr int SSM_IN = 5152;
constexpr int SSM_IN_PAD = 5376;
constexpr int LDS_HALF = 73728;
constexpr int LDS_MAIN = 2 * LDS_HALF;
constexpr int LDS_BYTES = LDS_MAIN + 16;
constexpr int LDT = 72;
constexpr int LDW = 136;
constexpr int TILE_ELEMS = 128 * LDT;

constexpr size_t O_Y = 0;
constexpr size_t O_KVP0 = (size_t)MROWS * 1024;
constexpr size_t O_KVP1 = O_KVP0 + (size_t)4 * 128 * 2048;
constexpr size_t O_KVP2 = O_KVP1 + (size_t)4 * 512 * 2048;
constexpr size_t O_KVS0 = O_KVP2 + (size_t)4 * 2048 * 2048;
constexpr size_t O_KVS1 = O_KVS0 + (size_t)256 * 2048;
constexpr size_t O_KVS2 = O_KVS1 + (size_t)256 * 2048;
constexpr size_t O_CONVP = O_KVS2 + (size_t)256 * 2048;
constexpr size_t O_CONVS = O_CONVP + (size_t)4 * 3 * 3072;
constexpr size_t O_SSMP = O_CONVS + (size_t)32 * 3 * 3072;
constexpr size_t O_SSMS = O_SSMP + (size_t)4 * 32 * 64 * 128;
constexpr size_t O_END = O_SSMS + (size_t)32 * 32 * 64 * 128;

struct Params {
  const float *x_prompt, *x_sample, *cache0, *cache1, *cache2, *state_conv, *state_ssm;
  const float *attn_norm, *attn_w_in, *attn_q_gain, *attn_k_gain, *attn_w_out;
  const float *ssm_norm, *ssm_w_in, *ssm_conv_w, *ssm_conv_b, *ssm_dt_bias, *ssm_A_log, *ssm_D, *ssm_gate_norm, *ssm_w_out;
  float* out;
  u16 *Wt1, *Wt2, *Wt3, *Wt4, *H, *QKVG, *OG, *Z, *XBC, *YG, *XBCC, *STATES, *QKVH;
  float *LSE, *X1, *DT, *SSQ, *CD, *ACS;
  unsigned* bar;
};

typedef __bf16 bf16v2 __attribute__((ext_vector_type(2)));
DI u16 f2bf(float x) { return __builtin_bit_cast(u16, (__bf16)x); }
DI float bf2f(u16 h) { return __uint_as_float(((unsigned)h) << 16); }
DI unsigned pack2(float a, float b) { bf16v2 v; v[0] = (__bf16)a; v[1] = (__bf16)b; return __builtin_bit_cast(unsigned, v); }
DI float lo_f(unsigned w) { return __uint_as_float(w << 16); }
DI float hi_f(unsigned w) { return __uint_as_float(w & 0xffff0000u); }
DI void unpack8(const uint4& v, float* f) {
  f[0] = lo_f(v.x); f[1] = hi_f(v.x); f[2] = lo_f(v.y); f[3] = hi_f(v.y);
  f[4] = lo_f(v.z); f[5] = hi_f(v.z); f[6] = lo_f(v.w); f[7] = hi_f(v.w);
}
DI uint4 pack8(const float* f) {
  uint4 v; v.x = pack2(f[0], f[1]); v.y = pack2(f[2], f[3]); v.z = pack2(f[4], f[5]); v.w = pack2(f[6], f[7]); return v;
}
DI float sum16(float v) {
  v += __builtin_bit_cast(float, __builtin_amdgcn_update_dpp(0, __builtin_bit_cast(int, v), 0xB1, 0xf, 0xf, true));
  v += __builtin_bit_cast(float, __builtin_amdgcn_update_dpp(0, __builtin_bit_cast(int, v), 0x4E, 0xf, 0xf, true));
  v += __builtin_bit_cast(float, __builtin_amdgcn_update_dpp(0, __builtin_bit_cast(int, v), 0x141, 0xf, 0xf, true));
  v += __builtin_bit_cast(float, __builtin_amdgcn_update_dpp(0, __builtin_bit_cast(int, v), 0x140, 0xf, 0xf, true));
  return v;
}
DI float sum4(float v) {
  v += __builtin_bit_cast(float, __builtin_amdgcn_update_dpp(0, __builtin_bit_cast(int, v), 0xB1, 0xf, 0xf, true));
  v += __builtin_bit_cast(float, __builtin_amdgcn_update_dpp(0, __builtin_bit_cast(int, v), 0x4E, 0xf, 0xf, true));
  return v;
}
DI float silu_f(float x) { return x / (1.f + __expf(-x)); }
DI s16x4 tr_read(const u16* ptr) {
  return __builtin_amdgcn_ds_read_tr16_b64_v4i16((s16x4 __attribute__((address_space(3)))*)(ptr));
}
DI bf16x8 cat4(s16x4 lo, s16x4 hi) { return __builtin_shufflevector(lo, hi, 0, 1, 2, 3, 4, 5, 6, 7); }
DI bf16x8 words_to_frag(unsigned a, unsigned b, unsigned c, unsigned d) {
  uint4 v; v.x = a; v.y = b; v.z = c; v.w = d; return __builtin_bit_cast(bf16x8, v);
}

constexpr int G8_HT = 128 * 64;
DI int g8_lds_byte(int r, int c) {
  const int st = (r >> 4) * 2 + (c >> 5), rr = r & 15, cc = c & 31, ob = rr * 64 + cc * 2;
  return st * 1024 + (ob ^ (((ob >> 9) & 1) << 5));
}
DI void g8_stage_rc(int b, int& R, int& C) {
  const int st = b / 1024, sb = b % 1024, swz = sb ^ (((sb >> 9) & 1) << 5);
  R = (st >> 1) * 16 + swz / 64; C = (st & 1) * 32 + (swz % 64) / 2;
}
template <class EP>
DI void gemm_tile_big(const u16* __restrict__ A, const u16* __restrict__ Bt, int K, int brow, int bcol, const EP& ep, char* smem) {
  u16* shm = (u16*)smem;
  const int rtid = opaque_tid();
#define SA(b, h) (shm + ((b) * 2 + (h)) * G8_HT)
#define SB(b, h) (shm + (4 + (b) * 2 + (h)) * G8_HT)
  unsigned offA[2], offB[2];
#pragma unroll
  for (int _i = 0; _i < 2; ++_i) {
    int _r, _c; g8_stage_rc(rtid * 16 + _i * 8192, _r, _c);
    offA[_i] = (unsigned)((_r * K + _c) * 2);
    offB[_i] = (unsigned)((((_r >> 5) * 64 + (_r & 31)) * K + _c) * 2);
  }
#define STAGE_A(P, br, kt) do { const char* _gb = (const char*)A + ((size_t)(br) * K + (size_t)(kt) * 64) * 2;          \
    _Pragma("unroll") for (int _i = 0; _i < 2; ++_i)                                                                    \
      __builtin_amdgcn_global_load_lds((const unsigned*)(_gb + offA[_i]), (unsigned*)((char*)(P) + rtid * 16 + _i * 8192), 16, 0, 0); } while (0)
#define STAGE_B(P, h, kt) do { const char* _gb = (const char*)Bt + ((size_t)(bcol + (h) * 32) * K + (size_t)(kt) * 64) * 2; \
    _Pragma("unroll") for (int _i = 0; _i < 2; ++_i)                                                                    \
      __builtin_amdgcn_global_load_lds((const unsigned*)(_gb + offB[_i]), (unsigned*)((char*)(P) + rtid * 16 + _i * 8192), 16, 0, 0); } while (0)
#define LDA(dst, b, h) _Pragma("unroll") for (int m = 0; m < 4; ++m) _Pragma("unroll") for (int k = 0; k < 2; ++k) \
    dst[m][k] = *reinterpret_cast<const bf16x8*>(a_rd + ((b) * 2 + (h)) * 16384 + m * 2048 + k * 1024)
#define LDB(dst, b, h) _Pragma("unroll") for (int n = 0; n < 2; ++n) _Pragma("unroll") for (int k = 0; k < 2; ++k) \
    dst[n][k] = *reinterpret_cast<const bf16x8*>(b_rd + ((b) * 2 + (h)) * 16384 + n * 2048 + k * 1024)
#define MMA(ai, bj, At, Bx) do { __builtin_amdgcn_s_setprio(1);                                                         \
    for (int m = 0; m < 4; ++m) for (int n = 0; n < 2; ++n) for (int k = 0; k < 2; ++k)                                 \
      acc[ai][m][(bj) * 2 + n] = MFMA16(At[m][k], Bx[n][k], acc[ai][m][(bj) * 2 + n]);                                 \
    __builtin_amdgcn_s_setprio(0); } while (0)
#define WAIT_V(n) asm volatile("s_waitcnt vmcnt(" #n ")" ::: "memory")
#define WAIT_L(n) asm volatile("s_waitcnt lgkmcnt(" #n ")" ::: "memory")
#define BAR __builtin_amdgcn_s_barrier()
#define SCHED __builtin_amdgcn_sched_barrier(0)
  const int wid = rtid >> 6, lane = rtid & 63, wr = wid >> 2, wc = wid & 3, fr = lane & 15, fq = lane >> 4;
  const int l0 = g8_lds_byte(fr, fq * 8);
  const char* a_rd = smem + wr * 8192 + l0;
  const char* b_rd = smem + 4 * 16384 + wc * 4096 + l0;
  f32x4 acc[2][4][4];
#pragma unroll
  for (int ai = 0; ai < 2; ++ai)
#pragma unroll
    for (int m = 0; m < 4; ++m)
#pragma unroll
      for (int n = 0; n < 4; ++n) acc[ai][m][n] = (f32x4){0.f, 0.f, 0.f, 0.f};
  bf16x8 At[4][2], B0[2][2], B1[2][2];
  const int nt = K / 64;
  STAGE_B(SB(0, 0), 0, 0); STAGE_A(SA(0, 0), brow, 0);
  STAGE_B(SB(0, 1), 1, 0); STAGE_A(SA(0, 1), brow + 128, 0);
  if (wr == 1) BAR;
  WAIT_V(4); BAR;
  STAGE_B(SB(1, 0), 0, 1); STAGE_A(SA(1, 0), brow, 1); STAGE_B(SB(1, 1), 1, 1);
  WAIT_V(6); BAR;
  for (int t = 0; t < nt - 2; t += 2) {
    LDB(B0, 0, 0); SCHED; LDA(At, 0, 0); STAGE_A(SA(1, 1), brow + 128, t + 1);
    WAIT_L(8); BAR; WAIT_L(0); MMA(0, 0, At, B0); BAR; SCHED;
    LDB(B1, 0, 1); STAGE_B(SB(0, 0), 0, t + 2);
    BAR; WAIT_L(0); MMA(0, 1, At, B1); BAR;
    LDA(At, 0, 1); STAGE_A(SA(0, 0), brow, t + 2);
    BAR; WAIT_L(0); MMA(1, 0, At, B0); BAR; SCHED;
    STAGE_B(SB(0, 1), 1, t + 2);
    WAIT_V(6); BAR; MMA(1, 1, At, B1); BAR;
    LDB(B0, 1, 0); SCHED; LDA(At, 1, 0); STAGE_A(SA(0, 1), brow + 128, t + 2);
    WAIT_L(8); BAR; WAIT_L(0); MMA(0, 0, At, B0); BAR; SCHED;
    LDB(B1, 1, 1); STAGE_B(SB(1, 0), 0, t + 3);
    BAR; WAIT_L(0); MMA(0, 1, At, B1); BAR;
    LDA(At, 1, 1); STAGE_A(SA(1, 0), brow, t + 3);
    BAR; WAIT_L(0); MMA(1, 0, At, B0); BAR; SCHED;
    STAGE_B(SB(1, 1), 1, t + 3);
    WAIT_V(6); BAR; MMA(1, 1, At, B1); BAR;
  }
  { LDB(B0, 0, 0); LDA(At, 0, 0); STAGE_A(SA(1, 1), brow + 128, nt - 1);
    BAR; WAIT_L(0); MMA(0, 0, At, B0); BAR;
    LDB(B1, 0, 1); BAR; WAIT_L(0); MMA(0, 1, At, B1); BAR;
    LDA(At, 0, 1); WAIT_V(4); BAR; WAIT_L(0); MMA(1, 0, At, B0); MMA(1, 1, At, B1); BAR; }
  { LDB(B0, 1, 0); LDA(At, 1, 0); WAIT_V(2); BAR; WAIT_L(0); MMA(0, 0, At, B0); BAR;
    LDB(B1, 1, 1); WAIT_V(0); BAR; WAIT_L(0); MMA(0, 1, At, B1); BAR;
    LDA(At, 1, 1); BAR; WAIT_L(0); MMA(1, 0, At, B0); MMA(1, 1, At, B1); BAR; }
  if (wr == 0) BAR;
#undef SA
#undef SB
#undef STAGE_A
#undef STAGE_B
#undef LDA
#undef LDB
#undef MMA
#undef WAIT_V
#undef WAIT_L
#undef BAR
#undef SCHED
  int late = 0;
  asm volatile("" : "+v"(late));
  ep(acc[0], brow + wr * 64 + late, bcol + wc * 64, lane + late);
  ep(acc[1], brow + 128 + wr * 64 + late, bcol + wc * 64, lane + late);
  __syncthreads();
}

template <class EP>
DI void gemm_phase_big(const u16* A, const u16* Bt, int K, int MT, int NT, const EP& ep, char* smem) {
  const int x = blockIdx.x & 7, j = blockIdx.x >> 3, per = gridDim.x >> 3;
  const int T = MT * NT, fullT = (MT >> 3) * 8 * NT, hlast = MT & 7;
  for (int v = j;; v += per) {
    const int chunk = x + 8 * (v >> 5);
    if (chunk * 32 >= T) break;
    const int s = chunk * 32 + (v & 31);
    if (s >= T) continue;
    int mt, nt;
    if (s < fullT) { const int band = s / (8 * NT), within = s - band * 8 * NT; nt = within >> 3; mt = band * 8 + (within & 7); }
    else { const int sp = s - fullT; nt = sp / hlast; mt = (MT >> 3) * 8 + (sp - nt * hlast); }
    gemm_tile_big(A, Bt, K, mt * 256, nt * 256, ep, smem);
  }
}

DI unsigned merge_word(unsigned a, unsigned b, unsigned c, unsigned g, float e0, float e1, float e2) {
  const float lo = (e0 * lo_f(a) + e1 * lo_f(b) + e2 * lo_f(c)) * silu_f(lo_f(g));
  const float hi = (e0 * hi_f(a) + e1 * hi_f(b) + e2 * hi_f(c)) * silu_f(hi_f(g));
  return pack2(lo, hi);
}
DI void phase_merge(const Params& p) {
  const int lane = VTID & 63;
  for (int it = VBID; it < MROWS / 4; it += VGRID) {
    const size_t row = (size_t)it * 4 + (VTID >> 6);
    const int k = lane * 16, head = lane >> 2;
    const float* lp = p.LSE + row * 48 + head;
    const float l0 = lp[0], l1 = lp[16], l2 = lp[32];
    const u16* op = p.OG + row * 3072 + k;
    const u16* gp = p.QKVG + row * ATT_IN + 9216 + k;
    uint4 a[2], b[2], c[2], g[2];
#pragma unroll
    for (int h = 0; h < 2; ++h) {
      a[h] = *(const uint4*)(op + h * 8); b[h] = *(const uint4*)(op + 1024 + h * 8); c[h] = *(const uint4*)(op + 2048 + h * 8);
      g[h] = *(const uint4*)(gp + h * 8);
    }
    const float mx = fmaxf(l0, fmaxf(l1, l2));
    float e0 = __expf(l0 - mx), e1 = __expf(l1 - mx), e2 = __expf(l2 - mx);
    const float inv = 1.f / (e0 + e1 + e2);
    e0 *= inv; e1 *= inv; e2 *= inv;
#pragma unroll
    for (int h = 0; h < 2; ++h) {
      uint4 o;
      o.x = merge_word(a[h].x, b[h].x, c[h].x, g[h].x, e0, e1, e2);
      o.y = merge_word(a[h].y, b[h].y, c[h].y, g[h].y, e0, e1, e2);
      o.z = merge_word(a[h].z, b[h].z, c[h].z, g[h].z, e0, e1, e2);
      o.w = merge_word(a[h].w, b[h].w, c[h].w, g[h].w, e0, e1, e2);
      *(uint4*)(p.H + row * 1024 + k + h * 8) = o;
    }
  }
}
DI void phase_gatenorm(const Params& p) {
  const int lane = VTID & 63;
  for (int it = VBID; it < MROWS / 4; it += VGRID) {
    const size_t row = (size_t)it * 4 + (VTID >> 6);
    const int k = lane * 32;
    const float* sp = p.SSQ + row * 32 + (lane >> 4) * 8;
    const float4 s0 = *(const float4*)sp, s1 = *(const float4*)(sp + 4);
    const float ss = (s0.x + s0.y) + (s0.z + s0.w) + (s1.x + s1.y) + (s1.z + s1.w);
    const float rstd = rsqrtf(ss * (1.f / 512.f) + 1e-5f);
    u16* yp = p.YG + row * 2048 + k;
    uint4 y[4];
#pragma unroll
    for (int h = 0; h < 4; ++h) y[h] = *(const uint4*)(yp + h * 8);
#pragma unroll
    for (int h = 0; h < 4; ++h) {
      const float4 g0 = *(const float4*)(p.ssm_gate_norm + k + h * 8), g1 = *(const float4*)(p.ssm_gate_norm + k + h * 8 + 4);
      uint4 o;
      o.x = pack2(lo_f(y[h].x) * rstd * g0.x, hi_f(y[h].x) * rstd * g0.y);
      o.y = pack2(lo_f(y[h].y) * rstd * g0.z, hi_f(y[h].y) * rstd * g0.w);
      o.z = pack2(lo_f(y[h].z) * rstd * g1.x, hi_f(y[h].z) * rstd * g1.y);
      o.w = pack2(lo_f(y[h].w) * rstd * g1.z, hi_f(y[h].w) * rstd * g1.w);
      *(uint4*)(yp + h * 8) = o;
    }
  }
}

struct Ep1 {
  const Params& p;
  DI void operator()(f32x4 (&acc)[4][4], int r0, int c0, int lane) const {
    const int l15 = lane & 15, G = lane >> 4;
    int kind, g = 0, head;
    if (c0 >= 9216) { kind = 3; head = (c0 - 9216) >> 6; }
    else { g = c0 / 3072; const int rem = c0 - g * 3072; kind = rem >> 10; head = (rem & 1023) >> 6; }
    if (kind < 2) {
      const float* gp = (kind == 0 ? p.attn_q_gain : p.attn_k_gain) + g * 64;
      float gain[4];
#pragma unroll
      for (int n = 0; n < 4; ++n) gain[n] = gp[n * 16 + l15];
      const float post = (kind == 0) ? 0.125f : 1.f;
#pragma unroll
      for (int m = 0; m < 4; ++m)
#pragma unroll
        for (int j = 0; j < 4; ++j) {
          float ss = 0.f;
#pragma unroll
          for (int n = 0; n < 4; ++n) ss += acc[m][n][j] * acc[m][n][j];
          ss = sum16(ss);
          const float sc = rsqrtf(ss * (1.f / 64.f) + 1e-6f) * post;
#pragma unroll
          for (int n = 0; n < 4; ++n) acc[m][n][j] *= sc * gain[n];
        }
    }
    if (kind < 3 && r0 < PROWS) {
      const int dsh = 2 * g;
      const size_t hb = ((size_t)(((r0 >> 12) * 3 + g) * 3 + kind) * 16 + head) * 4096;
#pragma unroll
      for (int m = 0; m < 4; ++m)
#pragma unroll
        for (int j = 0; j < 4; ++j) {
          const int t = (r0 + m * 16 + G * 4 + j) & 4095;
          const int pos = (t & ((1 << dsh) - 1)) * (4096 >> dsh) + (t >> dsh);
          u16* dst = p.QKVH + (hb + pos) * 64 + l15;
#pragma unroll
          for (int n = 0; n < 4; ++n) dst[n * 16] = f2bf(acc[m][n][j]);
        }
    } else {
#pragma unroll
      for (int m = 0; m < 4; ++m)
#pragma unroll
        for (int j = 0; j < 4; ++j) {
          const int row = r0 + m * 16 + G * 4 + j;
          u16* dst = p.QKVG + (size_t)row * ATT_IN + c0 + l15;
#pragma unroll
          for (int n = 0; n < 4; ++n) dst[n * 16] = f2bf(acc[m][n][j]);
        }
    }
    if (kind == 1 || kind == 2) {
      const int keep = 128 << (2 * g);
      const size_t okp = (g == 0) ? O_KVP0 : (g == 1) ? O_KVP1 : O_KVP2;
      const size_t oks = (g == 0) ? O_KVS0 : (g == 1) ? O_KVS1 : O_KVS2;
#pragma unroll
      for (int m = 0; m < 4; ++m)
#pragma unroll
        for (int j = 0; j < 4; ++j) {
          const int row = r0 + m * 16 + G * 4 + j;
          float* dst = nullptr;
          if (row < PROWS) {
            const int b = row >> 12, s = row & 4095;
            if (s >= 4096 - keep) dst = p.out + okp + ((size_t)(b * keep + s - (4096 - keep)) * 2 + (kind - 1)) * 1024 + head * 64 + l15;
          } else {
            dst = p.out + oks + ((size_t)(row - PROWS) * 2 + (kind - 1)) * 1024 + head * 64 + l15;
          }
          if (dst) {
#pragma unroll
            for (int n = 0; n < 4; ++n) dst[n * 16] = acc[m][n][j];
          }
        }
    }
  }
};
struct Ep2 {
  const Params& p;
  DI void operator()(f32x4 (&acc)[4][4], int r0, int c0, int lane) const {
    const int l15 = lane & 15, G = lane >> 4;
#pragma unroll
    for (int m = 0; m < 4; ++m)
#pragma unroll
      for (int j = 0; j < 4; ++j) {
        const int row = r0 + m * 16 + G * 4 + j;
        const float* xin = (row < PROWS) ? p.x_prompt + (size_t)row * 1024 : p.x_sample + (size_t)(row - PROWS) * 1024;
        float* dst = p.X1 + (size_t)row * 1024 + c0 + l15;
#pragma unroll
        for (int n = 0; n < 4; ++n) dst[n * 16] = xin[c0 + l15 + n * 16] + acc[m][n][j];
      }
  }
};
struct Ep3 {
  const Params& p;
  DI void operator()(f32x4 (&acc)[4][4], int r0, int c0, int lane) const {
    const int l15 = lane & 15, G = lane >> 4;
    if (c0 >= SSM_IN) return;
    if (c0 < 2048) {
#pragma unroll
      for (int m = 0; m < 4; ++m)
#pragma unroll
        for (int j = 0; j < 4; ++j) {
          const int row = r0 + m * 16 + G * 4 + j;
          u16* dst = p.Z + (size_t)row * 2048 + c0 + l15;
#pragma unroll
          for (int n = 0; n < 4; ++n) dst[n * 16] = f2bf(acc[m][n][j]);
        }
    } else if (c0 < 5120) {
      const int cc = c0 - 2048 + l15;
#pragma unroll
      for (int m = 0; m < 4; ++m)
#pragma unroll
        for (int j = 0; j < 4; ++j) {
          const int row = r0 + m * 16 + G * 4 + j;
          u16* dst = p.XBC + (size_t)row * 3072 + cc;
#pragma unroll
          for (int n = 0; n < 4; ++n) dst[n * 16] = f2bf(acc[m][n][j]);
          float* od = nullptr;
          if (row < PROWS) {
            const int b = row >> 12, s = row & 4095;
            if (s >= 4093) od = p.out + O_CONVP + (size_t)(b * 3 + s - 4093) * 3072 + cc;
          } else {
            const int rr = row - PROWS, b = rr >> 3, t = rr & 7;
            if (t >= 5) od = p.out + O_CONVS + (size_t)(b * 3 + t - 5) * 3072 + cc;
          }
          if (od) {
#pragma unroll
            for (int n = 0; n < 4; ++n) od[n * 16] = acc[m][n][j];
          }
        }
    } else {
#pragma unroll
      for (int m = 0; m < 4; ++m)
#pragma unroll
        for (int j = 0; j < 4; ++j) {
          const int row = r0 + m * 16 + G * 4 + j;
#pragma unroll
          for (int n = 0; n < 2; ++n) {
            const int h = n * 16 + l15;
            const float xv = acc[m][n][j] + p.ssm_dt_bias[h];
            p.DT[(size_t)row * 32 + h] = fmaxf(xv, 0.f) + log1pf(__expf(-fabsf(xv)));
          }
        }
    }
  }
};
struct Ep4 {
  const Params& p;
  DI void operator()(f32x4 (&acc)[4][4], int r0, int c0, int lane) const {
    const int l15 = lane & 15, G = lane >> 4;
#pragma unroll
    for (int m = 0; m < 4; ++m)
#pragma unroll
      for (int j = 0; j < 4; ++j) {
        const int row = r0 + m * 16 + G * 4 + j;
        const float* xin = p.X1 + (size_t)row * 1024 + c0 + l15;
        float* dst = p.out + O_Y + (size_t)row * 1024 + c0 + l15;
#pragma unroll
        for (int n = 0; n < 4; ++n) dst[n * 16] = xin[n * 16] + acc[m][n][j];
      }
  }
};

DI void transpose_task(const float* __restrict__ W, u16* __restrict__ Wt, int K, int N, int NTN, int tile, u16* smem) {
  const int tid = VTID;
  const int ktile = tile / NTN, ntile = tile % NTN;
  const int k0 = ktile * 64, n0 = ntile * 64;
#pragma unroll
  for (int i = 0; i < 4; ++i) {
    const int idx = tid + 256 * i;
    const int kk = idx >> 4, nq = idx & 15;
    const int n = n0 + nq * 4;
    float4 v = {0.f, 0.f, 0.f, 0.f};
    if (n < N) v = *(const float4*)(W + (size_t)(k0 + kk) * N + n);
    smem[(nq * 4 + 0) * LDT + kk] = f2bf(v.x);
    smem[(nq * 4 + 1) * LDT + kk] = f2bf(v.y);
    smem[(nq * 4 + 2) * LDT + kk] = f2bf(v.z);
    smem[(nq * 4 + 3) * LDT + kk] = f2bf(v.w);
  }
  __syncthreads();
#pragma unroll
  for (int i = 0; i < 2; ++i) {
    const int idx = tid + 256 * i;
    const int n = idx >> 3, kc = idx & 7;
    *(uint4*)(Wt + (size_t)(n0 + n) * K + k0 + kc * 8) = *(const uint4*)(smem + n * LDT + kc * 8);
  }
  __syncthreads();
}

DI void rmsnorm_row(const float* __restrict__ src, const float* __restrict__ wgt, u16* __restrict__ dst, int lane) {
  float4 v[4];
  float ss = 0.f;
#pragma unroll
  for (int i = 0; i < 4; ++i) {
    v[i] = *(const float4*)(src + lane * 4 + 256 * i);
    ss += v[i].x * v[i].x + v[i].y * v[i].y + v[i].z * v[i].z + v[i].w * v[i].w;
  }
  ss = sum16(ss);
  ss += __shfl_xor(ss, 16);
  ss += __shfl_xor(ss, 32);
  const float rstd = rsqrtf(ss * (1.f / 1024.f) + 1e-6f);
#pragma unroll
  for (int i = 0; i < 4; ++i) {
    const float4 g = *(const float4*)(wgt + lane * 4 + 256 * i);
    uint2 o;
    o.x = pack2(v[i].x * rstd * g.x, v[i].y * rstd * g.y);
    o.y = pack2(v[i].z * rstd * g.z, v[i].w * rstd * g.w);
    *(uint2*)(dst + lane * 4 + 256 * i) = o;
  }
}

constexpr int TR1 = 16 * 160, TR2 = 16 * 16, TR3 = 16 * 84, TR4 = 32 * 16;
DI void phase_prep(const Params& p, u16* smem) {
  constexpr int RT = MROWS / 4;
  for (int it = VBID; it < TR1 + RT; it += VGRID) {
    if (it < TR1) transpose_task(p.attn_w_in, p.Wt1, 1024, ATT_IN, 160, it, smem);
    else {
      const int row = (it - TR1) * 4 + (VTID >> 6);
      const float* src = (row < PROWS) ? p.x_prompt + (size_t)row * 1024 : p.x_sample + (size_t)(row - PROWS) * 1024;
      rmsnorm_row(src, p.attn_norm, p.H + (size_t)row * 1024, VTID & 63);
    }
  }
}
DI void late_transpose_task(const Params& p, int it, u16* smem) {
  if (it < TR2) transpose_task(p.attn_w_out, p.Wt2, 1024, 1024, 16, it, smem);
  else if (it < TR2 + TR3) transpose_task(p.ssm_w_in, p.Wt3, 1024, SSM_IN, 84, it - TR2, smem);
  else transpose_task(p.ssm_w_out, p.Wt4, 2048, 1024, 16, it - TR2 - TR3, smem);
}

DI void phase_norm2(const Params& p) {
  for (int it = VBID; it < MROWS / 4; it += VGRID) {
    const int row = it * 4 + (VTID >> 6);
    rmsnorm_row(p.X1 + (size_t)row * 1024, p.ssm_norm, p.H + (size_t)row * 1024, VTID & 63);
  }
}

struct PromptRegs { uint4 k[8], v[8]; bf16x8 q[2][2]; };
DI void attn_prompt_load(const Params& p, int item, PromptRegs& R) {
  const int tid = VTID, lane = tid & 63, w = tid >> 6, l15 = lane & 15, G = lane >> 4;
  const int rn = item & 31, head = (item >> 5) & 15, b = (item >> 9) & 3, g = item >> 11;
  const int dsh = 2 * g, dil = 1 << dsh, nbg = 32 >> dsh;
  const int r = rn / nbg, n = rn % nbg;
  const size_t hq = ((size_t)((b * 3 + g) * 3 + 0) * 16 + head) * 4096 + (size_t)r * (4096 >> dsh);
  const size_t hk = hq + (size_t)16 * 4096, hv = hq + (size_t)32 * 4096;
  (void)dil;
#pragma unroll
  for (int i = 0; i < 8; ++i) {
    const int c = tid + 256 * i;
    const int kj = c >> 3, ch = c & 7;
    const int u = (n - 1) * 128 + kj;
    R.k[i] = (uint4){0u, 0u, 0u, 0u}; R.v[i] = (uint4){0u, 0u, 0u, 0u};
    if (u >= 0) {
      R.k[i] = *(const uint4*)(p.QKVH + (hk + u) * 64 + ch * 8);
      R.v[i] = *(const uint4*)(p.QKVH + (hv + u) * 64 + ch * 8);
    }
  }
#pragma unroll
  for (int sub = 0; sub < 2; ++sub) {
    const u16* qp = p.QKVH + (hq + n * 128 + w * 32 + sub * 16 + l15) * 64 + G * 8;
    R.q[sub][0] = *(const bf16x8*)qp;
    R.q[sub][1] = *(const bf16x8*)(qp + 32);
  }
}
DI void attn_prompt_stage(const PromptRegs& R, u16* smem) {
  const int tid = VTID;
  u16* Ks = smem;
  u16* Vs = smem + 256 * LDT;
#pragma unroll
  for (int i = 0; i < 8; ++i) {
    const int c = tid + 256 * i;
    const int kj = c >> 3, ch = c & 7;
    *(uint4*)(Ks + kj * LDT + ch * 8) = R.k[i];
    *(uint4*)(Vs + kj * LDT + ch * 8) = R.v[i];
  }
}
DI void attn_prompt_compute(const Params& p, int item, const bf16x8 (&qpre)[2][2], u16* smem) {
  const int tid = VTID, lane = tid & 63, w = tid >> 6, l15 = lane & 15, G = lane >> 4;
  const int rn = item & 31, head = (item >> 5) & 15, b = (item >> 9) & 3, g = item >> 11;
  const int dsh = 2 * g, dil = 1 << dsh, nbg = 32 >> dsh;
  const int r = rn / nbg, n = rn % nbg;
  u16* Ks = smem;
  u16* Vs = smem + 256 * LDT;
#pragma unroll 1
  for (int sub = 0; sub < 2; ++sub) {
    const int q0 = w * 32 + sub * 16;
    const int qi = q0 + l15;
    const size_t rowq = (size_t)b * 4096 + (size_t)(n * 128 + qi) * dil + r;
    const bf16x8 qf0 = sub ? qpre[1][0] : qpre[0][0], qf1 = sub ? qpre[1][1] : qpre[0][1];
    f32x4 st[9];
#pragma unroll
    for (int s = 0; s < 9; ++s) {
      const u16* kp = Ks + (q0 + 16 * s + l15) * LDT + G * 8;
      const bf16x8 a0 = *(const bf16x8*)kp, a1 = *(const bf16x8*)(kp + 32);
      f32x4 z = {0.f, 0.f, 0.f, 0.f};
      z = MFMA16(a0, qf0, z);
      st[s] = MFMA16(a1, qf1, z);
    }
    float mx = -INFINITY;
#pragma unroll
    for (int s = 0; s < 9; ++s)
#pragma unroll
      for (int j = 0; j < 4; ++j) {
        const int kk = 16 * s + 4 * G + j;
        const bool valid = (kk >= l15) && (kk <= l15 + 128) && (n > 0 || q0 + kk >= 128);
        const float v = valid ? st[s][j] : -INFINITY;
        st[s][j] = v;
        mx = fmaxf(mx, v);
      }
    mx = fmaxf(mx, __shfl_xor(mx, 16));
    mx = fmaxf(mx, __shfl_xor(mx, 32));
    float sum = 0.f;
#pragma unroll
    for (int s = 0; s < 9; ++s)
#pragma unroll
      for (int j = 0; j < 4; ++j) {
        const float e = __expf(st[s][j] - mx);
        st[s][j] = e;
        sum += e;
      }
    sum += __shfl_xor(sum, 16);
    sum += __shfl_xor(sum, 32);
    const float inv = 1.f / sum;
    f32x4 o[4];
#pragma unroll
    for (int m = 0; m < 4; ++m) o[m] = (f32x4){0.f, 0.f, 0.f, 0.f};
#pragma unroll
    for (int t = 0; t < 5; ++t) {
      const int sA = 2 * t, sB = 2 * t + 1;
      bf16x8 pb;
      if (t < 4) pb = words_to_frag(pack2(st[sA][0], st[sA][1]), pack2(st[sA][2], st[sA][3]), pack2(st[sB < 9 ? sB : 8][0], st[sB < 9 ? sB : 8][1]), pack2(st[sB < 9 ? sB : 8][2], st[sB < 9 ? sB : 8][3]));
      else pb = words_to_frag(pack2(st[sA][0], st[sA][1]), pack2(st[sA][2], st[sA][3]), 0u, 0u);
      const u16* vA = Vs + (q0 + 16 * sA + 4 * G + (l15 >> 2)) * LDT + (l15 & 3) * 4;
      const u16* vB = Vs + (q0 + 16 * sB + 4 * G + (l15 >> 2)) * LDT + (l15 & 3) * 4;
#pragma unroll
      for (int m = 0; m < 4; ++m) {
        const s16x4 lo = tr_read(vA + 16 * m);
        s16x4 hi = {0, 0, 0, 0};
        if (t < 4) hi = tr_read(vB + 16 * m);
        o[m] = MFMA16(cat4(lo, hi), pb, o[m]);
      }
    }
    u16* op = p.OG + rowq * 3072 + g * 1024 + head * 64 + 4 * G;
#pragma unroll
    for (int m = 0; m < 4; ++m) {
      uint2 ov;
      ov.x = pack2(o[m][0] * inv, o[m][1] * inv);
      ov.y = pack2(o[m][2] * inv, o[m][3] * inv);
      *(uint2*)(op + 16 * m) = ov;
    }
    if (G == 0) p.LSE[rowq * 48 + g * 16 + head] = mx + __logf(sum);
  }
}

DI void attn_sample_task(const Params& p, int id) {
  const int lane = VTID & 63, l15 = lane & 15, G = lane >> 4;
  const int t = id & 7, head = (id >> 3) & 15, b = (id >> 7) & 31, g = id >> 12;
  const int L = 128 << (2 * g), dil = 1 << (2 * g);
  const float* cache = (g == 0) ? p.cache0 : (g == 1) ? p.cache1 : p.cache2;
  const float* newkv = p.out + ((g == 0) ? O_KVS0 : (g == 1) ? O_KVS1 : O_KVS2);
  const size_t rowq = (size_t)PROWS + b * 8 + t;
  const uint2 qq = *(const uint2*)(p.QKVG + rowq * ATT_IN + g * 3072 + head * 64 + 4 * l15);
  const float q0 = lo_f(qq.x), q1 = hi_f(qq.x), q2 = lo_f(qq.y), q3 = hi_f(qq.y);
  const int coff = head * 64 + 4 * l15;
  float mx = -INFINITY, sum = 0.f, a0 = 0.f, a1 = 0.f, a2 = 0.f, a3 = 0.f;
#pragma unroll 1
  for (int bt = 0; bt < 2; ++bt) {
    float4 kb[17], vb[17];
#pragma unroll
    for (int u = 0; u < 17; ++u) {
      const int j = 4 * (bt * 17 + u) + G;
      const int jc = j < 128 ? j : 128;
      const int idx = L + t - dil * jc;
      const float* kp = ((idx < L) ? cache + (size_t)(b * L + idx) * 2048 : newkv + (size_t)(b * 8 + idx - L) * 2048) + coff + 512;
      kb[u] = *(const float4*)(kp - 512);
      vb[u] = *(const float4*)(kp + 512);
    }
    float scb[17];
    float bm = -INFINITY;
#pragma unroll
    for (int u = 0; u < 17; ++u) {
      const int j = 4 * (bt * 17 + u) + G;
      float sv = q0 * kb[u].x + q1 * kb[u].y + q2 * kb[u].z + q3 * kb[u].w;
      sv = sum16(sv);
      sv = (j <= 128) ? sv : -INFINITY;
      scb[u] = sv;
      bm = fmaxf(bm, sv);
    }
    const float mn = fmaxf(mx, bm);
    const float corr = __expf(mx - mn);
    sum *= corr; a0 *= corr; a1 *= corr; a2 *= corr; a3 *= corr;
#pragma unroll
    for (int u = 0; u < 17; ++u) {
      const float pe = __expf(scb[u] - mn);
      sum += pe;
      a0 += pe * vb[u].x; a1 += pe * vb[u].y; a2 += pe * vb[u].z; a3 += pe * vb[u].w;
    }
    mx = mn;
  }
  {
    float M = fmaxf(mx, __shfl_xor(mx, 16));
    M = fmaxf(M, __shfl_xor(M, 32));
    const float f = __expf(mx - M);
    sum *= f; a0 *= f; a1 *= f; a2 *= f; a3 *= f;
    mx = M;
  }
  sum += __shfl_xor(sum, 16); sum += __shfl_xor(sum, 32);
  a0 += __shfl_xor(a0, 16); a0 += __shfl_xor(a0, 32);
  a1 += __shfl_xor(a1, 16); a1 += __shfl_xor(a1, 32);
  a2 += __shfl_xor(a2, 16); a2 += __shfl_xor(a2, 32);
  a3 += __shfl_xor(a3, 16); a3 += __shfl_xor(a3, 32);
  const float inv = 1.f / sum;
  if (G == 0) {
    uint2 ov;
    ov.x = pack2(a0 * inv, a1 * inv);
    ov.y = pack2(a2 * inv, a3 * inv);
    *(uint2*)(p.OG + rowq * 3072 + g * 1024 + coff) = ov;
    if (l15 == 0) p.LSE[rowq * 48 + g * 16 + head] = mx + __logf(sum);
  }
}

DI void attn_prompt_stream(const Params& p, u16* smem) {
  constexpr int NP = 6144;
  int item = VBID;
  PromptRegs R;
  if (item < NP) attn_prompt_load(p, item, R);
  while (item < NP) {
    attn_prompt_stage(R, smem);
    bf16x8 qc[2][2];
    qc[0][0] = R.q[0][0]; qc[0][1] = R.q[0][1]; qc[1][0] = R.q[1][0]; qc[1][1] = R.q[1][1];
    __syncthreads();
    const int next = item + VGRID;
    if (next < NP) attn_prompt_load(p, next, R);
    attn_prompt_compute(p, item, qc, smem);
    __syncthreads();
    item = next;
  }
}
DI void phase_attn(const Params& p, u16* smem) {
  constexpr int NS = 3072;
  const bool sample_first = ((blockIdx.x >> 3) & 1) != 0;
  if (!sample_first) attn_prompt_stream(p, smem);
  for (int it = VBID; it < NS; it += VGRID) attn_sample_task(p, it * 4 + (VTID >> 6));
  if (sample_first) attn_prompt_stream(p, smem);
  for (int it = VBID; it < TR2 + TR3 + TR4; it += VGRID) late_transpose_task(p, it, smem);
}

DI void conv_pass_task(const Params& p, int bt) {
  const int id = bt * 256 + VTID;
  const int ch = id % 384, seg = id / 384;
  const int col = ch * 8, row0 = seg * 8, t0 = row0 & 4095;
  const u16* src = p.XBC + (size_t)row0 * 3072 + col;
  uint4 raw[11];
#pragma unroll
  for (int j = 0; j < 3; ++j) {
    raw[j] = (uint4){0u, 0u, 0u, 0u};
    if (t0 > 0) raw[j] = *(const uint4*)(src - (ptrdiff_t)(3 - j) * 3072);
  }
#pragma unroll
  for (int j = 0; j < 8; ++j) raw[3 + j] = *(const uint4*)(src + (size_t)j * 3072);
  float wgt[4][8], bias[8];
#pragma unroll
  for (int j = 0; j < 4; ++j) {
    const float4 w0 = *(const float4*)(p.ssm_conv_w + j * 3072 + col), w1 = *(const float4*)(p.ssm_conv_w + j * 3072 + col + 4);
    wgt[j][0] = w0.x; wgt[j][1] = w0.y; wgt[j][2] = w0.z; wgt[j][3] = w0.w;
    wgt[j][4] = w1.x; wgt[j][5] = w1.y; wgt[j][6] = w1.z; wgt[j][7] = w1.w;
  }
  {
    const float4 b0 = *(const float4*)(p.ssm_conv_b + col), b1 = *(const float4*)(p.ssm_conv_b + col + 4);
    bias[0] = b0.x; bias[1] = b0.y; bias[2] = b0.z; bias[3] = b0.w;
    bias[4] = b1.x; bias[5] = b1.y; bias[6] = b1.z; bias[7] = b1.w;
  }
  float win[3][8];
  unpack8(raw[0], win[0]); unpack8(raw[1], win[1]); unpack8(raw[2], win[2]);
  u16* dst = p.XBCC + (size_t)row0 * 3072 + col;
#pragma unroll
  for (int i = 0; i < 8; ++i) {
    float cur[8], r[8];
    unpack8(raw[3 + i], cur);
#pragma unroll
    for (int e = 0; e < 8; ++e) {
      const float v = bias[e] + wgt[0][e] * win[0][e] + wgt[1][e] * win[1][e] + wgt[2][e] * win[2][e] + wgt[3][e] * cur[e];
      r[e] = silu_f(v);
      win[0][e] = win[1][e]; win[1][e] = win[2][e]; win[2][e] = cur[e];
    }
    *(uint4*)(dst + (size_t)i * 3072) = pack8(r);
  }
}

DI void acs_task(const Params& p, int bc) {
  const int lane = VTID & 63, head = lane & 31, half = lane >> 5;
  const float Aneg = -__expf(p.ssm_A_log[head]);
  const size_t rb = (size_t)bc * 128 + half * 64;
  float run = 0.f;
#pragma unroll 8
  for (int i = 0; i < 64; ++i) run += p.DT[(rb + i) * 32 + head] * Aneg;
  const float tot0 = __shfl(run, head);
  run = half ? tot0 : 0.f;
#pragma unroll 8
  for (int i = 0; i < 64; ++i) {
    run += p.DT[(rb + i) * 32 + head] * Aneg;
    p.ACS[(rb + i) * 32 + head] = run;
  }
}

DI void phase_convpass(const Params& p) {
  constexpr int NC = PROWS / 8 * 384 / 256;
  for (int it = VBID; it < NC + 32; it += VGRID) {
    if (it < NC) conv_pass_task(p, it);
    else acs_task(p, (it - NC) * 4 + (VTID >> 6));
  }
}

constexpr int SS_B = 0;
constexpr int SS_R2 = 34816;
constexpr int SS_H = 34816 + 18432;
constexpr int SS_F = 70656;

DI void ssd_states_item(const Params& p, int item, char* smem_raw) {
  const int tid = VTID, lane = tid & 63, w = tid >> 6, l15 = lane & 15, G = lane >> 4;
  const int head = item & 31, c = (item >> 5) & 31, b = item >> 10, g = head >> 3;
  u16* Bs = (u16*)(smem_raw + SS_B);
  u16* Xs = (u16*)(smem_raw + SS_R2);
  const size_t row0 = (size_t)b * 4096 + c * 128;
  const float a_end = p.ACS[(row0 + 127) * 32 + head];
#pragma unroll
  for (int i = 0; i < 4; ++i) {
    const int row = (tid >> 3) + 32 * i, ch = tid & 7;
    const float wl = p.DT[(row0 + row) * 32 + head] * __expf(a_end - p.ACS[(row0 + row) * 32 + head]);
    const uint4 v = *(const uint4*)(p.XBCC + (row0 + row) * 3072 + head * 64 + ch * 8);
    uint4 o;
    o.x = pack2(lo_f(v.x) * wl, hi_f(v.x) * wl); o.y = pack2(lo_f(v.y) * wl, hi_f(v.y) * wl);
    o.z = pack2(lo_f(v.z) * wl, hi_f(v.z) * wl); o.w = pack2(lo_f(v.w) * wl, hi_f(v.w) * wl);
    *(uint4*)(Xs + row * LDT + ch * 8) = o;
  }
#pragma unroll
  for (int i = 0; i < 8; ++i) {
    const int idx = tid + 256 * i, row = idx >> 4, ch = idx & 15;
    *(uint4*)(Bs + row * LDW + ch * 8) = *(const uint4*)(p.XBCC + (row0 + row) * 3072 + 2048 + g * 128 + ch * 8);
  }
  __syncthreads();
  f32x4 acc[4][2];
#pragma unroll
  for (int m = 0; m < 4; ++m) { acc[m][0] = (f32x4){0.f, 0.f, 0.f, 0.f}; acc[m][1] = (f32x4){0.f, 0.f, 0.f, 0.f}; }
#pragma unroll
  for (int k = 0; k < 4; ++k) {
    const int rowA = 32 * k + 8 * G + (l15 >> 2);
    bf16x8 a[4], bb[2];
#pragma unroll
    for (int m = 0; m < 4; ++m) {
      const u16* ap = Xs + rowA * LDT + 16 * m + (l15 & 3) * 4;
      a[m] = cat4(tr_read(ap), tr_read(ap + 4 * LDT));
    }
#pragma unroll
    for (int nn = 0; nn < 2; ++nn) {
      const u16* bp = Bs + rowA * LDW + 32 * w + 16 * nn + (l15 & 3) * 4;
      bb[nn] = cat4(tr_read(bp), tr_read(bp + 4 * LDW));
    }
#pragma unroll
    for (int m = 0; m < 4; ++m)
#pragma unroll
      for (int nn = 0; nn < 2; ++nn) acc[m][nn] = MFMA16(a[m], bb[nn], acc[m][nn]);
  }
  u16* sp = p.STATES + (size_t)item * 64 * 128;
#pragma unroll
  for (int m = 0; m < 4; ++m)
#pragma unroll
    for (int nn = 0; nn < 2; ++nn)
#pragma unroll
      for (int j = 0; j < 4; ++j) sp[(16 * m + 4 * G + j) * 128 + 32 * w + 16 * nn + l15] = f2bf(acc[m][nn][j]);
  if (tid == 0) p.CD[item] = __expf(a_end);
  __syncthreads();
}

DI void ssm_sample_item(const Params& p, int item, char* smem_raw) {
  const int tid = VTID;
  const int head = item & 31, b = item >> 5, g = head >> 3;
  float* sx = (float*)smem_raw;
  float* sB = sx + 512;
  float* sC = sB + 1024;
  float* sdt = sC + 1024;
  float* sdA = sdt + 8;
  float* sy2 = sdA + 8;
  const size_t row0 = (size_t)PROWS + b * 8;
  const float Aneg = -__expf(p.ssm_A_log[head]);
  for (int task = tid; task < 320; task += 256) {
    int col; float* dst;
    if (task < 64) { col = head * 64 + task; dst = sx + task; }
    else if (task < 192) { col = 2048 + g * 128 + (task - 64); dst = sB + (task - 64); }
    else { col = 2560 + g * 128 + (task - 192); dst = sC + (task - 192); }
    const int dstride = (task < 64) ? 64 : 128;
    const float w0 = p.ssm_conv_w[col], w1 = p.ssm_conv_w[3072 + col], w2 = p.ssm_conv_w[2 * 3072 + col], w3 = p.ssm_conv_w[3 * 3072 + col];
    const float bias = p.ssm_conv_b[col];
    float x0 = p.state_conv[(size_t)(b * 3 + 0) * 3072 + col];
    float x1 = p.state_conv[(size_t)(b * 3 + 1) * 3072 + col];
    float x2 = p.state_conv[(size_t)(b * 3 + 2) * 3072 + col];
#pragma unroll
    for (int t = 0; t < 8; ++t) {
      const float cur = bf2f(p.XBC[(row0 + t) * 3072 + col]);
      const float v = bias + w0 * x0 + w1 * x1 + w2 * x2 + w3 * cur;
      dst[t * dstride] = silu_f(v);
      x0 = x1; x1 = x2; x2 = cur;
    }
  }
  if (tid < 8) {
    const float dt = p.DT[(row0 + tid) * 32 + head];
    sdt[tid] = dt;
    sdA[tid] = __expf(dt * Aneg);
  }
  __syncthreads();
  const int pp = tid >> 2, nq = tid & 3;
  const size_t sbase = ((size_t)(b * 32 + head) * 64 + pp) * 128 + nq * 4;
  float4 h[8];
#pragma unroll
  for (int i = 0; i < 8; ++i) h[i] = *(const float4*)(p.state_ssm + sbase + i * 16);
  const float Dh = p.ssm_D[head];
#pragma unroll 1
  for (int t = 0; t < 8; ++t) {
    const float dA = sdA[t];
    const float xv = sx[t * 64 + pp];
    const float dtx = sdt[t] * xv;
    float y = 0.f;
#pragma unroll
    for (int i = 0; i < 8; ++i) {
      const float4 Bv = *(const float4*)(sB + t * 128 + i * 16 + nq * 4);
      const float4 Cv = *(const float4*)(sC + t * 128 + i * 16 + nq * 4);
      h[i].x = h[i].x * dA + dtx * Bv.x; h[i].y = h[i].y * dA + dtx * Bv.y;
      h[i].z = h[i].z * dA + dtx * Bv.z; h[i].w = h[i].w * dA + dtx * Bv.w;
      y += h[i].x * Cv.x + h[i].y * Cv.y + h[i].z * Cv.z + h[i].w * Cv.w;
    }
    y = sum4(y);
    if (nq == 0) {
      const float z = bf2f(p.Z[(row0 + t) * 2048 + head * 64 + pp]);
      const float yg = (y + Dh * xv) * silu_f(z);
      p.YG[(row0 + t) * 2048 + head * 64 + pp] = f2bf(yg);
      sy2[t * 64 + pp] = yg * yg;
    }
  }
  float* od = p.out + O_SSMS + sbase;
#pragma unroll
  for (int i = 0; i < 8; ++i) *(float4*)(od + i * 16) = h[i];
  __syncthreads();
  if (tid < 8) {
    float s = 0.f;
    for (int i = 0; i < 64; ++i) s += sy2[tid * 64 + i];
    p.SSQ[(row0 + tid) * 32 + head] = s;
  }
  __syncthreads();
}

DI void phase_states(const Params& p, char* smem_raw) {
  constexpr int NP = 4096, NS = 1024;
  for (int it = VBID; it < NP + NS; it += VGRID) {
    const int pr = it >> 1, sub = it & 1;
    const int q = pr / 5, rem = pr - q * 5;
    if (rem == 4) ssm_sample_item(p, q * 2 + sub, smem_raw);
    else ssd_states_item(p, (q * 4 + rem) * 2 + sub, smem_raw);
  }
}

DI void phase_scan(const Params& p) {
  for (int task = VBID * 256 + VTID; task < 131072; task += VGRID * 256) {
    const int n8 = task & 15, pp = (task >> 4) & 63, head = (task >> 10) & 31, b = task >> 15;
    float h[8];
#pragma unroll
    for (int e = 0; e < 8; ++e) h[e] = 0.f;
#pragma unroll 8
    for (int c = 0; c < 32; ++c) {
      const int item = (b * 32 + c) * 32 + head;
      uint4* sp = (uint4*)(p.STATES + ((size_t)item * 64 + pp) * 128 + n8 * 8);
      const uint4 sv = *sp;
      const float d = p.CD[item];
      *sp = pack8(h);
      float sf[8];
      unpack8(sv, sf);
#pragma unroll
      for (int e = 0; e < 8; ++e) h[e] = h[e] * d + sf[e];
    }
    float* od = p.out + O_SSMP + ((size_t)(b * 32 + head) * 64 + pp) * 128 + n8 * 8;
    *(float4*)od = (float4){h[0], h[1], h[2], h[3]};
    *(float4*)(od + 4) = (float4){h[4], h[5], h[6], h[7]};
  }
}

DI void ssd_out_item(const Params& p, int item, char* smem_raw) {
  const int tid = VTID, lane = tid & 63, w = tid >> 6, l15 = lane & 15, G = lane >> 4;
  const int head = item & 31, c = (item >> 5) & 31, b = item >> 10, g = head >> 3;
  u16* Bs = (u16*)(smem_raw + SS_B);
  u16* Xs = (u16*)(smem_raw + SS_R2);
  u16* Hs = (u16*)(smem_raw + SS_H);
  float* s_acs = (float*)(smem_raw + SS_F);
  float* s_dt = s_acs + 128;
  const size_t row0 = (size_t)b * 4096 + c * 128;
  if (tid < 128) {
    s_acs[tid] = p.ACS[(row0 + tid) * 32 + head];
    s_dt[tid] = p.DT[(row0 + tid) * 32 + head];
  }
#pragma unroll
  for (int i = 0; i < 8; ++i) {
    const int idx = tid + 256 * i, row = idx >> 4, ch = idx & 15;
    *(uint4*)(Bs + row * LDW + ch * 8) = *(const uint4*)(p.XBCC + (row0 + row) * 3072 + 2048 + g * 128 + ch * 8);
  }
#pragma unroll
  for (int i = 0; i < 4; ++i) {
    const int row = (tid >> 3) + 32 * i, ch = tid & 7;
    *(uint4*)(Xs + row * LDT + ch * 8) = *(const uint4*)(p.XBCC + (row0 + row) * 3072 + head * 64 + ch * 8);
  }
  {
    const u16* hp = p.STATES + (size_t)item * 64 * 128;
#pragma unroll
    for (int i = 0; i < 4; ++i) {
      const int idx = tid + 256 * i, pp = idx >> 4, ch = idx & 15;
      *(uint4*)(Hs + pp * LDW + ch * 8) = *(const uint4*)(hp + pp * 128 + ch * 8);
    }
  }
  bf16x8 cf[2][4];
#pragma unroll
  for (int sub = 0; sub < 2; ++sub)
#pragma unroll
    for (int ks = 0; ks < 4; ++ks)
      cf[sub][ks] = *(const bf16x8*)(p.XBCC + (row0 + w * 32 + sub * 16 + l15) * 3072 + 2560 + g * 128 + ks * 32 + G * 8);
  uint2 zpre[2][4];
#pragma unroll
  for (int sub = 0; sub < 2; ++sub)
#pragma unroll
    for (int m = 0; m < 4; ++m)
      zpre[sub][m] = *(const uint2*)(p.Z + (row0 + w * 32 + sub * 16 + l15) * 2048 + head * 64 + 16 * m + 4 * G);
  __syncthreads();
  const float Dh = p.ssm_D[head];
#pragma unroll
  for (int sub = 0; sub < 2; ++sub) {
    const int l0 = w * 32 + sub * 16, lq = l0 + l15;
    const float acs_q = s_acs[lq];
    f32x4 yo[4];
#pragma unroll
    for (int m = 0; m < 4; ++m) {
      f32x4 z = {0.f, 0.f, 0.f, 0.f};
#pragma unroll
      for (int ks = 0; ks < 4; ++ks) z = MFMA16(*(const bf16x8*)(Hs + (16 * m + l15) * LDW + ks * 32 + G * 8), cf[sub][ks], z);
      yo[m] = z;
    }
    {
      const float ea = __expf(acs_q);
#pragma unroll
      for (int m = 0; m < 4; ++m) { yo[m][0] *= ea; yo[m][1] *= ea; yo[m][2] *= ea; yo[m][3] *= ea; }
    }
    const int ns = (l0 >> 4) + 1, nsteps = (ns + 1) >> 1;
#pragma unroll 1
    for (int step = 0; step < nsteps; ++step) {
      unsigned pw[4];
#pragma unroll
      for (int h2 = 0; h2 < 2; ++h2) {
        const int ss = 2 * step + h2;
        f32x4 st = {0.f, 0.f, 0.f, 0.f};
#pragma unroll
        for (int ks = 0; ks < 4; ++ks) st = MFMA16(*(const bf16x8*)(Bs + (16 * ss + l15) * LDW + ks * 32 + G * 8), cf[sub][ks], st);
        float mv[4];
#pragma unroll
        for (int j = 0; j < 4; ++j) {
          const int s = 16 * ss + 4 * G + j;
          const float dec = __expf(fminf(acs_q - s_acs[s], 0.f)) * s_dt[s];
          mv[j] = (s <= lq) ? st[j] * dec : 0.f;
        }
        pw[2 * h2] = pack2(mv[0], mv[1]);
        pw[2 * h2 + 1] = pack2(mv[2], mv[3]);
      }
      const bf16x8 pb = words_to_frag(pw[0], pw[1], pw[2], pw[3]);
      const u16* xa = Xs + (32 * step + 4 * G + (l15 >> 2)) * LDT + (l15 & 3) * 4;
#pragma unroll
      for (int m = 0; m < 4; ++m) yo[m] = MFMA16(cat4(tr_read(xa + 16 * m), tr_read(xa + 16 * LDT + 16 * m)), pb, yo[m]);
    }
    const size_t rowg = (size_t)b * 4096 + c * 128 + lq;
    float ssq = 0.f;
#pragma unroll
    for (int m = 0; m < 4; ++m) {
      const uint2 xv = *(const uint2*)(Xs + lq * LDT + 16 * m + 4 * G);
      const uint2 zv = zpre[sub][m];
      const float xf[4] = {lo_f(xv.x), hi_f(xv.x), lo_f(xv.y), hi_f(xv.y)};
      const float zf[4] = {lo_f(zv.x), hi_f(zv.x), lo_f(zv.y), hi_f(zv.y)};
      float y[4];
#pragma unroll
      for (int j = 0; j < 4; ++j) {
        y[j] = (yo[m][j] + Dh * xf[j]) * silu_f(zf[j]);
        ssq += y[j] * y[j];
      }
      uint2 ov; ov.x = pack2(y[0], y[1]); ov.y = pack2(y[2], y[3]);
      *(uint2*)(p.YG + rowg * 2048 + head * 64 + 16 * m + 4 * G) = ov;
    }
    ssq += __shfl_xor(ssq, 16);
    ssq += __shfl_xor(ssq, 32);
    if (G == 0) p.SSQ[rowg * 32 + head] = ssq;
  }
  __syncthreads();
}

#define XB_TMO      128
#define XB_XCNT(j)  (256  + 64 * (j))
#define XB_XSUB(j)  (1280 + 64 * (j))
#define XB_XGEN(j)  (2304 + 64 * (j))
#define XB_TOP      3328
#define XB_TOPGEN   3392
#define XCD_BAR_WORDS 3456
#define XB_SPIN_CAP (1u << 20)
#define LAS __attribute__((address_space(3)))
DI unsigned xb_ld(unsigned* p) { return __hip_atomic_load(p, __ATOMIC_RELAXED, __HIP_MEMORY_SCOPE_AGENT); }
DI unsigned xb_add(unsigned* p, unsigned v) { return __hip_atomic_fetch_add(p, v, __ATOMIC_RELAXED, __HIP_MEMORY_SCOPE_AGENT); }
DI unsigned xb_xcc_id() { return (unsigned)__builtin_amdgcn_s_getreg((3 << 11) | 20) & 0xFu; }
#define XB_SPIN(cond, bar) do { unsigned _sp = 0; while (cond) { __builtin_amdgcn_s_sleep(1); \
    if ((++_sp & 255u) == 0u) { if (xb_ld(&(bar)[XB_TMO])) break; if (_sp > XB_SPIN_CAP) { atomicAdd(&(bar)[XB_TMO], 1u); break; } } } } while (0)
struct XcdBarrier { unsigned* bar; unsigned x; volatile LAS unsigned* st; };
DI XcdBarrier xcd_barrier_post(unsigned* bar, volatile LAS unsigned* st) {
  XcdBarrier b; b.bar = bar; b.x = xb_xcc_id(); b.st = st;
  if (threadIdx.x == 0) (void)xb_add(&bar[XB_XCNT(b.x)], 1u);
  return b;
}
DI void xcd_barrier_complete(unsigned* bar, unsigned x, unsigned& nloc, unsigned& nx) {
  const unsigned Gn = gridDim.x * gridDim.y * gridDim.z;
  unsigned sum, cnt, mine, sp = 0u;
  for (;;) {
    sum = 0u; cnt = 0u; mine = 0u;
#pragma unroll
    for (unsigned j = 0; j < 16; ++j) { const unsigned c = xb_ld(&bar[XB_XCNT(j)]); sum += c; cnt += (c > 0u) ? 1u : 0u; mine = (j == x) ? c : mine; }
    if (sum == Gn) break;
    __builtin_amdgcn_s_sleep(1);
    if ((++sp & 255u) == 0u) { if (xb_ld(&bar[XB_TMO])) break; if (sp > XB_SPIN_CAP) { atomicAdd(&bar[XB_TMO], 1u); break; } }
  }
  nloc = mine > 0u ? mine : 1u; nx = cnt > 0u ? cnt : 1u;
}
DI void xcd_barrier(const XcdBarrier& b) {
  asm volatile("s_waitcnt vmcnt(0)" ::: "memory");
  __syncthreads();
  if (threadIdx.x == 0) {
    unsigned* bar = b.bar;
    __builtin_amdgcn_s_waitcnt(0);
    unsigned nloc = b.st[0], nx = b.st[1];
    if (nloc == 0u) { xcd_barrier_complete(bar, b.x, nloc, nx); b.st[0] = nloc; b.st[1] = nx; }
    const unsigned old = xb_add(&bar[XB_XSUB(b.x)], 1u);
    const unsigned gen = old / nloc;
    if (old + 1u == (gen + 1u) * nloc) {
      __builtin_amdgcn_fence(__ATOMIC_RELEASE, "agent");
      asm volatile("s_waitcnt vmcnt(0)" ::: "memory");
      const unsigned og = xb_add(&bar[XB_TOP], 1u);
      const unsigned tg = og / nx;
      if (og + 1u == (tg + 1u) * nx) xb_add(&bar[XB_TOPGEN], 1u);
      else XB_SPIN(xb_ld(&bar[XB_TOPGEN]) == tg, bar);
      __builtin_amdgcn_fence(__ATOMIC_ACQUIRE, "agent");
      xb_add(&bar[XB_XGEN(b.x)], 1u);
      asm volatile("s_waitcnt vmcnt(0)" ::: "memory");
    } else {
      XB_SPIN(xb_ld(&bar[XB_XGEN(b.x)]) == gen, bar);
      __builtin_amdgcn_fence(__ATOMIC_ACQUIRE, "agent");
      asm volatile("s_waitcnt vmcnt(0)" ::: "memory");
    }
  }
  __syncthreads();
}

constexpr int NPHASE = 13;
#ifndef PH_MASK
#define PH_MASK 0x1fff
#endif
#define PH_ON(k) (((PH_MASK) >> (k)) & 1)
#ifndef PH_REPEAT
#define PH_REPEAT 0
#endif
#define PH_REP(k) (((PH_REPEAT) >> (k)) & 1)

template <bool COOP>
__global__ void __launch_bounds__(512, 2) mega(Params p, int ph0, int ph1) {
  extern __shared__ __attribute__((aligned(16))) char smem_all[];
  char* smem_raw = smem_all + (threadIdx.x >> 8) * LDS_HALF;
  u16* smem = (u16*)smem_raw;
#define PHASE_BODY(k)                                                                                                   \
  do {                                                                                                                  \
    if (k == 0) { if (PH_ON(0)) phase_prep(p, smem); }                                                                  \
    else if (k == 1) { if (PH_ON(1)) gemm_phase_big(p.H, p.Wt1, 1024, MROWS / 256, ATT_IN / 256, Ep1{p}, smem_all); }  \
    else if (k == 2) { if (PH_ON(2)) phase_attn(p, smem); }                                                             \
    else if (k == 3) { if (PH_ON(3)) phase_merge(p); }                                                                  \
    else if (k == 4) { if (PH_ON(4)) gemm_phase_big(p.H, p.Wt2, 1024, MROWS / 256, 4, Ep2{p}, smem_all); }             \
    else if (k == 5) { if (PH_ON(5)) phase_norm2(p); }                                                                  \
    else if (k == 6) { if (PH_ON(6)) gemm_phase_big(p.H, p.Wt3, 1024, MROWS / 256, SSM_IN_PAD / 256, Ep3{p}, smem_all); } \
    else if (k == 7) { if (PH_ON(7)) phase_convpass(p); }                                                               \
    else if (k == 8) { if (PH_ON(8)) phase_states(p, smem_raw); }                                                       \
    else if (k == 9) { if (PH_ON(9)) phase_scan(p); }                                                                   \
    else if (k == 10) { if (PH_ON(10)) for (int it = VBID; it < 4096; it += VGRID) ssd_out_item(p, it, smem_raw); } \
    else if (k == 11) { if (PH_ON(11)) phase_gatenorm(p); }                                                             \
    else if (k == 12) { if (PH_ON(12)) gemm_phase_big(p.YG, p.Wt4, 2048, MROWS / 256, 4, Ep4{p}, smem_all); }          \
  } while (0)
#define PHASE_STEP(k) PHASE_BODY(k); if (PH_REP(k)) { xcd_barrier(xb); PHASE_BODY(k); }
  if constexpr (COOP) {
    volatile LAS unsigned* xst = (volatile LAS unsigned*)(smem_all + LDS_MAIN);
    if (threadIdx.x == 0) { xst[0] = 0u; xst[1] = 0u; }
    __syncthreads();
    const XcdBarrier xb = xcd_barrier_post(p.bar, xst);
    if (ph0 == 0x7fffffff) cg::this_grid().sync();
    PHASE_STEP(0) xcd_barrier(xb);
    PHASE_STEP(1) xcd_barrier(xb);
    PHASE_STEP(2) xcd_barrier(xb);
    PHASE_STEP(3) xcd_barrier(xb);
    PHASE_STEP(4) xcd_barrier(xb);
    PHASE_STEP(5) xcd_barrier(xb);
    PHASE_STEP(6) xcd_barrier(xb);
    PHASE_STEP(7) xcd_barrier(xb);
    PHASE_STEP(8) xcd_barrier(xb);
    PHASE_STEP(9) xcd_barrier(xb);
    PHASE_STEP(10) xcd_barrier(xb);
    PHASE_STEP(11) xcd_barrier(xb);
    PHASE_STEP(12)
  } else {
    switch (ph0) {
      case 0: PHASE_BODY(0); break;
      case 1: PHASE_BODY(1); break;
      case 2: PHASE_BODY(2); break;
      case 3: PHASE_BODY(3); break;
      case 4: PHASE_BODY(4); break;
      case 5: PHASE_BODY(5); break;
      case 6: PHASE_BODY(6); break;
      case 7: PHASE_BODY(7); break;
      case 8: PHASE_BODY(8); break;
      case 9: PHASE_BODY(9); break;
      case 10: PHASE_BODY(10); break;
      case 11: PHASE_BODY(11); break;
      case 12: PHASE_BODY(12); break;
    }
  }
}

#ifndef MULTI_LAUNCH
#define MULTI_LAUNCH 0
#endif

extern "C" void kernel_launch(void* const* d_in, const int* in_sizes, int n_in, void* d_out, int out_size, void* d_ws, size_t ws_size,
                              hipStream_t stream) {
  static int grid = 0;
  size_t off = 0;
  auto carve = [&](size_t bytes) { size_t o = off; off += (bytes + 255) & ~(size_t)255; return (char*)d_ws + o; };
  Params p{};
  p.x_prompt = (const float*)d_in[0]; p.x_sample = (const float*)d_in[1];
  p.cache0 = (const float*)d_in[2]; p.cache1 = (const float*)d_in[3]; p.cache2 = (const float*)d_in[4];
  p.state_conv = (const float*)d_in[5]; p.state_ssm = (const float*)d_in[6];
  p.attn_norm = (const float*)d_in[7]; p.attn_w_in = (const float*)d_in[8]; p.attn_q_gain = (const float*)d_in[9];
  p.attn_k_gain = (const float*)d_in[10]; p.attn_w_out = (const float*)d_in[11];
  p.ssm_norm = (const float*)d_in[12]; p.ssm_w_in = (const float*)d_in[13]; p.ssm_conv_w = (const float*)d_in[14];
  p.ssm_conv_b = (const float*)d_in[15]; p.ssm_dt_bias = (const float*)d_in[16]; p.ssm_A_log = (const float*)d_in[17];
  p.ssm_D = (const float*)d_in[18]; p.ssm_gate_norm = (const float*)d_in[19]; p.ssm_w_out = (const float*)d_in[20];
  p.out = (float*)d_out;
  p.Wt1 = (u16*)carve((size_t)ATT_IN * 1024 * 2);
  p.Wt2 = (u16*)carve((size_t)1024 * 1024 * 2);
  p.Wt3 = (u16*)carve((size_t)SSM_IN_PAD * 1024 * 2);
  p.Wt4 = (u16*)carve((size_t)1024 * 2048 * 2);
  p.H = (u16*)carve((size_t)MROWS * 1024 * 2);
  p.QKVG = (u16*)carve((size_t)MROWS * ATT_IN * 2);
  p.OG = (u16*)carve((size_t)MROWS * 3072 * 2);
  p.Z = (u16*)carve((size_t)MROWS * 2048 * 2);
  p.XBC = (u16*)carve((size_t)MROWS * 3072 * 2);
  p.YG = (u16*)carve((size_t)MROWS * 2048 * 2);
  p.LSE = (float*)carve((size_t)MROWS * 48 * 4);
  p.X1 = (float*)carve((size_t)MROWS * 1024 * 4);
  p.DT = (float*)carve((size_t)MROWS * 32 * 4);
  p.STATES = (u16*)carve((size_t)4 * 32 * 32 * 64 * 128 * 2);
  p.XBCC = (u16*)carve((size_t)PROWS * 3072 * 2);
  p.ACS = (float*)carve((size_t)PROWS * 32 * 4);
  p.bar = (unsigned*)carve((size_t)XCD_BAR_WORDS * 4);
  p.QKVH = (u16*)carve((size_t)4 * 3 * 3 * 16 * 4096 * 64 * 2);
  p.SSQ = (float*)carve((size_t)MROWS * 32 * 4);
  p.CD = (float*)carve((size_t)4 * 32 * 32 * 4);
  if (grid == 0) {
    if (n_in != 21 || (size_t)out_size != O_END || ws_size < off) {
      fprintf(stderr, "kernel_launch: unexpected shapes: n_in %d out %d (want %zu) ws %zu (need %zu)\n", n_in, out_size, (size_t)O_END, ws_size, off);
      grid = -1; return;
    }
    int dev = 0, cus = 0, per_cu = 0;
    hipGetDevice(&dev);
    hipDeviceGetAttribute(&cus, hipDeviceAttributeMultiprocessorCount, dev);
    hipFuncSetAttribute((const void*)mega<true>, hipFuncAttributeMaxDynamicSharedMemorySize, LDS_BYTES);
    hipFuncSetAttribute((const void*)mega<false>, hipFuncAttributeMaxDynamicSharedMemorySize, LDS_BYTES);
    hipOccupancyMaxActiveBlocksPerMultiprocessor(&per_cu, (const void*)mega<true>, 512, LDS_BYTES);
    if (per_cu < 1) { fprintf(stderr, "kernel_launch: occupancy query returned %d\n", per_cu); grid = -1; return; }
    if (per_cu > 1) per_cu = 1;
    grid = cus * per_cu;
    grid &= ~7;
  }
  if (grid < 0) return;
#if MULTI_LAUNCH
  for (int ph = 0; ph < NPHASE; ++ph) hipLaunchKernelGGL(mega<false>, dim3(grid), dim3(512), LDS_BYTES, stream, p, ph, ph + 1);
#else
  hipMemsetAsync(p.bar, 0, (size_t)XCD_BAR_WORDS * 4, stream);
  int ph0 = 0, ph1 = NPHASE;
  void* args[] = {&p, &ph0, &ph1};
  hipError_t e = hipLaunchCooperativeKernel((const void*)mega<true>, dim3(grid), dim3(512), args, LDS_BYTES, stream);
  if (e != hipSuccess) fprintf(stderr, "cooperative launch failed: %s (grid %d)\n", hipGetErrorString(e), grid);
#endif
}
```

```cpp
#include <hip/hip_runtime.h>
#include <hip/hip_cooperative_groups.h>
#include <cstdio>
#include <cstdint>
namespace cg = cooperative_groups;

typedef unsigned short u16;
typedef short bf16x8 __attribute__((ext_vector_type(8)));
typedef short s16x4 __attribute__((ext_vector_type(4)));
typedef float f32x4 __attribute__((ext_vector_type(4)));

#define DI __device__ __forceinline__
__device__ __forceinline__ int opaque_tid() { int t = threadIdx.x; asm volatile("" : "+v"(t)); return t; }
#define VTID (opaque_tid() & 255)
#define VBID ((int)(blockIdx.x * 2 + (opaque_tid() >> 8)))
#define VGRID ((int)(gridDim.x * 2))
#define MFMA16(a, b, c) __builtin_amdgcn_mfma_f32_16x16x32_bf16((a), (b), (c), 0, 0, 0)

constexpr int MROWS = 16384 + 256;
constexpr int PROWS = 16384;
constexpr int ATT_IN = 10240;
constexpr int SSM_IN = 5152;
constexpr int SSM_IN_PAD = 5376;
constexpr int LDS_HALF = 73728;
constexpr int LDS_MAIN = 2 * LDS_HALF;
constexpr int LDS_BYTES = LDS_MAIN + 16;
constexpr int LDT = 72;
constexpr int LDW = 136;
constexpr int TILE_ELEMS = 128 * LDT;

constexpr size_t O_Y = 0;
constexpr size_t O_KVP0 = (size_t)MROWS * 1024;
constexpr size_t O_KVP1 = O_KVP0 + (size_t)4 * 128 * 2048;
constexpr size_t O_KVP2 = O_KVP1 + (size_t)4 * 512 * 2048;
constexpr size_t O_KVS0 = O_KVP2 + (size_t)4 * 2048 * 2048;
constexpr size_t O_KVS1 = O_KVS0 + (size_t)256 * 2048;
constexpr size_t O_KVS2 = O_KVS1 + (size_t)256 * 2048;
constexpr size_t O_CONVP = O_KVS2 + (size_t)256 * 2048;
constexpr size_t O_CONVS = O_CONVP + (size_t)4 * 3 * 3072;
constexpr size_t O_SSMP = O_CONVS + (size_t)32 * 3 * 3072;
constexpr size_t O_SSMS = O_SSMP + (size_t)4 * 32 * 64 * 128;
constexpr size_t O_END = O_SSMS + (size_t)32 * 32 * 64 * 128;

struct Params {
  const float *x_prompt, *x_sample, *cache0, *cache1, *cache2, *state_conv, *state_ssm;
  const float *attn_norm, *attn_w_in, *attn_q_gain, *attn_k_gain, *attn_w_out;
  const float *ssm_norm, *ssm_w_in, *ssm_conv_w, *ssm_conv_b, *ssm_dt_bias, *ssm_A_log, *ssm_D, *ssm_gate_norm, *ssm_w_out;
  float* out;
  u16 *Wt1, *Wt2, *Wt3, *Wt4, *H, *QKVG, *OG, *Z, *XBC, *YG, *XBCC, *STATES, *QKVH;
  float *LSE, *X1, *DT, *SSQ, *CD, *ACS;
  unsigned* bar;
};

typedef __bf16 bf16v2 __attribute__((ext_vector_type(2)));
DI u16 f2bf(float x) { return __builtin_bit_cast(u16, (__bf16)x); }
DI float bf2f(u16 h) { return __uint_as_float(((unsigned)h) << 16); }
DI unsigned pack2(float a, float b) { bf16v2 v; v[0] = (__bf16)a; v[1] = (__bf16)b; return __builtin_bit_cast(unsigned, v); }
DI float lo_f(unsigned w) { return __uint_as_float(w << 16); }
DI float hi_f(unsigned w) { return __uint_as_float(w & 0xffff0000u); }
DI void unpack8(const uint4& v, float* f) {
  f[0] = lo_f(v.x); f[1] = hi_f(v.x); f[2] = lo_f(v.y); f[3] = hi_f(v.y);
  f[4] = lo_f(v.z); f[5] = hi_f(v.z); f[6] = lo_f(v.w); f[7] = hi_f(v.w);
}
DI uint4 pack8(const float* f) {
  uint4 v; v.x = pack2(f[0], f[1]); v.y = pack2(f[2], f[3]); v.z = pack2(f[4], f[5]); v.w = pack2(f[6], f[7]); return v;
}
DI float sum16(float v) {
  v += __builtin_bit_cast(float, __builtin_amdgcn_update_dpp(0, __builtin_bit_cast(int, v), 0xB1, 0xf, 0xf, true));
  v += __builtin_bit_cast(float, __builtin_amdgcn_update_dpp(0, __builtin_bit_cast(int, v), 0x4E, 0xf, 0xf, true));
  v += __builtin_bit_cast(float, __builtin_amdgcn_update_dpp(0, __builtin_bit_cast(int, v), 0x141, 0xf, 0xf, true));
  v += __builtin_bit_cast(float, __builtin_amdgcn_update_dpp(0, __builtin_bit_cast(int, v), 0x140, 0xf, 0xf, true));
  return v;
}
DI float sum4(float v) {
  v += __builtin_bit_cast(float, __builtin_amdgcn_update_dpp(0, __builtin_bit_cast(int, v), 0xB1, 0xf, 0xf, true));
  v += __builtin_bit_cast(float, __builtin_amdgcn_update_dpp(0, __builtin_bit_cast(int, v), 0x4E, 0xf, 0xf, true));
  return v;
}
DI float silu_f(float x) { return x / (1.f + __expf(-x)); }
DI s16x4 tr_read(const u16* ptr) {
  return __builtin_amdgcn_ds_read_tr16_b64_v4i16((s16x4 __attribute__((address_space(3)))*)(ptr));
}
DI bf16x8 cat4(s16x4 lo, s16x4 hi) { return __builtin_shufflevector(lo, hi, 0, 1, 2, 3, 4, 5, 6, 7); }
DI bf16x8 words_to_frag(unsigned a, unsigned b, unsigned c, unsigned d) {
  uint4 v; v.x = a; v.y = b; v.z = c; v.w = d; return __builtin_bit_cast(bf16x8, v);
}

constexpr int G8_HT = 128 * 64;
DI int g8_lds_byte(int r, int c) {
  const int st = (r >> 4) * 2 + (c >> 5), rr = r & 15, cc = c & 31, ob = rr * 64 + cc * 2;
  return st * 1024 + (ob ^ (((ob >> 9) & 1) << 5));
}
DI void g8_stage_rc(int b, int& R, int& C) {
  const int st = b / 1024, sb = b % 1024, swz = sb ^ (((sb >> 9) & 1) << 5);
  R = (st >> 1) * 16 + swz / 64; C = (st & 1) * 32 + (swz % 64) / 2;
}
template <class EP>
DI void gemm_tile_big(const u16* __restrict__ A, const u16* __restrict__ Bt, int K, int brow, int bcol, const EP& ep, char* smem) {
  u16* shm = (u16*)smem;
  const int rtid = opaque_tid();
#define SA(b, h) (shm + ((b) * 2 + (h)) * G8_HT)
#define SB(b, h) (shm + (4 + (b) * 2 + (h)) * G8_HT)
  unsigned offA[2], offB[2];
#pragma unroll
  for (int _i = 0; _i < 2; ++_i) {
    int _r, _c; g8_stage_rc(rtid * 16 + _i * 8192, _r, _c);
    offA[_i] = (unsigned)((_r * K + _c) * 2);
    offB[_i] = (unsigned)((((_r >> 5) * 64 + (_r & 31)) * K + _c) * 2);
  }
#define STAGE_A(P, br, kt) do { const char* _gb = (const char*)A + ((size_t)(br) * K + (size_t)(kt) * 64) * 2;          \
    _Pragma("unroll") for (int _i = 0; _i < 2; ++_i)                                                                    \
      __builtin_amdgcn_global_load_lds((const unsigned*)(_gb + offA[_i]), (unsigned*)((char*)(P) + rtid * 16 + _i * 8192), 16, 0, 0); } while (0)
#define STAGE_B(P, h, kt) do { const char* _gb = (const char*)Bt + ((size_t)(bcol + (h) * 32) * K + (size_t)(kt) * 64) * 2; \
    _Pragma("unroll") for (int _i = 0; _i < 2; ++_i)                                                                    \
      __builtin_amdgcn_global_load_lds((const unsigned*)(_gb + offB[_i]), (unsigned*)((char*)(P) + rtid * 16 + _i * 8192), 16, 0, 0); } while (0)
#define LDA(dst, b, h) _Pragma("unroll") for (int m = 0; m < 4; ++m) _Pragma("unroll") for (int k = 0; k < 2; ++k) \
    dst[m][k] = *reinterpret_cast<const bf16x8*>(a_rd + ((b) * 2 + (h)) * 16384 + m * 2048 + k * 1024)
#define LDB(dst, b, h) _Pragma("unroll") for (int n = 0; n < 2; ++n) _Pragma("unroll") for (int k = 0; k < 2; ++k) \
    dst[n][k] = *reinterpret_cast<const bf16x8*>(b_rd + ((b) * 2 + (h)) * 16384 + n * 2048 + k * 1024)
#define MMA(ai, bj, At, Bx) do { __builtin_amdgcn_s_setprio(1);                                                         \
    for (int m = 0; m < 4; ++m) for (int n = 0; n < 2; ++n) for (int k = 0; k < 2; ++k)                                 \
      acc[ai][m][(bj) * 2 + n] = MFMA16(At[m][k], Bx[n][k], acc[ai][m][(bj) * 2 + n]);                                 \
    __builtin_amdgcn_s_setprio(0); } while (0)
#define WAIT_V(n) asm volatile("s_waitcnt vmcnt(" #n ")" ::: "memory")
#define WAIT_L(n) asm volatile("s_waitcnt lgkmcnt(" #n ")" ::: "memory")
#define BAR __builtin_amdgcn_s_barrier()
#define SCHED __builtin_amdgcn_sched_barrier(0)
  const int wid = rtid >> 6, lane = rtid & 63, wr = wid >> 2, wc = wid & 3, fr = lane & 15, fq = lane >> 4;
  const int l0 = g8_lds_byte(fr, fq * 8);
  const char* a_rd = smem + wr * 8192 + l0;
  const char* b_rd = smem + 4 * 16384 + wc * 4096 + l0;
  f32x4 acc[2][4][4];
#pragma unroll
  for (int ai = 0; ai < 2; ++ai)
#pragma unroll
    for (int m = 0; m < 4; ++m)
#pragma unroll
      for (int n = 0; n < 4; ++n) acc[ai][m][n] = (f32x4){0.f, 0.f, 0.f, 0.f};
  bf16x8 At[4][2], B0[2][2], B1[2][2];
  const int nt = K / 64;
  STAGE_B(SB(0, 0), 0, 0); STAGE_A(SA(0, 0), brow, 0);
  STAGE_B(SB(0, 1), 1, 0); STAGE_A(SA(0, 1), brow + 128, 0);
  if (wr == 1) BAR;
  WAIT_V(4); BAR;
  STAGE_B(SB(1, 0), 0, 1); STAGE_A(SA(1, 0), brow, 1); STAGE_B(SB(1, 1), 1, 1);
  WAIT_V(6); BAR;
  for (int t = 0; t < nt - 2; t += 2) {
    LDB(B0, 0, 0); SCHED; LDA(At, 0, 0); STAGE_A(SA(1, 1), brow + 128, t + 1);
    WAIT_L(8); BAR; WAIT_L(0); MMA(0, 0, At, B0); BAR; SCHED;
    LDB(B1, 0, 1); STAGE_B(SB(0, 0), 0, t + 2);
    BAR; WAIT_L(0); MMA(0, 1, At, B1); BAR;
    LDA(At, 0, 1); STAGE_A(SA(0, 0), brow, t + 2);
    BAR; WAIT_L(0); MMA(1, 0, At, B0); BAR; SCHED;
    STAGE_B(SB(0, 1), 1, t + 2);
    WAIT_V(6); BAR; MMA(1, 1, At, B1); BAR;
    LDB(B0, 1, 0); SCHED; LDA(At, 1, 0); STAGE_A(SA(0, 1), brow + 128, t + 2);
    WAIT_L(8); BAR; WAIT_L(0); MMA(0, 0, At, B0); BAR; SCHED;
    LDB(B1, 1, 1); STAGE_B(SB(1, 0), 0, t + 3);
    BAR; WAIT_L(0); MMA(0, 1, At, B1); BAR;
    LDA(At, 1, 1); STAGE_A(SA(1, 0), brow, t + 3);
    BAR; WAIT_L(0); MMA(1, 0, At, B0); BAR; SCHED;
    STAGE_B(SB(1, 1), 1, t + 3);
    WAIT_V(6); BAR; MMA(1, 1, At, B1); BAR;
  }
  { LDB(B0, 0, 0); LDA(At, 0, 0); STAGE_A(SA(1, 1), brow + 128, nt - 1);
    BAR; WAIT_L(0); MMA(0, 0, At, B0); BAR;
    LDB(B1, 0, 1); BAR; WAIT_L(0); MMA(0, 1, At, B1); BAR;
    LDA(At, 0, 1); WAIT_V(4); BAR; WAIT_L(0); MMA(1, 0, At, B0); MMA(1, 1, At, B1); BAR; }
  { LDB(B0, 1, 0); LDA(At, 1, 0); WAIT_V(2); BAR; WAIT_L(0); MMA(0, 0, At, B0); BAR;
    LDB(B1, 1, 1); WAIT_V(0); BAR; WAIT_L(0); MMA(0, 1, At, B1); BAR;
    LDA(At, 1, 1); BAR; WAIT_L(0); MMA(1, 0, At, B0); MMA(1, 1, At, B1); BAR; }
  if (wr == 0) BAR;
#undef SA
#undef SB
#undef STAGE_A
#undef STAGE_B
#undef LDA
#undef LDB
#undef MMA
#undef WAIT_V
#undef WAIT_L
#undef BAR
#undef SCHED
  int late = 0;
  asm volatile("" : "+v"(late));
  ep(acc[0], brow + wr * 64 + late, bcol + wc * 64, lane + late);
  ep(acc[1], brow + 128 + wr * 64 + late, bcol + wc * 64, lane + late);
  __syncthreads();
}

template <class EP>
DI void gemm_phase_big(const u16* A, const u16* Bt, int K, int MT, int NT, const EP& ep, char* smem) {
  const int x = blockIdx.x & 7, j = blockIdx.x >> 3, per = gridDim.x >> 3;
  const int T = MT * NT, fullT = (MT >> 3) * 8 * NT, hlast = MT & 7;
  for (int v = j;; v += per) {
    const int chunk = x + 8 * (v >> 5);
    if (chunk * 32 >= T) break;
    const int s = chunk * 32 + (v & 31);
    if (s >= T) continue;
    int mt, nt;
    if (s < fullT) { const int band = s / (8 * NT), within = s - band * 8 * NT; nt = within >> 3; mt = band * 8 + (within & 7); }
    else { const int sp = s - fullT; nt = sp / hlast; mt = (MT >> 3) * 8 + (sp - nt * hlast); }
    gemm_tile_big(A, Bt, K, mt * 256, nt * 256, ep, smem);
  }
}

DI unsigned merge_word(unsigned a, unsigned b, unsigned c, unsigned g, float e0, float e1, float e2) {
  const float lo = (e0 * lo_f(a) + e1 * lo_f(b) + e2 * lo_f(c)) * silu_f(lo_f(g));
  const float hi = (e0 * hi_f(a) + e1 * hi_f(b) + e2 * hi_f(c)) * silu_f(hi_f(g));
  return pack2(lo, hi);
}
DI void phase_merge(const Params& p) {
  const int lane = VTID & 63;
  for (int it = VBID; it < MROWS / 4; it += VGRID) {
    const size_t row = (size_t)it * 4 + (VTID >> 6);
    const int k = lane * 16, head = lane >> 2;
    const float* lp = p.LSE + row * 48 + head;
    const float l0 = lp[0], l1 = lp[16], l2 = lp[32];
    const u16* op = p.OG + row * 3072 + k;
    const u16* gp = p.QKVG + row * ATT_IN + 9216 + k;
    uint4 a[2], b[2], c[2], g[2];
#pragma unroll
    for (int h = 0; h < 2; ++h) {
      a[h] = *(const uint4*)(op + h * 8); b[h] = *(const uint4*)(op + 1024 + h * 8); c[h] = *(const uint4*)(op + 2048 + h * 8);
      g[h] = *(const uint4*)(gp + h * 8);
    }
    const float mx = fmaxf(l0, fmaxf(l1, l2));
    float e0 = __expf(l0 - mx), e1 = __expf(l1 - mx), e2 = __expf(l2 - mx);
    const float inv = 1.f / (e0 + e1 + e2);
    e0 *= inv; e1 *= inv; e2 *= inv;
#pragma unroll
    for (int h = 0; h < 2; ++h) {
      uint4 o;
      o.x = merge_word(a[h].x, b[h].x, c[h].x, g[h].x, e0, e1, e2);
      o.y = merge_word(a[h].y, b[h].y, c[h].y, g[h].y, e0, e1, e2);
      o.z = merge_word(a[h].z, b[h].z, c[h].z, g[h].z, e0, e1, e2);
      o.w = merge_word(a[h].w, b[h].w, c[h].w, g[h].w, e0, e1, e2);
      *(uint4*)(p.H + row * 1024 + k + h * 8) = o;
    }
  }
}
DI void phase_gatenorm(const Params& p) {
  const int lane = VTID & 63;
  for (int it = VBID; it < MROWS / 4; it += VGRID) {
    const size_t row = (size_t)it * 4 + (VTID >> 6);
    const int k = lane * 32;
    const float* sp = p.SSQ + row * 32 + (lane >> 4) * 8;
    const float4 s0 = *(const float4*)sp, s1 = *(const float4*)(sp + 4);
    const float ss = (s0.x + s0.y) + (s0.z + s0.w) + (s1.x + s1.y) + (s1.z + s1.w);
    const float rstd = rsqrtf(ss * (1.f / 512.f) + 1e-5f);
    u16* yp = p.YG + row * 2048 + k;
    uint4 y[4];
#pragma unroll
    for (int h = 0; h < 4; ++h) y[h] = *(const uint4*)(yp + h * 8);
#pragma unroll
    for (int h = 0; h < 4; ++h) {
      const float4 g0 = *(const float4*)(p.ssm_gate_norm + k + h * 8), g1 = *(const float4*)(p.ssm_gate_norm + k + h * 8 + 4);
      uint4 o;
      o.x = pack2(lo_f(y[h].x) * rstd * g0.x, hi_f(y[h].x) * rstd * g0.y);
      o.y = pack2(lo_f(y[h].y) * rstd * g0.z, hi_f(y[h].y) * rstd * g0.w);
      o.z = pack2(lo_f(y[h].z) * rstd * g1.x, hi_f(y[h].z) * rstd * g1.y);
      o.w = pack2(lo_f(y[h].w) * rstd * g1.z, hi_f(y[h].w) * rstd * g1.w);
      *(uint4*)(yp + h * 8) = o;
    }
  }
}

struct Ep1 {
  const Params& p;
  DI void operator()(f32x4 (&acc)[4][4], int r0, int c0, int lane) const {
    const int l15 = lane & 15, G = lane >> 4;
    int kind, g = 0, head;
    if (c0 >= 9216) { kind = 3; head = (c0 - 9216) >> 6; }
    else { g = c0 / 3072; const int rem = c0 - g * 3072; kind = rem >> 10; head = (rem & 1023) >> 6; }
    if (kind < 2) {
      const float* gp = (kind == 0 ? p.attn_q_gain : p.attn_k_gain) + g * 64;
      float gain[4];
#pragma unroll
      for (int n = 0; n < 4; ++n) gain[n] = gp[n * 16 + l15];
      const float post = (kind == 0) ? 0.125f : 1.f;
#pragma unroll
      for (int m = 0; m < 4; ++m)
#pragma unroll
        for (int j = 0; j < 4; ++j) {
          float ss = 0.f;
#pragma unroll
          for (int n = 0; n < 4; ++n) ss += acc[m][n][j] * acc[m][n][j];
          ss = sum16(ss);
          const float sc = rsqrtf(ss * (1.f / 64.f) + 1e-6f) * post;
#pragma unroll
          for (int n = 0; n < 4; ++n) acc[m][n][j] *= sc * gain[n];
        }
    }
    if (kind < 3 && r0 < PROWS) {
      const int dsh = 2 * g;
      const size_t hb = ((size_t)(((r0 >> 12) * 3 + g) * 3 + kind) * 16 + head) * 4096;
#pragma unroll
      for (int m = 0; m < 4; ++m)
#pragma unroll
        for (int j = 0; j < 4; ++j) {
          const int t = (r0 + m * 16 + G * 4 + j) & 4095;
          const int pos = (t & ((1 << dsh) - 1)) * (4096 >> dsh) + (t >> dsh);
          u16* dst = p.QKVH + (hb + pos) * 64 + l15;
#pragma unroll
          for (int n = 0; n < 4; ++n) dst[n * 16] = f2bf(acc[m][n][j]);
        }
    } else {
#pragma unroll
      for (int m = 0; m < 4; ++m)
#pragma unroll
        for (int j = 0; j < 4; ++j) {
          const int row = r0 + m * 16 + G * 4 + j;
          u16* dst = p.QKVG + (size_t)row * ATT_IN + c0 + l15;
#pragma unroll
          for (int n = 0; n < 4; ++n) dst[n * 16] = f2bf(acc[m][n][j]);
        }
    }
    if (kind == 1 || kind == 2) {
      const int keep = 128 << (2 * g);
      const size_t okp = (g == 0) ? O_KVP0 : (g == 1) ? O_KVP1 : O_KVP2;
      const size_t oks = (g == 0) ? O_KVS0 : (g == 1) ? O_KVS1 : O_KVS2;
#pragma unroll
      for (int m = 0; m < 4; ++m)
#pragma unroll
        for (int j = 0; j < 4; ++j) {
          const int row = r0 + m * 16 + G * 4 + j;
          float* dst = nullptr;
          if (row < PROWS) {
            const int b = row >> 12, s = row & 4095;
            if (s >= 4096 - keep) dst = p.out + okp + ((size_t)(b * keep + s - (4096 - keep)) * 2 + (kind - 1)) * 1024 + head * 64 + l15;
          } else {
            dst = p.out + oks + ((size_t)(row - PROWS) * 2 + (kind - 1)) * 1024 + head * 64 + l15;
          }
          if (dst) {
#pragma unroll
            for (int n = 0; n < 4; ++n) dst[n * 16] = acc[m][n][j];
          }
        }
    }
  }
};
struct Ep2 {
  const Params& p;
  DI void operator()(f32x4 (&acc)[4][4], int r0, int c0, int lane) const {
    const int l15 = lane & 15, G = lane >> 4;
#pragma unroll
    for (int m = 0; m < 4; ++m)
#pragma unroll
      for (int j = 0; j < 4; ++j) {
        const int row = r0 + m * 16 + G * 4 + j;
        const float* xin = (row < PROWS) ? p.x_prompt + (size_t)row * 1024 : p.x_sample + (size_t)(row - PROWS) * 1024;
        float* dst = p.X1 + (size_t)row * 1024 + c0 + l15;
#pragma unroll
        for (int n = 0; n < 4; ++n) dst[n * 16] = xin[c0 + l15 + n * 16] + acc[m][n][j];
      }
  }
};
struct Ep3 {
  const Params& p;
  DI void operator()(f32x4 (&acc)[4][4], int r0, int c0, int lane) const {
    const int l15 = lane & 15, G = lane >> 4;
    if (c0 >= SSM_IN) return;
    if (c0 < 2048) {
#pragma unroll
      for (int m = 0; m < 4; ++m)
#pragma unroll
        for (int j = 0; j < 4; ++j) {
          const int row = r0 + m * 16 + G * 4 + j;
          u16* dst = p.Z + (size_t)row * 2048 + c0 + l15;
#pragma unroll
          for (int n = 0; n < 4; ++n) dst[n * 16] = f2bf(acc[m][n][j]);
        }
    } else if (c0 < 5120) {
      const int cc = c0 - 2048 + l15;
#pragma unroll
      for (int m = 0; m < 4; ++m)
#pragma unroll
        for (int j = 0; j < 4; ++j) {
          const int row = r0 + m * 16 + G * 4 + j;
          u16* dst = p.XBC + (size_t)row * 3072 + cc;
#pragma unroll
          for (int n = 0; n < 4; ++n) dst[n * 16] = f2bf(acc[m][n][j]);
          float* od = nullptr;
          if (row < PROWS) {
            const int b = row >> 12, s = row & 4095;
            if (s >= 4093) od = p.out + O_CONVP + (size_t)(b * 3 + s - 4093) * 3072 + cc;
          } else {
            const int rr = row - PROWS, b = rr >> 3, t = rr & 7;
            if (t >= 5) od = p.out + O_CONVS + (size_t)(b * 3 + t - 5) * 3072 + cc;
          }
          if (od) {
#pragma unroll
            for (int n = 0; n < 4; ++n) od[n * 16] = acc[m][n][j];
          }
        }
    } else {
#pragma unroll
      for (int m = 0; m < 4; ++m)
#pragma unroll
        for (int j = 0; j < 4; ++j) {
          const int row = r0 + m * 16 + G * 4 + j;
#pragma unroll
          for (int n = 0; n < 2; ++n) {
            const int h = n * 16 + l15;
            const float xv = acc[m][n][j] + p.ssm_dt_bias[h];
            p.DT[(size_t)row * 32 + h] = fmaxf(xv, 0.f) + log1pf(__expf(-fabsf(xv)));
          }
        }
    }
  }
};
struct Ep4 {
  const Params& p;
  DI void operator()(f32x4 (&acc)[4][4], int r0, int c0, int lane) const {
    const int l15 = lane & 15, G = lane >> 4;
#pragma unroll
    for (int m = 0; m < 4; ++m)
#pragma unroll
      for (int j = 0; j < 4; ++j) {
        const int row = r0 + m * 16 + G * 4 + j;
        const float* xin = p.X1 + (size_t)row * 1024 + c0 + l15;
        float* dst = p.out + O_Y + (size_t)row * 1024 + c0 + l15;
#pragma unroll
        for (int n = 0; n < 4; ++n) dst[n * 16] = xin[n * 16] + acc[m][n][j];
      }
  }
};

DI void transpose_task(const float* __restrict__ W, u16* __restrict__ Wt, int K, int N, int NTN, int tile, u16* smem) {
  const int tid = VTID;
  const int ktile = tile / NTN, ntile = tile % NTN;
  const int k0 = ktile * 64, n0 = ntile * 64;
#pragma unroll
  for (int i = 0; i < 4; ++i) {
    const int idx = tid + 256 * i;
    const int kk = idx >> 4, nq = idx & 15;
    const int n = n0 + nq * 4;
    float4 v = {0.f, 0.f, 0.f, 0.f};
    if (n < N) v = *(const float4*)(W + (size_t)(k0 + kk) * N + n);
    smem[(nq * 4 + 0) * LDT + kk] = f2bf(v.x);
    smem[(nq * 4 + 1) * LDT + kk] = f2bf(v.y);
    smem[(nq * 4 + 2) * LDT + kk] = f2bf(v.z);
    smem[(nq * 4 + 3) * LDT + kk] = f2bf(v.w);
  }
  __syncthreads();
#pragma unroll
  for (int i = 0; i < 2; ++i) {
    const int idx = tid + 256 * i;
    const int n = idx >> 3, kc = idx & 7;
    *(uint4*)(Wt + (size_t)(n0 + n) * K + k0 + kc * 8) = *(const uint4*)(smem + n * LDT + kc * 8);
  }
  __syncthreads();
}

DI void rmsnorm_row(const float* __restrict__ src, const float* __restrict__ wgt, u16* __restrict__ dst, int lane) {
  float4 v[4];
  float ss = 0.f;
#pragma unroll
  for (int i = 0; i < 4; ++i) {
    v[i] = *(const float4*)(src + lane * 4 + 256 * i);
    ss += v[i].x * v[i].x + v[i].y * v[i].y + v[i].z * v[i].z + v[i].w * v[i].w;
  }
  ss = sum16(ss);
  ss += __shfl_xor(ss, 16);
  ss += __shfl_xor(ss, 32);
  const float rstd = rsqrtf(ss * (1.f / 1024.f) + 1e-6f);
#pragma unroll
  for (int i = 0; i < 4; ++i) {
    const float4 g = *(const float4*)(wgt + lane * 4 + 256 * i);
    uint2 o;
    o.x = pack2(v[i].x * rstd * g.x, v[i].y * rstd * g.y);
    o.y = pack2(v[i].z * rstd * g.z, v[i].w * rstd * g.w);
    *(uint2*)(dst + lane * 4 + 256 * i) = o;
  }
}

constexpr int TR1 = 16 * 160, TR2 = 16 * 16, TR3 = 16 * 84, TR4 = 32 * 16;
DI void phase_prep(const Params& p, u16* smem) {
  constexpr int RT = MROWS / 4;
  for (int it = VBID; it < TR1 + RT; it += VGRID) {
    if (it < TR1) transpose_task(p.attn_w_in, p.Wt1, 1024, ATT_IN, 160, it, smem);
    else {
      const int row = (it - TR1) * 4 + (VTID >> 6);
      const float* src = (row < PROWS) ? p.x_prompt + (size_t)row * 1024 : p.x_sample + (size_t)(row - PROWS) * 1024;
      rmsnorm_row(src, p.attn_norm, p.H + (size_t)row * 1024, VTID & 63);
    }
  }
}
DI void late_transpose_task(const Params& p, int it, u16* smem) {
  if (it < TR2) transpose_task(p.attn_w_out, p.Wt2, 1024, 1024, 16, it, smem);
  else if (it < TR2 + TR3) transpose_task(p.ssm_w_in, p.Wt3, 1024, SSM_IN, 84, it - TR2, smem);
  else transpose_task(p.ssm_w_out, p.Wt4, 2048, 1024, 16, it - TR2 - TR3, smem);
}

DI void phase_norm2(const Params& p) {
  for (int it = VBID; it < MROWS / 4; it += VGRID) {
    const int row = it * 4 + (VTID >> 6);
    rmsnorm_row(p.X1 + (size_t)row * 1024, p.ssm_norm, p.H + (size_t)row * 1024, VTID & 63);
  }
}

struct PromptRegs { uint4 k[8], v[8]; bf16x8 q[2][2]; };
DI void attn_prompt_load(const Params& p, int item, PromptRegs& R) {
  const int tid = VTID, lane = tid & 63, w = tid >> 6, l15 = lane & 15, G = lane >> 4;
  const int rn = item & 31, head = (item >> 5) & 15, b = (item >> 9) & 3, g = item >> 11;
  const int dsh = 2 * g, dil = 1 << dsh, nbg = 32 >> dsh;
  const int r = rn / nbg, n = rn % nbg;
  const size_t hq = ((size_t)((b * 3 + g) * 3 + 0) * 16 + head) * 4096 + (size_t)r * (4096 >> dsh);
  const size_t hk = hq + (size_t)16 * 4096, hv = hq + (size_t)32 * 4096;
  (void)dil;
#pragma unroll
  for (int i = 0; i < 8; ++i) {
    const int c = tid + 256 * i;
    const int kj = c >> 3, ch = c & 7;
    const int u = (n - 1) * 128 + kj;
    R.k[i] = (uint4){0u, 0u, 0u, 0u}; R.v[i] = (uint4){0u, 0u, 0u, 0u};
    if (u >= 0) {
      R.k[i] = *(const uint4*)(p.QKVH + (hk + u) * 64 + ch * 8);
      R.v[i] = *(const uint4*)(p.QKVH + (hv + u) * 64 + ch * 8);
    }
  }
#pragma unroll
  for (int sub = 0; sub < 2; ++sub) {
    const u16* qp = p.QKVH + (hq + n * 128 + w * 32 + sub * 16 + l15) * 64 + G * 8;
    R.q[sub][0] = *(const bf16x8*)qp;
    R.q[sub][1] = *(const bf16x8*)(qp + 32);
  }
}
DI void attn_prompt_stage(const PromptRegs& R, u16* smem) {
  const int tid = VTID;
  u16* Ks = smem;
  u16* Vs = smem + 256 * LDT;
#pragma unroll
  for (int i = 0; i < 8; ++i) {
    const int c = tid + 256 * i;
    const int kj = c >> 3, ch = c & 7;
    *(uint4*)(Ks + kj * LDT + ch * 8) = R.k[i];
    *(uint4*)(Vs + kj * LDT + ch * 8) = R.v[i];
  }
}
DI void attn_prompt_compute(const Params& p, int item, const bf16x8 (&qpre)[2][2], u16* smem) {
  const int tid = VTID, lane = tid & 63, w = tid >> 6, l15 = lane & 15, G = lane >> 4;
  const int rn = item & 31, head = (item >> 5) & 15, b = (item >> 9) & 3, g = item >> 11;
  const int dsh = 2 * g, dil = 1 << dsh, nbg = 32 >> dsh;
  const int r = rn / nbg, n = rn % nbg;
  u16* Ks = smem;
  u16* Vs = smem + 256 * LDT;
#pragma unroll 1
  for (int sub = 0; sub < 2; ++sub) {
    const int q0 = w * 32 + sub * 16;
    const int qi = q0 + l15;
    const size_t rowq = (size_t)b * 4096 + (size_t)(n * 128 + qi) * dil + r;
    const bf16x8 qf0 = sub ? qpre[1][0] : qpre[0][0], qf1 = sub ? qpre[1][1] : qpre[0][1];
    f32x4 st[9];
#pragma unroll
    for (int s = 0; s < 9; ++s) {
      const u16* kp = Ks + (q0 + 16 * s + l15) * LDT + G * 8;
      const bf16x8 a0 = *(const bf16x8*)kp, a1 = *(const bf16x8*)(kp + 32);
      f32x4 z = {0.f, 0.f, 0.f, 0.f};
      z = MFMA16(a0, qf0, z);
      st[s] = MFMA16(a1, qf1, z);
    }
    float mx = -INFINITY;
#pragma unroll
    for (int s = 0; s < 9; ++s)
#pragma unroll
      for (int j = 0; j < 4; ++j) {
        const int kk = 16 * s + 4 * G + j;
        const bool valid = (kk >= l15) && (kk <= l15 + 128) && (n > 0 || q0 + kk >= 128);
        const float v = valid ? st[s][j] : -INFINITY;
        st[s][j] = v;
        mx = fmaxf(mx, v);
      }
    mx = fmaxf(mx, __shfl_xor(mx, 16));
    mx = fmaxf(mx, __shfl_xor(mx, 32));
    float sum = 0.f;
#pragma unroll
    for (int s = 0; s < 9; ++s)
#pragma unroll
      for (int j = 0; j < 4; ++j) {
        const float e = __expf(st[s][j] - mx);
        st[s][j] = e;
        sum += e;
      }
    sum += __shfl_xor(sum, 16);
    sum += __shfl_xor(sum, 32);
    const float inv = 1.f / sum;
    f32x4 o[4];
#pragma unroll
    for (int m = 0; m < 4; ++m) o[m] = (f32x4){0.f, 0.f, 0.f, 0.f};
#pragma unroll
    for (int t = 0; t < 5; ++t) {
      const int sA = 2 * t, sB = 2 * t + 1;
      bf16x8 pb;
      if (t < 4) pb = words_to_frag(pack2(st[sA][0], st[sA][1]), pack2(st[sA][2], st[sA][3]), pack2(st[sB < 9 ? sB : 8][0], st[sB < 9 ? sB : 8][1]), pack2(st[sB < 9 ? sB : 8][2], st[sB < 9 ? sB : 8][3]));
      else pb = words_to_frag(pack2(st[sA][0], st[sA][1]), pack2(st[sA][2], st[sA][3]), 0u, 0u);
      const u16* vA = Vs + (q0 + 16 * sA + 4 * G + (l15 >> 2)) * LDT + (l15 & 3) * 4;
      const u16* vB = Vs + (q0 + 16 * sB + 4 * G + (l15 >> 2)) * LDT + (l15 & 3) * 4;
#pragma unroll
      for (int m = 0; m < 4; ++m) {
        const s16x4 lo = tr_read(vA + 16 * m);
        s16x4 hi = {0, 0, 0, 0};
        if (t < 4) hi = tr_read(vB + 16 * m);
        o[m] = MFMA16(cat4(lo, hi), pb, o[m]);
      }
    }
    u16* op = p.OG + rowq * 3072 + g * 1024 + head * 64 + 4 * G;
#pragma unroll
    for (int m = 0; m < 4; ++m) {
      uint2 ov;
      ov.x = pack2(o[m][0] * inv, o[m][1] * inv);
      ov.y = pack2(o[m][2] * inv, o[m][3] * inv);
      *(uint2*)(op + 16 * m) = ov;
    }
    if (G == 0) p.LSE[rowq * 48 + g * 16 + head] = mx + __logf(sum);
  }
}

DI void attn_sample_task(const Params& p, int id) {
  const int lane = VTID & 63, l15 = lane & 15, G = lane >> 4;
  const int t = id & 7, head = (id >> 3) & 15, b = (id >> 7) & 31, g = id >> 12;
  const int L = 128 << (2 * g), dil = 1 << (2 * g);
  const float* cache = (g == 0) ? p.cache0 : (g == 1) ? p.cache1 : p.cache2;
  const float* newkv = p.out + ((g == 0) ? O_KVS0 : (g == 1) ? O_KVS1 : O_KVS2);
  const size_t rowq = (size_t)PROWS + b * 8 + t;
  const uint2 qq = *(const uint2*)(p.QKVG + rowq * ATT_IN + g * 3072 + head * 64 + 4 * l15);
  const float q0 = lo_f(qq.x), q1 = hi_f(qq.x), q2 = lo_f(qq.y), q3 = hi_f(qq.y);
  const int coff = head * 64 + 4 * l15;
  float mx = -INFINITY, sum = 0.f, a0 = 0.f, a1 = 0.f, a2 = 0.f, a3 = 0.f;
#pragma unroll 1
  for (int bt = 0; bt < 2; ++bt) {
    float4 kb[17], vb[17];
#pragma unroll
    for (int u = 0; u < 17; ++u) {
      const int j = 4 * (bt * 17 + u) + G;
      const int jc = j < 128 ? j : 128;
      const int idx = L + t - dil * jc;
      const float* kp = ((idx < L) ? cache + (size_t)(b * L + idx) * 2048 : newkv + (size_t)(b * 8 + idx - L) * 2048) + coff + 512;
      kb[u] = *(const float4*)(kp - 512);
      vb[u] = *(const float4*)(kp + 512);
    }
    float scb[17];
    float bm = -INFINITY;
#pragma unroll
    for (int u = 0; u < 17; ++u) {
      const int j = 4 * (bt * 17 + u) + G;
      float sv = q0 * kb[u].x + q1 * kb[u].y + q2 * kb[u].z + q3 * kb[u].w;
      sv = sum16(sv);
      sv = (j <= 128) ? sv : -INFINITY;
      scb[u] = sv;
      bm = fmaxf(bm, sv);
    }
    const float mn = fmaxf(mx, bm);
    const float corr = __expf(mx - mn);
    sum *= corr; a0 *= corr; a1 *= corr; a2 *= corr; a3 *= corr;
#pragma unroll
    for (int u = 0; u < 17; ++u) {
      const float pe = __expf(scb[u] - mn);
      sum += pe;
      a0 += pe * vb[u].x; a1 += pe * vb[u].y; a2 += pe * vb[u].z; a3 += pe * vb[u].w;
    }
    mx = mn;
  }
  {
    float M = fmaxf(mx, __shfl_xor(mx, 16));
    M = fmaxf(M, __shfl_xor(M, 32));
    const float f = __expf(mx - M);
    sum *= f; a0 *= f; a1 *= f; a2 *= f; a3 *= f;
    mx = M;
  }
  sum += __shfl_xor(sum, 16); sum += __shfl_xor(sum, 32);
  a0 += __shfl_xor(a0, 16); a0 += __shfl_xor(a0, 32);
  a1 += __shfl_xor(a1, 16); a1 += __shfl_xor(a1, 32);
  a2 += __shfl_xor(a2, 16); a2 += __shfl_xor(a2, 32);
  a3 += __shfl_xor(a3, 16); a3 += __shfl_xor(a3, 32);
  const float inv = 1.f / sum;
  if (G == 0) {
    uint2 ov;
    ov.x = pack2(a0 * inv, a1 * inv);
    ov.y = pack2(a2 * inv, a3 * inv);
    *(uint2*)(p.OG + rowq * 3072 + g * 1024 + coff) = ov;
    if (l15 == 0) p.LSE[rowq * 48 + g * 16 + head] = mx + __logf(sum);
  }
}

DI void attn_prompt_stream(const Params& p, u16* smem) {
  constexpr int NP = 6144;
  int item = VBID;
  PromptRegs R;
  if (item < NP) attn_prompt_load(p, item, R);
  while (item < NP) {
    attn_prompt_stage(R, smem);
    bf16x8 qc[2][2];
    qc[0][0] = R.q[0][0]; qc[0][1] = R.q[0][1]; qc[1][0] = R.q[1][0]; qc[1][1] = R.q[1][1];
    __syncthreads();
    const int next = item + VGRID;
    if (next < NP) attn_prompt_load(p, next, R);
    attn_prompt_compute(p, item, qc, smem);
    __syncthreads();
    item = next;
  }
}
DI void phase_attn(const Params& p, u16* smem) {
  constexpr int NS = 3072;
  const bool sample_first = false;
  if (!sample_first) attn_prompt_stream(p, smem);
  for (int it = VBID; it < NS; it += VGRID) attn_sample_task(p, it * 4 + (VTID >> 6));
  if (sample_first) attn_prompt_stream(p, smem);
}

DI void conv_pass_task(const Params& p, int bt) {
  const int id = bt * 256 + VTID;
  const int ch = id % 384, seg = id / 384;
  const int col = ch * 8, row0 = seg * 8, t0 = row0 & 4095;
  const u16* src = p.XBC + (size_t)row0 * 3072 + col;
  uint4 raw[11];
#pragma unroll
  for (int j = 0; j < 3; ++j) {
    raw[j] = (uint4){0u, 0u, 0u, 0u};
    if (t0 > 0) raw[j] = *(const uint4*)(src - (ptrdiff_t)(3 - j) * 3072);
  }
#pragma unroll
  for (int j = 0; j < 8; ++j) raw[3 + j] = *(const uint4*)(src + (size_t)j * 3072);
  float wgt[4][8], bias[8];
#pragma unroll
  for (int j = 0; j < 4; ++j) {
    const float4 w0 = *(const float4*)(p.ssm_conv_w + j * 3072 + col), w1 = *(const float4*)(p.ssm_conv_w + j * 3072 + col + 4);
    wgt[j][0] = w0.x; wgt[j][1] = w0.y; wgt[j][2] = w0.z; wgt[j][3] = w0.w;
    wgt[j][4] = w1.x; wgt[j][5] = w1.y; wgt[j][6] = w1.z; wgt[j][7] = w1.w;
  }
  {
    const float4 b0 = *(const float4*)(p.ssm_conv_b + col), b1 = *(const float4*)(p.ssm_conv_b + col + 4);
    bias[0] = b0.x; bias[1] = b0.y; bias[2] = b0.z; bias[3] = b0.w;
    bias[4] = b1.x; bias[5] = b1.y; bias[6] = b1.z; bias[7] = b1.w;
  }
  float win[3][8];
  unpack8(raw[0], win[0]); unpack8(raw[1], win[1]); unpack8(raw[2], win[2]);
  u16* dst = p.XBCC + (size_t)row0 * 3072 + col;
#pragma unroll
  for (int i = 0; i < 8; ++i) {
    float cur[8], r[8];
    unpack8(raw[3 + i], cur);
#pragma unroll
    for (int e = 0; e < 8; ++e) {
      const float v = bias[e] + wgt[0][e] * win[0][e] + wgt[1][e] * win[1][e] + wgt[2][e] * win[2][e] + wgt[3][e] * cur[e];
      r[e] = silu_f(v);
      win[0][e] = win[1][e]; win[1][e] = win[2][e]; win[2][e] = cur[e];
    }
    *(uint4*)(dst + (size_t)i * 3072) = pack8(r);
  }
}

DI void acs_task(const Params& p, int bc) {
  const int lane = VTID & 63, head = lane & 31, half = lane >> 5;
  const float Aneg = -__expf(p.ssm_A_log[head]);
  const size_t rb = (size_t)bc * 128 + half * 64;
  float run = 0.f;
#pragma unroll 8
  for (int i = 0; i < 64; ++i) run += p.DT[(rb + i) * 32 + head] * Aneg;
  const float tot0 = __shfl(run, head);
  run = half ? tot0 : 0.f;
#pragma unroll 8
  for (int i = 0; i < 64; ++i) {
    run += p.DT[(rb + i) * 32 + head] * Aneg;
    p.ACS[(rb + i) * 32 + head] = run;
  }
}

DI void phase_convpass(const Params& p) {
  constexpr int NC = PROWS / 8 * 384 / 256;
  for (int it = VBID; it < NC + 32; it += VGRID) {
    if (it < NC) conv_pass_task(p, it);
    else acs_task(p, (it - NC) * 4 + (VTID >> 6));
  }
}

constexpr int SS_B = 0;
constexpr int SS_R2 = 34816;
constexpr int SS_H = 34816 + 18432;
constexpr int SS_F = 70656;

DI void ssd_states_item(const Params& p, int item, char* smem_raw) {
  const int tid = VTID, lane = tid & 63, w = tid >> 6, l15 = lane & 15, G = lane >> 4;
  const int head = item & 31, c = (item >> 5) & 31, b = item >> 10, g = head >> 3;
  u16* Bs = (u16*)(smem_raw + SS_B);
  u16* Xs = (u16*)(smem_raw + SS_R2);
  const size_t row0 = (size_t)b * 4096 + c * 128;
  const float a_end = p.ACS[(row0 + 127) * 32 + head];
#pragma unroll
  for (int i = 0; i < 4; ++i) {
    const int row = (tid >> 3) + 32 * i, ch = tid & 7;
    const float wl = p.DT[(row0 + row) * 32 + head] * __expf(a_end - p.ACS[(row0 + row) * 32 + head]);
    const uint4 v = *(const uint4*)(p.XBCC + (row0 + row) * 3072 + head * 64 + ch * 8);
    uint4 o;
    o.x = pack2(lo_f(v.x) * wl, hi_f(v.x) * wl); o.y = pack2(lo_f(v.y) * wl, hi_f(v.y) * wl);
    o.z = pack2(lo_f(v.z) * wl, hi_f(v.z) * wl); o.w = pack2(lo_f(v.w) * wl, hi_f(v.w) * wl);
    *(uint4*)(Xs + row * LDT + ch * 8) = o;
  }
#pragma unroll
  for (int i = 0; i < 8; ++i) {
    const int idx = tid + 256 * i, row = idx >> 4, ch = idx & 15;
    *(uint4*)(Bs + row * LDW + ch * 8) = *(const uint4*)(p.XBCC + (row0 + row) * 3072 + 2048 + g * 128 + ch * 8);
  }
  __syncthreads();
  f32x4 acc[4][2];
#pragma unroll
  for (int m = 0; m < 4; ++m) { acc[m][0] = (f32x4){0.f, 0.f, 0.f, 0.f}; acc[m][1] = (f32x4){0.f, 0.f, 0.f, 0.f}; }
#pragma unroll
  for (int k = 0; k < 4; ++k) {
    const int rowA = 32 * k + 8 * G + (l15 >> 2);
    bf16x8 a[4], bb[2];
#pragma unroll
    for (int m = 0; m < 4; ++m) {
      const u16* ap = Xs + rowA * LDT + 16 * m + (l15 & 3) * 4;
      a[m] = cat4(tr_read(ap), tr_read(ap + 4 * LDT));
    }
#pragma unroll
    for (int nn = 0; nn < 2; ++nn) {
      const u16* bp = Bs + rowA * LDW + 32 * w + 16 * nn + (l15 & 3) * 4;
      bb[nn] = cat4(tr_read(bp), tr_read(bp + 4 * LDW));
    }
#pragma unroll
    for (int m = 0; m < 4; ++m)
#pragma unroll
      for (int nn = 0; nn < 2; ++nn) acc[m][nn] = MFMA16(a[m], bb[nn], acc[m][nn]);
  }
  u16* sp = p.STATES + (size_t)item * 64 * 128;
#pragma unroll
  for (int m = 0; m < 4; ++m)
#pragma unroll
    for (int nn = 0; nn < 2; ++nn)
#pragma unroll
      for (int j = 0; j < 4; ++j) sp[(16 * m + 4 * G + j) * 128 + 32 * w + 16 * nn + l15] = f2bf(acc[m][nn][j]);
  if (tid == 0) p.CD[item] = __expf(a_end);
  __syncthreads();
}

DI void ssm_sample_item(const Params& p, int item, char* smem_raw) {
  const int tid = VTID;
  const int head = item & 31, b = item >> 5, g = head >> 3;
  float* sx = (float*)smem_raw;
  float* sB = sx + 512;
  float* sC = sB + 1024;
  float* sdt = sC + 1024;
  float* sdA = sdt + 8;
  float* sy2 = sdA + 8;
  const size_t row0 = (size_t)PROWS + b * 8;
  const float Aneg = -__expf(p.ssm_A_log[head]);
  for (int task = tid; task < 320; task += 256) {
    int col; float* dst;
    if (task < 64) { col = head * 64 + task; dst = sx + task; }
    else if (task < 192) { col = 2048 + g * 128 + (task - 64); dst = sB + (task - 64); }
    else { col = 2560 + g * 128 + (task - 192); dst = sC + (task - 192); }
    const int dstride = (task < 64) ? 64 : 128;
    const float w0 = p.ssm_conv_w[col], w1 = p.ssm_conv_w[3072 + col], w2 = p.ssm_conv_w[2 * 3072 + col], w3 = p.ssm_conv_w[3 * 3072 + col];
    const float bias = p.ssm_conv_b[col];
    float x0 = p.state_conv[(size_t)(b * 3 + 0) * 3072 + col];
    float x1 = p.state_conv[(size_t)(b * 3 + 1) * 3072 + col];
    float x2 = p.state_conv[(size_t)(b * 3 + 2) * 3072 + col];
#pragma unroll
    for (int t = 0; t < 8; ++t) {
      const float cur = bf2f(p.XBC[(row0 + t) * 3072 + col]);
      const float v = bias + w0 * x0 + w1 * x1 + w2 * x2 + w3 * cur;
      dst[t * dstride] = silu_f(v);
      x0 = x1; x1 = x2; x2 = cur;
    }
  }
  if (tid < 8) {
    const float dt = p.DT[(row0 + tid) * 32 + head];
    sdt[tid] = dt;
    sdA[tid] = __expf(dt * Aneg);
  }
  __syncthreads();
  const int pp = tid >> 2, nq = tid & 3;
  const size_t sbase = ((size_t)(b * 32 + head) * 64 + pp) * 128 + nq * 4;
  float4 h[8];
#pragma unroll
  for (int i = 0; i < 8; ++i) h[i] = *(const float4*)(p.state_ssm + sbase + i * 16);
  const float Dh = p.ssm_D[head];
#pragma unroll 1
  for (int t = 0; t < 8; ++t) {
    const float dA = sdA[t];
    const float xv = sx[t * 64 + pp];
    const float dtx = sdt[t] * xv;
    float y = 0.f;
#pragma unroll
    for (int i = 0; i < 8; ++i) {
      const float4 Bv = *(const float4*)(sB + t * 128 + i * 16 + nq * 4);
      const float4 Cv = *(const float4*)(sC + t * 128 + i * 16 + nq * 4);
      h[i].x = h[i].x * dA + dtx * Bv.x; h[i].y = h[i].y * dA + dtx * Bv.y;
      h[i].z = h[i].z * dA + dtx * Bv.z; h[i].w = h[i].w * dA + dtx * Bv.w;
      y += h[i].x * Cv.x + h[i].y * Cv.y + h[i].z * Cv.z + h[i].w * Cv.w;
    }
    y = sum4(y);
    if (nq == 0) {
      const float z = bf2f(p.Z[(row0 + t) * 2048 + head * 64 + pp]);
      const float yg = (y + Dh * xv) * silu_f(z);
      p.YG[(row0 + t) * 2048 + head * 64 + pp] = f2bf(yg);
      sy2[t * 64 + pp] = yg * yg;
    }
  }
  float* od = p.out + O_SSMS + sbase;
#pragma unroll
  for (int i = 0; i < 8; ++i) *(float4*)(od + i * 16) = h[i];
  __syncthreads();
  if (tid < 8) {
    float s = 0.f;
    for (int i = 0; i < 64; ++i) s += sy2[tid * 64 + i];
    p.SSQ[(row0 + tid) * 32 + head] = s;
  }
  __syncthreads();
}

DI void phase_states(const Params& p, char* smem_raw) {
  constexpr int NP = 4096, NS = 1024;
  for (int it = VBID; it < NP + NS; it += VGRID) {
    const int pr = it >> 1, sub = it & 1;
    const int q = pr / 5, rem = pr - q * 5;
    if (rem == 4) ssm_sample_item(p, q * 2 + sub, smem_raw);
    else ssd_states_item(p, (q * 4 + rem) * 2 + sub, smem_raw);
  }
}

DI void phase_scan(const Params& p) {
  for (int task = VBID * 256 + VTID; task < 131072; task += VGRID * 256) {
    const int n8 = task & 15, pp = (task >> 4) & 63, head = (task >> 10) & 31, b = task >> 15;
    float h[8];
#pragma unroll
    for (int e = 0; e < 8; ++e) h[e] = 0.f;
#pragma unroll 8
    for (int c = 0; c < 32; ++c) {
      const int item = (b * 32 + c) * 32 + head;
      uint4* sp = (uint4*)(p.STATES + ((size_t)item * 64 + pp) * 128 + n8 * 8);
      const uint4 sv = *sp;
      const float d = p.CD[item];
      *sp = pack8(h);
      float sf[8];
      unpack8(sv, sf);
#pragma unroll
      for (int e = 0; e < 8; ++e) h[e] = h[e] * d + sf[e];
    }
    float* od = p.out + O_SSMP + ((size_t)(b * 32 + head) * 64 + pp) * 128 + n8 * 8;
    *(float4*)od = (float4){h[0], h[1], h[2], h[3]};
    *(float4*)(od + 4) = (float4){h[4], h[5], h[6], h[7]};
  }
}

DI void ssd_out_item(const Params& p, int item, char* smem_raw) {
  const int tid = VTID, lane = tid & 63, w = tid >> 6, l15 = lane & 15, G = lane >> 4;
  const int head = item & 31, c = (item >> 5) & 31, b = item >> 10, g = head >> 3;
  u16* Bs = (u16*)(smem_raw + SS_B);
  u16* Xs = (u16*)(smem_raw + SS_R2);
  u16* Hs = (u16*)(smem_raw + SS_H);
  float* s_acs = (float*)(smem_raw + SS_F);
  float* s_dt = s_acs + 128;
  const size_t row0 = (size_t)b * 4096 + c * 128;
  if (tid < 128) {
    s_acs[tid] = p.ACS[(row0 + tid) * 32 + head];
    s_dt[tid] = p.DT[(row0 + tid) * 32 + head];
  }
#pragma unroll
  for (int i = 0; i < 8; ++i) {
    const int idx = tid + 256 * i, row = idx >> 4, ch = idx & 15;
    *(uint4*)(Bs + row * LDW + ch * 8) = *(const uint4*)(p.XBCC + (row0 + row) * 3072 + 2048 + g * 128 + ch * 8);
  }
#pragma unroll
  for (int i = 0; i < 4; ++i) {
    const int row = (tid >> 3) + 32 * i, ch = tid & 7;
    *(uint4*)(Xs + row * LDT + ch * 8) = *(const uint4*)(p.XBCC + (row0 + row) * 3072 + head * 64 + ch * 8);
  }
  {
    const u16* hp = p.STATES + (size_t)item * 64 * 128;
#pragma unroll
    for (int i = 0; i < 4; ++i) {
      const int idx = tid + 256 * i, pp = idx >> 4, ch = idx & 15;
      *(uint4*)(Hs + pp * LDW + ch * 8) = *(const uint4*)(hp + pp * 128 + ch * 8);
    }
  }
  bf16x8 cf[2][4];
#pragma unroll
  for (int sub = 0; sub < 2; ++sub)
#pragma unroll
    for (int ks = 0; ks < 4; ++ks)
      cf[sub][ks] = *(const bf16x8*)(p.XBCC + (row0 + w * 32 + sub * 16 + l15) * 3072 + 2560 + g * 128 + ks * 32 + G * 8);
  uint2 zpre[2][4];
#pragma unroll
  for (int sub = 0; sub < 2; ++sub)
#pragma unroll
    for (int m = 0; m < 4; ++m)
      zpre[sub][m] = *(const uint2*)(p.Z + (row0 + w * 32 + sub * 16 + l15) * 2048 + head * 64 + 16 * m + 4 * G);
  __syncthreads();
  const float Dh = p.ssm_D[head];
#pragma unroll
  for (int sub = 0; sub < 2; ++sub) {
    const int l0 = w * 32 + sub * 16, lq = l0 + l15;
    const float acs_q = s_acs[lq];
    f32x4 yo[4];
#pragma unroll
    for (int m = 0; m < 4; ++m) {
      f32x4 z = {0.f, 0.f, 0.f, 0.f};
#pragma unroll
      for (int ks = 0; ks < 4; ++ks) z = MFMA16(*(const bf16x8*)(Hs + (16 * m + l15) * LDW + ks * 32 + G * 8), cf[sub][ks], z);
      yo[m] = z;
    }
    {
      const float ea = __expf(acs_q);
#pragma unroll
      for (int m = 0; m < 4; ++m) { yo[m][0] *= ea; yo[m][1] *= ea; yo[m][2] *= ea; yo[m][3] *= ea; }
    }
    const int ns = (l0 >> 4) + 1, nsteps = (ns + 1) >> 1;
#pragma unroll 1
    for (int step = 0; step < nsteps; ++step) {
      unsigned pw[4];
#pragma unroll
      for (int h2 = 0; h2 < 2; ++h2) {
        const int ss = 2 * step + h2;
        f32x4 st = {0.f, 0.f, 0.f, 0.f};
#pragma unroll
        for (int ks = 0; ks < 4; ++ks) st = MFMA16(*(const bf16x8*)(Bs + (16 * ss + l15) * LDW + ks * 32 + G * 8), cf[sub][ks], st);
        float mv[4];
#pragma unroll
        for (int j = 0; j < 4; ++j) {
          const int s = 16 * ss + 4 * G + j;
          const float dec = __expf(fminf(acs_q - s_acs[s], 0.f)) * s_dt[s];
          mv[j] = (s <= lq) ? st[j] * dec : 0.f;
        }
        pw[2 * h2] = pack2(mv[0], mv[1]);
        pw[2 * h2 + 1] = pack2(mv[2], mv[3]);
      }
      const bf16x8 pb = words_to_frag(pw[0], pw[1], pw[2], pw[3]);
      const u16* xa = Xs + (32 * step + 4 * G + (l15 >> 2)) * LDT + (l15 & 3) * 4;
#pragma unroll
      for (int m = 0; m < 4; ++m) yo[m] = MFMA16(cat4(tr_read(xa + 16 * m), tr_read(xa + 16 * LDT + 16 * m)), pb, yo[m]);
    }
    const size_t rowg = (size_t)b * 4096 + c * 128 + lq;
    float ssq = 0.f;
#pragma unroll
    for (int m = 0; m < 4; ++m) {
      const uint2 xv = *(const uint2*)(Xs + lq * LDT + 16 * m + 4 * G);
      const uint2 zv = zpre[sub][m];
      const float xf[4] = {lo_f(xv.x), hi_f(xv.x), lo_f(xv.y), hi_f(xv.y)};
      const float zf[4] = {lo_f(zv.x), hi_f(zv.x), lo_f(zv.y), hi_f(zv.y)};
      float y[4];
#pragma unroll
      for (int j = 0; j < 4; ++j) {
        y[j] = (yo[m][j] + Dh * xf[j]) * silu_f(zf[j]);
        ssq += y[j] * y[j];
      }
      uint2 ov; ov.x = pack2(y[0], y[1]); ov.y = pack2(y[2], y[3]);
      *(uint2*)(p.YG + rowg * 2048 + head * 64 + 16 * m + 4 * G) = ov;
    }
    ssq += __shfl_xor(ssq, 16);
    ssq += __shfl_xor(ssq, 32);
    if (G == 0) p.SSQ[rowg * 32 + head] = ssq;
  }
  __syncthreads();
}

DI void idle_transposes(const Params& p, int idle_idx, int n_idle, int first, int count, u16* smem) {
  const int vb = idle_idx * 2 + (opaque_tid() >> 8), vg = n_idle * 2;
  for (int it = vb; it < count; it += vg) late_transpose_task(p, first + it, smem);
}

#define XB_TMO      128
#define XB_XCNT(j)  (256  + 64 * (j))
#define XB_XSUB(j)  (1280 + 64 * (j))
#define XB_XGEN(j)  (2304 + 64 * (j))
#define XB_TOP      3328
#define XB_TOPGEN   3392
#define XCD_BAR_WORDS 3456
#define XB_SPIN_CAP (1u << 20)
#define LAS __attribute__((address_space(3)))
DI unsigned xb_ld(unsigned* p) { return __hip_atomic_load(p, __ATOMIC_RELAXED, __HIP_MEMORY_SCOPE_AGENT); }
DI unsigned xb_add(unsigned* p, unsigned v) { return __hip_atomic_fetch_add(p, v, __ATOMIC_RELAXED, __HIP_MEMORY_SCOPE_AGENT); }
DI unsigned xb_xcc_id() { return (unsigned)__builtin_amdgcn_s_getreg((3 << 11) | 20) & 0xFu; }
#define XB_SPIN(cond, bar) do { unsigned _sp = 0; while (cond) { __builtin_amdgcn_s_sleep(1); \
    if ((++_sp & 255u) == 0u) { if (xb_ld(&(bar)[XB_TMO])) break; if (_sp > XB_SPIN_CAP) { atomicAdd(&(bar)[XB_TMO], 1u); break; } } } } while (0)
struct XcdBarrier { unsigned* bar; unsigned x; volatile LAS unsigned* st; };
DI XcdBarrier xcd_barrier_post(unsigned* bar, volatile LAS unsigned* st) {
  XcdBarrier b; b.bar = bar; b.x = xb_xcc_id(); b.st = st;
  if (threadIdx.x == 0) (void)xb_add(&bar[XB_XCNT(b.x)], 1u);
  return b;
}
DI void xcd_barrier_complete(unsigned* bar, unsigned x, unsigned& nloc, unsigned& nx) {
  const unsigned Gn = gridDim.x * gridDim.y * gridDim.z;
  unsigned sum, cnt, mine, sp = 0u;
  for (;;) {
    sum = 0u; cnt = 0u; mine = 0u;
#pragma unroll
    for (unsigned j = 0; j < 16; ++j) { const unsigned c = xb_ld(&bar[XB_XCNT(j)]); sum += c; cnt += (c > 0u) ? 1u : 0u; mine = (j == x) ? c : mine; }
    if (sum == Gn) break;
    __builtin_amdgcn_s_sleep(1);
    if ((++sp & 255u) == 0u) { if (xb_ld(&bar[XB_TMO])) break; if (sp > XB_SPIN_CAP) { atomicAdd(&bar[XB_TMO], 1u); break; } }
  }
  nloc = mine > 0u ? mine : 1u; nx = cnt > 0u ? cnt : 1u;
}
DI void xcd_barrier(const XcdBarrier& b) {
  asm volatile("s_waitcnt vmcnt(0)" ::: "memory");
  __syncthreads();
  if (threadIdx.x == 0) {
    unsigned* bar = b.bar;
    __builtin_amdgcn_s_waitcnt(0);
    unsigned nloc = b.st[0], nx = b.st[1];
    if (nloc == 0u) { xcd_barrier_complete(bar, b.x, nloc, nx); b.st[0] = nloc; b.st[1] = nx; }
    const unsigned old = xb_add(&bar[XB_XSUB(b.x)], 1u);
    const unsigned gen = old / nloc;
    if (old + 1u == (gen + 1u) * nloc) {
      __builtin_amdgcn_fence(__ATOMIC_RELEASE, "agent");
      asm volatile("s_waitcnt vmcnt(0)" ::: "memory");
      const unsigned og = xb_add(&bar[XB_TOP], 1u);
      const unsigned tg = og / nx;
      if (og + 1u == (tg + 1u) * nx) xb_add(&bar[XB_TOPGEN], 1u);
      else XB_SPIN(xb_ld(&bar[XB_TOPGEN]) == tg, bar);
      __builtin_amdgcn_fence(__ATOMIC_ACQUIRE, "agent");
      xb_add(&bar[XB_XGEN(b.x)], 1u);
      asm volatile("s_waitcnt vmcnt(0)" ::: "memory");
    } else {
      XB_SPIN(xb_ld(&bar[XB_XGEN(b.x)]) == gen, bar);
      __builtin_amdgcn_fence(__ATOMIC_ACQUIRE, "agent");
      asm volatile("s_waitcnt vmcnt(0)" ::: "memory");
    }
  }
  __syncthreads();
}

constexpr int NPHASE = 13;
#ifndef PH_MASK
#define PH_MASK 0x1fff
#endif
#define PH_ON(k) (((PH_MASK) >> (k)) & 1)
#ifndef PH_REPEAT
#define PH_REPEAT 0
#endif
#define PH_REP(k) (((PH_REPEAT) >> (k)) & 1)

template <bool COOP>
__global__ void __launch_bounds__(512, 2) mega(Params p, int ph0, int ph1) {
  extern __shared__ __attribute__((aligned(16))) char smem_all[];
  char* smem_raw = smem_all + (threadIdx.x >> 8) * LDS_HALF;
  u16* smem = (u16*)smem_raw;
#define PHASE_BODY(k)                                                                                                   \
  do {                                                                                                                  \
    if (k == 0) { if (PH_ON(0)) phase_prep(p, smem); }                                                                  \
    else if (k == 1) { if (PH_ON(1)) { gemm_phase_big(p.H, p.Wt1, 1024, MROWS / 256, ATT_IN / 256, Ep1{p}, smem_all); \
      const int x_ = blockIdx.x & 7, j_ = blockIdx.x >> 3; const bool busy_ = (x_ == 0) || (x_ == 1 && j_ < 8); \
      if (gridDim.x != 256) idle_transposes(p, blockIdx.x, gridDim.x, 0, TR2 + TR3, smem); \
      else if (!busy_) idle_transposes(p, (x_ >= 2) ? (x_ - 2) * 32 + j_ : 192 + (j_ - 8), 216, 0, TR2 + TR3, smem); } }  \
    else if (k == 2) { if (PH_ON(2)) phase_attn(p, smem); }                                                             \
    else if (k == 3) { if (PH_ON(3)) phase_merge(p); }                                                                  \
    else if (k == 4) { if (PH_ON(4)) { gemm_phase_big(p.H, p.Wt2, 1024, MROWS / 256, 4, Ep2{p}, smem_all); \
      const int x_ = blockIdx.x & 7, j_ = blockIdx.x >> 3; const bool busy_ = (x_ == 0 && j_ < 4); \
      if (gridDim.x != 256) idle_transposes(p, blockIdx.x, gridDim.x, TR2 + TR3, TR4, smem); \
      else if (!busy_) idle_transposes(p, (x_ == 0) ? (j_ - 4) : 28 + (x_ - 1) * 32 + j_, 252, TR2 + TR3, TR4, smem); } }             \
    else if (k == 5) { if (PH_ON(5)) phase_norm2(p); }                                                                  \
    else if (k == 6) { if (PH_ON(6)) gemm_phase_big(p.H, p.Wt3, 1024, MROWS / 256, SSM_IN_PAD / 256, Ep3{p}, smem_all); } \
    else if (k == 7) { if (PH_ON(7)) phase_convpass(p); }                                                               \
    else if (k == 8) { if (PH_ON(8)) phase_states(p, smem_raw); }                                                       \
    else if (k == 9) { if (PH_ON(9)) phase_scan(p); }                                                                   \
    else if (k == 10) { if (PH_ON(10)) for (int it = VBID; it < 4096; it += VGRID) ssd_out_item(p, it, smem_raw); } \
    else if (k == 11) { if (PH_ON(11)) phase_gatenorm(p); }                                                             \
    else if (k == 12) { if (PH_ON(12)) gemm_phase_big(p.YG, p.Wt4, 2048, MROWS / 256, 4, Ep4{p}, smem_all); }          \
  } while (0)
#define PHASE_STEP(k) PHASE_BODY(k); if (PH_REP(k)) { xcd_barrier(xb); PHASE_BODY(k); }
  if constexpr (COOP) {
    volatile LAS unsigned* xst = (volatile LAS unsigned*)(smem_all + LDS_MAIN);
    if (threadIdx.x == 0) { xst[0] = 0u; xst[1] = 0u; }
    __syncthreads();
    const XcdBarrier xb = xcd_barrier_post(p.bar, xst);
    if (ph0 == 0x7fffffff) cg::this_grid().sync();
    PHASE_STEP(0) xcd_barrier(xb);
    PHASE_STEP(1) xcd_barrier(xb);
    PHASE_STEP(2) xcd_barrier(xb);
    PHASE_STEP(3) xcd_barrier(xb);
    PHASE_STEP(4) xcd_barrier(xb);
    PHASE_STEP(5) xcd_barrier(xb);
    PHASE_STEP(6) xcd_barrier(xb);
    PHASE_STEP(7) xcd_barrier(xb);
    PHASE_STEP(8) xcd_barrier(xb);
    PHASE_STEP(9) xcd_barrier(xb);
    PHASE_STEP(10) xcd_barrier(xb);
    PHASE_STEP(11) xcd_barrier(xb);
    PHASE_STEP(12)
  } else {
    switch (ph0) {
      case 0: PHASE_BODY(0); break;
      case 1: PHASE_BODY(1); break;
      case 2: PHASE_BODY(2); break;
      case 3: PHASE_BODY(3); break;
      case 4: PHASE_BODY(4); break;
      case 5: PHASE_BODY(5); break;
      case 6: PHASE_BODY(6); break;
      case 7: PHASE_BODY(7); break;
      case 8: PHASE_BODY(8); break;
      case 9: PHASE_BODY(9); break;
      case 10: PHASE_BODY(10); break;
      case 11: PHASE_BODY(11); break;
      case 12: PHASE_BODY(12); break;
    }
  }
}

#ifndef MULTI_LAUNCH
#define MULTI_LAUNCH 0
#endif

extern "C" void kernel_launch(void* const* d_in, const int* in_sizes, int n_in, void* d_out, int out_size, void* d_ws, size_t ws_size,
                              hipStream_t stream) {
  static int grid = 0;
  size_t off = 0;
  auto carve = [&](size_t bytes) { size_t o = off; off += (bytes + 255) & ~(size_t)255; return (char*)d_ws + o; };
  Params p{};
  p.x_prompt = (const float*)d_in[0]; p.x_sample = (const float*)d_in[1];
  p.cache0 = (const float*)d_in[2]; p.cache1 = (const float*)d_in[3]; p.cache2 = (const float*)d_in[4];
  p.state_conv = (const float*)d_in[5]; p.state_ssm = (const float*)d_in[6];
  p.attn_norm = (const float*)d_in[7]; p.attn_w_in = (const float*)d_in[8]; p.attn_q_gain = (const float*)d_in[9];
  p.attn_k_gain = (const float*)d_in[10]; p.attn_w_out = (const float*)d_in[11];
  p.ssm_norm = (const float*)d_in[12]; p.ssm_w_in = (const float*)d_in[13]; p.ssm_conv_w = (const float*)d_in[14];
  p.ssm_conv_b = (const float*)d_in[15]; p.ssm_dt_bias = (const float*)d_in[16]; p.ssm_A_log = (const float*)d_in[17];
  p.ssm_D = (const float*)d_in[18]; p.ssm_gate_norm = (const float*)d_in[19]; p.ssm_w_out = (const float*)d_in[20];
  p.out = (float*)d_out;
  p.Wt1 = (u16*)carve((size_t)ATT_IN * 1024 * 2);
  p.Wt2 = (u16*)carve((size_t)1024 * 1024 * 2);
  p.Wt3 = (u16*)carve((size_t)SSM_IN_PAD * 1024 * 2);
  p.Wt4 = (u16*)carve((size_t)1024 * 2048 * 2);
  p.H = (u16*)carve((size_t)MROWS * 1024 * 2);
  p.QKVG = (u16*)carve((size_t)MROWS * ATT_IN * 2);
  p.OG = (u16*)carve((size_t)MROWS * 3072 * 2);
  p.Z = (u16*)carve((size_t)MROWS * 2048 * 2);
  p.XBC = (u16*)carve((size_t)MROWS * 3072 * 2);
  p.YG = (u16*)carve((size_t)MROWS * 2048 * 2);
  p.LSE = (float*)carve((size_t)MROWS * 48 * 4);
  p.X1 = (float*)carve((size_t)MROWS * 1024 * 4);
  p.DT = (float*)carve((size_t)MROWS * 32 * 4);
  p.STATES = (u16*)carve((size_t)4 * 32 * 32 * 64 * 128 * 2);
  p.XBCC = (u16*)carve((size_t)PROWS * 3072 * 2);
  p.ACS = (float*)carve((size_t)PROWS * 32 * 4);
  p.bar = (unsigned*)carve((size_t)XCD_BAR_WORDS * 4);
  p.QKVH = (u16*)carve((size_t)4 * 3 * 3 * 16 * 4096 * 64 * 2);
  p.SSQ = (float*)carve((size_t)MROWS * 32 * 4);
  p.CD = (float*)carve((size_t)4 * 32 * 32 * 4);
  if (grid == 0) {
    if (n_in != 21 || (size_t)out_size != O_END || ws_size < off) {
      fprintf(stderr, "kernel_launch: unexpected shapes: n_in %d out %d (want %zu) ws %zu (need %zu)\n", n_in, out_size, (size_t)O_END, ws_size, off);
      grid = -1; return;
    }
    int dev = 0, cus = 0, per_cu = 0;
    hipGetDevice(&dev);
    hipDeviceGetAttribute(&cus, hipDeviceAttributeMultiprocessorCount, dev);
    hipFuncSetAttribute((const void*)mega<true>, hipFuncAttributeMaxDynamicSharedMemorySize, LDS_BYTES);
    hipFuncSetAttribute((const void*)mega<false>, hipFuncAttributeMaxDynamicSharedMemorySize, LDS_BYTES);
    hipOccupancyMaxActiveBlocksPerMultiprocessor(&per_cu, (const void*)mega<true>, 512, LDS_BYTES);
    if (per_cu < 1) { fprintf(stderr, "kernel_launch: occupancy query returned %d\n", per_cu); grid = -1; return; }
    if (per_cu > 1) per_cu = 1;
    grid = cus * per_cu;
    grid &= ~7;
  }
  if (grid < 0) return;
#if MULTI_LAUNCH
  for (int ph = 0; ph < NPHASE; ++ph) hipLaunchKernelGGL(mega<false>, dim3(grid), dim3(512), LDS_BYTES, stream, p, ph, ph + 1);
#else
  hipMemsetAsync(p.bar, 0, (size_t)XCD_BAR_WORDS * 4, stream);
  int ph0 = 0, ph1 = NPHASE;
  void* args[] = {&p, &ph0, &ph1};
  hipError_t e = hipLaunchCooperativeKernel((const void*)mega<true>, dim3(grid), dim3(512), args, LDS_BYTES, stream);
  if (e != hipSuccess) fprintf(stderr, "cooperative launch failed: %s (grid %d)\n", hipGetErrorString(e), grid);
#endif
}
```

```cpp
#include <hip/hip_runtime.h>
#include <hip/hip_cooperative_groups.h>
#include <cstdio>
#include <cstdint>
namespace cg = cooperative_groups;

typedef unsigned short u16;
typedef short bf16x8 __attribute__((ext_vector_type(8)));
typedef short s16x4 __attribute__((ext_vector_type(4)));
typedef float f32x4 __attribute__((ext_vector_type(4)));

#define DI __device__ __forceinline__
__device__ __forceinline__ int opaque_tid() { int t = threadIdx.x; asm volatile("" : "+v"(t)); return t; }
#define VTID (opaque_tid() & 255)
#define VBID ((int)(blockIdx.x * 2 + (opaque_tid() >> 8)))
#define VGRID ((int)(gridDim.x * 2))
#define MFMA16(a, b, c) __builtin_amdgcn_mfma_f32_16x16x32_bf16((a), (b), (c), 0, 0, 0)

constexpr int MROWS = 16384 + 256;
constexpr int PROWS = 16384;
constexpr int ATT_IN = 10240;
constexpr int SSM_IN = 5152;
constexpr int SSM_IN_PAD = 5376;
constexpr int LDS_HALF = 73728;
constexpr int LDS_MAIN = 2 * LDS_HALF;
constexpr int LDS_BYTES = LDS_MAIN + 16;
constexpr int LDT = 72;
constexpr int LDW = 136;
constexpr int TILE_ELEMS = 128 * LDT;

constexpr size_t O_Y = 0;
constexpr size_t O_KVP0 = (size_t)MROWS * 1024;
constexpr size_t O_KVP1 = O_KVP0 + (size_t)4 * 128 * 2048;
constexpr size_t O_KVP2 = O_KVP1 + (size_t)4 * 512 * 2048;
constexpr size_t O_KVS0 = O_KVP2 + (size_t)4 * 2048 * 2048;
constexpr size_t O_KVS1 = O_KVS0 + (size_t)256 * 2048;
constexpr size_t O_KVS2 = O_KVS1 + (size_t)256 * 2048;
constexpr size_t O_CONVP = O_KVS2 + (size_t)256 * 2048;
constexpr size_t O_CONVS = O_CONVP + (size_t)4 * 3 * 3072;
constexpr size_t O_SSMP = O_CONVS + (size_t)32 * 3 * 3072;
constexpr size_t O_SSMS = O_SSMP + (size_t)4 * 32 * 64 * 128;
constexpr size_t O_END = O_SSMS + (size_t)32 * 32 * 64 * 128;

struct Params {
  const float *x_prompt, *x_sample, *cache0, *cache1, *cache2, *state_conv, *state_ssm;
  const float *attn_norm, *attn_w_in, *attn_q_gain, *attn_k_gain, *attn_w_out;
  const float *ssm_norm, *ssm_w_in, *ssm_conv_w, *ssm_conv_b, *ssm_dt_bias, *ssm_A_log, *ssm_D, *ssm_gate_norm, *ssm_w_out;
  float* out;
  u16 *Wt1, *Wt2, *Wt3, *Wt4, *H, *QKVG, *OG, *Z, *XBC, *YG, *XBCC, *STATES, *QKVH;
  float *LSE, *X1, *DT, *SSQ, *CD, *ACS;
  unsigned* bar;
};

typedef __bf16 bf16v2 __attribute__((ext_vector_type(2)));
DI u16 f2bf(float x) { return __builtin_bit_cast(u16, (__bf16)x); }
DI float bf2f(u16 h) { return __uint_as_float(((unsigned)h) << 16); }
DI unsigned pack2(float a, float b) { bf16v2 v; v[0] = (__bf16)a; v[1] = (__bf16)b; return __builtin_bit_cast(unsigned, v); }
DI float lo_f(unsigned w) { return __uint_as_float(w << 16); }
DI float hi_f(unsigned w) { return __uint_as_float(w & 0xffff0000u); }
DI void unpack8(const uint4& v, float* f) {
  f[0] = lo_f(v.x); f[1] = hi_f(v.x); f[2] = lo_f(v.y); f[3] = hi_f(v.y);
  f[4] = lo_f(v.z); f[5] = hi_f(v.z); f[6] = lo_f(v.w); f[7] = hi_f(v.w);
}
DI uint4 pack8(const float* f) {
  uint4 v; v.x = pack2(f[0], f[1]); v.y = pack2(f[2], f[3]); v.z = pack2(f[4], f[5]); v.w = pack2(f[6], f[7]); return v;
}
DI float sum16(float v) {
  v += __builtin_bit_cast(float, __builtin_amdgcn_update_dpp(0, __builtin_bit_cast(int, v), 0xB1, 0xf, 0xf, true));
  v += __builtin_bit_cast(float, __builtin_amdgcn_update_dpp(0, __builtin_bit_cast(int, v), 0x4E, 0xf, 0xf, true));
  v += __builtin_bit_cast(float, __builtin_amdgcn_update_dpp(0, __builtin_bit_cast(int, v), 0x141, 0xf, 0xf, true));
  v += __builtin_bit_cast(float, __builtin_amdgcn_update_dpp(0, __builtin_bit_cast(int, v), 0x140, 0xf, 0xf, true));
  return v;
}
DI float sum4(float v) {
  v += __builtin_bit_cast(float, __builtin_amdgcn_update_dpp(0, __builtin_bit_cast(int, v), 0xB1, 0xf, 0xf, true));
  v += __builtin_bit_cast(float, __builtin_amdgcn_update_dpp(0, __builtin_bit_cast(int, v), 0x4E, 0xf, 0xf, true));
  return v;
}
DI float silu_f(float x) { return x / (1.f + __expf(-x)); }
DI s16x4 tr_read(const u16* ptr) {
  return __builtin_amdgcn_ds_read_tr16_b64_v4i16((s16x4 __attribute__((address_space(3)))*)(ptr));
}
DI bf16x8 cat4(s16x4 lo, s16x4 hi) { return __builtin_shufflevector(lo, hi, 0, 1, 2, 3, 4, 5, 6, 7); }
DI bf16x8 words_to_frag(unsigned a, unsigned b, unsigned c, unsigned d) {
  uint4 v; v.x = a; v.y = b; v.z = c; v.w = d; return __builtin_bit_cast(bf16x8, v);
}

constexpr int G8_HT = 128 * 64;
DI int g8_lds_byte(int r, int c) {
  const int st = (r >> 4) * 2 + (c >> 5), rr = r & 15, cc = c & 31, ob = rr * 64 + cc * 2;
  return st * 1024 + (ob ^ (((ob >> 9) & 1) << 5));
}
DI void g8_stage_rc(int b, int& R, int& C) {
  const int st = b / 1024, sb = b % 1024, swz = sb ^ (((sb >> 9) & 1) << 5);
  R = (st >> 1) * 16 + swz / 64; C = (st & 1) * 32 + (swz % 64) / 2;
}
template <class EP>
DI void gemm_tile_big(const u16* __restrict__ A, const u16* __restrict__ Bt, int K, int brow, int bcol, const EP& ep, char* smem) {
  u16* shm = (u16*)smem;
  const int rtid = opaque_tid();
#define SA(b, h) (shm + ((b) * 2 + (h)) * G8_HT)
#define SB(b, h) (shm + (4 + (b) * 2 + (h)) * G8_HT)
  unsigned offA[2], offB[2];
#pragma unroll
  for (int _i = 0; _i < 2; ++_i) {
    int _r, _c; g8_stage_rc(rtid * 16 + _i * 8192, _r, _c);
    offA[_i] = (unsigned)((_r * K + _c) * 2);
    offB[_i] = (unsigned)((((_r >> 5) * 64 + (_r & 31)) * K + _c) * 2);
  }
#define STAGE_A(P, br, kt) do { const char* _gb = (const char*)A + ((size_t)(br) * K + (size_t)(kt) * 64) * 2;          \
    _Pragma("unroll") for (int _i = 0; _i < 2; ++_i)                                                                    \
      __builtin_amdgcn_global_load_lds((const unsigned*)(_gb + offA[_i]), (unsigned*)((char*)(P) + rtid * 16 + _i * 8192), 16, 0, 0); } while (0)
#define STAGE_B(P, h, kt) do { const char* _gb = (const char*)Bt + ((size_t)(bcol + (h) * 32) * K + (size_t)(kt) * 64) * 2; \
    _Pragma("unroll") for (int _i = 0; _i < 2; ++_i)                                                                    \
      __builtin_amdgcn_global_load_lds((const unsigned*)(_gb + offB[_i]), (unsigned*)((char*)(P) + rtid * 16 + _i * 8192), 16, 0, 0); } while (0)
#define LDA(dst, b, h) _Pragma("unroll") for (int m = 0; m < 4; ++m) _Pragma("unroll") for (int k = 0; k < 2; ++k) \
    dst[m][k] = *reinterpret_cast<const bf16x8*>(a_rd + ((b) * 2 + (h)) * 16384 + m * 2048 + k * 1024)
#define LDB(dst, b, h) _Pragma("unroll") for (int n = 0; n < 2; ++n) _Pragma("unroll") for (int k = 0; k < 2; ++k) \
    dst[n][k] = *reinterpret_cast<const bf16x8*>(b_rd + ((b) * 2 + (h)) * 16384 + n * 2048 + k * 1024)
#define MMA(ai, bj, At, Bx) do { __builtin_amdgcn_s_setprio(1);                                                         \
    for (int m = 0; m < 4; ++m) for (int n = 0; n < 2; ++n) for (int k = 0; k < 2; ++k)                                 \
      acc[ai][m][(bj) * 2 + n] = MFMA16(At[m][k], Bx[n][k], acc[ai][m][(bj) * 2 + n]);                                 \
    __builtin_amdgcn_s_setprio(0); } while (0)
#define WAIT_V(n) asm volatile("s_waitcnt vmcnt(" #n ")" ::: "memory")
#define WAIT_L(n) asm volatile("s_waitcnt lgkmcnt(" #n ")" ::: "memory")
#define BAR __builtin_amdgcn_s_barrier()
#define SCHED __builtin_amdgcn_sched_barrier(0)
  const int wid = rtid >> 6, lane = rtid & 63, wr = wid >> 2, wc = wid & 3, fr = lane & 15, fq = lane >> 4;
  const int l0 = g8_lds_byte(fr, fq * 8);
  const char* a_rd = smem + wr * 8192 + l0;
  const char* b_rd = smem + 4 * 16384 + wc * 4096 + l0;
  f32x4 acc[2][4][4];
#pragma unroll
  for (int ai = 0; ai < 2; ++ai)
#pragma unroll
    for (int m = 0; m < 4; ++m)
#pragma unroll
      for (int n = 0; n < 4; ++n) acc[ai][m][n] = (f32x4){0.f, 0.f, 0.f, 0.f};
  bf16x8 At[4][2], B0[2][2], B1[2][2];
  const int nt = K / 64;
  STAGE_B(SB(0, 0), 0, 0); STAGE_A(SA(0, 0), brow, 0);
  STAGE_B(SB(0, 1), 1, 0); STAGE_A(SA(0, 1), brow + 128, 0);
  if (wr == 1) BAR;
  WAIT_V(4); BAR;
  STAGE_B(SB(1, 0), 0, 1); STAGE_A(SA(1, 0), brow, 1); STAGE_B(SB(1, 1), 1, 1);
  WAIT_V(6); BAR;
  for (int t = 0; t < nt - 2; t += 2) {
    LDB(B0, 0, 0); SCHED; LDA(At, 0, 0); STAGE_A(SA(1, 1), brow + 128, t + 1);
    WAIT_L(8); BAR; WAIT_L(0); MMA(0, 0, At, B0); BAR; SCHED;
    LDB(B1, 0, 1); STAGE_B(SB(0, 0), 0, t + 2);
    BAR; WAIT_L(0); MMA(0, 1, At, B1); BAR;
    LDA(At, 0, 1); STAGE_A(SA(0, 0), brow, t + 2);
    BAR; WAIT_L(0); MMA(1, 0, At, B0); BAR; SCHED;
    STAGE_B(SB(0, 1), 1, t + 2);
    WAIT_V(6); BAR; MMA(1, 1, At, B1); BAR;
    LDB(B0, 1, 0); SCHED; LDA(At, 1, 0); STAGE_A(SA(0, 1), brow + 128, t + 2);
    WAIT_L(8); BAR; WAIT_L(0); MMA(0, 0, At, B0); BAR; SCHED;
    LDB(B1, 1, 1); STAGE_B(SB(1, 0), 0, t + 3);
    BAR; WAIT_L(0); MMA(0, 1, At, B1); BAR;
    LDA(At, 1, 1); STAGE_A(SA(1, 0), brow, t + 3);
    BAR; WAIT_L(0); MMA(1, 0, At, B0); BAR; SCHED;
    STAGE_B(SB(1, 1), 1, t + 3);
    WAIT_V(6); BAR; MMA(1, 1, At, B1); BAR;
  }
  { LDB(B0, 0, 0); LDA(At, 0, 0); STAGE_A(SA(1, 1), brow + 128, nt - 1);
    BAR; WAIT_L(0); MMA(0, 0, At, B0); BAR;
    LDB(B1, 0, 1); BAR; WAIT_L(0); MMA(0, 1, At, B1); BAR;
    LDA(At, 0, 1); WAIT_V(4); BAR; WAIT_L(0); MMA(1, 0, At, B0); MMA(1, 1, At, B1); BAR; }
  { LDB(B0, 1, 0); LDA(At, 1, 0); WAIT_V(2); BAR; WAIT_L(0); MMA(0, 0, At, B0); BAR;
    LDB(B1, 1, 1); WAIT_V(0); BAR; WAIT_L(0); MMA(0, 1, At, B1); BAR;
    LDA(At, 1, 1); BAR; WAIT_L(0); MMA(1, 0, At, B0); MMA(1, 1, At, B1); BAR; }
  if (wr == 0) BAR;
#undef SA
#undef SB
#undef STAGE_A
#undef STAGE_B
#undef LDA
#undef LDB
#undef MMA
#undef WAIT_V
#undef WAIT_L
#undef BAR
#undef SCHED
  int late = 0;
  asm volatile("" : "+v"(late));
  ep(acc[0], brow + wr * 64 + late, bcol + wc * 64, lane + late);
  ep(acc[1], brow + 128 + wr * 64 + late, bcol + wc * 64, lane + late);
  __syncthreads();
}

template <class EP>
DI void gemm_phase_big(const u16* A, const u16* Bt, int K, int MT, int NT, const EP& ep, char* smem) {
  const int x = blockIdx.x & 7, j = blockIdx.x >> 3, per = gridDim.x >> 3;
  const int T = MT * NT, fullT = (MT >> 3) * 8 * NT, hlast = MT & 7;
  for (int v = j;; v += per) {
    const int chunk = x + 8 * (v >> 5);
    if (chunk * 32 >= T) break;
    const int s = chunk * 32 + (v & 31);
    if (s >= T) continue;
    int mt, nt;
    if (s < fullT) { const int band = s / (8 * NT), within = s - band * 8 * NT; nt = within >> 3; mt = band * 8 + (within & 7); }
    else { const int sp = s - fullT; nt = sp / hlast; mt = (MT >> 3) * 8 + (sp - nt * hlast); }
    gemm_tile_big(A, Bt, K, mt * 256, nt * 256, ep, smem);
  }
}

DI unsigned merge_word(unsigned a, unsigned b, unsigned c, unsigned g, float e0, float e1, float e2) {
  const float lo = (e0 * lo_f(a) + e1 * lo_f(b) + e2 * lo_f(c)) * silu_f(lo_f(g));
  const float hi = (e0 * hi_f(a) + e1 * hi_f(b) + e2 * hi_f(c)) * silu_f(hi_f(g));
  return pack2(lo, hi);
}
DI void phase_merge(const Params& p) {
  const int lane = VTID & 63;
  for (int it = VBID; it < MROWS / 4; it += VGRID) {
    const size_t row = (size_t)it * 4 + (VTID >> 6);
    const int k = lane * 16, head = lane >> 2;
    const float* lp = p.LSE + row * 48 + head;
    const float l0 = lp[0], l1 = lp[16], l2 = lp[32];
    const u16* op = p.OG + row * 3072 + k;
    const u16* gp = p.QKVG + row * ATT_IN + 9216 + k;
    uint4 a[2], b[2], c[2], g[2];
#pragma unroll
    for (int h = 0; h < 2; ++h) {
      a[h] = *(const uint4*)(op + h * 8); b[h] = *(const uint4*)(op + 1024 + h * 8); c[h] = *(const uint4*)(op + 2048 + h * 8);
      g[h] = *(const uint4*)(gp + h * 8);
    }
    const float mx = fmaxf(l0, fmaxf(l1, l2));
    float e0 = __expf(l0 - mx), e1 = __expf(l1 - mx), e2 = __expf(l2 - mx);
    const float inv = 1.f / (e0 + e1 + e2);
    e0 *= inv; e1 *= inv; e2 *= inv;
#pragma unroll
    for (int h = 0; h < 2; ++h) {
      uint4 o;
      o.x = merge_word(a[h].x, b[h].x, c[h].x, g[h].x, e0, e1, e2);
      o.y = merge_word(a[h].y, b[h].y, c[h].y, g[h].y, e0, e1, e2);
      o.z = merge_word(a[h].z, b[h].z, c[h].z, g[h].z, e0, e1, e2);
      o.w = merge_word(a[h].w, b[h].w, c[h].w, g[h].w, e0, e1, e2);
      *(uint4*)(p.H + row * 1024 + k + h * 8) = o;
    }
  }
}
DI void phase_gatenorm(const Params& p) {
  const int lane = VTID & 63;
  for (int it = VBID; it < MROWS / 4; it += VGRID) {
    const size_t row = (size_t)it * 4 + (VTID >> 6);
    const int k = lane * 32;
    const float* sp = p.SSQ + row * 32 + (lane >> 4) * 8;
    const float4 s0 = *(const float4*)sp, s1 = *(const float4*)(sp + 4);
    const float ss = (s0.x + s0.y) + (s0.z + s0.w) + (s1.x + s1.y) + (s1.z + s1.w);
    const float rstd = rsqrtf(ss * (1.f / 512.f) + 1e-5f);
    u16* yp = p.YG + row * 2048 + k;
    uint4 y[4];
#pragma unroll
    for (int h = 0; h < 4; ++h) y[h] = *(const uint4*)(yp + h * 8);
#pragma unroll
    for (int h = 0; h < 4; ++h) {
      const float4 g0 = *(const float4*)(p.ssm_gate_norm + k + h * 8), g1 = *(const float4*)(p.ssm_gate_norm + k + h * 8 + 4);
      uint4 o;
      o.x = pack2(lo_f(y[h].x) * rstd * g0.x, hi_f(y[h].x) * rstd * g0.y);
      o.y = pack2(lo_f(y[h].y) * rstd * g0.z, hi_f(y[h].y) * rstd * g0.w);
      o.z = pack2(lo_f(y[h].z) * rstd * g1.x, hi_f(y[h].z) * rstd * g1.y);
      o.w = pack2(lo_f(y[h].w) * rstd * g1.z, hi_f(y[h].w) * rstd * g1.w);
      *(uint4*)(yp + h * 8) = o;
    }
  }
}

struct Ep1 {
  const Params& p;
  DI void operator()(f32x4 (&acc)[4][4], int r0, int c0, int lane) const {
    const int l15 = lane & 15, G = lane >> 4;
    int kind, g = 0, head;
    if (c0 >= 9216) { kind = 3; head = (c0 - 9216) >> 6; }
    else { g = c0 / 3072; const int rem = c0 - g * 3072; kind = rem >> 10; head = (rem & 1023) >> 6; }
    if (kind < 2) {
      const float* gp = (kind == 0 ? p.attn_q_gain : p.attn_k_gain) + g * 64;
      float gain[4];
#pragma unroll
      for (int n = 0; n < 4; ++n) gain[n] = gp[n * 16 + l15];
      const float post = (kind == 0) ? 0.125f : 1.f;
#pragma unroll
      for (int m = 0; m < 4; ++m)
#pragma unroll
        for (int j = 0; j < 4; ++j) {
          float ss = 0.f;
#pragma unroll
          for (int n = 0; n < 4; ++n) ss += acc[m][n][j] * acc[m][n][j];
          ss = sum16(ss);
          const float sc = rsqrtf(ss * (1.f / 64.f) + 1e-6f) * post;
#pragma unroll
          for (int n = 0; n < 4; ++n) acc[m][n][j] *= sc * gain[n];
        }
    }
    if (kind < 3 && r0 < PROWS) {
      const int dsh = 2 * g;
      const size_t hb = ((size_t)(((r0 >> 12) * 3 + g) * 3 + kind) * 16 + head) * 4096;
#pragma unroll
      for (int m = 0; m < 4; ++m)
#pragma unroll
        for (int j = 0; j < 4; ++j) {
          const int t = (r0 + m * 16 + G * 4 + j) & 4095;
          const int pos = (t & ((1 << dsh) - 1)) * (4096 >> dsh) + (t >> dsh);
          u16* dst = p.QKVH + (hb + pos) * 64 + l15;
#pragma unroll
          for (int n = 0; n < 4; ++n) dst[n * 16] = f2bf(acc[m][n][j]);
        }
    } else {
#pragma unroll
      for (int m = 0; m < 4; ++m)
#pragma unroll
        for (int j = 0; j < 4; ++j) {
          const int row = r0 + m * 16 + G * 4 + j;
          u16* dst = p.QKVG + (size_t)row * ATT_IN + c0 + l15;
#pragma unroll
          for (int n = 0; n < 4; ++n) dst[n * 16] = f2bf(acc[m][n][j]);
        }
    }
    if (kind == 1 || kind == 2) {
      const int keep = 128 << (2 * g);
      const size_t okp = (g == 0) ? O_KVP0 : (g == 1) ? O_KVP1 : O_KVP2;
      const size_t oks = (g == 0) ? O_KVS0 : (g == 1) ? O_KVS1 : O_KVS2;
#pragma unroll
      for (int m = 0; m < 4; ++m)
#pragma unroll
        for (int j = 0; j < 4; ++j) {
          const int row = r0 + m * 16 + G * 4 + j;
          float* dst = nullptr;
          if (row < PROWS) {
            const int b = row >> 12, s = row & 4095;
            if (s >= 4096 - keep) dst = p.out + okp + ((size_t)(b * keep + s - (4096 - keep)) * 2 + (kind - 1)) * 1024 + head * 64 + l15;
          } else {
            dst = p.out + oks + ((size_t)(row - PROWS) * 2 + (kind - 1)) * 1024 + head * 64 + l15;
          }
          if (dst) {
#pragma unroll
            for (int n = 0; n < 4; ++n) dst[n * 16] = acc[m][n][j];
          }
        }
    }
  }
};
struct Ep2 {
  const Params& p;
  DI void operator()(f32x4 (&acc)[4][4], int r0, int c0, int lane) const {
    const int l15 = lane & 15, G = lane >> 4;
#pragma unroll
    for (int m = 0; m < 4; ++m)
#pragma unroll
      for (int j = 0; j < 4; ++j) {
        const int row = r0 + m * 16 + G * 4 + j;
        const float* xin = (row < PROWS) ? p.x_prompt + (size_t)row * 1024 : p.x_sample + (size_t)(row - PROWS) * 1024;
        float* dst = p.X1 + (size_t)row * 1024 + c0 + l15;
#pragma unroll
        for (int n = 0; n < 4; ++n) dst[n * 16] = xin[c0 + l15 + n * 16] + acc[m][n][j];
      }
  }
};
struct Ep3 {
  const Params& p;
  DI void operator()(f32x4 (&acc)[4][4], int r0, int c0, int lane) const {
    const int l15 = lane & 15, G = lane >> 4;
    if (c0 >= SSM_IN) return;
    if (c0 < 2048) {
#pragma unroll
      for (int m = 0; m < 4; ++m)
#pragma unroll
        for (int j = 0; j < 4; ++j) {
          const int row = r0 + m * 16 + G * 4 + j;
          u16* dst = p.Z + (size_t)row * 2048 + c0 + l15;
#pragma unroll
          for (int n = 0; n < 4; ++n) dst[n * 16] = f2bf(acc[m][n][j]);
        }
    } else if (c0 < 5120) {
      const int cc = c0 - 2048 + l15;
#pragma unroll
      for (int m = 0; m < 4; ++m)
#pragma unroll
        for (int j = 0; j < 4; ++j) {
          const int row = r0 + m * 16 + G * 4 + j;
          u16* dst = p.XBC + (size_t)row * 3072 + cc;
#pragma unroll
          for (int n = 0; n < 4; ++n) dst[n * 16] = f2bf(acc[m][n][j]);
          float* od = nullptr;
          if (row < PROWS) {
            const int b = row >> 12, s = row & 4095;
            if (s >= 4093) od = p.out + O_CONVP + (size_t)(b * 3 + s - 4093) * 3072 + cc;
          } else {
            const int rr = row - PROWS, b = rr >> 3, t = rr & 7;
            if (t >= 5) od = p.out + O_CONVS + (size_t)(b * 3 + t - 5) * 3072 + cc;
          }
          if (od) {
#pragma unroll
            for (int n = 0; n < 4; ++n) od[n * 16] = acc[m][n][j];
          }
        }
    } else {
#pragma unroll
      for (int m = 0; m < 4; ++m)
#pragma unroll
        for (int j = 0; j < 4; ++j) {
          const int row = r0 + m * 16 + G * 4 + j;
#pragma unroll
          for (int n = 0; n < 2; ++n) {
            const int h = n * 16 + l15;
            const float xv = acc[m][n][j] + p.ssm_dt_bias[h];
            p.DT[(size_t)row * 32 + h] = fmaxf(xv, 0.f) + log1pf(__expf(-fabsf(xv)));
          }
        }
    }
  }
};
struct Ep4 {
  const Params& p;
  DI void operator()(f32x4 (&acc)[4][4], int r0, int c0, int lane) const {
    const int l15 = lane & 15, G = lane >> 4;
#pragma unroll
    for (int m = 0; m < 4; ++m)
#pragma unroll
      for (int j = 0; j < 4; ++j) {
        const int row = r0 + m * 16 + G * 4 + j;
        const float* xin = p.X1 + (size_t)row * 1024 + c0 + l15;
        float* dst = p.out + O_Y + (size_t)row * 1024 + c0 + l15;
#pragma unroll
        for (int n = 0; n < 4; ++n) dst[n * 16] = xin[n * 16] + acc[m][n][j];
      }
  }
};

DI void transpose_task(const float* __restrict__ W, u16* __restrict__ Wt, int K, int N, int NTN, int tile, u16* smem) {
  const int tid = VTID;
  const int ktile = tile / NTN, ntile = tile % NTN;
  const int k0 = ktile * 64, n0 = ntile * 64;
#pragma unroll
  for (int i = 0; i < 4; ++i) {
    const int idx = tid + 256 * i;
    const int kk = idx >> 4, nq = idx & 15;
    const int n = n0 + nq * 4;
    float4 v = {0.f, 0.f, 0.f, 0.f};
    if (n < N) v = *(const float4*)(W + (size_t)(k0 + kk) * N + n);
    smem[(nq * 4 + 0) * LDT + kk] = f2bf(v.x);
    smem[(nq * 4 + 1) * LDT + kk] = f2bf(v.y);
    smem[(nq * 4 + 2) * LDT + kk] = f2bf(v.z);
    smem[(nq * 4 + 3) * LDT + kk] = f2bf(v.w);
  }
  __syncthreads();
#pragma unroll
  for (int i = 0; i < 2; ++i) {
    const int idx = tid + 256 * i;
    const int n = idx >> 3, kc = idx & 7;
    *(uint4*)(Wt + (size_t)(n0 + n) * K + k0 + kc * 8) = *(const uint4*)(smem + n * LDT + kc * 8);
  }
  __syncthreads();
}

DI void rmsnorm_row(const float* __restrict__ src, const float* __restrict__ wgt, u16* __restrict__ dst, int lane) {
  float4 v[4];
  float ss = 0.f;
#pragma unroll
  for (int i = 0; i < 4; ++i) {
    v[i] = *(const float4*)(src + lane * 4 + 256 * i);
    ss += v[i].x * v[i].x + v[i].y * v[i].y + v[i].z * v[i].z + v[i].w * v[i].w;
  }
  ss = sum16(ss);
  ss += __shfl_xor(ss, 16);
  ss += __shfl_xor(ss, 32);
  const float rstd = rsqrtf(ss * (1.f / 1024.f) + 1e-6f);
#pragma unroll
  for (int i = 0; i < 4; ++i) {
    const float4 g = *(const float4*)(wgt + lane * 4 + 256 * i);
    uint2 o;
    o.x = pack2(v[i].x * rstd * g.x, v[i].y * rstd * g.y);
    o.y = pack2(v[i].z * rstd * g.z, v[i].w * rstd * g.w);
    *(uint2*)(dst + lane * 4 + 256 * i) = o;
  }
}

constexpr int TR1 = 16 * 160, TR2 = 16 * 16, TR3 = 16 * 84, TR4 = 32 * 16;
DI void phase_prep(const Params& p, u16* smem) {
  constexpr int RT = MROWS / 4;
  for (int it = VBID; it < TR1 + RT; it += VGRID) {
    if (it < TR1) transpose_task(p.attn_w_in, p.Wt1, 1024, ATT_IN, 160, it, smem);
    else {
      const int row = (it - TR1) * 4 + (VTID >> 6);
      const float* src = (row < PROWS) ? p.x_prompt + (size_t)row * 1024 : p.x_sample + (size_t)(row - PROWS) * 1024;
      rmsnorm_row(src, p.attn_norm, p.H + (size_t)row * 1024, VTID & 63);
    }
  }
}
DI void late_transpose_task(const Params& p, int it, u16* smem) {
  if (it < TR2) transpose_task(p.attn_w_out, p.Wt2, 1024, 1024, 16, it, smem);
  else if (it < TR2 + TR3) transpose_task(p.ssm_w_in, p.Wt3, 1024, SSM_IN, 84, it - TR2, smem);
  else transpose_task(p.ssm_w_out, p.Wt4, 2048, 1024, 16, it - TR2 - TR3, smem);
}

DI void phase_norm2(const Params& p) {
  for (int it = VBID; it < MROWS / 4; it += VGRID) {
    const int row = it * 4 + (VTID >> 6);
    rmsnorm_row(p.X1 + (size_t)row * 1024, p.ssm_norm, p.H + (size_t)row * 1024, VTID & 63);
  }
}

struct PromptRegs { uint4 k[8], v[8]; bf16x8 q[2][2]; };
DI void attn_prompt_load(const Params& p, int item, PromptRegs& R) {
  const int tid = VTID, lane = tid & 63, w = tid >> 6, l15 = lane & 15, G = lane >> 4;
  const int rn = item & 31, head = (item >> 5) & 15, b = (item >> 9) & 3, g = item >> 11;
  const int dsh = 2 * g, dil = 1 << dsh, nbg = 32 >> dsh;
  const int r = rn / nbg, n = rn % nbg;
  const size_t hq = ((size_t)((b * 3 + g) * 3 + 0) * 16 + head) * 4096 + (size_t)r * (4096 >> dsh);
  const size_t hk = hq + (size_t)16 * 4096, hv = hq + (size_t)32 * 4096;
  (void)dil;
#pragma unroll
  for (int i = 0; i < 8; ++i) {
    const int c = tid + 256 * i;
    const int kj = c >> 3, ch = c & 7;
    const int u = (n - 1) * 128 + kj;
    R.k[i] = (uint4){0u, 0u, 0u, 0u}; R.v[i] = (uint4){0u, 0u, 0u, 0u};
    if (u >= 0) {
      R.k[i] = *(const uint4*)(p.QKVH + (hk + u) * 64 + ch * 8);
      R.v[i] = *(const uint4*)(p.QKVH + (hv + u) * 64 + ch * 8);
    }
  }
#pragma unroll
  for (int sub = 0; sub < 2; ++sub) {
    const u16* qp = p.QKVH + (hq + n * 128 + w * 32 + sub * 16 + l15) * 64 + G * 8;
    R.q[sub][0] = *(const bf16x8*)qp;
    R.q[sub][1] = *(const bf16x8*)(qp + 32);
  }
}
DI void attn_prompt_stage(const PromptRegs& R, u16* smem) {
  const int tid = VTID;
  u16* Ks = smem;
  u16* Vs = smem + 256 * LDT;
#pragma unroll
  for (int i = 0; i < 8; ++i) {
    const int c = tid + 256 * i;
    const int kj = c >> 3, ch = c & 7;
    *(uint4*)(Ks + kj * LDT + ch * 8) = R.k[i];
    *(uint4*)(Vs + kj * LDT + ch * 8) = R.v[i];
  }
}
DI void attn_prompt_compute(const Params& p, int item, const bf16x8 (&qpre)[2][2], u16* smem) {
  const int tid = VTID, lane = tid & 63, w = tid >> 6, l15 = lane & 15, G = lane >> 4;
  const int rn = item & 31, head = (item >> 5) & 15, b = (item >> 9) & 3, g = item >> 11;
  const int dsh = 2 * g, dil = 1 << dsh, nbg = 32 >> dsh;
  const int r = rn / nbg, n = rn % nbg;
  u16* Ks = smem;
  u16* Vs = smem + 256 * LDT;
#pragma unroll 1
  for (int sub = 0; sub < 2; ++sub) {
    const int q0 = w * 32 + sub * 16;
    const int qi = q0 + l15;
    const size_t rowq = (size_t)b * 4096 + (size_t)(n * 128 + qi) * dil + r;
    const bf16x8 qf0 = sub ? qpre[1][0] : qpre[0][0], qf1 = sub ? qpre[1][1] : qpre[0][1];
    f32x4 st[9];
#pragma unroll
    for (int s = 0; s < 9; ++s) {
      const u16* kp = Ks + (q0 + 16 * s + l15) * LDT + G * 8;
      const bf16x8 a0 = *(const bf16x8*)kp, a1 = *(const bf16x8*)(kp + 32);
      f32x4 z = {0.f, 0.f, 0.f, 0.f};
      z = MFMA16(a0, qf0, z);
      st[s] = MFMA16(a1, qf1, z);
    }
    float mx = -INFINITY;
#pragma unroll
    for (int s = 0; s < 9; ++s)
#pragma unroll
      for (int j = 0; j < 4; ++j) {
        const int kk = 16 * s + 4 * G + j;
        const bool valid = (kk >= l15) && (kk <= l15 + 128) && (n > 0 || q0 + kk >= 128);
        const float v = valid ? st[s][j] : -INFINITY;
        st[s][j] = v;
        mx = fmaxf(mx, v);
      }
    mx = fmaxf(mx, __shfl_xor(mx, 16));
    mx = fmaxf(mx, __shfl_xor(mx, 32));
    float sum = 0.f;
#pragma unroll
    for (int s = 0; s < 9; ++s)
#pragma unroll
      for (int j = 0; j < 4; ++j) {
        const float e = __expf(st[s][j] - mx);
        st[s][j] = e;
        sum += e;
      }
    sum += __shfl_xor(sum, 16);
    sum += __shfl_xor(sum, 32);
    const float inv = 1.f / sum;
    f32x4 o[4];
#pragma unroll
    for (int m = 0; m < 4; ++m) o[m] = (f32x4){0.f, 0.f, 0.f, 0.f};
#pragma unroll
    for (int t = 0; t < 5; ++t) {
      const int sA = 2 * t, sB = 2 * t + 1;
      bf16x8 pb;
      if (t < 4) pb = words_to_frag(pack2(st[sA][0], st[sA][1]), pack2(st[sA][2], st[sA][3]), pack2(st[sB < 9 ? sB : 8][0], st[sB < 9 ? sB : 8][1]), pack2(st[sB < 9 ? sB : 8][2], st[sB < 9 ? sB : 8][3]));
      else pb = words_to_frag(pack2(st[sA][0], st[sA][1]), pack2(st[sA][2], st[sA][3]), 0u, 0u);
      const u16* vA = Vs + (q0 + 16 * sA + 4 * G + (l15 >> 2)) * LDT + (l15 & 3) * 4;
      const u16* vB = Vs + (q0 + 16 * sB + 4 * G + (l15 >> 2)) * LDT + (l15 & 3) * 4;
#pragma unroll
      for (int m = 0; m < 4; ++m) {
        const s16x4 lo = tr_read(vA + 16 * m);
        s16x4 hi = {0, 0, 0, 0};
        if (t < 4) hi = tr_read(vB + 16 * m);
        o[m] = MFMA16(cat4(lo, hi), pb, o[m]);
      }
    }
    u16* op = p.OG + rowq * 3072 + g * 1024 + head * 64 + 4 * G;
#pragma unroll
    for (int m = 0; m < 4; ++m) {
      uint2 ov;
      ov.x = pack2(o[m][0] * inv, o[m][1] * inv);
      ov.y = pack2(o[m][2] * inv, o[m][3] * inv);
      *(uint2*)(op + 16 * m) = ov;
    }
    if (G == 0) p.LSE[rowq * 48 + g * 16 + head] = mx + __logf(sum);
  }
}

DI void attn_sample_task(const Params& p, int id) {
  const int lane = VTID & 63, l15 = lane & 15, G = lane >> 4;
  const int t = id & 7, head = (id >> 3) & 15, b = (id >> 7) & 31, g = id >> 12;
  const int L = 128 << (2 * g), dil = 1 << (2 * g);
  const float* cache = (g == 0) ? p.cache0 : (g == 1) ? p.cache1 : p.cache2;
  const float* newkv = p.out + ((g == 0) ? O_KVS0 : (g == 1) ? O_KVS1 : O_KVS2);
  const size_t rowq = (size_t)PROWS + b * 8 + t;
  const uint2 qq = *(const uint2*)(p.QKVG + rowq * ATT_IN + g * 3072 + head * 64 + 4 * l15);
  const float q0 = lo_f(qq.x), q1 = hi_f(qq.x), q2 = lo_f(qq.y), q3 = hi_f(qq.y);
  const int coff = head * 64 + 4 * l15;
  float mx = -INFINITY, sum = 0.f, a0 = 0.f, a1 = 0.f, a2 = 0.f, a3 = 0.f;
#pragma unroll 1
  for (int bt = 0; bt < 2; ++bt) {
    float4 kb[17], vb[17];
#pragma unroll
    for (int u = 0; u < 17; ++u) {
      const int j = 4 * (bt * 17 + u) + G;
      const int jc = j < 128 ? j : 128;
      const int idx = L + t - dil * jc;
      const float* kp = ((idx < L) ? cache + (size_t)(b * L + idx) * 2048 : newkv + (size_t)(b * 8 + idx - L) * 2048) + coff + 512;
      kb[u] = *(const float4*)(kp - 512);
      vb[u] = *(const float4*)(kp + 512);
    }
    float scb[17];
    float bm = -INFINITY;
#pragma unroll
    for (int u = 0; u < 17; ++u) {
      const int j = 4 * (bt * 17 + u) + G;
      float sv = q0 * kb[u].x + q1 * kb[u].y + q2 * kb[u].z + q3 * kb[u].w;
      sv = sum16(sv);
      sv = (j <= 128) ? sv : -INFINITY;
      scb[u] = sv;
      bm = fmaxf(bm, sv);
    }
    const float mn = fmaxf(mx, bm);
    const float corr = __expf(mx - mn);
    sum *= corr; a0 *= corr; a1 *= corr; a2 *= corr; a3 *= corr;
#pragma unroll
    for (int u = 0; u < 17; ++u) {
      const float pe = __expf(scb[u] - mn);
      sum += pe;
      a0 += pe * vb[u].x; a1 += pe * vb[u].y; a2 += pe * vb[u].z; a3 += pe * vb[u].w;
    }
    mx = mn;
  }
  {
    float M = fmaxf(mx, __shfl_xor(mx, 16));
    M = fmaxf(M, __shfl_xor(M, 32));
    const float f = __expf(mx - M);
    sum *= f; a0 *= f; a1 *= f; a2 *= f; a3 *= f;
    mx = M;
  }
  sum += __shfl_xor(sum, 16); sum += __shfl_xor(sum, 32);
  a0 += __shfl_xor(a0, 16); a0 += __shfl_xor(a0, 32);
  a1 += __shfl_xor(a1, 16); a1 += __shfl_xor(a1, 32);
  a2 += __shfl_xor(a2, 16); a2 += __shfl_xor(a2, 32);
  a3 += __shfl_xor(a3, 16); a3 += __shfl_xor(a3, 32);
  const float inv = 1.f / sum;
  if (G == 0) {
    uint2 ov;
    ov.x = pack2(a0 * inv, a1 * inv);
    ov.y = pack2(a2 * inv, a3 * inv);
    *(uint2*)(p.OG + rowq * 3072 + g * 1024 + coff) = ov;
    if (l15 == 0) p.LSE[rowq * 48 + g * 16 + head] = mx + __logf(sum);
  }
}

DI int attn_item_of(int round) {
  if (gridDim.x != 256) return VBID + round * VGRID;
  const int x = blockIdx.x & 7, jj = (blockIdx.x >> 3) * 2 + (opaque_tid() >> 8);
  return ((round * 64 + (jj >> 3) * 8 + x) << 3) + (jj & 7);
}
DI void attn_prompt_stream(const Params& p, u16* smem) {
  constexpr int NP = 6144;
  int round = 0;
  int item = attn_item_of(0);
  PromptRegs R;
  if (item < NP) attn_prompt_load(p, item, R);
  while (item < NP) {
    attn_prompt_stage(R, smem);
    bf16x8 qc[2][2];
    qc[0][0] = R.q[0][0]; qc[0][1] = R.q[0][1]; qc[1][0] = R.q[1][0]; qc[1][1] = R.q[1][1];
    __syncthreads();
    const int next = attn_item_of(++round);
    if (next < NP) attn_prompt_load(p, next, R);
    attn_prompt_compute(p, item, qc, smem);
    __syncthreads();
    item = next;
  }
}
DI void phase_attn(const Params& p, u16* smem) {
  constexpr int NS = 3072;
  const bool sample_first = false;
  if (!sample_first) attn_prompt_stream(p, smem);
  for (int it = VBID; it < NS; it += VGRID) attn_sample_task(p, it * 4 + (VTID >> 6));
  if (sample_first) attn_prompt_stream(p, smem);
}

DI void conv_pass_task(const Params& p, int bt) {
  const int id = bt * 256 + VTID;
  const int ch = id % 384, seg = id / 384;
  const int col = ch * 8, row0 = seg * 8, t0 = row0 & 4095;
  const u16* src = p.XBC + (size_t)row0 * 3072 + col;
  uint4 raw[11];
#pragma unroll
  for (int j = 0; j < 3; ++j) {
    raw[j] = (uint4){0u, 0u, 0u, 0u};
    if (t0 > 0) raw[j] = *(const uint4*)(src - (ptrdiff_t)(3 - j) * 3072);
  }
#pragma unroll
  for (int j = 0; j < 8; ++j) raw[3 + j] = *(const uint4*)(src + (size_t)j * 3072);
  float wgt[4][8], bias[8];
#pragma unroll
  for (int j = 0; j < 4; ++j) {
    const float4 w0 = *(const float4*)(p.ssm_conv_w + j * 3072 + col), w1 = *(const float4*)(p.ssm_conv_w + j * 3072 + col + 4);
    wgt[j][0] = w0.x; wgt[j][1] = w0.y; wgt[j][2] = w0.z; wgt[j][3] = w0.w;
    wgt[j][4] = w1.x; wgt[j][5] = w1.y; wgt[j][6] = w1.z; wgt[j][7] = w1.w;
  }
  {
    const float4 b0 = *(const float4*)(p.ssm_conv_b + col), b1 = *(const float4*)(p.ssm_conv_b + col + 4);
    bias[0] = b0.x; bias[1] = b0.y; bias[2] = b0.z; bias[3] = b0.w;
    bias[4] = b1.x; bias[5] = b1.y; bias[6] = b1.z; bias[7] = b1.w;
  }
  float win[3][8];
  unpack8(raw[0], win[0]); unpack8(raw[1], win[1]); unpack8(raw[2], win[2]);
  u16* dst = p.XBCC + (size_t)row0 * 3072 + col;
#pragma unroll
  for (int i = 0; i < 8; ++i) {
    float cur[8], r[8];
    unpack8(raw[3 + i], cur);
#pragma unroll
    for (int e = 0; e < 8; ++e) {
      const float v = bias[e] + wgt[0][e] * win[0][e] + wgt[1][e] * win[1][e] + wgt[2][e] * win[2][e] + wgt[3][e] * cur[e];
      r[e] = silu_f(v);
      win[0][e] = win[1][e]; win[1][e] = win[2][e]; win[2][e] = cur[e];
    }
    *(uint4*)(dst + (size_t)i * 3072) = pack8(r);
  }
}

DI void acs_task(const Params& p, int bc) {
  const int lane = VTID & 63, head = lane & 31, half = lane >> 5;
  const float Aneg = -__expf(p.ssm_A_log[head]);
  const size_t rb = (size_t)bc * 128 + half * 64;
  float run = 0.f;
#pragma unroll 8
  for (int i = 0; i < 64; ++i) run += p.DT[(rb + i) * 32 + head] * Aneg;
  const float tot0 = __shfl(run, head);
  run = half ? tot0 : 0.f;
#pragma unroll 8
  for (int i = 0; i < 64; ++i) {
    run += p.DT[(rb + i) * 32 + head] * Aneg;
    p.ACS[(rb + i) * 32 + head] = run;
  }
}

DI void phase_convpass(const Params& p) {
  constexpr int NC = PROWS / 8 * 384 / 256;
  for (int it = VBID; it < NC + 32; it += VGRID) {
    if (it < NC) conv_pass_task(p, it);
    else acs_task(p, (it - NC) * 4 + (VTID >> 6));
  }
}

constexpr int SS_B = 0;
constexpr int SS_R2 = 34816;
constexpr int SS_H = 34816 + 18432;
constexpr int SS_F = 70656;

DI void ssd_states_item(const Params& p, int item, char* smem_raw) {
  const int tid = VTID, lane = tid & 63, w = tid >> 6, l15 = lane & 15, G = lane >> 4;
  const int head = item & 31, c = (item >> 5) & 31, b = item >> 10, g = head >> 3;
  u16* Bs = (u16*)(smem_raw + SS_B);
  u16* Xs = (u16*)(smem_raw + SS_R2);
  const size_t row0 = (size_t)b * 4096 + c * 128;
  const float a_end = p.ACS[(row0 + 127) * 32 + head];
#pragma unroll
  for (int i = 0; i < 4; ++i) {
    const int row = (tid >> 3) + 32 * i, ch = tid & 7;
    const float wl = p.DT[(row0 + row) * 32 + head] * __expf(a_end - p.ACS[(row0 + row) * 32 + head]);
    const uint4 v = *(const uint4*)(p.XBCC + (row0 + row) * 3072 + head * 64 + ch * 8);
    uint4 o;
    o.x = pack2(lo_f(v.x) * wl, hi_f(v.x) * wl); o.y = pack2(lo_f(v.y) * wl, hi_f(v.y) * wl);
    o.z = pack2(lo_f(v.z) * wl, hi_f(v.z) * wl); o.w = pack2(lo_f(v.w) * wl, hi_f(v.w) * wl);
    *(uint4*)(Xs + row * LDT + ch * 8) = o;
  }
#pragma unroll
  for (int i = 0; i < 8; ++i) {
    const int idx = tid + 256 * i, row = idx >> 4, ch = idx & 15;
    *(uint4*)(Bs + row * LDW + ch * 8) = *(const uint4*)(p.XBCC + (row0 + row) * 3072 + 2048 + g * 128 + ch * 8);
  }
  __syncthreads();
  f32x4 acc[4][2];
#pragma unroll
  for (int m = 0; m < 4; ++m) { acc[m][0] = (f32x4){0.f, 0.f, 0.f, 0.f}; acc[m][1] = (f32x4){0.f, 0.f, 0.f, 0.f}; }
#pragma unroll
  for (int k = 0; k < 4; ++k) {
    const int rowA = 32 * k + 8 * G + (l15 >> 2);
    bf16x8 a[4], bb[2];
#pragma unroll
    for (int m = 0; m < 4; ++m) {
      const u16* ap = Xs + rowA * LDT + 16 * m + (l15 & 3) * 4;
      a[m] = cat4(tr_read(ap), tr_read(ap + 4 * LDT));
    }
#pragma unroll
    for (int nn = 0; nn < 2; ++nn) {
      const u16* bp = Bs + rowA * LDW + 32 * w + 16 * nn + (l15 & 3) * 4;
      bb[nn] = cat4(tr_read(bp), tr_read(bp + 4 * LDW));
    }
#pragma unroll
    for (int m = 0; m < 4; ++m)
#pragma unroll
      for (int nn = 0; nn < 2; ++nn) acc[m][nn] = MFMA16(a[m], bb[nn], acc[m][nn]);
  }
  u16* sp = p.STATES + (size_t)item * 64 * 128;
#pragma unroll
  for (int m = 0; m < 4; ++m)
#pragma unroll
    for (int nn = 0; nn < 2; ++nn)
#pragma unroll
      for (int j = 0; j < 4; ++j) sp[(16 * m + 4 * G + j) * 128 + 32 * w + 16 * nn + l15] = f2bf(acc[m][nn][j]);
  if (tid == 0) p.CD[item] = __expf(a_end);
  __syncthreads();
}

DI void ssm_sample_item(const Params& p, int item, char* smem_raw) {
  const int tid = VTID;
  const int head = item & 31, b = item >> 5, g = head >> 3;
  float* sx = (float*)smem_raw;
  float* sB = sx + 512;
  float* sC = sB + 1024;
  float* sdt = sC + 1024;
  float* sdA = sdt + 8;
  float* sy2 = sdA + 8;
  const size_t row0 = (size_t)PROWS + b * 8;
  const float Aneg = -__expf(p.ssm_A_log[head]);
  for (int task = tid; task < 320; task += 256) {
    int col; float* dst;
    if (task < 64) { col = head * 64 + task; dst = sx + task; }
    else if (task < 192) { col = 2048 + g * 128 + (task - 64); dst = sB + (task - 64); }
    else { col = 2560 + g * 128 + (task - 192); dst = sC + (task - 192); }
    const int dstride = (task < 64) ? 64 : 128;
    const float w0 = p.ssm_conv_w[col], w1 = p.ssm_conv_w[3072 + col], w2 = p.ssm_conv_w[2 * 3072 + col], w3 = p.ssm_conv_w[3 * 3072 + col];
    const float bias = p.ssm_conv_b[col];
    float x0 = p.state_conv[(size_t)(b * 3 + 0) * 3072 + col];
    float x1 = p.state_conv[(size_t)(b * 3 + 1) * 3072 + col];
    float x2 = p.state_conv[(size_t)(b * 3 + 2) * 3072 + col];
#pragma unroll
    for (int t = 0; t < 8; ++t) {
      const float cur = bf2f(p.XBC[(row0 + t) * 3072 + col]);
      const float v = bias + w0 * x0 + w1 * x1 + w2 * x2 + w3 * cur;
      dst[t * dstride] = silu_f(v);
      x0 = x1; x1 = x2; x2 = cur;
    }
  }
  if (tid < 8) {
    const float dt = p.DT[(row0 + tid) * 32 + head];
    sdt[tid] = dt;
    sdA[tid] = __expf(dt * Aneg);
  }
  __syncthreads();
  const int pp = tid >> 2, nq = tid & 3;
  const size_t sbase = ((size_t)(b * 32 + head) * 64 + pp) * 128 + nq * 4;
  float4 h[8];
#pragma unroll
  for (int i = 0; i < 8; ++i) h[i] = *(const float4*)(p.state_ssm + sbase + i * 16);
  const float Dh = p.ssm_D[head];
#pragma unroll 1
  for (int t = 0; t < 8; ++t) {
    const float dA = sdA[t];
    const float xv = sx[t * 64 + pp];
    const float dtx = sdt[t] * xv;
    float y = 0.f;
#pragma unroll
    for (int i = 0; i < 8; ++i) {
      const float4 Bv = *(const float4*)(sB + t * 128 + i * 16 + nq * 4);
      const float4 Cv = *(const float4*)(sC + t * 128 + i * 16 + nq * 4);
      h[i].x = h[i].x * dA + dtx * Bv.x; h[i].y = h[i].y * dA + dtx * Bv.y;
      h[i].z = h[i].z * dA + dtx * Bv.z; h[i].w = h[i].w * dA + dtx * Bv.w;
      y += h[i].x * Cv.x + h[i].y * Cv.y + h[i].z * Cv.z + h[i].w * Cv.w;
    }
    y = sum4(y);
    if (nq == 0) {
      const float z = bf2f(p.Z[(row0 + t) * 2048 + head * 64 + pp]);
      const float yg = (y + Dh * xv) * silu_f(z);
      p.YG[(row0 + t) * 2048 + head * 64 + pp] = f2bf(yg);
      sy2[t * 64 + pp] = yg * yg;
    }
  }
  float* od = p.out + O_SSMS + sbase;
#pragma unroll
  for (int i = 0; i < 8; ++i) *(float4*)(od + i * 16) = h[i];
  __syncthreads();
  if (tid < 8) {
    float s = 0.f;
    for (int i = 0; i < 64; ++i) s += sy2[tid * 64 + i];
    p.SSQ[(row0 + tid) * 32 + head] = s;
  }
  __syncthreads();
}

DI int ssd_item_of(int round) {
  const int x = blockIdx.x & 7, jj = (blockIdx.x >> 3) * 2 + (opaque_tid() >> 8);
  return ((round * 64 + (jj >> 3) * 8 + x) << 3) + (jj & 7);
}
DI void phase_states(const Params& p, char* smem_raw) {
  constexpr int NP = 4096, NS = 1024;
  for (int it = VBID; it < NS; it += VGRID) ssm_sample_item(p, it, smem_raw);
  if (gridDim.x == 256) { for (int r = 0; r < 8; ++r) ssd_states_item(p, ssd_item_of(r), smem_raw); }
  else for (int it = VBID; it < NP; it += VGRID) ssd_states_item(p, it, smem_raw);
}

DI void phase_scan(const Params& p) {
  for (int task = VBID * 256 + VTID; task < 131072; task += VGRID * 256) {
    const int n8 = task & 15, pp = (task >> 4) & 63, head = (task >> 10) & 31, b = task >> 15;
    float h[8];
#pragma unroll
    for (int e = 0; e < 8; ++e) h[e] = 0.f;
#pragma unroll 8
    for (int c = 0; c < 32; ++c) {
      const int item = (b * 32 + c) * 32 + head;
      uint4* sp = (uint4*)(p.STATES + ((size_t)item * 64 + pp) * 128 + n8 * 8);
      const uint4 sv = *sp;
      const float d = p.CD[item];
      *sp = pack8(h);
      float sf[8];
      unpack8(sv, sf);
#pragma unroll
      for (int e = 0; e < 8; ++e) h[e] = h[e] * d + sf[e];
    }
    float* od = p.out + O_SSMP + ((size_t)(b * 32 + head) * 64 + pp) * 128 + n8 * 8;
    *(float4*)od = (float4){h[0], h[1], h[2], h[3]};
    *(float4*)(od + 4) = (float4){h[4], h[5], h[6], h[7]};
  }
}

DI void ssd_out_item(const Params& p, int item, char* smem_raw) {
  const int tid = VTID, lane = tid & 63, w = tid >> 6, l15 = lane & 15, G = lane >> 4;
  const int head = item & 31, c = (item >> 5) & 31, b = item >> 10, g = head >> 3;
  u16* Bs = (u16*)(smem_raw + SS_B);
  u16* Xs = (u16*)(smem_raw + SS_R2);
  u16* Hs = (u16*)(smem_raw + SS_H);
  float* s_acs = (float*)(smem_raw + SS_F);
  float* s_dt = s_acs + 128;
  const size_t row0 = (size_t)b * 4096 + c * 128;
  if (tid < 128) {
    s_acs[tid] = p.ACS[(row0 + tid) * 32 + head];
    s_dt[tid] = p.DT[(row0 + tid) * 32 + head];
  }
#pragma unroll
  for (int i = 0; i < 8; ++i) {
    const int idx = tid + 256 * i, row = idx >> 4, ch = idx & 15;
    *(uint4*)(Bs + row * LDW + ch * 8) = *(const uint4*)(p.XBCC + (row0 + row) * 3072 + 2048 + g * 128 + ch * 8);
  }
#pragma unroll
  for (int i = 0; i < 4; ++i) {
    const int row = (tid >> 3) + 32 * i, ch = tid & 7;
    *(uint4*)(Xs + row * LDT + ch * 8) = *(const uint4*)(p.XBCC + (row0 + row) * 3072 + head * 64 + ch * 8);
  }
  {
    const u16* hp = p.STATES + (size_t)item * 64 * 128;
#pragma unroll
    for (int i = 0; i < 4; ++i) {
      const int idx = tid + 256 * i, pp = idx >> 4, ch = idx & 15;
      *(uint4*)(Hs + pp * LDW + ch * 8) = *(const uint4*)(hp + pp * 128 + ch * 8);
    }
  }
  bf16x8 cf[2][4];
#pragma unroll
  for (int sub = 0; sub < 2; ++sub)
#pragma unroll
    for (int ks = 0; ks < 4; ++ks)
      cf[sub][ks] = *(const bf16x8*)(p.XBCC + (row0 + w * 32 + sub * 16 + l15) * 3072 + 2560 + g * 128 + ks * 32 + G * 8);
  uint2 zpre[2][4];
#pragma unroll
  for (int sub = 0; sub < 2; ++sub)
#pragma unroll
    for (int m = 0; m < 4; ++m)
      zpre[sub][m] = *(const uint2*)(p.Z + (row0 + w * 32 + sub * 16 + l15) * 2048 + head * 64 + 16 * m + 4 * G);
  __syncthreads();
  const float Dh = p.ssm_D[head];
#pragma unroll
  for (int sub = 0; sub < 2; ++sub) {
    const int l0 = w * 32 + sub * 16, lq = l0 + l15;
    const float acs_q = s_acs[lq];
    f32x4 yo[4];
#pragma unroll
    for (int m = 0; m < 4; ++m) {
      f32x4 z = {0.f, 0.f, 0.f, 0.f};
#pragma unroll
      for (int ks = 0; ks < 4; ++ks) z = MFMA16(*(const bf16x8*)(Hs + (16 * m + l15) * LDW + ks * 32 + G * 8), cf[sub][ks], z);
      yo[m] = z;
    }
    {
      const float ea = __expf(acs_q);
#pragma unroll
      for (int m = 0; m < 4; ++m) { yo[m][0] *= ea; yo[m][1] *= ea; yo[m][2] *= ea; yo[m][3] *= ea; }
    }
    const int ns = (l0 >> 4) + 1, nsteps = (ns + 1) >> 1;
#pragma unroll 1
    for (int step = 0; step < nsteps; ++step) {
      unsigned pw[4];
#pragma unroll
      for (int h2 = 0; h2 < 2; ++h2) {
        const int ss = 2 * step + h2;
        f32x4 st = {0.f, 0.f, 0.f, 0.f};
#pragma unroll
        for (int ks = 0; ks < 4; ++ks) st = MFMA16(*(const bf16x8*)(Bs + (16 * ss + l15) * LDW + ks * 32 + G * 8), cf[sub][ks], st);
        float mv[4];
#pragma unroll
        for (int j = 0; j < 4; ++j) {
          const int s = 16 * ss + 4 * G + j;
          const float dec = __expf(fminf(acs_q - s_acs[s], 0.f)) * s_dt[s];
          mv[j] = (s <= lq) ? st[j] * dec : 0.f;
        }
        pw[2 * h2] = pack2(mv[0], mv[1]);
        pw[2 * h2 + 1] = pack2(mv[2], mv[3]);
      }
      const bf16x8 pb = words_to_frag(pw[0], pw[1], pw[2], pw[3]);
      const u16* xa = Xs + (32 * step + 4 * G + (l15 >> 2)) * LDT + (l15 & 3) * 4;
#pragma unroll
      for (int m = 0; m < 4; ++m) yo[m] = MFMA16(cat4(tr_read(xa + 16 * m), tr_read(xa + 16 * LDT + 16 * m)), pb, yo[m]);
    }
    const size_t rowg = (size_t)b * 4096 + c * 128 + lq;
    float ssq = 0.f;
#pragma unroll
    for (int m = 0; m < 4; ++m) {
      const uint2 xv = *(const uint2*)(Xs + lq * LDT + 16 * m + 4 * G);
      const uint2 zv = zpre[sub][m];
      const float xf[4] = {lo_f(xv.x), hi_f(xv.x), lo_f(xv.y), hi_f(xv.y)};
      const float zf[4] = {lo_f(zv.x), hi_f(zv.x), lo_f(zv.y), hi_f(zv.y)};
      float y[4];
#pragma unroll
      for (int j = 0; j < 4; ++j) {
        y[j] = (yo[m][j] + Dh * xf[j]) * silu_f(zf[j]);
        ssq += y[j] * y[j];
      }
      uint2 ov; ov.x = pack2(y[0], y[1]); ov.y = pack2(y[2], y[3]);
      *(uint2*)(p.YG + rowg * 2048 + head * 64 + 16 * m + 4 * G) = ov;
    }
    ssq += __shfl_xor(ssq, 16);
    ssq += __shfl_xor(ssq, 32);
    if (G == 0) p.SSQ[rowg * 32 + head] = ssq;
  }
  __syncthreads();
}

DI void idle_transposes(const Params& p, int idle_idx, int n_idle, int first, int count, u16* smem) {
  const int vb = idle_idx * 2 + (opaque_tid() >> 8), vg = n_idle * 2;
  for (int it = vb; it < count; it += vg) late_transpose_task(p, first + it, smem);
}

#define XB_TMO      128
#define XB_XCNT(j)  (256  + 64 * (j))
#define XB_XSUB(j)  (1280 + 64 * (j))
#define XB_XGEN(j)  (2304 + 64 * (j))
#define XB_TOP      3328
#define XB_TOPGEN   3392
#define XCD_BAR_WORDS 3456
#define XB_SPIN_CAP (1u << 20)
#define LAS __attribute__((address_space(3)))
DI unsigned xb_ld(unsigned* p) { return __hip_atomic_load(p, __ATOMIC_RELAXED, __HIP_MEMORY_SCOPE_AGENT); }
DI unsigned xb_add(unsigned* p, unsigned v) { return __hip_atomic_fetch_add(p, v, __ATOMIC_RELAXED, __HIP_MEMORY_SCOPE_AGENT); }
DI unsigned xb_xcc_id() { return (unsigned)__builtin_amdgcn_s_getreg((3 << 11) | 20) & 0xFu; }
#define XB_SPIN(cond, bar) do { unsigned _sp = 0; while (cond) { __builtin_amdgcn_s_sleep(1); \
    if ((++_sp & 255u) == 0u) { if (xb_ld(&(bar)[XB_TMO])) break; if (_sp > XB_SPIN_CAP) { atomicAdd(&(bar)[XB_TMO], 1u); break; } } } } while (0)
struct XcdBarrier { unsigned* bar; unsigned x; volatile LAS unsigned* st; };
DI XcdBarrier xcd_barrier_post(unsigned* bar, volatile LAS unsigned* st) {
  XcdBarrier b; b.bar = bar; b.x = xb_xcc_id(); b.st = st;
  if (threadIdx.x == 0) (void)xb_add(&bar[XB_XCNT(b.x)], 1u);
  return b;
}
DI void xcd_barrier_complete(unsigned* bar, unsigned x, unsigned& nloc, unsigned& nx) {
  const unsigned Gn = gridDim.x * gridDim.y * gridDim.z;
  unsigned sum, cnt, mine, sp = 0u;
  for (;;) {
    sum = 0u; cnt = 0u; mine = 0u;
#pragma unroll
    for (unsigned j = 0; j < 16; ++j) { const unsigned c = xb_ld(&bar[XB_XCNT(j)]); sum += c; cnt += (c > 0u) ? 1u : 0u; mine = (j == x) ? c : mine; }
    if (sum == Gn) break;
    __builtin_amdgcn_s_sleep(1);
    if ((++sp & 255u) == 0u) { if (xb_ld(&bar[XB_TMO])) break; if (sp > XB_SPIN_CAP) { atomicAdd(&bar[XB_TMO], 1u); break; } }
  }
  nloc = mine > 0u ? mine : 1u; nx = cnt > 0u ? cnt : 1u;
}
DI void xcd_barrier(const XcdBarrier& b) {
  asm volatile("s_waitcnt vmcnt(0)" ::: "memory");
  __syncthreads();
  if (threadIdx.x == 0) {
    unsigned* bar = b.bar;
    __builtin_amdgcn_s_waitcnt(0);
    unsigned nloc = b.st[0], nx = b.st[1];
    if (nloc == 0u) { xcd_barrier_complete(bar, b.x, nloc, nx); b.st[0] = nloc; b.st[1] = nx; }
    const unsigned old = xb_add(&bar[XB_XSUB(b.x)], 1u);
    const unsigned gen = old / nloc;
    if (old + 1u == (gen + 1u) * nloc) {
      __builtin_amdgcn_fence(__ATOMIC_RELEASE, "agent");
      asm volatile("s_waitcnt vmcnt(0)" ::: "memory");
      const unsigned og = xb_add(&bar[XB_TOP], 1u);
      const unsigned tg = og / nx;
      if (og + 1u == (tg + 1u) * nx) xb_add(&bar[XB_TOPGEN], 1u);
      else XB_SPIN(xb_ld(&bar[XB_TOPGEN]) == tg, bar);
      __builtin_amdgcn_fence(__ATOMIC_ACQUIRE, "agent");
      xb_add(&bar[XB_XGEN(b.x)], 1u);
      asm volatile("s_waitcnt vmcnt(0)" ::: "memory");
    } else {
      XB_SPIN(xb_ld(&bar[XB_XGEN(b.x)]) == gen, bar);
      __builtin_amdgcn_fence(__ATOMIC_ACQUIRE, "agent");
      asm volatile("s_waitcnt vmcnt(0)" ::: "memory");
    }
  }
  __syncthreads();
}

constexpr int NPHASE = 13;
#ifndef PH_MASK
#define PH_MASK 0x1fff
#endif
#define PH_ON(k) (((PH_MASK) >> (k)) & 1)
#ifndef PH_REPEAT
#define PH_REPEAT 0
#endif
#define PH_REP(k) (((PH_REPEAT) >> (k)) & 1)

template <bool COOP>
__global__ void __launch_bounds__(512, 2) mega(Params p, int ph0, int ph1) {
  extern __shared__ __attribute__((aligned(16))) char smem_all[];
  char* smem_raw = smem_all + (threadIdx.x >> 8) * LDS_HALF;
  u16* smem = (u16*)smem_raw;
#define PHASE_BODY(k)                                                                                                   \
  do {                                                                                                                  \
    if (k == 0) { if (PH_ON(0)) phase_prep(p, smem); }                                                                  \
    else if (k == 1) { if (PH_ON(1)) { gemm_phase_big(p.H, p.Wt1, 1024, MROWS / 256, ATT_IN / 256, Ep1{p}, smem_all); \
      const int x_ = blockIdx.x & 7, j_ = blockIdx.x >> 3; const bool busy_ = (x_ == 0) || (x_ == 1 && j_ < 8); \
      if (gridDim.x != 256) idle_transposes(p, blockIdx.x, gridDim.x, 0, TR2 + TR3, smem); \
      else if (!busy_) idle_transposes(p, (x_ >= 2) ? (x_ - 2) * 32 + j_ : 192 + (j_ - 8), 216, 0, TR2 + TR3, smem); } }  \
    else if (k == 2) { if (PH_ON(2)) phase_attn(p, smem); }                                                             \
    else if (k == 3) { if (PH_ON(3)) phase_merge(p); }                                                                  \
    else if (k == 4) { if (PH_ON(4)) { gemm_phase_big(p.H, p.Wt2, 1024, MROWS / 256, 4, Ep2{p}, smem_all); \
      const int x_ = blockIdx.x & 7, j_ = blockIdx.x >> 3; const bool busy_ = (x_ == 0 && j_ < 4); \
      if (gridDim.x != 256) idle_transposes(p, blockIdx.x, gridDim.x, TR2 + TR3, TR4, smem); \
      else if (!busy_) idle_transposes(p, (x_ == 0) ? (j_ - 4) : 28 + (x_ - 1) * 32 + j_, 252, TR2 + TR3, TR4, smem); } }             \
    else if (k == 5) { if (PH_ON(5)) phase_norm2(p); }                                                                  \
    else if (k == 6) { if (PH_ON(6)) gemm_phase_big(p.H, p.Wt3, 1024, MROWS / 256, SSM_IN_PAD / 256, Ep3{p}, smem_all); } \
    else if (k == 7) { if (PH_ON(7)) phase_convpass(p); }                                                               \
    else if (k == 8) { if (PH_ON(8)) phase_states(p, smem_raw); }                                                       \
    else if (k == 9) { if (PH_ON(9)) phase_scan(p); }                                                                   \
    else if (k == 10) { if (PH_ON(10)) { if (gridDim.x == 256) { for (int r = 0; r < 8; ++r) ssd_out_item(p, ssd_item_of(r), smem_raw); } \
      else for (int it = VBID; it < 4096; it += VGRID) ssd_out_item(p, it, smem_raw); } } \
    else if (k == 11) { if (PH_ON(11)) phase_gatenorm(p); }                                                             \
    else if (k == 12) { if (PH_ON(12)) gemm_phase_big(p.YG, p.Wt4, 2048, MROWS / 256, 4, Ep4{p}, smem_all); }          \
  } while (0)
#define PHASE_STEP(k) PHASE_BODY(k); if (PH_REP(k)) { xcd_barrier(xb); PHASE_BODY(k); }
  if constexpr (COOP) {
    volatile LAS unsigned* xst = (volatile LAS unsigned*)(smem_all + LDS_MAIN);
    if (threadIdx.x == 0) { xst[0] = 0u; xst[1] = 0u; }
    __syncthreads();
    const XcdBarrier xb = xcd_barrier_post(p.bar, xst);
    if (ph0 == 0x7fffffff) cg::this_grid().sync();
    PHASE_STEP(0) xcd_barrier(xb);
    PHASE_STEP(1) xcd_barrier(xb);
    PHASE_STEP(2) xcd_barrier(xb);
    PHASE_STEP(3) xcd_barrier(xb);
    PHASE_STEP(4) xcd_barrier(xb);
    PHASE_STEP(5) xcd_barrier(xb);
    PHASE_STEP(6) xcd_barrier(xb);
    PHASE_STEP(7) xcd_barrier(xb);
    PHASE_STEP(8) xcd_barrier(xb);
    PHASE_STEP(9) xcd_barrier(xb);
    PHASE_STEP(10) xcd_barrier(xb);
    PHASE_STEP(11) xcd_barrier(xb);
    PHASE_STEP(12)
  } else {
    switch (ph0) {
      case 0: PHASE_BODY(0); break;
      case 1: PHASE_BODY(1); break;
      case 2: PHASE_BODY(2); break;
      case 3: PHASE_BODY(3); break;
      case 4: PHASE_BODY(4); break;
      case 5: PHASE_BODY(5); break;
      case 6: PHASE_BODY(6); break;
      case 7: PHASE_BODY(7); break;
      case 8: PHASE_BODY(8); break;
      case 9: PHASE_BODY(9); break;
      case 10: PHASE_BODY(10); break;
      case 11: PHASE_BODY(11); break;
      case 12: PHASE_BODY(12); break;
    }
  }
}

#ifndef MULTI_LAUNCH
#define MULTI_LAUNCH 0
#endif

extern "C" void kernel_launch(void* const* d_in, const int* in_sizes, int n_in, void* d_out, int out_size, void* d_ws, size_t ws_size,
                              hipStream_t stream) {
  static int grid = 0;
  size_t off = 0;
  auto carve = [&](size_t bytes) { size_t o = off; off += (bytes + 255) & ~(size_t)255; return (char*)d_ws + o; };
  Params p{};
  p.x_prompt = (const float*)d_in[0]; p.x_sample = (const float*)d_in[1];
  p.cache0 = (const float*)d_in[2]; p.cache1 = (const float*)d_in[3]; p.cache2 = (const float*)d_in[4];
  p.state_conv = (const float*)d_in[5]; p.state_ssm = (const float*)d_in[6];
  p.attn_norm = (const float*)d_in[7]; p.attn_w_in = (const float*)d_in[8]; p.attn_q_gain = (const float*)d_in[9];
  p.attn_k_gain = (const float*)d_in[10]; p.attn_w_out = (const float*)d_in[11];
  p.ssm_norm = (const float*)d_in[12]; p.ssm_w_in = (const float*)d_in[13]; p.ssm_conv_w = (const float*)d_in[14];
  p.ssm_conv_b = (const float*)d_in[15]; p.ssm_dt_bias = (const float*)d_in[16]; p.ssm_A_log = (const float*)d_in[17];
  p.ssm_D = (const float*)d_in[18]; p.ssm_gate_norm = (const float*)d_in[19]; p.ssm_w_out = (const float*)d_in[20];
  p.out = (float*)d_out;
  p.Wt1 = (u16*)carve((size_t)ATT_IN * 1024 * 2);
  p.Wt2 = (u16*)carve((size_t)1024 * 1024 * 2);
  p.Wt3 = (u16*)carve((size_t)SSM_IN_PAD * 1024 * 2);
  p.Wt4 = (u16*)carve((size_t)1024 * 2048 * 2);
  p.H = (u16*)carve((size_t)MROWS * 1024 * 2);
  p.QKVG = (u16*)carve((size_t)MROWS * ATT_IN * 2);
  p.OG = (u16*)carve((size_t)MROWS * 3072 * 2);
  p.Z = (u16*)carve((size_t)MROWS * 2048 * 2);
  p.XBC = (u16*)carve((size_t)MROWS * 3072 * 2);
  p.YG = (u16*)carve((size_t)MROWS * 2048 * 2);
  p.LSE = (float*)carve((size_t)MROWS * 48 * 4);
  p.X1 = (float*)carve((size_t)MROWS * 1024 * 4);
  p.DT = (float*)carve((size_t)MROWS * 32 * 4);
  p.STATES = (u16*)carve((size_t)4 * 32 * 32 * 64 * 128 * 2);
  p.XBCC = (u16*)carve((size_t)PROWS * 3072 * 2);
  p.ACS = (float*)carve((size_t)PROWS * 32 * 4);
  p.bar = (unsigned*)carve((size_t)XCD_BAR_WORDS * 4);
  p.QKVH = (u16*)carve((size_t)4 * 3 * 3 * 16 * 4096 * 64 * 2);
  p.SSQ = (float*)carve((size_t)MROWS * 32 * 4);
  p.CD = (float*)carve((size_t)4 * 32 * 32 * 4);
  if (grid == 0) {
    if (n_in != 21 || (size_t)out_size != O_END || ws_size < off) {
      fprintf(stderr, "kernel_launch: unexpected shapes: n_in %d out %d (want %zu) ws %zu (need %zu)\n", n_in, out_size, (size_t)O_END, ws_size, off);
      grid = -1; return;
    }
    int dev = 0, cus = 0, per_cu = 0;
    hipGetDevice(&dev);
    hipDeviceGetAttribute(&cus, hipDeviceAttributeMultiprocessorCount, dev);
    hipFuncSetAttribute((const void*)mega<true>, hipFuncAttributeMaxDynamicSharedMemorySize, LDS_BYTES);
    hipFuncSetAttribute((const void*)mega<false>, hipFuncAttributeMaxDynamicSharedMemorySize, LDS_BYTES);
    hipOccupancyMaxActiveBlocksPerMultiprocessor(&per_cu, (const void*)mega<true>, 512, LDS_BYTES);
    if (per_cu < 1) { fprintf(stderr, "kernel_launch: occupancy query returned %d\n", per_cu); grid = -1; return; }
    if (per_cu > 1) per_cu = 1;
    grid = cus * per_cu;
    grid &= ~7;
  }
  if (grid < 0) return;
#if MULTI_LAUNCH
  for (int ph = 0; ph < NPHASE; ++ph) hipLaunchKernelGGL(mega<false>, dim3(grid), dim3(512), LDS_BYTES, stream, p, ph, ph + 1);
#else
  hipMemsetAsync(p.bar, 0, (size_t)XCD_BAR_WORDS * 4, stream);
  int ph0 = 0, ph1 = NPHASE;
  void* args[] = {&p, &ph0, &ph1};
  hipError_t e = hipLaunchCooperativeKernel((const void*)mega<true>, dim3(grid), dim3(512), args, LDS_BYTES, stream);
  if (e != hipSuccess) fprintf(stderr, "cooperative launch failed: %s (grid %d)\n", hipGetErrorString(e), grid);
#endif
}
```

```cpp
#include <hip/hip_runtime.h>
#include <hip/hip_cooperative_groups.h>
#include <cstdio>
#include <cstdint>
namespace cg = cooperative_groups;

typedef unsigned short u16;
typedef short bf16x8 __attribute__((ext_vector_type(8)));
typedef short s16x4 __attribute__((ext_vector_type(4)));
typedef float f32x4 __attribute__((ext_vector_type(4)));

#define DI __device__ __forceinline__
__device__ __forceinline__ int opaque_tid() { int t = threadIdx.x; asm volatile("" : "+v"(t)); return t; }
#define VTID (opaque_tid() & 255)
#define VBID ((int)(blockIdx.x * 2 + (opaque_tid() >> 8)))
#define VGRID ((int)(gridDim.x * 2))
#define MFMA16(a, b, c) __builtin_amdgcn_mfma_f32_16x16x32_bf16((a), (b), (c), 0, 0, 0)

constexpr int MROWS = 16384 + 256;
constexpr int PROWS = 16384;
constexpr int ATT_IN = 10240;
constexpr int SSM_IN = 5152;
constexpr int SSM_IN_PAD = 5376;
constexpr int LDS_HALF = 73728;
constexpr int LDS_MAIN = 2 * LDS_HALF;
constexpr int LDS_BYTES = LDS_MAIN + 16;
constexpr int LDT = 72;
constexpr int LDW = 136;
constexpr int TILE_ELEMS = 128 * LDT;

constexpr size_t O_Y = 0;
constexpr size_t O_KVP0 = (size_t)MROWS * 1024;
constexpr size_t O_KVP1 = O_KVP0 + (size_t)4 * 128 * 2048;
constexpr size_t O_KVP2 = O_KVP1 + (size_t)4 * 512 * 2048;
constexpr size_t O_KVS0 = O_KVP2 + (size_t)4 * 2048 * 2048;
constexpr size_t O_KVS1 = O_KVS0 + (size_t)256 * 2048;
constexpr size_t O_KVS2 = O_KVS1 + (size_t)256 * 2048;
constexpr size_t O_CONVP = O_KVS2 + (size_t)256 * 2048;
constexpr size_t O_CONVS = O_CONVP + (size_t)4 * 3 * 3072;
constexpr size_t O_SSMP = O_CONVS + (size_t)32 * 3 * 3072;
constexpr size_t O_SSMS = O_SSMP + (size_t)4 * 32 * 64 * 128;
constexpr size_t O_END = O_SSMS + (size_t)32 * 32 * 64 * 128;

struct Params {
  const float *x_prompt, *x_sample, *cache0, *cache1, *cache2, *state_conv, *state_ssm;
  const float *attn_norm, *attn_w_in, *attn_q_gain, *attn_k_gain, *attn_w_out;
  const float *ssm_norm, *ssm_w_in, *ssm_conv_w, *ssm_conv_b, *ssm_dt_bias, *ssm_A_log, *ssm_D, *ssm_gate_norm, *ssm_w_out;
  float* out;
  u16 *Wt1, *Wt2, *Wt3, *Wt4, *H, *QKVG, *OG, *Z, *XBC, *YG, *XBCC, *STATES, *QKVH;
  float *LSE, *X1, *DT, *SSQ, *CD, *ACS;
  unsigned* bar;
};

typedef __bf16 bf16v2 __attribute__((ext_vector_type(2)));
DI u16 f2bf(float x) { return __builtin_bit_cast(u16, (__bf16)x); }
DI float bf2f(u16 h) { return __uint_as_float(((unsigned)h) << 16); }
DI unsigned pack2(float a, float b) { bf16v2 v; v[0] = (__bf16)a; v[1] = (__bf16)b; return __builtin_bit_cast(unsigned, v); }
DI float lo_f(unsigned w) { return __uint_as_float(w << 16); }
DI float hi_f(unsigned w) { return __uint_as_float(w & 0xffff0000u); }
DI void unpack8(const uint4& v, float* f) {
  f[0] = lo_f(v.x); f[1] = hi_f(v.x); f[2] = lo_f(v.y); f[3] = hi_f(v.y);
  f[4] = lo_f(v.z); f[5] = hi_f(v.z); f[6] = lo_f(v.w); f[7] = hi_f(v.w);
}
DI uint4 pack8(const float* f) {
  uint4 v; v.x = pack2(f[0], f[1]); v.y = pack2(f[2], f[3]); v.z = pack2(f[4], f[5]); v.w = pack2(f[6], f[7]); return v;
}
DI float sum16(float v) {
  v += __builtin_bit_cast(float, __builtin_amdgcn_update_dpp(0, __builtin_bit_cast(int, v), 0xB1, 0xf, 0xf, true));
  v += __builtin_bit_cast(float, __builtin_amdgcn_update_dpp(0, __builtin_bit_cast(int, v), 0x4E, 0xf, 0xf, true));
  v += __builtin_bit_cast(float, __builtin_amdgcn_update_dpp(0, __builtin_bit_cast(int, v), 0x141, 0xf, 0xf, true));
  v += __builtin_bit_cast(float, __builtin_amdgcn_update_dpp(0, __builtin_bit_cast(int, v), 0x140, 0xf, 0xf, true));
  return v;
}
DI float sum4(float v) {
  v += __builtin_bit_cast(float, __builtin_amdgcn_update_dpp(0, __builtin_bit_cast(int, v), 0xB1, 0xf, 0xf, true));
  v += __builtin_bit_cast(float, __builtin_amdgcn_update_dpp(0, __builtin_bit_cast(int, v), 0x4E, 0xf, 0xf, true));
  return v;
}
DI float silu_f(float x) { return x / (1.f + __expf(-x)); }
DI s16x4 tr_read(const u16* ptr) {
  return __builtin_amdgcn_ds_read_tr16_b64_v4i16((s16x4 __attribute__((address_space(3)))*)(ptr));
}
DI bf16x8 cat4(s16x4 lo, s16x4 hi) { return __builtin_shufflevector(lo, hi, 0, 1, 2, 3, 4, 5, 6, 7); }
DI bf16x8 words_to_frag(unsigned a, unsigned b, unsigned c, unsigned d) {
  uint4 v; v.x = a; v.y = b; v.z = c; v.w = d; return __builtin_bit_cast(bf16x8, v);
}

constexpr int G8_HT = 128 * 64;
DI int g8_lds_byte(int r, int c) {
  const int st = (r >> 4) * 2 + (c >> 5), rr = r & 15, cc = c & 31, ob = rr * 64 + cc * 2;
  return st * 1024 + (ob ^ (((ob >> 9) & 1) << 5));
}
DI void g8_stage_rc(int b, int& R, int& C) {
  const int st = b / 1024, sb = b % 1024, swz = sb ^ (((sb >> 9) & 1) << 5);
  R = (st >> 1) * 16 + swz / 64; C = (st & 1) * 32 + (swz % 64) / 2;
}
template <class EP>
DI void gemm_tile_big(const u16* __restrict__ A, const u16* __restrict__ Bt, int K, int klen, int brow, int bcol, const EP& ep, char* smem) {
  u16* shm = (u16*)smem;
  const int rtid = opaque_tid();
#define SA(b, h) (shm + ((b) * 2 + (h)) * G8_HT)
#define SB(b, h) (shm + (4 + (b) * 2 + (h)) * G8_HT)
  unsigned offA[2], offB[2];
#pragma unroll
  for (int _i = 0; _i < 2; ++_i) {
    int _r, _c; g8_stage_rc(rtid * 16 + _i * 8192, _r, _c);
    offA[_i] = (unsigned)((_r * K + _c) * 2);
    offB[_i] = (unsigned)((((_r >> 5) * 64 + (_r & 31)) * K + _c) * 2);
  }
#define STAGE_A(P, br, kt) do { const char* _gb = (const char*)A + ((size_t)(br) * K + (size_t)(kt) * 64) * 2;          \
    _Pragma("unroll") for (int _i = 0; _i < 2; ++_i)                                                                    \
      __builtin_amdgcn_global_load_lds((const unsigned*)(_gb + offA[_i]), (unsigned*)((char*)(P) + rtid * 16 + _i * 8192), 16, 0, 0); } while (0)
#define STAGE_B(P, h, kt) do { const char* _gb = (const char*)Bt + ((size_t)(bcol + (h) * 32) * K + (size_t)(kt) * 64) * 2; \
    _Pragma("unroll") for (int _i = 0; _i < 2; ++_i)                                                                    \
      __builtin_amdgcn_global_load_lds((const unsigned*)(_gb + offB[_i]), (unsigned*)((char*)(P) + rtid * 16 + _i * 8192), 16, 0, 0); } while (0)
#define LDA(dst, b, h) _Pragma("unroll") for (int m = 0; m < 4; ++m) _Pragma("unroll") for (int k = 0; k < 2; ++k) \
    dst[m][k] = *reinterpret_cast<const bf16x8*>(a_rd + ((b) * 2 + (h)) * 16384 + m * 2048 + k * 1024)
#define LDB(dst, b, h) _Pragma("unroll") for (int n = 0; n < 2; ++n) _Pragma("unroll") for (int k = 0; k < 2; ++k) \
    dst[n][k] = *reinterpret_cast<const bf16x8*>(b_rd + ((b) * 2 + (h)) * 16384 + n * 2048 + k * 1024)
#define MMA(ai, bj, At, Bx) do { __builtin_amdgcn_s_setprio(1);                                                         \
    for (int m = 0; m < 4; ++m) for (int n = 0; n < 2; ++n) for (int k = 0; k < 2; ++k)                                 \
      acc[ai][m][(bj) * 2 + n] = MFMA16(At[m][k], Bx[n][k], acc[ai][m][(bj) * 2 + n]);                                 \
    __builtin_amdgcn_s_setprio(0); } while (0)
#define WAIT_V(n) asm volatile("s_waitcnt vmcnt(" #n ")" ::: "memory")
#define WAIT_L(n) asm volatile("s_waitcnt lgkmcnt(" #n ")" ::: "memory")
#define BAR __builtin_amdgcn_s_barrier()
#define SCHED __builtin_amdgcn_sched_barrier(0)
  const int wid = rtid >> 6, lane = rtid & 63, wr = wid >> 2, wc = wid & 3, fr = lane & 15, fq = lane >> 4;
  const int l0 = g8_lds_byte(fr, fq * 8);
  const char* a_rd = smem + wr * 8192 + l0;
  const char* b_rd = smem + 4 * 16384 + wc * 4096 + l0;
  f32x4 acc[2][4][4];
#pragma unroll
  for (int ai = 0; ai < 2; ++ai)
#pragma unroll
    for (int m = 0; m < 4; ++m)
#pragma unroll
      for (int n = 0; n < 4; ++n) acc[ai][m][n] = (f32x4){0.f, 0.f, 0.f, 0.f};
  bf16x8 At[4][2], B0[2][2], B1[2][2];
  const int nt = klen / 64;
  STAGE_B(SB(0, 0), 0, 0); STAGE_A(SA(0, 0), brow, 0);
  STAGE_B(SB(0, 1), 1, 0); STAGE_A(SA(0, 1), brow + 128, 0);
  if (wr == 1) BAR;
  WAIT_V(4); BAR;
  STAGE_B(SB(1, 0), 0, 1); STAGE_A(SA(1, 0), brow, 1); STAGE_B(SB(1, 1), 1, 1);
  WAIT_V(6); BAR;
  for (int t = 0; t < nt - 2; t += 2) {
    LDB(B0, 0, 0); SCHED; LDA(At, 0, 0); STAGE_A(SA(1, 1), brow + 128, t + 1);
    WAIT_L(8); BAR; WAIT_L(0); MMA(0, 0, At, B0); BAR; SCHED;
    LDB(B1, 0, 1); STAGE_B(SB(0, 0), 0, t + 2);
    BAR; WAIT_L(0); MMA(0, 1, At, B1); BAR;
    LDA(At, 0, 1); STAGE_A(SA(0, 0), brow, t + 2);
    BAR; WAIT_L(0); MMA(1, 0, At, B0); BAR; SCHED;
    STAGE_B(SB(0, 1), 1, t + 2);
    WAIT_V(6); BAR; MMA(1, 1, At, B1); BAR;
    LDB(B0, 1, 0); SCHED; LDA(At, 1, 0); STAGE_A(SA(0, 1), brow + 128, t + 2);
    WAIT_L(8); BAR; WAIT_L(0); MMA(0, 0, At, B0); BAR; SCHED;
    LDB(B1, 1, 1); STAGE_B(SB(1, 0), 0, t + 3);
    BAR; WAIT_L(0); MMA(0, 1, At, B1); BAR;
    LDA(At, 1, 1); STAGE_A(SA(1, 0), brow, t + 3);
    BAR; WAIT_L(0); MMA(1, 0, At, B0); BAR; SCHED;
    STAGE_B(SB(1, 1), 1, t + 3);
    WAIT_V(6); BAR; MMA(1, 1, At, B1); BAR;
  }
  { LDB(B0, 0, 0); LDA(At, 0, 0); STAGE_A(SA(1, 1), brow + 128, nt - 1);
    BAR; WAIT_L(0); MMA(0, 0, At, B0); BAR;
    LDB(B1, 0, 1); BAR; WAIT_L(0); MMA(0, 1, At, B1); BAR;
    LDA(At, 0, 1); WAIT_V(4); BAR; WAIT_L(0); MMA(1, 0, At, B0); MMA(1, 1, At, B1); BAR; }
  { LDB(B0, 1, 0); LDA(At, 1, 0); WAIT_V(2); BAR; WAIT_L(0); MMA(0, 0, At, B0); BAR;
    LDB(B1, 1, 1); WAIT_V(0); BAR; WAIT_L(0); MMA(0, 1, At, B1); BAR;
    LDA(At, 1, 1); BAR; WAIT_L(0); MMA(1, 0, At, B0); MMA(1, 1, At, B1); BAR; }
  if (wr == 0) BAR;
#undef SA
#undef SB
#undef STAGE_A
#undef STAGE_B
#undef LDA
#undef LDB
#undef MMA
#undef WAIT_V
#undef WAIT_L
#undef BAR
#undef SCHED
  int late = 0;
  asm volatile("" : "+v"(late));
  ep(acc[0], brow + wr * 64 + late, bcol + wc * 64, lane + late);
  ep(acc[1], brow + 128 + wr * 64 + late, bcol + wc * 64, lane + late);
  __syncthreads();
}

template <class EP>
DI void gemm_phase_big(const u16* A, const u16* Bt, int K, int MT, int NT, const EP& ep, char* smem) {
  const int x = blockIdx.x & 7, j = blockIdx.x >> 3, per = gridDim.x >> 3;
  const int T = MT * NT, fullT = (MT >> 3) * 8 * NT, hlast = MT & 7;
  for (int v = j;; v += per) {
    const int chunk = x + 8 * (v >> 5);
    if (chunk * 32 >= T) break;
    const int s = chunk * 32 + (v & 31);
    if (s >= T) continue;
    int mt, nt;
    if (s < fullT) { const int band = s / (8 * NT), within = s - band * 8 * NT; nt = within >> 3; mt = band * 8 + (within & 7); }
    else { const int sp = s - fullT; nt = sp / hlast; mt = (MT >> 3) * 8 + (sp - nt * hlast); }
    gemm_tile_big(A, Bt, K, K, mt * 256, nt * 256, ep, smem);
  }
}

template <class EP>
DI void gemm_sample_splitk(const u16* A, const u16* Bt, int K, int NT, int S, const EP& ep, char* smem) {
  const int i = blockIdx.x;
  if (i < NT * S) {
    const int nt = i / S, ks = i - nt * S, klen = K / S;
    gemm_tile_big(A + ks * klen, Bt + ks * klen, K, klen, PROWS, nt * 256, ep, smem);
  }
}

DI unsigned merge_word(unsigned a, unsigned b, unsigned c, unsigned g, float e0, float e1, float e2) {
  const float lo = (e0 * lo_f(a) + e1 * lo_f(b) + e2 * lo_f(c)) * silu_f(lo_f(g));
  const float hi = (e0 * hi_f(a) + e1 * hi_f(b) + e2 * hi_f(c)) * silu_f(hi_f(g));
  return pack2(lo, hi);
}
DI void phase_merge(const Params& p) {
  const int lane = VTID & 63;
  for (int it = VBID; it < MROWS / 4; it += VGRID) {
    const size_t row = (size_t)it * 4 + (VTID >> 6);
    const int k = lane * 16, head = lane >> 2;
    const float* lp = p.LSE + row * 48 + head;
    const float l0 = lp[0], l1 = lp[16], l2 = lp[32];
    const u16* op = p.OG + row * 3072 + k;
    const u16* gp = p.QKVG + row * ATT_IN + 9216 + k;
    uint4 a[2], b[2], c[2], g[2];
#pragma unroll
    for (int h = 0; h < 2; ++h) {
      a[h] = *(const uint4*)(op + h * 8); b[h] = *(const uint4*)(op + 1024 + h * 8); c[h] = *(const uint4*)(op + 2048 + h * 8);
      g[h] = *(const uint4*)(gp + h * 8);
    }
    const float mx = fmaxf(l0, fmaxf(l1, l2));
    float e0 = __expf(l0 - mx), e1 = __expf(l1 - mx), e2 = __expf(l2 - mx);
    const float inv = 1.f / (e0 + e1 + e2);
    e0 *= inv; e1 *= inv; e2 *= inv;
#pragma unroll
    for (int h = 0; h < 2; ++h) {
      uint4 o;
      o.x = merge_word(a[h].x, b[h].x, c[h].x, g[h].x, e0, e1, e2);
      o.y = merge_word(a[h].y, b[h].y, c[h].y, g[h].y, e0, e1, e2);
      o.z = merge_word(a[h].z, b[h].z, c[h].z, g[h].z, e0, e1, e2);
      o.w = merge_word(a[h].w, b[h].w, c[h].w, g[h].w, e0, e1, e2);
      *(uint4*)(p.H + row * 1024 + k + h * 8) = o;
    }
    if (row >= PROWS) {
      const float* xs = p.x_sample + (row - PROWS) * 1024 + k;
      float* xd = p.X1 + row * 1024 + k;
#pragma unroll
      for (int h = 0; h < 4; ++h) *(float4*)(xd + h * 4) = *(const float4*)(xs + h * 4);
    }
  }
}
DI void phase_gatenorm(const Params& p) {
  const int lane = VTID & 63;
  for (int it = VBID; it < MROWS / 4; it += VGRID) {
    const size_t row = (size_t)it * 4 + (VTID >> 6);
    const int k = lane * 32;
    const float* sp = p.SSQ + row * 32 + (lane >> 4) * 8;
    const float4 s0 = *(const float4*)sp, s1 = *(const float4*)(sp + 4);
    const float ss = (s0.x + s0.y) + (s0.z + s0.w) + (s1.x + s1.y) + (s1.z + s1.w);
    const float rstd = rsqrtf(ss * (1.f / 512.f) + 1e-5f);
    u16* yp = p.YG + row * 2048 + k;
    uint4 y[4];
#pragma unroll
    for (int h = 0; h < 4; ++h) y[h] = *(const uint4*)(yp + h * 8);
#pragma unroll
    for (int h = 0; h < 4; ++h) {
      const float4 g0 = *(const float4*)(p.ssm_gate_norm + k + h * 8), g1 = *(const float4*)(p.ssm_gate_norm + k + h * 8 + 4);
      uint4 o;
      o.x = pack2(lo_f(y[h].x) * rstd * g0.x, hi_f(y[h].x) * rstd * g0.y);
      o.y = pack2(lo_f(y[h].y) * rstd * g0.z, hi_f(y[h].y) * rstd * g0.w);
      o.z = pack2(lo_f(y[h].z) * rstd * g1.x, hi_f(y[h].z) * rstd * g1.y);
      o.w = pack2(lo_f(y[h].w) * rstd * g1.z, hi_f(y[h].w) * rstd * g1.w);
      *(uint4*)(yp + h * 8) = o;
    }
    if (row >= PROWS) {
      const float* xs = p.X1 + row * 1024 + lane * 16;
      float* xd = p.out + O_Y + row * 1024 + lane * 16;
#pragma unroll
      for (int h = 0; h < 4; ++h) *(float4*)(xd + h * 4) = *(const float4*)(xs + h * 4);
    }
  }
}

struct Ep1 {
  const Params& p;
  DI void operator()(f32x4 (&acc)[4][4], int r0, int c0, int lane) const {
    const int l15 = lane & 15, G = lane >> 4;
    int kind, g = 0, head;
    if (c0 >= 9216) { kind = 3; head = (c0 - 9216) >> 6; }
    else { g = c0 / 3072; const int rem = c0 - g * 3072; kind = rem >> 10; head = (rem & 1023) >> 6; }
    if (kind < 2) {
      const float* gp = (kind == 0 ? p.attn_q_gain : p.attn_k_gain) + g * 64;
      float gain[4];
#pragma unroll
      for (int n = 0; n < 4; ++n) gain[n] = gp[n * 16 + l15];
      const float post = (kind == 0) ? 0.125f : 1.f;
#pragma unroll
      for (int m = 0; m < 4; ++m)
#pragma unroll
        for (int j = 0; j < 4; ++j) {
          float ss = 0.f;
#pragma unroll
          for (int n = 0; n < 4; ++n) ss += acc[m][n][j] * acc[m][n][j];
          ss = sum16(ss);
          const float sc = rsqrtf(ss * (1.f / 64.f) + 1e-6f) * post;
#pragma unroll
          for (int n = 0; n < 4; ++n) acc[m][n][j] *= sc * gain[n];
        }
    }
    if (kind < 3 && r0 < PROWS) {
      const int dsh = 2 * g;
      const size_t hb = ((size_t)(((r0 >> 12) * 3 + g) * 3 + kind) * 16 + head) * 4096;
#pragma unroll
      for (int m = 0; m < 4; ++m)
#pragma unroll
        for (int j = 0; j < 4; ++j) {
          const int t = (r0 + m * 16 + G * 4 + j) & 4095;
          const int pos = (t & ((1 << dsh) - 1)) * (4096 >> dsh) + (t >> dsh);
          u16* dst = p.QKVH + (hb + pos) * 64 + l15;
#pragma unroll
          for (int n = 0; n < 4; ++n) dst[n * 16] = f2bf(acc[m][n][j]);
        }
    } else {
#pragma unroll
      for (int m = 0; m < 4; ++m)
#pragma unroll
        for (int j = 0; j < 4; ++j) {
          const int row = r0 + m * 16 + G * 4 + j;
          u16* dst = p.QKVG + (size_t)row * ATT_IN + c0 + l15;
#pragma unroll
          for (int n = 0; n < 4; ++n) dst[n * 16] = f2bf(acc[m][n][j]);
        }
    }
    if (kind == 1 || kind == 2) {
      const int keep = 128 << (2 * g);
      const size_t okp = (g == 0) ? O_KVP0 : (g == 1) ? O_KVP1 : O_KVP2;
      const size_t oks = (g == 0) ? O_KVS0 : (g == 1) ? O_KVS1 : O_KVS2;
#pragma unroll
      for (int m = 0; m < 4; ++m)
#pragma unroll
        for (int j = 0; j < 4; ++j) {
          const int row = r0 + m * 16 + G * 4 + j;
          float* dst = nullptr;
          if (row < PROWS) {
            const int b = row >> 12, s = row & 4095;
            if (s >= 4096 - keep) dst = p.out + okp + ((size_t)(b * keep + s - (4096 - keep)) * 2 + (kind - 1)) * 1024 + head * 64 + l15;
          } else {
            dst = p.out + oks + ((size_t)(row - PROWS) * 2 + (kind - 1)) * 1024 + head * 64 + l15;
          }
          if (dst) {
#pragma unroll
            for (int n = 0; n < 4; ++n) dst[n * 16] = acc[m][n][j];
          }
        }
    }
  }
};
struct Ep2 {
  const Params& p;
  DI void operator()(f32x4 (&acc)[4][4], int r0, int c0, int lane) const {
    const int l15 = lane & 15, G = lane >> 4;
#pragma unroll
    for (int m = 0; m < 4; ++m)
#pragma unroll
      for (int j = 0; j < 4; ++j) {
        const int row = r0 + m * 16 + G * 4 + j;
        const float* xin = (row < PROWS) ? p.x_prompt + (size_t)row * 1024 : p.x_sample + (size_t)(row - PROWS) * 1024;
        float* dst = p.X1 + (size_t)row * 1024 + c0 + l15;
#pragma unroll
        for (int n = 0; n < 4; ++n) dst[n * 16] = xin[c0 + l15 + n * 16] + acc[m][n][j];
      }
  }
};
struct EpAtomic {
  float* dst;
  DI void operator()(f32x4 (&acc)[4][4], int r0, int c0, int lane) const {
    const int l15 = lane & 15, G = lane >> 4;
#pragma unroll
    for (int m = 0; m < 4; ++m)
#pragma unroll
      for (int j = 0; j < 4; ++j) {
        float* d = dst + (size_t)(r0 + m * 16 + G * 4 + j) * 1024 + c0 + l15;
#pragma unroll
        for (int n = 0; n < 4; ++n) unsafeAtomicAdd(d + n * 16, acc[m][n][j]);
      }
  }
};
struct Ep3 {
  const Params& p;
  DI void operator()(f32x4 (&acc)[4][4], int r0, int c0, int lane) const {
    const int l15 = lane & 15, G = lane >> 4;
    if (c0 >= SSM_IN) return;
    if (c0 < 2048) {
#pragma unroll
      for (int m = 0; m < 4; ++m)
#pragma unroll
        for (int j = 0; j < 4; ++j) {
          const int row = r0 + m * 16 + G * 4 + j;
          u16* dst = p.Z + (size_t)row * 2048 + c0 + l15;
#pragma unroll
          for (int n = 0; n < 4; ++n) dst[n * 16] = f2bf(acc[m][n][j]);
        }
    } else if (c0 < 5120) {
      const int cc = c0 - 2048 + l15;
#pragma unroll
      for (int m = 0; m < 4; ++m)
#pragma unroll
        for (int j = 0; j < 4; ++j) {
          const int row = r0 + m * 16 + G * 4 + j;
          u16* dst = p.XBC + (size_t)row * 3072 + cc;
#pragma unroll
          for (int n = 0; n < 4; ++n) dst[n * 16] = f2bf(acc[m][n][j]);
          float* od = nullptr;
          if (row < PROWS) {
            const int b = row >> 12, s = row & 4095;
            if (s >= 4093) od = p.out + O_CONVP + (size_t)(b * 3 + s - 4093) * 3072 + cc;
          } else {
            const int rr = row - PROWS, b = rr >> 3, t = rr & 7;
            if (t >= 5) od = p.out + O_CONVS + (size_t)(b * 3 + t - 5) * 3072 + cc;
          }
          if (od) {
#pragma unroll
            for (int n = 0; n < 4; ++n) od[n * 16] = acc[m][n][j];
          }
        }
    } else {
#pragma unroll
      for (int m = 0; m < 4; ++m)
#pragma unroll
        for (int j = 0; j < 4; ++j) {
          const int row = r0 + m * 16 + G * 4 + j;
#pragma unroll
          for (int n = 0; n < 2; ++n) {
            const int h = n * 16 + l15;
            const float xv = acc[m][n][j] + p.ssm_dt_bias[h];
            p.DT[(size_t)row * 32 + h] = fmaxf(xv, 0.f) + log1pf(__expf(-fabsf(xv)));
          }
        }
    }
  }
};
struct Ep4 {
  const Params& p;
  DI void operator()(f32x4 (&acc)[4][4], int r0, int c0, int lane) const {
    const int l15 = lane & 15, G = lane >> 4;
#pragma unroll
    for (int m = 0; m < 4; ++m)
#pragma unroll
      for (int j = 0; j < 4; ++j) {
        const int row = r0 + m * 16 + G * 4 + j;
        const float* xin = p.X1 + (size_t)row * 1024 + c0 + l15;
        float* dst = p.out + O_Y + (size_t)row * 1024 + c0 + l15;
#pragma unroll
        for (int n = 0; n < 4; ++n) dst[n * 16] = xin[n * 16] + acc[m][n][j];
      }
  }
};

DI void transpose_task(const float* __restrict__ W, u16* __restrict__ Wt, int K, int N, int NTN, int tile, u16* smem) {
  const int tid = VTID;
  const int ktile = tile / NTN, ntile = tile % NTN;
  const int k0 = ktile * 64, n0 = ntile * 64;
#pragma unroll
  for (int i = 0; i < 4; ++i) {
    const int idx = tid + 256 * i;
    const int kk = idx >> 4, nq = idx & 15;
    const int n = n0 + nq * 4;
    float4 v = {0.f, 0.f, 0.f, 0.f};
    if (n < N) v = *(const float4*)(W + (size_t)(k0 + kk) * N + n);
    smem[(nq * 4 + 0) * LDT + kk] = f2bf(v.x);
    smem[(nq * 4 + 1) * LDT + kk] = f2bf(v.y);
    smem[(nq * 4 + 2) * LDT + kk] = f2bf(v.z);
    smem[(nq * 4 + 3) * LDT + kk] = f2bf(v.w);
  }
  __syncthreads();
#pragma unroll
  for (int i = 0; i < 2; ++i) {
    const int idx = tid + 256 * i;
    const int n = idx >> 3, kc = idx & 7;
    *(uint4*)(Wt + (size_t)(n0 + n) * K + k0 + kc * 8) = *(const uint4*)(smem + n * LDT + kc * 8);
  }
  __syncthreads();
}

DI void rmsnorm_row(const float* __restrict__ src, const float* __restrict__ wgt, u16* __restrict__ dst, int lane) {
  float4 v[4];
  float ss = 0.f;
#pragma unroll
  for (int i = 0; i < 4; ++i) {
    v[i] = *(const float4*)(src + lane * 4 + 256 * i);
    ss += v[i].x * v[i].x + v[i].y * v[i].y + v[i].z * v[i].z + v[i].w * v[i].w;
  }
  ss = sum16(ss);
  ss += __shfl_xor(ss, 16);
  ss += __shfl_xor(ss, 32);
  const float rstd = rsqrtf(ss * (1.f / 1024.f) + 1e-6f);
#pragma unroll
  for (int i = 0; i < 4; ++i) {
    const float4 g = *(const float4*)(wgt + lane * 4 + 256 * i);
    uint2 o;
    o.x = pack2(v[i].x * rstd * g.x, v[i].y * rstd * g.y);
    o.y = pack2(v[i].z * rstd * g.z, v[i].w * rstd * g.w);
    *(uint2*)(dst + lane * 4 + 256 * i) = o;
  }
}

constexpr int TR1 = 16 * 160, TR2 = 16 * 16, TR3 = 16 * 84, TR4 = 32 * 16;
DI void phase_prep(const Params& p, u16* smem) {
  constexpr int RT = MROWS / 4;
  for (int it = VBID; it < TR1 + RT; it += VGRID) {
    if (it < TR1) transpose_task(p.attn_w_in, p.Wt1, 1024, ATT_IN, 160, it, smem);
    else {
      const int row = (it - TR1) * 4 + (VTID >> 6);
      const float* src = (row < PROWS) ? p.x_prompt + (size_t)row * 1024 : p.x_sample + (size_t)(row - PROWS) * 1024;
      rmsnorm_row(src, p.attn_norm, p.H + (size_t)row * 1024, VTID & 63);
    }
  }
}
DI void late_transpose_task(const Params& p, int it, u16* smem) {
  if (it < TR2) transpose_task(p.attn_w_out, p.Wt2, 1024, 1024, 16, it, smem);
  else if (it < TR2 + TR3) transpose_task(p.ssm_w_in, p.Wt3, 1024, SSM_IN, 84, it - TR2, smem);
  else transpose_task(p.ssm_w_out, p.Wt4, 2048, 1024, 16, it - TR2 - TR3, smem);
}

DI void phase_norm2(const Params& p) {
  for (int it = VBID; it < MROWS / 4; it += VGRID) {
    const int row = it * 4 + (VTID >> 6);
    rmsnorm_row(p.X1 + (size_t)row * 1024, p.ssm_norm, p.H + (size_t)row * 1024, VTID & 63);
  }
}

struct PromptRegs { uint4 k[8], v[8]; bf16x8 q[2][2]; };
DI void attn_prompt_load(const Params& p, int item, PromptRegs& R) {
  const int tid = VTID, lane = tid & 63, w = tid >> 6, l15 = lane & 15, G = lane >> 4;
  const int rn = item & 31, head = (item >> 5) & 15, b = (item >> 9) & 3, g = item >> 11;
  const int dsh = 2 * g, dil = 1 << dsh, nbg = 32 >> dsh;
  const int r = rn / nbg, n = rn % nbg;
  const size_t hq = ((size_t)((b * 3 + g) * 3 + 0) * 16 + head) * 4096 + (size_t)r * (4096 >> dsh);
  const size_t hk = hq + (size_t)16 * 4096, hv = hq + (size_t)32 * 4096;
  (void)dil;
#pragma unroll
  for (int i = 0; i < 8; ++i) {
    const int c = tid + 256 * i;
    const int kj = c >> 3, ch = c & 7;
    const int u = (n - 1) * 128 + kj;
    R.k[i] = (uint4){0u, 0u, 0u, 0u}; R.v[i] = (uint4){0u, 0u, 0u, 0u};
    if (u >= 0) {
      R.k[i] = *(const uint4*)(p.QKVH + (hk + u) * 64 + ch * 8);
      R.v[i] = *(const uint4*)(p.QKVH + (hv + u) * 64 + ch * 8);
    }
  }
#pragma unroll
  for (int sub = 0; sub < 2; ++sub) {
    const u16* qp = p.QKVH + (hq + n * 128 + w * 32 + sub * 16 + l15) * 64 + G * 8;
    R.q[sub][0] = *(const bf16x8*)qp;
    R.q[sub][1] = *(const bf16x8*)(qp + 32);
  }
}
DI void attn_prompt_stage(const PromptRegs& R, u16* smem) {
  const int tid = VTID;
  u16* Ks = smem;
  u16* Vs = smem + 256 * LDT;
#pragma unroll
  for (int i = 0; i < 8; ++i) {
    const int c = tid + 256 * i;
    const int kj = c >> 3, ch = c & 7;
    *(uint4*)(Ks + kj * LDT + ch * 8) = R.k[i];
    *(uint4*)(Vs + kj * LDT + ch * 8) = R.v[i];
  }
}
DI void attn_prompt_compute(const Params& p, int item, const bf16x8 (&qpre)[2][2], u16* smem) {
  const int tid = VTID, lane = tid & 63, w = tid >> 6, l15 = lane & 15, G = lane >> 4;
  const int rn = item & 31, head = (item >> 5) & 15, b = (item >> 9) & 3, g = item >> 11;
  const int dsh = 2 * g, dil = 1 << dsh, nbg = 32 >> dsh;
  const int r = rn / nbg, n = rn % nbg;
  u16* Ks = smem;
  u16* Vs = smem + 256 * LDT;
#pragma unroll 1
  for (int sub = 0; sub < 2; ++sub) {
    const int q0 = w * 32 + sub * 16;
    const int qi = q0 + l15;
    const size_t rowq = (size_t)b * 4096 + (size_t)(n * 128 + qi) * dil + r;
    const bf16x8 qf0 = sub ? qpre[1][0] : qpre[0][0], qf1 = sub ? qpre[1][1] : qpre[0][1];
    f32x4 st[9];
#pragma unroll
    for (int s = 0; s < 9; ++s) {
      const u16* kp = Ks + (q0 + 16 * s + l15) * LDT + G * 8;
      const bf16x8 a0 = *(const bf16x8*)kp, a1 = *(const bf16x8*)(kp + 32);
      f32x4 z = {0.f, 0.f, 0.f, 0.f};
      z = MFMA16(a0, qf0, z);
      st[s] = MFMA16(a1, qf1, z);
    }
    float mx = -INFINITY;
#pragma unroll
    for (int s = 0; s < 9; ++s)
#pragma unroll
      for (int j = 0; j < 4; ++j) {
        const int kk = 16 * s + 4 * G + j;
        const bool valid = (kk >= l15) && (kk <= l15 + 128) && (n > 0 || q0 + kk >= 128);
        const float v = valid ? st[s][j] : -INFINITY;
        st[s][j] = v;
        mx = fmaxf(mx, v);
      }
    mx = fmaxf(mx, __shfl_xor(mx, 16));
    mx = fmaxf(mx, __shfl_xor(mx, 32));
    float sum = 0.f;
#pragma unroll
    for (int s = 0; s < 9; ++s)
#pragma unroll
      for (int j = 0; j < 4; ++j) {
        const float e = __expf(st[s][j] - mx);
        st[s][j] = e;
        sum += e;
      }
    sum += __shfl_xor(sum, 16);
    sum += __shfl_xor(sum, 32);
    const float inv = 1.f / sum;
    f32x4 o[4];
#pragma unroll
    for (int m = 0; m < 4; ++m) o[m] = (f32x4){0.f, 0.f, 0.f, 0.f};
#pragma unroll
    for (int t = 0; t < 5; ++t) {
      const int sA = 2 * t, sB = 2 * t + 1;
      bf16x8 pb;
      if (t < 4) pb = words_to_frag(pack2(st[sA][0], st[sA][1]), pack2(st[sA][2], st[sA][3]), pack2(st[sB < 9 ? sB : 8][0], st[sB < 9 ? sB : 8][1]), pack2(st[sB < 9 ? sB : 8][2], st[sB < 9 ? sB : 8][3]));
      else pb = words_to_frag(pack2(st[sA][0], st[sA][1]), pack2(st[sA][2], st[sA][3]), 0u, 0u);
      const u16* vA = Vs + (q0 + 16 * sA + 4 * G + (l15 >> 2)) * LDT + (l15 & 3) * 4;
      const u16* vB = Vs + (q0 + 16 * sB + 4 * G + (l15 >> 2)) * LDT + (l15 & 3) * 4;
#pragma unroll
      for (int m = 0; m < 4; ++m) {
        const s16x4 lo = tr_read(vA + 16 * m);
        s16x4 hi = {0, 0, 0, 0};
        if (t < 4) hi = tr_read(vB + 16 * m);
        o[m] = MFMA16(cat4(lo, hi), pb, o[m]);
      }
    }
    u16* op = p.OG + rowq * 3072 + g * 1024 + head * 64 + 4 * G;
#pragma unroll
    for (int m = 0; m < 4; ++m) {
      uint2 ov;
      ov.x = pack2(o[m][0] * inv, o[m][1] * inv);
      ov.y = pack2(o[m][2] * inv, o[m][3] * inv);
      *(uint2*)(op + 16 * m) = ov;
    }
    if (G == 0) p.LSE[rowq * 48 + g * 16 + head] = mx + __logf(sum);
  }
}

DI void attn_sample_task(const Params& p, int id) {
  const int lane = VTID & 63, l15 = lane & 15, G = lane >> 4;
  const int t = id & 7, head = (id >> 3) & 15, b = (id >> 7) & 31, g = id >> 12;
  const int L = 128 << (2 * g), dil = 1 << (2 * g);
  const float* cache = (g == 0) ? p.cache0 : (g == 1) ? p.cache1 : p.cache2;
  const float* newkv = p.out + ((g == 0) ? O_KVS0 : (g == 1) ? O_KVS1 : O_KVS2);
  const size_t rowq = (size_t)PROWS + b * 8 + t;
  const uint2 qq = *(const uint2*)(p.QKVG + rowq * ATT_IN + g * 3072 + head * 64 + 4 * l15);
  const float q0 = lo_f(qq.x), q1 = hi_f(qq.x), q2 = lo_f(qq.y), q3 = hi_f(qq.y);
  const int coff = head * 64 + 4 * l15;
  float mx = -INFINITY, sum = 0.f, a0 = 0.f, a1 = 0.f, a2 = 0.f, a3 = 0.f;
#pragma unroll 1
  for (int bt = 0; bt < 2; ++bt) {
    float4 kb[17], vb[17];
#pragma unroll
    for (int u = 0; u < 17; ++u) {
      const int j = 4 * (bt * 17 + u) + G;
      const int jc = j < 128 ? j : 128;
      const int idx = L + t - dil * jc;
      const float* kp = ((idx < L) ? cache + (size_t)(b * L + idx) * 2048 : newkv + (size_t)(b * 8 + idx - L) * 2048) + coff + 512;
      kb[u] = *(const float4*)(kp - 512);
      vb[u] = *(const float4*)(kp + 512);
    }
    float scb[17];
    float bm = -INFINITY;
#pragma unroll
    for (int u = 0; u < 17; ++u) {
      const int j = 4 * (bt * 17 + u) + G;
      float sv = q0 * kb[u].x + q1 * kb[u].y + q2 * kb[u].z + q3 * kb[u].w;
      sv = sum16(sv);
      sv = (j <= 128) ? sv : -INFINITY;
      scb[u] = sv;
      bm = fmaxf(bm, sv);
    }
    const float mn = fmaxf(mx, bm);
    const float corr = __expf(mx - mn);
    sum *= corr; a0 *= corr; a1 *= corr; a2 *= corr; a3 *= corr;
#pragma unroll
    for (int u = 0; u < 17; ++u) {
      const float pe = __expf(scb[u] - mn);
      sum += pe;
      a0 += pe * vb[u].x; a1 += pe * vb[u].y; a2 += pe * vb[u].z; a3 += pe * vb[u].w;
    }
    mx = mn;
  }
  {
    float M = fmaxf(mx, __shfl_xor(mx, 16));
    M = fmaxf(M, __shfl_xor(M, 32));
    const float f = __expf(mx - M);
    sum *= f; a0 *= f; a1 *= f; a2 *= f; a3 *= f;
    mx = M;
  }
  sum += __shfl_xor(sum, 16); sum += __shfl_xor(sum, 32);
  a0 += __shfl_xor(a0, 16); a0 += __shfl_xor(a0, 32);
  a1 += __shfl_xor(a1, 16); a1 += __shfl_xor(a1, 32);
  a2 += __shfl_xor(a2, 16); a2 += __shfl_xor(a2, 32);
  a3 += __shfl_xor(a3, 16); a3 += __shfl_xor(a3, 32);
  const float inv = 1.f / sum;
  if (G == 0) {
    uint2 ov;
    ov.x = pack2(a0 * inv, a1 * inv);
    ov.y = pack2(a2 * inv, a3 * inv);
    *(uint2*)(p.OG + rowq * 3072 + g * 1024 + coff) = ov;
    if (l15 == 0) p.LSE[rowq * 48 + g * 16 + head] = mx + __logf(sum);
  }
}

DI int attn_item_of(int round) {
  if (gridDim.x != 256) return VBID + round * VGRID;
  const int x = blockIdx.x & 7, jj = (blockIdx.x >> 3) * 2 + (opaque_tid() >> 8);
  return ((round * 64 + (jj >> 3) * 8 + x) << 3) + (jj & 7);
}
DI void attn_prompt_stream(const Params& p, u16* smem) {
  constexpr int NP = 6144;
  int round = 0;
  int item = attn_item_of(0);
  PromptRegs R;
  if (item < NP) attn_prompt_load(p, item, R);
  while (item < NP) {
    attn_prompt_stage(R, smem);
    bf16x8 qc[2][2];
    qc[0][0] = R.q[0][0]; qc[0][1] = R.q[0][1]; qc[1][0] = R.q[1][0]; qc[1][1] = R.q[1][1];
    __syncthreads();
    const int next = attn_item_of(++round);
    if (next < NP) attn_prompt_load(p, next, R);
    attn_prompt_compute(p, item, qc, smem);
    __syncthreads();
    item = next;
  }
}
DI void phase_attn(const Params& p, u16* smem) {
  constexpr int NS = 3072;
  const bool sample_first = false;
  if (!sample_first) attn_prompt_stream(p, smem);
  for (int it = VBID; it < NS; it += VGRID) attn_sample_task(p, it * 4 + (VTID >> 6));
  if (sample_first) attn_prompt_stream(p, smem);
}

DI void conv_pass_task(const Params& p, int bt) {
  const int id = bt * 256 + VTID;
  const int ch = id % 384, seg = id / 384;
  const int col = ch * 8, row0 = seg * 8, t0 = row0 & 4095;
  const u16* src = p.XBC + (size_t)row0 * 3072 + col;
  uint4 raw[11];
#pragma unroll
  for (int j = 0; j < 3; ++j) {
    raw[j] = (uint4){0u, 0u, 0u, 0u};
    if (t0 > 0) raw[j] = *(const uint4*)(src - (ptrdiff_t)(3 - j) * 3072);
  }
#pragma unroll
  for (int j = 0; j < 8; ++j) raw[3 + j] = *(const uint4*)(src + (size_t)j * 3072);
  float wgt[4][8], bias[8];
#pragma unroll
  for (int j = 0; j < 4; ++j) {
    const float4 w0 = *(const float4*)(p.ssm_conv_w + j * 3072 + col), w1 = *(const float4*)(p.ssm_conv_w + j * 3072 + col + 4);
    wgt[j][0] = w0.x; wgt[j][1] = w0.y; wgt[j][2] = w0.z; wgt[j][3] = w0.w;
    wgt[j][4] = w1.x; wgt[j][5] = w1.y; wgt[j][6] = w1.z; wgt[j][7] = w1.w;
  }
  {
    const float4 b0 = *(const float4*)(p.ssm_conv_b + col), b1 = *(const float4*)(p.ssm_conv_b + col + 4);
    bias[0] = b0.x; bias[1] = b0.y; bias[2] = b0.z; bias[3] = b0.w;
    bias[4] = b1.x; bias[5] = b1.y; bias[6] = b1.z; bias[7] = b1.w;
  }
  float win[3][8];
  unpack8(raw[0], win[0]); unpack8(raw[1], win[1]); unpack8(raw[2], win[2]);
  u16* dst = p.XBCC + (size_t)row0 * 3072 + col;
#pragma unroll
  for (int i = 0; i < 8; ++i) {
    float cur[8], r[8];
    unpack8(raw[3 + i], cur);
#pragma unroll
    for (int e = 0; e < 8; ++e) {
      const float v = bias[e] + wgt[0][e] * win[0][e] + wgt[1][e] * win[1][e] + wgt[2][e] * win[2][e] + wgt[3][e] * cur[e];
      r[e] = silu_f(v);
      win[0][e] = win[1][e]; win[1][e] = win[2][e]; win[2][e] = cur[e];
    }
    *(uint4*)(dst + (size_t)i * 3072) = pack8(r);
  }
}

DI void acs_task(const Params& p, int bc) {
  const int lane = VTID & 63, head = lane & 31, half = lane >> 5;
  const float Aneg = -__expf(p.ssm_A_log[head]);
  const size_t rb = (size_t)bc * 128 + half * 64;
  float run = 0.f;
#pragma unroll 8
  for (int i = 0; i < 64; ++i) run += p.DT[(rb + i) * 32 + head] * Aneg;
  const float tot0 = __shfl(run, head);
  run = half ? tot0 : 0.f;
#pragma unroll 8
  for (int i = 0; i < 64; ++i) {
    run += p.DT[(rb + i) * 32 + head] * Aneg;
    p.ACS[(rb + i) * 32 + head] = run;
  }
}

DI void phase_convpass(const Params& p) {
  constexpr int NC = PROWS / 8 * 384 / 256;
  for (int it = VBID; it < NC + 32; it += VGRID) {
    if (it < NC) conv_pass_task(p, it);
    else acs_task(p, (it - NC) * 4 + (VTID >> 6));
  }
}

constexpr int SS_B = 0;
constexpr int SS_R2 = 34816;
constexpr int SS_H = 34816 + 18432;
constexpr int SS_F = 70656;

DI void ssd_states_item(const Params& p, int item, char* smem_raw) {
  const int tid = VTID, lane = tid & 63, w = tid >> 6, l15 = lane & 15, G = lane >> 4;
  const int head = item & 31, c = (item >> 5) & 31, b = item >> 10, g = head >> 3;
  u16* Bs = (u16*)(smem_raw + SS_B);
  u16* Xs = (u16*)(smem_raw + SS_R2);
  const size_t row0 = (size_t)b * 4096 + c * 128;
  const float a_end = p.ACS[(row0 + 127) * 32 + head];
#pragma unroll
  for (int i = 0; i < 4; ++i) {
    const int row = (tid >> 3) + 32 * i, ch = tid & 7;
    const float wl = p.DT[(row0 + row) * 32 + head] * __expf(a_end - p.ACS[(row0 + row) * 32 + head]);
    const uint4 v = *(const uint4*)(p.XBCC + (row0 + row) * 3072 + head * 64 + ch * 8);
    uint4 o;
    o.x = pack2(lo_f(v.x) * wl, hi_f(v.x) * wl); o.y = pack2(lo_f(v.y) * wl, hi_f(v.y) * wl);
    o.z = pack2(lo_f(v.z) * wl, hi_f(v.z) * wl); o.w = pack2(lo_f(v.w) * wl, hi_f(v.w) * wl);
    *(uint4*)(Xs + row * LDT + ch * 8) = o;
  }
#pragma unroll
  for (int i = 0; i < 8; ++i) {
    const int idx = tid + 256 * i, row = idx >> 4, ch = idx & 15;
    *(uint4*)(Bs + row * LDW + ch * 8) = *(const uint4*)(p.XBCC + (row0 + row) * 3072 + 2048 + g * 128 + ch * 8);
  }
  __syncthreads();
  f32x4 acc[4][2];
#pragma unroll
  for (int m = 0; m < 4; ++m) { acc[m][0] = (f32x4){0.f, 0.f, 0.f, 0.f}; acc[m][1] = (f32x4){0.f, 0.f, 0.f, 0.f}; }
#pragma unroll
  for (int k = 0; k < 4; ++k) {
    const int rowA = 32 * k + 8 * G + (l15 >> 2);
    bf16x8 a[4], bb[2];
#pragma unroll
    for (int m = 0; m < 4; ++m) {
      const u16* ap = Xs + rowA * LDT + 16 * m + (l15 & 3) * 4;
      a[m] = cat4(tr_read(ap), tr_read(ap + 4 * LDT));
    }
#pragma unroll
    for (int nn = 0; nn < 2; ++nn) {
      const u16* bp = Bs + rowA * LDW + 32 * w + 16 * nn + (l15 & 3) * 4;
      bb[nn] = cat4(tr_read(bp), tr_read(bp + 4 * LDW));
    }
#pragma unroll
    for (int m = 0; m < 4; ++m)
#pragma unroll
      for (int nn = 0; nn < 2; ++nn) acc[m][nn] = MFMA16(a[m], bb[nn], acc[m][nn]);
  }
  u16* sp = p.STATES + (size_t)item * 64 * 128;
#pragma unroll
  for (int m = 0; m < 4; ++m)
#pragma unroll
    for (int nn = 0; nn < 2; ++nn)
#pragma unroll
      for (int j = 0; j < 4; ++j) sp[(16 * m + 4 * G + j) * 128 + 32 * w + 16 * nn + l15] = f2bf(acc[m][nn][j]);
  if (tid == 0) p.CD[item] = __expf(a_end);
  __syncthreads();
}

DI void ssm_sample_item(const Params& p, int item, char* smem_raw) {
  const int tid = VTID;
  const int head = item & 31, b = item >> 5, g = head >> 3;
  float* sx = (float*)smem_raw;
  float* sB = sx + 512;
  float* sC = sB + 1024;
  float* sdt = sC + 1024;
  float* sdA = sdt + 8;
  float* sy2 = sdA + 8;
  const size_t row0 = (size_t)PROWS + b * 8;
  const float Aneg = -__expf(p.ssm_A_log[head]);
  for (int task = tid; task < 320; task += 256) {
    int col; float* dst;
    if (task < 64) { col = head * 64 + task; dst = sx + task; }
    else if (task < 192) { col = 2048 + g * 128 + (task - 64); dst = sB + (task - 64); }
    else { col = 2560 + g * 128 + (task - 192); dst = sC + (task - 192); }
    const int dstride = (task < 64) ? 64 : 128;
    const float w0 = p.ssm_conv_w[col], w1 = p.ssm_conv_w[3072 + col], w2 = p.ssm_conv_w[2 * 3072 + col], w3 = p.ssm_conv_w[3 * 3072 + col];
    const float bias = p.ssm_conv_b[col];
    float x0 = p.state_conv[(size_t)(b * 3 + 0) * 3072 + col];
    float x1 = p.state_conv[(size_t)(b * 3 + 1) * 3072 + col];
    float x2 = p.state_conv[(size_t)(b * 3 + 2) * 3072 + col];
#pragma unroll
    for (int t = 0; t < 8; ++t) {
      const float cur = bf2f(p.XBC[(row0 + t) * 3072 + col]);
      const float v = bias + w0 * x0 + w1 * x1 + w2 * x2 + w3 * cur;
      dst[t * dstride] = silu_f(v);
      x0 = x1; x1 = x2; x2 = cur;
    }
  }
  if (tid < 8) {
    const float dt = p.DT[(row0 + tid) * 32 + head];
    sdt[tid] = dt;
    sdA[tid] = __expf(dt * Aneg);
  }
  __syncthreads();
  const int pp = tid >> 2, nq = tid & 3;
  const size_t sbase = ((size_t)(b * 32 + head) * 64 + pp) * 128 + nq * 4;
  float4 h[8];
#pragma unroll
  for (int i = 0; i < 8; ++i) h[i] = *(const float4*)(p.state_ssm + sbase + i * 16);
  const float Dh = p.ssm_D[head];
#pragma unroll 1
  for (int t = 0; t < 8; ++t) {
    const float dA = sdA[t];
    const float xv = sx[t * 64 + pp];
    const float dtx = sdt[t] * xv;
    float y = 0.f;
#pragma unroll
    for (int i = 0; i < 8; ++i) {
      const float4 Bv = *(const float4*)(sB + t * 128 + i * 16 + nq * 4);
      const float4 Cv = *(const float4*)(sC + t * 128 + i * 16 + nq * 4);
      h[i].x = h[i].x * dA + dtx * Bv.x; h[i].y = h[i].y * dA + dtx * Bv.y;
      h[i].z = h[i].z * dA + dtx * Bv.z; h[i].w = h[i].w * dA + dtx * Bv.w;
      y += h[i].x * Cv.x + h[i].y * Cv.y + h[i].z * Cv.z + h[i].w * Cv.w;
    }
    y = sum4(y);
    if (nq == 0) {
      const float z = bf2f(p.Z[(row0 + t) * 2048 + head * 64 + pp]);
      const float yg = (y + Dh * xv) * silu_f(z);
      p.YG[(row0 + t) * 2048 + head * 64 + pp] = f2bf(yg);
      sy2[t * 64 + pp] = yg * yg;
    }
  }
  float* od = p.out + O_SSMS + sbase;
#pragma unroll
  for (int i = 0; i < 8; ++i) *(float4*)(od + i * 16) = h[i];
  __syncthreads();
  if (tid < 8) {
    float s = 0.f;
    for (int i = 0; i < 64; ++i) s += sy2[tid * 64 + i];
    p.SSQ[(row0 + tid) * 32 + head] = s;
  }
  __syncthreads();
}

DI int ssd_item_of(int round) {
  const int x = blockIdx.x & 7, jj = (blockIdx.x >> 3) * 2 + (opaque_tid() >> 8);
  return ((round * 64 + (jj >> 3) * 8 + x) << 3) + (jj & 7);
}
DI void phase_states(const Params& p, char* smem_raw) {
  constexpr int NP = 4096, NS = 1024;
  for (int it = VBID; it < NS; it += VGRID) ssm_sample_item(p, it, smem_raw);
  if (gridDim.x == 256) { for (int r = 0; r < 8; ++r) ssd_states_item(p, ssd_item_of(r), smem_raw); }
  else for (int it = VBID; it < NP; it += VGRID) ssd_states_item(p, it, smem_raw);
}

DI void phase_scan(const Params& p) {
  for (int task = VBID * 256 + VTID; task < 131072; task += VGRID * 256) {
    const int n8 = task & 15, pp = (task >> 4) & 63, head = (task >> 10) & 31, b = task >> 15;
    float h[8];
#pragma unroll
    for (int e = 0; e < 8; ++e) h[e] = 0.f;
#pragma unroll 8
    for (int c = 0; c < 32; ++c) {
      const int item = (b * 32 + c) * 32 + head;
      uint4* sp = (uint4*)(p.STATES + ((size_t)item * 64 + pp) * 128 + n8 * 8);
      const uint4 sv = *sp;
      const float d = p.CD[item];
      *sp = pack8(h);
      float sf[8];
      unpack8(sv, sf);
#pragma unroll
      for (int e = 0; e < 8; ++e) h[e] = h[e] * d + sf[e];
    }
    float* od = p.out + O_SSMP + ((size_t)(b * 32 + head) * 64 + pp) * 128 + n8 * 8;
    *(float4*)od = (float4){h[0], h[1], h[2], h[3]};
    *(float4*)(od + 4) = (float4){h[4], h[5], h[6], h[7]};
  }
}

DI void ssd_out_item(const Params& p, int item, char* smem_raw) {
  const int tid = VTID, lane = tid & 63, w = tid >> 6, l15 = lane & 15, G = lane >> 4;
  const int head = item & 31, c = (item >> 5) & 31, b = item >> 10, g = head >> 3;
  u16* Bs = (u16*)(smem_raw + SS_B);
  u16* Xs = (u16*)(smem_raw + SS_R2);
  u16* Hs = (u16*)(smem_raw + SS_H);
  float* s_acs = (float*)(smem_raw + SS_F);
  float* s_dt = s_acs + 128;
  const size_t row0 = (size_t)b * 4096 + c * 128;
  if (tid < 128) {
    s_acs[tid] = p.ACS[(row0 + tid) * 32 + head];
    s_dt[tid] = p.DT[(row0 + tid) * 32 + head];
  }
#pragma unroll
  for (int i = 0; i < 8; ++i) {
    const int idx = tid + 256 * i, row = idx >> 4, ch = idx & 15;
    *(uint4*)(Bs + row * LDW + ch * 8) = *(const uint4*)(p.XBCC + (row0 + row) * 3072 + 2048 + g * 128 + ch * 8);
  }
#pragma unroll
  for (int i = 0; i < 4; ++i) {
    const int row = (tid >> 3) + 32 * i, ch = tid & 7;
    *(uint4*)(Xs + row * LDT + ch * 8) = *(const uint4*)(p.XBCC + (row0 + row) * 3072 + head * 64 + ch * 8);
  }
  {
    const u16* hp = p.STATES + (size_t)item * 64 * 128;
#pragma unroll
    for (int i = 0; i < 4; ++i) {
      const int idx = tid + 256 * i, pp = idx >> 4, ch = idx & 15;
      *(uint4*)(Hs + pp * LDW + ch * 8) = *(const uint4*)(hp + pp * 128 + ch * 8);
    }
  }
  bf16x8 cf[2][4];
#pragma unroll
  for (int sub = 0; sub < 2; ++sub)
#pragma unroll
    for (int ks = 0; ks < 4; ++ks)
      cf[sub][ks] = *(const bf16x8*)(p.XBCC + (row0 + w * 32 + sub * 16 + l15) * 3072 + 2560 + g * 128 + ks * 32 + G * 8);
  uint2 zpre[2][4];
#pragma unroll
  for (int sub = 0; sub < 2; ++sub)
#pragma unroll
    for (int m = 0; m < 4; ++m)
      zpre[sub][m] = *(const uint2*)(p.Z + (row0 + w * 32 + sub * 16 + l15) * 2048 + head * 64 + 16 * m + 4 * G);
  __syncthreads();
  const float Dh = p.ssm_D[head];
#pragma unroll
  for (int sub = 0; sub < 2; ++sub) {
    const int l0 = w * 32 + sub * 16, lq = l0 + l15;
    const float acs_q = s_acs[lq];
    f32x4 yo[4];
#pragma unroll
    for (int m = 0; m < 4; ++m) {
      f32x4 z = {0.f, 0.f, 0.f, 0.f};
#pragma unroll
      for (int ks = 0; ks < 4; ++ks) z = MFMA16(*(const bf16x8*)(Hs + (16 * m + l15) * LDW + ks * 32 + G * 8), cf[sub][ks], z);
      yo[m] = z;
    }
    {
      const float ea = __expf(acs_q);
#pragma unroll
      for (int m = 0; m < 4; ++m) { yo[m][0] *= ea; yo[m][1] *= ea; yo[m][2] *= ea; yo[m][3] *= ea; }
    }
    const int ns = (l0 >> 4) + 1, nsteps = (ns + 1) >> 1;
#pragma unroll 1
    for (int step = 0; step < nsteps; ++step) {
      unsigned pw[4];
#pragma unroll
      for (int h2 = 0; h2 < 2; ++h2) {
        const int ss = 2 * step + h2;
        f32x4 st = {0.f, 0.f, 0.f, 0.f};
#pragma unroll
        for (int ks = 0; ks < 4; ++ks) st = MFMA16(*(const bf16x8*)(Bs + (16 * ss + l15) * LDW + ks * 32 + G * 8), cf[sub][ks], st);
        float mv[4];
#pragma unroll
        for (int j = 0; j < 4; ++j) {
          const int s = 16 * ss + 4 * G + j;
          const float dec = __expf(fminf(acs_q - s_acs[s], 0.f)) * s_dt[s];
          mv[j] = (s <= lq) ? st[j] * dec : 0.f;
        }
        pw[2 * h2] = pack2(mv[0], mv[1]);
        pw[2 * h2 + 1] = pack2(mv[2], mv[3]);
      }
      const bf16x8 pb = words_to_frag(pw[0], pw[1], pw[2], pw[3]);
      const u16* xa = Xs + (32 * step + 4 * G + (l15 >> 2)) * LDT + (l15 & 3) * 4;
#pragma unroll
      for (int m = 0; m < 4; ++m) yo[m] = MFMA16(cat4(tr_read(xa + 16 * m), tr_read(xa + 16 * LDT + 16 * m)), pb, yo[m]);
    }
    const size_t rowg = (size_t)b * 4096 + c * 128 + lq;
    float ssq = 0.f;
#pragma unroll
    for (int m = 0; m < 4; ++m) {
      const uint2 xv = *(const uint2*)(Xs + lq * LDT + 16 * m + 4 * G);
      const uint2 zv = zpre[sub][m];
      const float xf[4] = {lo_f(xv.x), hi_f(xv.x), lo_f(xv.y), hi_f(xv.y)};
      const float zf[4] = {lo_f(zv.x), hi_f(zv.x), lo_f(zv.y), hi_f(zv.y)};
      float y[4];
#pragma unroll
      for (int j = 0; j < 4; ++j) {
        y[j] = (yo[m][j] + Dh * xf[j]) * silu_f(zf[j]);
        ssq += y[j] * y[j];
      }
      uint2 ov; ov.x = pack2(y[0], y[1]); ov.y = pack2(y[2], y[3]);
      *(uint2*)(p.YG + rowg * 2048 + head * 64 + 16 * m + 4 * G) = ov;
    }
    ssq += __shfl_xor(ssq, 16);
    ssq += __shfl_xor(ssq, 32);
    if (G == 0) p.SSQ[rowg * 32 + head] = ssq;
  }
  __syncthreads();
}

DI void idle_transposes(const Params& p, int idle_idx, int n_idle, int first, int count, u16* smem) {
  const int vb = idle_idx * 2 + (opaque_tid() >> 8), vg = n_idle * 2;
  for (int it = vb; it < count; it += vg) late_transpose_task(p, first + it, smem);
}

#define XB_TMO      128
#define XB_XCNT(j)  (256  + 64 * (j))
#define XB_XSUB(j)  (1280 + 64 * (j))
#define XB_XGEN(j)  (2304 + 64 * (j))
#define XB_TOP      3328
#define XB_TOPGEN   3392
#define XCD_BAR_WORDS 3456
#define XB_SPIN_CAP (1u << 20)
#define LAS __attribute__((address_space(3)))
DI unsigned xb_ld(unsigned* p) { return __hip_atomic_load(p, __ATOMIC_RELAXED, __HIP_MEMORY_SCOPE_AGENT); }
DI unsigned xb_add(unsigned* p, unsigned v) { return __hip_atomic_fetch_add(p, v, __ATOMIC_RELAXED, __HIP_MEMORY_SCOPE_AGENT); }
DI unsigned xb_xcc_id() { return (unsigned)__builtin_amdgcn_s_getreg((3 << 11) | 20) & 0xFu; }
#define XB_SPIN(cond, bar) do { unsigned _sp = 0; while (cond) { __builtin_amdgcn_s_sleep(1); \
    if ((++_sp & 255u) == 0u) { if (xb_ld(&(bar)[XB_TMO])) break; if (_sp > XB_SPIN_CAP) { atomicAdd(&(bar)[XB_TMO], 1u); break; } } } } while (0)
struct XcdBarrier { unsigned* bar; unsigned x; volatile LAS unsigned* st; };
DI XcdBarrier xcd_barrier_post(unsigned* bar, volatile LAS unsigned* st) {
  XcdBarrier b; b.bar = bar; b.x = xb_xcc_id(); b.st = st;
  if (threadIdx.x == 0) (void)xb_add(&bar[XB_XCNT(b.x)], 1u);
  return b;
}
DI void xcd_barrier_complete(unsigned* bar, unsigned x, unsigned& nloc, unsigned& nx) {
  const unsigned Gn = gridDim.x * gridDim.y * gridDim.z;
  unsigned sum, cnt, mine, sp = 0u;
  for (;;) {
    sum = 0u; cnt = 0u; mine = 0u;
#pragma unroll
    for (unsigned j = 0; j < 16; ++j) { const unsigned c = xb_ld(&bar[XB_XCNT(j)]); sum += c; cnt += (c > 0u) ? 1u : 0u; mine = (j == x) ? c : mine; }
    if (sum == Gn) break;
    __builtin_amdgcn_s_sleep(1);
    if ((++sp & 255u) == 0u) { if (xb_ld(&bar[XB_TMO])) break; if (sp > XB_SPIN_CAP) { atomicAdd(&bar[XB_TMO], 1u); break; } }
  }
  nloc = mine > 0u ? mine : 1u; nx = cnt > 0u ? cnt : 1u;
}
DI void xcd_barrier(const XcdBarrier& b) {
  asm volatile("s_waitcnt vmcnt(0)" ::: "memory");
  __syncthreads();
  if (threadIdx.x == 0) {
    unsigned* bar = b.bar;
    __builtin_amdgcn_s_waitcnt(0);
    unsigned nloc = b.st[0], nx = b.st[1];
    if (nloc == 0u) { xcd_barrier_complete(bar, b.x, nloc, nx); b.st[0] = nloc; b.st[1] = nx; }
    const unsigned old = xb_add(&bar[XB_XSUB(b.x)], 1u);
    const unsigned gen = old / nloc;
    if (old + 1u == (gen + 1u) * nloc) {
      __builtin_amdgcn_fence(__ATOMIC_RELEASE, "agent");
      asm volatile("s_waitcnt vmcnt(0)" ::: "memory");
      const unsigned og = xb_add(&bar[XB_TOP], 1u);
      const unsigned tg = og / nx;
      if (og + 1u == (tg + 1u) * nx) xb_add(&bar[XB_TOPGEN], 1u);
      else XB_SPIN(xb_ld(&bar[XB_TOPGEN]) == tg, bar);
      __builtin_amdgcn_fence(__ATOMIC_ACQUIRE, "agent");
      xb_add(&bar[XB_XGEN(b.x)], 1u);
      asm volatile("s_waitcnt vmcnt(0)" ::: "memory");
    } else {
      XB_SPIN(xb_ld(&bar[XB_XGEN(b.x)]) == gen, bar);
      __builtin_amdgcn_fence(__ATOMIC_ACQUIRE, "agent");
      asm volatile("s_waitcnt vmcnt(0)" ::: "memory");
    }
  }
  __syncthreads();
}

constexpr int NPHASE = 13;
#ifndef PH_MASK
#define PH_MASK 0x1fff
#endif
#define PH_ON(k) (((PH_MASK) >> (k)) & 1)
#ifndef PH_REPEAT
#define PH_REPEAT 0
#endif
#define PH_REP(k) (((PH_REPEAT) >> (k)) & 1)

template <bool COOP>
__global__ void __launch_bounds__(512, 2) mega(Params p, int ph0, int ph1) {
  extern __shared__ __attribute__((aligned(16))) char smem_all[];
  char* smem_raw = smem_all + (threadIdx.x >> 8) * LDS_HALF;
  u16* smem = (u16*)smem_raw;
#define PHASE_BODY(k)                                                                                                   \
  do {                                                                                                                  \
    if (k == 0) { if (PH_ON(0)) phase_prep(p, smem); }                                                                  \
    else if (k == 1) { if (PH_ON(1)) { gemm_phase_big(p.H, p.Wt1, 1024, MROWS / 256, ATT_IN / 256, Ep1{p}, smem_all); \
      const int x_ = blockIdx.x & 7, j_ = blockIdx.x >> 3; const bool busy_ = (x_ == 0) || (x_ == 1 && j_ < 8); \
      if (gridDim.x != 256) idle_transposes(p, blockIdx.x, gridDim.x, 0, TR2 + TR3, smem); \
      else if (!busy_) idle_transposes(p, (x_ >= 2) ? (x_ - 2) * 32 + j_ : 192 + (j_ - 8), 216, 0, TR2 + TR3, smem); } }  \
    else if (k == 2) { if (PH_ON(2)) phase_attn(p, smem); }                                                             \
    else if (k == 3) { if (PH_ON(3)) phase_merge(p); }                                                                  \
    else if (k == 4) { if (PH_ON(4)) { gemm_phase_big(p.H, p.Wt2, 1024, PROWS / 256, 4, Ep2{p}, smem_all); \
      gemm_sample_splitk(p.H, p.Wt2, 1024, 4, 4, EpAtomic{p.X1}, smem_all); \
      if (gridDim.x != 256) idle_transposes(p, blockIdx.x, gridDim.x, TR2 + TR3, TR4, smem); \
      else if (blockIdx.x >= 16) idle_transposes(p, blockIdx.x - 16, 240, TR2 + TR3, TR4, smem); } } \
    else if (k == 5) { if (PH_ON(5)) phase_norm2(p); }                                                                  \
    else if (k == 6) { if (PH_ON(6)) gemm_phase_big(p.H, p.Wt3, 1024, MROWS / 256, SSM_IN_PAD / 256, Ep3{p}, smem_all); } \
    else if (k == 7) { if (PH_ON(7)) phase_convpass(p); }                                                               \
    else if (k == 8) { if (PH_ON(8)) phase_states(p, smem_raw); }                                                       \
    else if (k == 9) { if (PH_ON(9)) phase_scan(p); }                                                                   \
    else if (k == 10) { if (PH_ON(10)) { if (gridDim.x == 256) { for (int r = 0; r < 8; ++r) ssd_out_item(p, ssd_item_of(r), smem_raw); } \
      else for (int it = VBID; it < 4096; it += VGRID) ssd_out_item(p, it, smem_raw); } } \
    else if (k == 11) { if (PH_ON(11)) phase_gatenorm(p); }                                                             \
    else if (k == 12) { if (PH_ON(12)) { gemm_phase_big(p.YG, p.Wt4, 2048, PROWS / 256, 4, Ep4{p}, smem_all); \
      gemm_sample_splitk(p.YG, p.Wt4, 2048, 4, 8, EpAtomic{p.out + O_Y}, smem_all); } }          \
  } while (0)
#define PHASE_STEP(k) PHASE_BODY(k); if (PH_REP(k)) { xcd_barrier(xb); PHASE_BODY(k); }
  if constexpr (COOP) {
    volatile LAS unsigned* xst = (volatile LAS unsigned*)(smem_all + LDS_MAIN);
    if (threadIdx.x == 0) { xst[0] = 0u; xst[1] = 0u; }
    __syncthreads();
    const XcdBarrier xb = xcd_barrier_post(p.bar, xst);
    if (ph0 == 0x7fffffff) cg::this_grid().sync();
    PHASE_STEP(0) xcd_barrier(xb);
    PHASE_STEP(1) xcd_barrier(xb);
    PHASE_STEP(2) xcd_barrier(xb);
    PHASE_STEP(3) xcd_barrier(xb);
    PHASE_STEP(4) xcd_barrier(xb);
    PHASE_STEP(5) xcd_barrier(xb);
    PHASE_STEP(6) xcd_barrier(xb);
    PHASE_STEP(7) xcd_barrier(xb);
    PHASE_STEP(8) xcd_barrier(xb);
    PHASE_STEP(9) xcd_barrier(xb);
    PHASE_STEP(10) xcd_barrier(xb);
    PHASE_STEP(11) xcd_barrier(xb);
    PHASE_STEP(12)
  } else {
    switch (ph0) {
      case 0: PHASE_BODY(0); break;
      case 1: PHASE_BODY(1); break;
      case 2: PHASE_BODY(2); break;
      case 3: PHASE_BODY(3); break;
      case 4: PHASE_BODY(4); break;
      case 5: PHASE_BODY(5); break;
      case 6: PHASE_BODY(6); break;
      case 7: PHASE_BODY(7); break;
      case 8: PHASE_BODY(8); break;
      case 9: PHASE_BODY(9); break;
      case 10: PHASE_BODY(10); break;
      case 11: PHASE_BODY(11); break;
      case 12: PHASE_BODY(12); break;
    }
  }
}

#ifndef MULTI_LAUNCH
#define MULTI_LAUNCH 0
#endif

extern "C" void kernel_launch(void* const* d_in, const int* in_sizes, int n_in, void* d_out, int out_size, void* d_ws, size_t ws_size,
                              hipStream_t stream) {
  static int grid = 0;
  size_t off = 0;
  auto carve = [&](size_t bytes) { size_t o = off; off += (bytes + 255) & ~(size_t)255; return (char*)d_ws + o; };
  Params p{};
  p.x_prompt = (const float*)d_in[0]; p.x_sample = (const float*)d_in[1];
  p.cache0 = (const float*)d_in[2]; p.cache1 = (const float*)d_in[3]; p.cache2 = (const float*)d_in[4];
  p.state_conv = (const float*)d_in[5]; p.state_ssm = (const float*)d_in[6];
  p.attn_norm = (const float*)d_in[7]; p.attn_w_in = (const float*)d_in[8]; p.attn_q_gain = (const float*)d_in[9];
  p.attn_k_gain = (const float*)d_in[10]; p.attn_w_out = (const float*)d_in[11];
  p.ssm_norm = (const float*)d_in[12]; p.ssm_w_in = (const float*)d_in[13]; p.ssm_conv_w = (const float*)d_in[14];
  p.ssm_conv_b = (const float*)d_in[15]; p.ssm_dt_bias = (const float*)d_in[16]; p.ssm_A_log = (const float*)d_in[17];
  p.ssm_D = (const float*)d_in[18]; p.ssm_gate_norm = (const float*)d_in[19]; p.ssm_w_out = (const float*)d_in[20];
  p.out = (float*)d_out;
  p.Wt1 = (u16*)carve((size_t)ATT_IN * 1024 * 2);
  p.Wt2 = (u16*)carve((size_t)1024 * 1024 * 2);
  p.Wt3 = (u16*)carve((size_t)SSM_IN_PAD * 1024 * 2);
  p.Wt4 = (u16*)carve((size_t)1024 * 2048 * 2);
  p.H = (u16*)carve((size_t)MROWS * 1024 * 2);
  p.QKVG = (u16*)carve((size_t)MROWS * ATT_IN * 2);
  p.OG = (u16*)carve((size_t)MROWS * 3072 * 2);
  p.Z = (u16*)carve((size_t)MROWS * 2048 * 2);
  p.XBC = (u16*)carve((size_t)MROWS * 3072 * 2);
  p.YG = (u16*)carve((size_t)MROWS * 2048 * 2);
  p.LSE = (float*)carve((size_t)MROWS * 48 * 4);
  p.X1 = (float*)carve((size_t)MROWS * 1024 * 4);
  p.DT = (float*)carve((size_t)MROWS * 32 * 4);
  p.STATES = (u16*)carve((size_t)4 * 32 * 32 * 64 * 128 * 2);
  p.XBCC = (u16*)carve((size_t)PROWS * 3072 * 2);
  p.ACS = (float*)carve((size_t)PROWS * 32 * 4);
  p.bar = (unsigned*)carve((size_t)XCD_BAR_WORDS * 4);
  p.QKVH = (u16*)carve((size_t)4 * 3 * 3 * 16 * 4096 * 64 * 2);
  p.SSQ = (float*)carve((size_t)MROWS * 32 * 4);
  p.CD = (float*)carve((size_t)4 * 32 * 32 * 4);
  if (grid == 0) {
    if (n_in != 21 || (size_t)out_size != O_END || ws_size < off) {
      fprintf(stderr, "kernel_launch: unexpected shapes: n_in %d out %d (want %zu) ws %zu (need %zu)\n", n_in, out_size, (size_t)O_END, ws_size, off);
      grid = -1; return;
    }
    int dev = 0, cus = 0, per_cu = 0;
    hipGetDevice(&dev);
    hipDeviceGetAttribute(&cus, hipDeviceAttributeMultiprocessorCount, dev);
    hipFuncSetAttribute((const void*)mega<true>, hipFuncAttributeMaxDynamicSharedMemorySize, LDS_BYTES);
    hipFuncSetAttribute((const void*)mega<false>, hipFuncAttributeMaxDynamicSharedMemorySize, LDS_BYTES);
    hipOccupancyMaxActiveBlocksPerMultiprocessor(&per_cu, (const void*)mega<true>, 512, LDS_BYTES);
    if (per_cu < 1) { fprintf(stderr, "kernel_launch: occupancy query returned %d\n", per_cu); grid = -1; return; }
    if (per_cu > 1) per_cu = 1;
    grid = cus * per_cu;
    grid &= ~7;
  }
  if (grid < 0) return;
#if MULTI_LAUNCH
  for (int ph = 0; ph < NPHASE; ++ph) hipLaunchKernelGGL(mega<false>, dim3(grid), dim3(512), LDS_BYTES, stream, p, ph, ph + 1);
#else
  hipMemsetAsync(p.bar, 0, (size_t)XCD_BAR_WORDS * 4, stream);
  int ph0 = 0, ph1 = NPHASE;
  void* args[] = {&p, &ph0, &ph1};
  hipError_t e = hipLaunchCooperativeKernel((const void*)mega<true>, dim3(grid), dim3(512), args, LDS_BYTES, stream);
  if (e != hipSuccess) fprintf(stderr, "cooperative launch failed: %s (grid %d)\n", hipGetErrorString(e), grid);
#endif
}
```

```cpp
#include <hip/hip_runtime.h>
#include <hip/hip_cooperative_groups.h>
#include <cstdio>
#include <cstdint>
namespace cg = cooperative_groups;

typedef unsigned short u16;
typedef short bf16x8 __attribute__((ext_vector_type(8)));
typedef short s16x4 __attribute__((ext_vector_type(4)));
typedef float f32x4 __attribute__((ext_vector_type(4)));

#define DI __device__ __forceinline__
__device__ __forceinline__ int opaque_tid() { int t = threadIdx.x; asm volatile("" : "+v"(t)); return t; }
#define VTID (opaque_tid() & 255)
#define VBID ((int)(blockIdx.x * 2 + (opaque_tid() >> 8)))
#define VGRID ((int)(gridDim.x * 2))
#define MFMA16(a, b, c) __builtin_amdgcn_mfma_f32_16x16x32_bf16((a), (b), (c), 0, 0, 0)

constexpr int MROWS = 16384 + 256;
constexpr int PROWS = 16384;
constexpr int ATT_IN = 10240;
constexpr int SSM_IN = 5152;
constexpr int SSM_IN_PAD = 5376;
constexpr int LDS_HALF = 73728;
constexpr int LDS_MAIN = 2 * LDS_HALF;
constexpr int LDS_BYTES = LDS_MAIN + 16;
constexpr int LDT = 72;
constexpr int LDW = 136;
constexpr int TILE_ELEMS = 128 * LDT;

constexpr size_t O_Y = 0;
constexpr size_t O_KVP0 = (size_t)MROWS * 1024;
constexpr size_t O_KVP1 = O_KVP0 + (size_t)4 * 128 * 2048;
constexpr size_t O_KVP2 = O_KVP1 + (size_t)4 * 512 * 2048;
constexpr size_t O_KVS0 = O_KVP2 + (size_t)4 * 2048 * 2048;
constexpr size_t O_KVS1 = O_KVS0 + (size_t)256 * 2048;
constexpr size_t O_KVS2 = O_KVS1 + (size_t)256 * 2048;
constexpr size_t O_CONVP = O_KVS2 + (size_t)256 * 2048;
constexpr size_t O_CONVS = O_CONVP + (size_t)4 * 3 * 3072;
constexpr size_t O_SSMP = O_CONVS + (size_t)32 * 3 * 3072;
constexpr size_t O_SSMS = O_SSMP + (size_t)4 * 32 * 64 * 128;
constexpr size_t O_END = O_SSMS + (size_t)32 * 32 * 64 * 128;

struct Params {
  const float *x_prompt, *x_sample, *cache0, *cache1, *cache2, *state_conv, *state_ssm;
  const float *attn_norm, *attn_w_in, *attn_q_gain, *attn_k_gain, *attn_w_out;
  const float *ssm_norm, *ssm_w_in, *ssm_conv_w, *ssm_conv_b, *ssm_dt_bias, *ssm_A_log, *ssm_D, *ssm_gate_norm, *ssm_w_out;
  float* out;
  u16 *Wt1, *Wt2, *Wt3, *Wt4, *H, *QKVG, *OG, *Z, *XBC, *YG, *XBCC, *STATES, *QKVH;
  float *LSE, *X1, *DT, *SSQ, *CD, *ACS;
  unsigned* bar;
};

typedef __bf16 bf16v2 __attribute__((ext_vector_type(2)));
DI u16 f2bf(float x) { return __builtin_bit_cast(u16, (__bf16)x); }
DI float bf2f(u16 h) { return __uint_as_float(((unsigned)h) << 16); }
DI unsigned pack2(float a, float b) { bf16v2 v; v[0] = (__bf16)a; v[1] = (__bf16)b; return __builtin_bit_cast(unsigned, v); }
DI float lo_f(unsigned w) { return __uint_as_float(w << 16); }
DI float hi_f(unsigned w) { return __uint_as_float(w & 0xffff0000u); }
DI void unpack8(const uint4& v, float* f) {
  f[0] = lo_f(v.x); f[1] = hi_f(v.x); f[2] = lo_f(v.y); f[3] = hi_f(v.y);
  f[4] = lo_f(v.z); f[5] = hi_f(v.z); f[6] = lo_f(v.w); f[7] = hi_f(v.w);
}
DI uint4 pack8(const float* f) {
  uint4 v; v.x = pack2(f[0], f[1]); v.y = pack2(f[2], f[3]); v.z = pack2(f[4], f[5]); v.w = pack2(f[6], f[7]); return v;
}
DI float sum16(float v) {
  v += __builtin_bit_cast(float, __builtin_amdgcn_update_dpp(0, __builtin_bit_cast(int, v), 0xB1, 0xf, 0xf, true));
  v += __builtin_bit_cast(float, __builtin_amdgcn_update_dpp(0, __builtin_bit_cast(int, v), 0x4E, 0xf, 0xf, true));
  v += __builtin_bit_cast(float, __builtin_amdgcn_update_dpp(0, __builtin_bit_cast(int, v), 0x141, 0xf, 0xf, true));
  v += __builtin_bit_cast(float, __builtin_amdgcn_update_dpp(0, __builtin_bit_cast(int, v), 0x140, 0xf, 0xf, true));
  return v;
}
DI float sum4(float v) {
  v += __builtin_bit_cast(float, __builtin_amdgcn_update_dpp(0, __builtin_bit_cast(int, v), 0xB1, 0xf, 0xf, true));
  v += __builtin_bit_cast(float, __builtin_amdgcn_update_dpp(0, __builtin_bit_cast(int, v), 0x4E, 0xf, 0xf, true));
  return v;
}
DI float silu_f(float x) { return x / (1.f + __expf(-x)); }
DI s16x4 tr_read(const u16* ptr) {
  return __builtin_amdgcn_ds_read_tr16_b64_v4i16((s16x4 __attribute__((address_space(3)))*)(ptr));
}
DI bf16x8 cat4(s16x4 lo, s16x4 hi) { return __builtin_shufflevector(lo, hi, 0, 1, 2, 3, 4, 5, 6, 7); }
DI bf16x8 words_to_frag(unsigned a, unsigned b, unsigned c, unsigned d) {
  uint4 v; v.x = a; v.y = b; v.z = c; v.w = d; return __builtin_bit_cast(bf16x8, v);
}

constexpr int G8_HT = 128 * 64;
DI int g8_lds_byte(int r, int c) {
  const int st = (r >> 4) * 2 + (c >> 5), rr = r & 15, cc = c & 31, ob = rr * 64 + cc * 2;
  return st * 1024 + (ob ^ (((ob >> 9) & 1) << 5));
}
DI void g8_stage_rc(int b, int& R, int& C) {
  const int st = b / 1024, sb = b % 1024, swz = sb ^ (((sb >> 9) & 1) << 5);
  R = (st >> 1) * 16 + swz / 64; C = (st & 1) * 32 + (swz % 64) / 2;
}
template <class EP>
DI void gemm_tile_big(const u16* __restrict__ A, const u16* __restrict__ Bt, int K, int klen, int brow, int bcol, const EP& ep, char* smem) {
  u16* shm = (u16*)smem;
  const int rtid = opaque_tid();
#define SA(b, h) (shm + ((b) * 2 + (h)) * G8_HT)
#define SB(b, h) (shm + (4 + (b) * 2 + (h)) * G8_HT)
  unsigned offA[2], offB[2];
#pragma unroll
  for (int _i = 0; _i < 2; ++_i) {
    int _r, _c; g8_stage_rc(rtid * 16 + _i * 8192, _r, _c);
    offA[_i] = (unsigned)((_r * K + _c) * 2);
    offB[_i] = (unsigned)((((_r >> 5) * 64 + (_r & 31)) * K + _c) * 2);
  }
#define STAGE_A(P, br, kt) do { const char* _gb = (const char*)A + ((size_t)(br) * K + (size_t)(kt) * 64) * 2;          \
    _Pragma("unroll") for (int _i = 0; _i < 2; ++_i)                                                                    \
      __builtin_amdgcn_global_load_lds((const unsigned*)(_gb + offA[_i]), (unsigned*)((char*)(P) + rtid * 16 + _i * 8192), 16, 0, 0); } while (0)
#define STAGE_B(P, h, kt) do { const char* _gb = (const char*)Bt + ((size_t)(bcol + (h) * 32) * K + (size_t)(kt) * 64) * 2; \
    _Pragma("unroll") for (int _i = 0; _i < 2; ++_i)                                                                    \
      __builtin_amdgcn_global_load_lds((const unsigned*)(_gb + offB[_i]), (unsigned*)((char*)(P) + rtid * 16 + _i * 8192), 16, 0, 0); } while (0)
#define LDA(dst, b, h) _Pragma("unroll") for (int m = 0; m < 4; ++m) _Pragma("unroll") for (int k = 0; k < 2; ++k) \
    dst[m][k] = *reinterpret_cast<const bf16x8*>(a_rd + ((b) * 2 + (h)) * 16384 + m * 2048 + k * 1024)
#define LDB(dst, b, h) _Pragma("unroll") for (int n = 0; n < 2; ++n) _Pragma("unroll") for (int k = 0; k < 2; ++k) \
    dst[n][k] = *reinterpret_cast<const bf16x8*>(b_rd + ((b) * 2 + (h)) * 16384 + n * 2048 + k * 1024)
#define MMA(ai, bj, At, Bx) do { __builtin_amdgcn_s_setprio(1);                                                         \
    for (int m = 0; m < 4; ++m) for (int n = 0; n < 2; ++n) for (int k = 0; k < 2; ++k)                                 \
      acc[ai][m][(bj) * 2 + n] = MFMA16(At[m][k], Bx[n][k], acc[ai][m][(bj) * 2 + n]);                                 \
    __builtin_amdgcn_s_setprio(0); } while (0)
#define WAIT_V(n) asm volatile("s_waitcnt vmcnt(" #n ")" ::: "memory")
#define WAIT_L(n) asm volatile("s_waitcnt lgkmcnt(" #n ")" ::: "memory")
#define BAR __builtin_amdgcn_s_barrier()
#define SCHED __builtin_amdgcn_sched_barrier(0)
  const int wid = rtid >> 6, lane = rtid & 63, wr = wid >> 2, wc = wid & 3, fr = lane & 15, fq = lane >> 4;
  const int l0 = g8_lds_byte(fr, fq * 8);
  const char* a_rd = smem + wr * 8192 + l0;
  const char* b_rd = smem + 4 * 16384 + wc * 4096 + l0;
  f32x4 acc[2][4][4];
#pragma unroll
  for (int ai = 0; ai < 2; ++ai)
#pragma unroll
    for (int m = 0; m < 4; ++m)
#pragma unroll
      for (int n = 0; n < 4; ++n) acc[ai][m][n] = (f32x4){0.f, 0.f, 0.f, 0.f};
  bf16x8 At[4][2], B0[2][2], B1[2][2];
  const int nt = klen / 64;
  STAGE_B(SB(0, 0), 0, 0); STAGE_A(SA(0, 0), brow, 0);
  STAGE_B(SB(0, 1), 1, 0); STAGE_A(SA(0, 1), brow + 128, 0);
  if (wr == 1) BAR;
  WAIT_V(4); BAR;
  STAGE_B(SB(1, 0), 0, 1); STAGE_A(SA(1, 0), brow, 1); STAGE_B(SB(1, 1), 1, 1);
  WAIT_V(6); BAR;
  for (int t = 0; t < nt - 2; t += 2) {
    LDB(B0, 0, 0); SCHED; LDA(At, 0, 0); STAGE_A(SA(1, 1), brow + 128, t + 1);
    WAIT_L(8); BAR; WAIT_L(0); MMA(0, 0, At, B0); BAR; SCHED;
    LDB(B1, 0, 1); STAGE_B(SB(0, 0), 0, t + 2);
    BAR; WAIT_L(0); MMA(0, 1, At, B1); BAR;
    LDA(At, 0, 1); STAGE_A(SA(0, 0), brow, t + 2);
    BAR; WAIT_L(0); MMA(1, 0, At, B0); BAR; SCHED;
    STAGE_B(SB(0, 1), 1, t + 2);
    WAIT_V(6); BAR; MMA(1, 1, At, B1); BAR;
    LDB(B0, 1, 0); SCHED; LDA(At, 1, 0); STAGE_A(SA(0, 1), brow + 128, t + 2);
    WAIT_L(8); BAR; WAIT_L(0); MMA(0, 0, At, B0); BAR; SCHED;
    LDB(B1, 1, 1); STAGE_B(SB(1, 0), 0, t + 3);
    BAR; WAIT_L(0); MMA(0, 1, At, B1); BAR;
    LDA(At, 1, 1); STAGE_A(SA(1, 0), brow, t + 3);
    BAR; WAIT_L(0); MMA(1, 0, At, B0); BAR; SCHED;
    STAGE_B(SB(1, 1), 1, t + 3);
    WAIT_V(6); BAR; MMA(1, 1, At, B1); BAR;
  }
  { LDB(B0, 0, 0); LDA(At, 0, 0); STAGE_A(SA(1, 1), brow + 128, nt - 1);
    BAR; WAIT_L(0); MMA(0, 0, At, B0); BAR;
    LDB(B1, 0, 1); BAR; WAIT_L(0); MMA(0, 1, At, B1); BAR;
    LDA(At, 0, 1); WAIT_V(4); BAR; WAIT_L(0); MMA(1, 0, At, B0); MMA(1, 1, At, B1); BAR; }
  { LDB(B0, 1, 0); LDA(At, 1, 0); WAIT_V(2); BAR; WAIT_L(0); MMA(0, 0, At, B0); BAR;
    LDB(B1, 1, 1); WAIT_V(0); BAR; WAIT_L(0); MMA(0, 1, At, B1); BAR;
    LDA(At, 1, 1); BAR; WAIT_L(0); MMA(1, 0, At, B0); MMA(1, 1, At, B1); BAR; }
  if (wr == 0) BAR;
#undef SA
#undef SB
#undef STAGE_A
#undef STAGE_B
#undef LDA
#undef LDB
#undef MMA
#undef WAIT_V
#undef WAIT_L
#undef BAR
#undef SCHED
  int late = 0;
  asm volatile("" : "+v"(late));
  ep(acc[0], brow + wr * 64 + late, bcol + wc * 64, lane + late);
  ep(acc[1], brow + 128 + wr * 64 + late, bcol + wc * 64, lane + late);
  __syncthreads();
}

template <class EP>
DI void gemm_phase_big(const u16* A, const u16* Bt, int K, int MT, int NT, const EP& ep, char* smem) {
  const int x = blockIdx.x & 7, j = blockIdx.x >> 3, per = gridDim.x >> 3;
  const int T = MT * NT, fullT = (MT >> 3) * 8 * NT, hlast = MT & 7;
  for (int v = j;; v += per) {
    const int chunk = x + 8 * (v >> 5);
    if (chunk * 32 >= T) break;
    const int s = chunk * 32 + (v & 31);
    if (s >= T) continue;
    int mt, nt;
    if (s < fullT) { const int band = s / (8 * NT), within = s - band * 8 * NT; nt = within >> 3; mt = band * 8 + (within & 7); }
    else { const int sp = s - fullT; nt = sp / hlast; mt = (MT >> 3) * 8 + (sp - nt * hlast); }
    gemm_tile_big(A, Bt, K, K, mt * 256, nt * 256, ep, smem);
  }
}

template <class EP>
DI void gemm_sample_splitk(const u16* A, const u16* Bt, int K, int NT, int S, const EP& ep, char* smem) {
  const int i = blockIdx.x;
  if (i < NT * S) {
    const int nt = i / S, ks = i - nt * S, klen = K / S;
    gemm_tile_big(A + ks * klen, Bt + ks * klen, K, klen, PROWS, nt * 256, ep, smem);
  }
}

DI unsigned merge_word(unsigned a, unsigned b, unsigned c, unsigned g, float e0, float e1, float e2) {
  const float lo = (e0 * lo_f(a) + e1 * lo_f(b) + e2 * lo_f(c)) * silu_f(lo_f(g));
  const float hi = (e0 * hi_f(a) + e1 * hi_f(b) + e2 * hi_f(c)) * silu_f(hi_f(g));
  return pack2(lo, hi);
}
DI void phase_merge(const Params& p) {
  const int lane = VTID & 63;
  for (int it = VBID; it < MROWS / 4; it += VGRID) {
    const size_t row = (size_t)it * 4 + (VTID >> 6);
    const int k = lane * 16, head = lane >> 2;
    const float* lp = p.LSE + row * 48 + head;
    const float l0 = lp[0], l1 = lp[16], l2 = lp[32];
    const u16* op = p.OG + row * 3072 + k;
    const u16* gp = p.QKVG + row * ATT_IN + 9216 + k;
    uint4 a[2], b[2], c[2], g[2];
#pragma unroll
    for (int h = 0; h < 2; ++h) {
      a[h] = *(const uint4*)(op + h * 8); b[h] = *(const uint4*)(op + 1024 + h * 8); c[h] = *(const uint4*)(op + 2048 + h * 8);
      g[h] = *(const uint4*)(gp + h * 8);
    }
    const float mx = fmaxf(l0, fmaxf(l1, l2));
    float e0 = __expf(l0 - mx), e1 = __expf(l1 - mx), e2 = __expf(l2 - mx);
    const float inv = 1.f / (e0 + e1 + e2);
    e0 *= inv; e1 *= inv; e2 *= inv;
#pragma unroll
    for (int h = 0; h < 2; ++h) {
      uint4 o;
      o.x = merge_word(a[h].x, b[h].x, c[h].x, g[h].x, e0, e1, e2);
      o.y = merge_word(a[h].y, b[h].y, c[h].y, g[h].y, e0, e1, e2);
      o.z = merge_word(a[h].z, b[h].z, c[h].z, g[h].z, e0, e1, e2);
      o.w = merge_word(a[h].w, b[h].w, c[h].w, g[h].w, e0, e1, e2);
      *(uint4*)(p.H + row * 1024 + k + h * 8) = o;
    }
    if (row >= PROWS) {
      const float* xs = p.x_sample + (row - PROWS) * 1024 + k;
      float* xd = p.X1 + row * 1024 + k;
#pragma unroll
      for (int h = 0; h < 4; ++h) *(float4*)(xd + h * 4) = *(const float4*)(xs + h * 4);
    }
  }
}
DI void phase_gatenorm(const Params& p) {
  const int lane = VTID & 63;
  for (int it = VBID; it < MROWS / 4; it += VGRID) {
    const size_t row = (size_t)it * 4 + (VTID >> 6);
    const int k = lane * 32;
    const float* sp = p.SSQ + row * 32 + (lane >> 4) * 8;
    const float4 s0 = *(const float4*)sp, s1 = *(const float4*)(sp + 4);
    const float ss = (s0.x + s0.y) + (s0.z + s0.w) + (s1.x + s1.y) + (s1.z + s1.w);
    const float rstd = rsqrtf(ss * (1.f / 512.f) + 1e-5f);
    u16* yp = p.YG + row * 2048 + k;
    uint4 y[4];
#pragma unroll
    for (int h = 0; h < 4; ++h) y[h] = *(const uint4*)(yp + h * 8);
#pragma unroll
    for (int h = 0; h < 4; ++h) {
      const float4 g0 = *(const float4*)(p.ssm_gate_norm + k + h * 8), g1 = *(const float4*)(p.ssm_gate_norm + k + h * 8 + 4);
      uint4 o;
      o.x = pack2(lo_f(y[h].x) * rstd * g0.x, hi_f(y[h].x) * rstd * g0.y);
      o.y = pack2(lo_f(y[h].y) * rstd * g0.z, hi_f(y[h].y) * rstd * g0.w);
      o.z = pack2(lo_f(y[h].z) * rstd * g1.x, hi_f(y[h].z) * rstd * g1.y);
      o.w = pack2(lo_f(y[h].w) * rstd * g1.z, hi_f(y[h].w) * rstd * g1.w);
      *(uint4*)(yp + h * 8) = o;
    }
    if (row >= PROWS) {
      const float* xs = p.X1 + row * 1024 + lane * 16;
      float* xd = p.out + O_Y + row * 1024 + lane * 16;
#pragma unroll
      for (int h = 0; h < 4; ++h) *(float4*)(xd + h * 4) = *(const float4*)(xs + h * 4);
    }
  }
}

struct Ep1 {
  const Params& p;
  DI void operator()(f32x4 (&acc)[4][4], int r0, int c0, int lane) const {
    const int l15 = lane & 15, G = lane >> 4;
    int kind, g = 0, head;
    if (c0 >= 9216) { kind = 3; head = (c0 - 9216) >> 6; }
    else { g = c0 / 3072; const int rem = c0 - g * 3072; kind = rem >> 10; head = (rem & 1023) >> 6; }
    if (kind < 2) {
      const float* gp = (kind == 0 ? p.attn_q_gain : p.attn_k_gain) + g * 64;
      float gain[4];
#pragma unroll
      for (int n = 0; n < 4; ++n) gain[n] = gp[n * 16 + l15];
      const float post = (kind == 0) ? 0.125f : 1.f;
#pragma unroll
      for (int m = 0; m < 4; ++m)
#pragma unroll
        for (int j = 0; j < 4; ++j) {
          float ss = 0.f;
#pragma unroll
          for (int n = 0; n < 4; ++n) ss += acc[m][n][j] * acc[m][n][j];
          ss = sum16(ss);
          const float sc = rsqrtf(ss * (1.f / 64.f) + 1e-6f) * post;
#pragma unroll
          for (int n = 0; n < 4; ++n) acc[m][n][j] *= sc * gain[n];
        }
    }
    if (kind < 3 && r0 < PROWS) {
      const int dsh = 2 * g;
      const size_t hb = ((size_t)(((r0 >> 12) * 3 + g) * 3 + kind) * 16 + head) * 4096;
#pragma unroll
      for (int m = 0; m < 4; ++m)
#pragma unroll
        for (int j = 0; j < 4; ++j) {
          const int t = (r0 + m * 16 + G * 4 + j) & 4095;
          const int pos = (t & ((1 << dsh) - 1)) * (4096 >> dsh) + (t >> dsh);
          u16* dst = p.QKVH + (hb + pos) * 64 + l15;
#pragma unroll
          for (int n = 0; n < 4; ++n) dst[n * 16] = f2bf(acc[m][n][j]);
        }
    } else {
#pragma unroll
      for (int m = 0; m < 4; ++m)
#pragma unroll
        for (int j = 0; j < 4; ++j) {
          const int row = r0 + m * 16 + G * 4 + j;
          u16* dst = p.QKVG + (size_t)row * ATT_IN + c0 + l15;
#pragma unroll
          for (int n = 0; n < 4; ++n) dst[n * 16] = f2bf(acc[m][n][j]);
        }
    }
    if (kind == 1 || kind == 2) {
      const int keep = 128 << (2 * g);
      const size_t okp = (g == 0) ? O_KVP0 : (g == 1) ? O_KVP1 : O_KVP2;
      const size_t oks = (g == 0) ? O_KVS0 : (g == 1) ? O_KVS1 : O_KVS2;
#pragma unroll
      for (int m = 0; m < 4; ++m)
#pragma unroll
        for (int j = 0; j < 4; ++j) {
          const int row = r0 + m * 16 + G * 4 + j;
          float* dst = nullptr;
          if (row < PROWS) {
            const int b = row >> 12, s = row & 4095;
            if (s >= 4096 - keep) dst = p.out + okp + ((size_t)(b * keep + s - (4096 - keep)) * 2 + (kind - 1)) * 1024 + head * 64 + l15;
          } else {
            dst = p.out + oks + ((size_t)(row - PROWS) * 2 + (kind - 1)) * 1024 + head * 64 + l15;
          }
          if (dst) {
#pragma unroll
            for (int n = 0; n < 4; ++n) dst[n * 16] = acc[m][n][j];
          }
        }
    }
  }
};
struct Ep2 {
  const Params& p;
  DI void operator()(f32x4 (&acc)[4][4], int r0, int c0, int lane) const {
    const int l15 = lane & 15, G = lane >> 4;
#pragma unroll
    for (int m = 0; m < 4; ++m)
#pragma unroll
      for (int j = 0; j < 4; ++j) {
        const int row = r0 + m * 16 + G * 4 + j;
        const float* xin = (row < PROWS) ? p.x_prompt + (size_t)row * 1024 : p.x_sample + (size_t)(row - PROWS) * 1024;
        float* dst = p.X1 + (size_t)row * 1024 + c0 + l15;
#pragma unroll
        for (int n = 0; n < 4; ++n) dst[n * 16] = xin[c0 + l15 + n * 16] + acc[m][n][j];
      }
  }
};
struct EpAtomic {
  float* dst;
  DI void operator()(f32x4 (&acc)[4][4], int r0, int c0, int lane) const {
    const int l15 = lane & 15, G = lane >> 4;
#pragma unroll
    for (int m = 0; m < 4; ++m)
#pragma unroll
      for (int j = 0; j < 4; ++j) {
        float* d = dst + (size_t)(r0 + m * 16 + G * 4 + j) * 1024 + c0 + l15;
#pragma unroll
        for (int n = 0; n < 4; ++n) unsafeAtomicAdd(d + n * 16, acc[m][n][j]);
      }
  }
};
struct Ep3 {
  const Params& p;
  DI void operator()(f32x4 (&acc)[4][4], int r0, int c0, int lane) const {
    const int l15 = lane & 15, G = lane >> 4;
    if (c0 >= SSM_IN) return;
    if (c0 < 2048) {
#pragma unroll
      for (int m = 0; m < 4; ++m)
#pragma unroll
        for (int j = 0; j < 4; ++j) {
          const int row = r0 + m * 16 + G * 4 + j;
          u16* dst = p.Z + (size_t)row * 2048 + c0 + l15;
#pragma unroll
          for (int n = 0; n < 4; ++n) dst[n * 16] = f2bf(acc[m][n][j]);
        }
    } else if (c0 < 5120) {
      const int cc = c0 - 2048 + l15;
#pragma unroll
      for (int m = 0; m < 4; ++m)
#pragma unroll
        for (int j = 0; j < 4; ++j) {
          const int row = r0 + m * 16 + G * 4 + j;
          u16* dst = p.XBC + (size_t)row * 3072 + cc;
#pragma unroll
          for (int n = 0; n < 4; ++n) dst[n * 16] = f2bf(acc[m][n][j]);
          float* od = nullptr;
          if (row < PROWS) {
            const int b = row >> 12, s = row & 4095;
            if (s >= 4093) od = p.out + O_CONVP + (size_t)(b * 3 + s - 4093) * 3072 + cc;
          } else {
            const int rr = row - PROWS, b = rr >> 3, t = rr & 7;
            if (t >= 5) od = p.out + O_CONVS + (size_t)(b * 3 + t - 5) * 3072 + cc;
          }
          if (od) {
#pragma unroll
            for (int n = 0; n < 4; ++n) od[n * 16] = acc[m][n][j];
          }
        }
    } else {
#pragma unroll
      for (int m = 0; m < 4; ++m)
#pragma unroll
        for (int j = 0; j < 4; ++j) {
          const int row = r0 + m * 16 + G * 4 + j;
#pragma unroll
          for (int n = 0; n < 2; ++n) {
            const int h = n * 16 + l15;
            const float xv = acc[m][n][j] + p.ssm_dt_bias[h];
            p.DT[(size_t)row * 32 + h] = fmaxf(xv, 0.f) + log1pf(__expf(-fabsf(xv)));
          }
        }
    }
  }
};
struct Ep4 {
  const Params& p;
  DI void operator()(f32x4 (&acc)[4][4], int r0, int c0, int lane) const {
    const int l15 = lane & 15, G = lane >> 4;
#pragma unroll
    for (int m = 0; m < 4; ++m)
#pragma unroll
      for (int j = 0; j < 4; ++j) {
        const int row = r0 + m * 16 + G * 4 + j;
        const float* xin = p.X1 + (size_t)row * 1024 + c0 + l15;
        float* dst = p.out + O_Y + (size_t)row * 1024 + c0 + l15;
#pragma unroll
        for (int n = 0; n < 4; ++n) dst[n * 16] = xin[n * 16] + acc[m][n][j];
      }
  }
};

DI void transpose_task(const float* __restrict__ W, u16* __restrict__ Wt, int K, int N, int NTN, int tile, u16* smem) {
  const int tid = VTID;
  const int ktile = tile / NTN, ntile = tile % NTN;
  const int k0 = ktile * 64, n0 = ntile * 64;
#pragma unroll
  for (int i = 0; i < 4; ++i) {
    const int idx = tid + 256 * i;
    const int kk = idx >> 4, nq = idx & 15;
    const int n = n0 + nq * 4;
    float4 v = {0.f, 0.f, 0.f, 0.f};
    if (n < N) v = *(const float4*)(W + (size_t)(k0 + kk) * N + n);
    smem[(nq * 4 + 0) * LDT + kk] = f2bf(v.x);
    smem[(nq * 4 + 1) * LDT + kk] = f2bf(v.y);
    smem[(nq * 4 + 2) * LDT + kk] = f2bf(v.z);
    smem[(nq * 4 + 3) * LDT + kk] = f2bf(v.w);
  }
  __syncthreads();
#pragma unroll
  for (int i = 0; i < 2; ++i) {
    const int idx = tid + 256 * i;
    const int n = idx >> 3, kc = idx & 7;
    *(uint4*)(Wt + (size_t)(n0 + n) * K + k0 + kc * 8) = *(const uint4*)(smem + n * LDT + kc * 8);
  }
  __syncthreads();
}

DI void rmsnorm_row(const float* __restrict__ src, const float* __restrict__ wgt, u16* __restrict__ dst, int lane) {
  float4 v[4];
  float ss = 0.f;
#pragma unroll
  for (int i = 0; i < 4; ++i) {
    v[i] = *(const float4*)(src + lane * 4 + 256 * i);
    ss += v[i].x * v[i].x + v[i].y * v[i].y + v[i].z * v[i].z + v[i].w * v[i].w;
  }
  ss = sum16(ss);
  ss += __shfl_xor(ss, 16);
  ss += __shfl_xor(ss, 32);
  const float rstd = rsqrtf(ss * (1.f / 1024.f) + 1e-6f);
#pragma unroll
  for (int i = 0; i < 4; ++i) {
    const float4 g = *(const float4*)(wgt + lane * 4 + 256 * i);
    uint2 o;
    o.x = pack2(v[i].x * rstd * g.x, v[i].y * rstd * g.y);
    o.y = pack2(v[i].z * rstd * g.z, v[i].w * rstd * g.w);
    *(uint2*)(dst + lane * 4 + 256 * i) = o;
  }
}

constexpr int TR1 = 16 * 160, TR2 = 16 * 16, TR3 = 16 * 84, TR4 = 32 * 16;
DI void phase_prep(const Params& p, u16* smem) {
  constexpr int RT = MROWS / 4;
  for (int it = VBID; it < TR1 + RT; it += VGRID) {
    if (it < TR1) transpose_task(p.attn_w_in, p.Wt1, 1024, ATT_IN, 160, it, smem);
    else {
      const int row = (it - TR1) * 4 + (VTID >> 6);
      const float* src = (row < PROWS) ? p.x_prompt + (size_t)row * 1024 : p.x_sample + (size_t)(row - PROWS) * 1024;
      rmsnorm_row(src, p.attn_norm, p.H + (size_t)row * 1024, VTID & 63);
    }
  }
}
DI void late_transpose_task(const Params& p, int it, u16* smem) {
  if (it < TR2) transpose_task(p.attn_w_out, p.Wt2, 1024, 1024, 16, it, smem);
  else if (it < TR2 + TR3) transpose_task(p.ssm_w_in, p.Wt3, 1024, SSM_IN, 84, it - TR2, smem);
  else transpose_task(p.ssm_w_out, p.Wt4, 2048, 1024, 16, it - TR2 - TR3, smem);
}

DI void phase_norm2(const Params& p) {
  for (int it = VBID; it < MROWS / 4; it += VGRID) {
    const int row = it * 4 + (VTID >> 6);
    rmsnorm_row(p.X1 + (size_t)row * 1024, p.ssm_norm, p.H + (size_t)row * 1024, VTID & 63);
  }
}

struct PromptRegs { uint4 k[8], v[8]; bf16x8 q[2][2]; };
DI void attn_prompt_load(const Params& p, int item, PromptRegs& R) {
  const int tid = VTID, lane = tid & 63, w = tid >> 6, l15 = lane & 15, G = lane >> 4;
  const int rn = item & 31, head = (item >> 5) & 15, b = (item >> 9) & 3, g = item >> 11;
  const int dsh = 2 * g, dil = 1 << dsh, nbg = 32 >> dsh;
  const int r = rn / nbg, n = rn % nbg;
  const size_t hq = ((size_t)((b * 3 + g) * 3 + 0) * 16 + head) * 4096 + (size_t)r * (4096 >> dsh);
  const size_t hk = hq + (size_t)16 * 4096, hv = hq + (size_t)32 * 4096;
  (void)dil;
#pragma unroll
  for (int i = 0; i < 8; ++i) {
    const int c = tid + 256 * i;
    const int kj = c >> 3, ch = c & 7;
    const int u = (n - 1) * 128 + kj;
    R.k[i] = (uint4){0u, 0u, 0u, 0u}; R.v[i] = (uint4){0u, 0u, 0u, 0u};
    if (u >= 0) {
      R.k[i] = *(const uint4*)(p.QKVH + (hk + u) * 64 + ch * 8);
      R.v[i] = *(const uint4*)(p.QKVH + (hv + u) * 64 + ch * 8);
    }
  }
#pragma unroll
  for (int sub = 0; sub < 2; ++sub) {
    const u16* qp = p.QKVH + (hq + n * 128 + w * 32 + sub * 16 + l15) * 64 + G * 8;
    R.q[sub][0] = *(const bf16x8*)qp;
    R.q[sub][1] = *(const bf16x8*)(qp + 32);
  }
}
DI void attn_prompt_stage(const PromptRegs& R, u16* smem) {
  const int tid = VTID;
  u16* Ks = smem;
  u16* Vs = smem + 256 * LDT;
#pragma unroll
  for (int i = 0; i < 8; ++i) {
    const int c = tid + 256 * i;
    const int kj = c >> 3, ch = c & 7;
    *(uint4*)(Ks + kj * LDT + ch * 8) = R.k[i];
    *(uint4*)(Vs + kj * LDT + ch * 8) = R.v[i];
  }
}
DI void attn_prompt_compute(const Params& p, int item, const bf16x8 (&qpre)[2][2], u16* smem) {
  const int tid = VTID, lane = tid & 63, w = tid >> 6, l15 = lane & 15, G = lane >> 4;
  const int rn = item & 31, head = (item >> 5) & 15, b = (item >> 9) & 3, g = item >> 11;
  const int dsh = 2 * g, dil = 1 << dsh, nbg = 32 >> dsh;
  const int r = rn / nbg, n = rn % nbg;
  u16* Ks = smem;
  u16* Vs = smem + 256 * LDT;
#pragma unroll 1
  for (int sub = 0; sub < 2; ++sub) {
    const int q0 = w * 32 + sub * 16;
    const int qi = q0 + l15;
    const size_t rowq = (size_t)b * 4096 + (size_t)(n * 128 + qi) * dil + r;
    const bf16x8 qf0 = sub ? qpre[1][0] : qpre[0][0], qf1 = sub ? qpre[1][1] : qpre[0][1];
    f32x4 st[9];
#pragma unroll
    for (int s = 0; s < 9; ++s) {
      const u16* kp = Ks + (q0 + 16 * s + l15) * LDT + G * 8;
      const bf16x8 a0 = *(const bf16x8*)kp, a1 = *(const bf16x8*)(kp + 32);
      f32x4 z = {0.f, 0.f, 0.f, 0.f};
      z = MFMA16(a0, qf0, z);
      st[s] = MFMA16(a1, qf1, z);
    }
    float mx = -INFINITY;
#pragma unroll
    for (int s = 0; s < 9; ++s)
#pragma unroll
      for (int j = 0; j < 4; ++j) {
        const int kk = 16 * s + 4 * G + j;
        const bool valid = (kk >= l15) && (kk <= l15 + 128) && (n > 0 || q0 + kk >= 128);
        const float v = valid ? st[s][j] : -INFINITY;
        st[s][j] = v;
        mx = fmaxf(mx, v);
      }
    mx = fmaxf(mx, __shfl_xor(mx, 16));
    mx = fmaxf(mx, __shfl_xor(mx, 32));
    float sum = 0.f;
#pragma unroll
    for (int s = 0; s < 9; ++s)
#pragma unroll
      for (int j = 0; j < 4; ++j) {
        const float e = __expf(st[s][j] - mx);
        st[s][j] = e;
        sum += e;
      }
    sum += __shfl_xor(sum, 16);
    sum += __shfl_xor(sum, 32);
    const float inv = 1.f / sum;
    f32x4 o[4];
#pragma unroll
    for (int m = 0; m < 4; ++m) o[m] = (f32x4){0.f, 0.f, 0.f, 0.f};
#pragma unroll
    for (int t = 0; t < 5; ++t) {
      const int sA = 2 * t, sB = 2 * t + 1;
      bf16x8 pb;
      if (t < 4) pb = words_to_frag(pack2(st[sA][0], st[sA][1]), pack2(st[sA][2], st[sA][3]), pack2(st[sB < 9 ? sB : 8][0], st[sB < 9 ? sB : 8][1]), pack2(st[sB < 9 ? sB : 8][2], st[sB < 9 ? sB : 8][3]));
      else pb = words_to_frag(pack2(st[sA][0], st[sA][1]), pack2(st[sA][2], st[sA][3]), 0u, 0u);
      const u16* vA = Vs + (q0 + 16 * sA + 4 * G + (l15 >> 2)) * LDT + (l15 & 3) * 4;
      const u16* vB = Vs + (q0 + 16 * sB + 4 * G + (l15 >> 2)) * LDT + (l15 & 3) * 4;
#pragma unroll
      for (int m = 0; m < 4; ++m) {
        const s16x4 lo = tr_read(vA + 16 * m);
        s16x4 hi = {0, 0, 0, 0};
        if (t < 4) hi = tr_read(vB + 16 * m);
        o[m] = MFMA16(cat4(lo, hi), pb, o[m]);
      }
    }
    u16* op = p.OG + rowq * 3072 + g * 1024 + head * 64 + 4 * G;
#pragma unroll
    for (int m = 0; m < 4; ++m) {
      uint2 ov;
      ov.x = pack2(o[m][0] * inv, o[m][1] * inv);
      ov.y = pack2(o[m][2] * inv, o[m][3] * inv);
      *(uint2*)(op + 16 * m) = ov;
    }
    if (G == 0) p.LSE[rowq * 48 + g * 16 + head] = mx + __logf(sum);
  }
}

DI void attn_sample_task(const Params& p, int id) {
  const int lane = VTID & 63, l15 = lane & 15, G = lane >> 4;
  const int t = id & 7, head = (id >> 3) & 15, b = (id >> 7) & 31, g = id >> 12;
  const int L = 128 << (2 * g), dil = 1 << (2 * g);
  const float* cache = (g == 0) ? p.cache0 : (g == 1) ? p.cache1 : p.cache2;
  const float* newkv = p.out + ((g == 0) ? O_KVS0 : (g == 1) ? O_KVS1 : O_KVS2);
  const size_t rowq = (size_t)PROWS + b * 8 + t;
  const uint2 qq = *(const uint2*)(p.QKVG + rowq * ATT_IN + g * 3072 + head * 64 + 4 * l15);
  const float q0 = lo_f(qq.x), q1 = hi_f(qq.x), q2 = lo_f(qq.y), q3 = hi_f(qq.y);
  const int coff = head * 64 + 4 * l15;
  float mx = -INFINITY, sum = 0.f, a0 = 0.f, a1 = 0.f, a2 = 0.f, a3 = 0.f;
#pragma unroll 1
  for (int bt = 0; bt < 2; ++bt) {
    float4 kb[17], vb[17];
#pragma unroll
    for (int u = 0; u < 17; ++u) {
      const int j = 4 * (bt * 17 + u) + G;
      const int jc = j < 128 ? j : 128;
      const int idx = L + t - dil * jc;
      const float* kp = ((idx < L) ? cache + (size_t)(b * L + idx) * 2048 : newkv + (size_t)(b * 8 + idx - L) * 2048) + coff + 512;
      kb[u] = *(const float4*)(kp - 512);
      vb[u] = *(const float4*)(kp + 512);
    }
    float scb[17];
    float bm = -INFINITY;
#pragma unroll
    for (int u = 0; u < 17; ++u) {
      const int j = 4 * (bt * 17 + u) + G;
      float sv = q0 * kb[u].x + q1 * kb[u].y + q2 * kb[u].z + q3 * kb[u].w;
      sv = sum16(sv);
      sv = (j <= 128) ? sv : -INFINITY;
      scb[u] = sv;
      bm = fmaxf(bm, sv);
    }
    const float mn = fmaxf(mx, bm);
    const float corr = __expf(mx - mn);
    sum *= corr; a0 *= corr; a1 *= corr; a2 *= corr; a3 *= corr;
#pragma unroll
    for (int u = 0; u < 17; ++u) {
      const float pe = __expf(scb[u] - mn);
      sum += pe;
      a0 += pe * vb[u].x; a1 += pe * vb[u].y; a2 += pe * vb[u].z; a3 += pe * vb[u].w;
    }
    mx = mn;
  }
  {
    float M = fmaxf(mx, __shfl_xor(mx, 16));
    M = fmaxf(M, __shfl_xor(M, 32));
    const float f = __expf(mx - M);
    sum *= f; a0 *= f; a1 *= f; a2 *= f; a3 *= f;
    mx = M;
  }
  sum += __shfl_xor(sum, 16); sum += __shfl_xor(sum, 32);
  a0 += __shfl_xor(a0, 16); a0 += __shfl_xor(a0, 32);
  a1 += __shfl_xor(a1, 16); a1 += __shfl_xor(a1, 32);
  a2 += __shfl_xor(a2, 16); a2 += __shfl_xor(a2, 32);
  a3 += __shfl_xor(a3, 16); a3 += __shfl_xor(a3, 32);
  const float inv = 1.f / sum;
  if (G == 0) {
    uint2 ov;
    ov.x = pack2(a0 * inv, a1 * inv);
    ov.y = pack2(a2 * inv, a3 * inv);
    *(uint2*)(p.OG + rowq * 3072 + g * 1024 + coff) = ov;
    if (l15 == 0) p.LSE[rowq * 48 + g * 16 + head] = mx + __logf(sum);
  }
}

DI int attn_item_of(int round) {
  if (gridDim.x != 256) return VBID + round * VGRID;
  const int x = blockIdx.x & 7, jj = (blockIdx.x >> 3) * 2 + (opaque_tid() >> 8);
  return ((round * 64 + (jj >> 3) * 8 + x) << 3) + (jj & 7);
}
DI void attn_prompt_stream(const Params& p, u16* smem) {
  constexpr int NP = 6144;
  int round = 0;
  int item = attn_item_of(0);
  PromptRegs R;
  if (item < NP) attn_prompt_load(p, item, R);
  while (item < NP) {
    attn_prompt_stage(R, smem);
    bf16x8 qc[2][2];
    qc[0][0] = R.q[0][0]; qc[0][1] = R.q[0][1]; qc[1][0] = R.q[1][0]; qc[1][1] = R.q[1][1];
    __syncthreads();
    const int next = attn_item_of(++round);
    if (next < NP) attn_prompt_load(p, next, R);
    attn_prompt_compute(p, item, qc, smem);
    __syncthreads();
    item = next;
  }
}
DI void phase_attn(const Params& p, u16* smem) {
  constexpr int NS = 3072;
  const bool sample_first = false;
  if (!sample_first) attn_prompt_stream(p, smem);
  for (int it = VBID; it < NS; it += VGRID) attn_sample_task(p, it * 4 + (VTID >> 6));
  if (sample_first) attn_prompt_stream(p, smem);
}

DI void conv_pass_task(const Params& p, int bt) {
  const int id = bt * 256 + VTID;
  const int ch = id % 384, seg = id / 384;
  const int col = ch * 8, row0 = seg * 8, t0 = row0 & 4095;
  const u16* src = p.XBC + (size_t)row0 * 3072 + col;
  uint4 raw[11];
#pragma unroll
  for (int j = 0; j < 3; ++j) {
    raw[j] = (uint4){0u, 0u, 0u, 0u};
    if (t0 > 0) raw[j] = *(const uint4*)(src - (ptrdiff_t)(3 - j) * 3072);
  }
#pragma unroll
  for (int j = 0; j < 8; ++j) raw[3 + j] = *(const uint4*)(src + (size_t)j * 3072);
  float wgt[4][8], bias[8];
#pragma unroll
  for (int j = 0; j < 4; ++j) {
    const float4 w0 = *(const float4*)(p.ssm_conv_w + j * 3072 + col), w1 = *(const float4*)(p.ssm_conv_w + j * 3072 + col + 4);
    wgt[j][0] = w0.x; wgt[j][1] = w0.y; wgt[j][2] = w0.z; wgt[j][3] = w0.w;
    wgt[j][4] = w1.x; wgt[j][5] = w1.y; wgt[j][6] = w1.z; wgt[j][7] = w1.w;
  }
  {
    const float4 b0 = *(const float4*)(p.ssm_conv_b + col), b1 = *(const float4*)(p.ssm_conv_b + col + 4);
    bias[0] = b0.x; bias[1] = b0.y; bias[2] = b0.z; bias[3] = b0.w;
    bias[4] = b1.x; bias[5] = b1.y; bias[6] = b1.z; bias[7] = b1.w;
  }
  float win[3][8];
  unpack8(raw[0], win[0]); unpack8(raw[1], win[1]); unpack8(raw[2], win[2]);
  u16* dst = p.XBCC + (size_t)row0 * 3072 + col;
#pragma unroll
  for (int i = 0; i < 8; ++i) {
    float cur[8], r[8];
    unpack8(raw[3 + i], cur);
#pragma unroll
    for (int e = 0; e < 8; ++e) {
      const float v = bias[e] + wgt[0][e] * win[0][e] + wgt[1][e] * win[1][e] + wgt[2][e] * win[2][e] + wgt[3][e] * cur[e];
      r[e] = silu_f(v);
      win[0][e] = win[1][e]; win[1][e] = win[2][e]; win[2][e] = cur[e];
    }
    *(uint4*)(dst + (size_t)i * 3072) = pack8(r);
  }
}

DI void acs_task(const Params& p, int bc) {
  const int lane = VTID & 63, head = lane & 31, half = lane >> 5;
  const float Aneg = -__expf(p.ssm_A_log[head]);
  const size_t rb = (size_t)bc * 128 + half * 64;
  float run = 0.f;
#pragma unroll 8
  for (int i = 0; i < 64; ++i) run += p.DT[(rb + i) * 32 + head] * Aneg;
  const float tot0 = __shfl(run, head);
  run = half ? tot0 : 0.f;
#pragma unroll 8
  for (int i = 0; i < 64; ++i) {
    run += p.DT[(rb + i) * 32 + head] * Aneg;
    p.ACS[(rb + i) * 32 + head] = run;
  }
}

DI void phase_convpass(const Params& p) {
  constexpr int NC = PROWS / 8 * 384 / 256;
  for (int it = VBID; it < NC + 32; it += VGRID) {
    if (it < NC) conv_pass_task(p, it);
    else acs_task(p, (it - NC) * 4 + (VTID >> 6));
  }
}

constexpr int SS_B = 0;
constexpr int SS_R2 = 34816;
constexpr int SS_H = 34816 + 18432;
constexpr int SS_F = 70656;

DI void ssd_states_item(const Params& p, int item, char* smem_raw) {
  const int tid = VTID, lane = tid & 63, w = tid >> 6, l15 = lane & 15, G = lane >> 4;
  const int head = item & 31, c = (item >> 5) & 31, b = item >> 10, g = head >> 3;
  u16* Bs = (u16*)(smem_raw + SS_B);
  u16* Xs = (u16*)(smem_raw + SS_R2);
  const size_t row0 = (size_t)b * 4096 + c * 128;
  const float a_end = p.ACS[(row0 + 127) * 32 + head];
#pragma unroll
  for (int i = 0; i < 4; ++i) {
    const int row = (tid >> 3) + 32 * i, ch = tid & 7;
    const float wl = p.DT[(row0 + row) * 32 + head] * __expf(a_end - p.ACS[(row0 + row) * 32 + head]);
    const uint4 v = *(const uint4*)(p.XBCC + (row0 + row) * 3072 + head * 64 + ch * 8);
    uint4 o;
    o.x = pack2(lo_f(v.x) * wl, hi_f(v.x) * wl); o.y = pack2(lo_f(v.y) * wl, hi_f(v.y) * wl);
    o.z = pack2(lo_f(v.z) * wl, hi_f(v.z) * wl); o.w = pack2(lo_f(v.w) * wl, hi_f(v.w) * wl);
    *(uint4*)(Xs + row * LDT + ch * 8) = o;
  }
#pragma unroll
  for (int i = 0; i < 8; ++i) {
    const int idx = tid + 256 * i, row = idx >> 4, ch = idx & 15;
    *(uint4*)(Bs + row * LDW + ch * 8) = *(const uint4*)(p.XBCC + (row0 + row) * 3072 + 2048 + g * 128 + ch * 8);
  }
  __syncthreads();
  f32x4 acc[4][2];
#pragma unroll
  for (int m = 0; m < 4; ++m) { acc[m][0] = (f32x4){0.f, 0.f, 0.f, 0.f}; acc[m][1] = (f32x4){0.f, 0.f, 0.f, 0.f}; }
#pragma unroll
  for (int k = 0; k < 4; ++k) {
    const int rowA = 32 * k + 8 * G + (l15 >> 2);
    bf16x8 a[4], bb[2];
#pragma unroll
    for (int m = 0; m < 4; ++m) {
      const u16* ap = Xs + rowA * LDT + 16 * m + (l15 & 3) * 4;
      a[m] = cat4(tr_read(ap), tr_read(ap + 4 * LDT));
    }
#pragma unroll
    for (int nn = 0; nn < 2; ++nn) {
      const u16* bp = Bs + rowA * LDW + 32 * w + 16 * nn + (l15 & 3) * 4;
      bb[nn] = cat4(tr_read(bp), tr_read(bp + 4 * LDW));
    }
#pragma unroll
    for (int m = 0; m < 4; ++m)
#pragma unroll
      for (int nn = 0; nn < 2; ++nn) acc[m][nn] = MFMA16(a[m], bb[nn], acc[m][nn]);
  }
  u16* sp = p.STATES + (size_t)item * 64 * 128;
#pragma unroll
  for (int m = 0; m < 4; ++m)
#pragma unroll
    for (int nn = 0; nn < 2; ++nn)
#pragma unroll
      for (int j = 0; j < 4; ++j) sp[(16 * m + 4 * G + j) * 128 + 32 * w + 16 * nn + l15] = f2bf(acc[m][nn][j]);
  if (tid == 0) p.CD[item] = __expf(a_end);
  __syncthreads();
}

DI void ssm_sample_item(const Params& p, int item, char* smem_raw) {
  const int tid = VTID;
  const int head = item & 31, b = item >> 5, g = head >> 3;
  float* sx = (float*)smem_raw;
  float* sB = sx + 512;
  float* sC = sB + 1024;
  float* sdt = sC + 1024;
  float* sdA = sdt + 8;
  float* sy2 = sdA + 8;
  const size_t row0 = (size_t)PROWS + b * 8;
  const float Aneg = -__expf(p.ssm_A_log[head]);
  for (int task = tid; task < 320; task += 256) {
    int col; float* dst;
    if (task < 64) { col = head * 64 + task; dst = sx + task; }
    else if (task < 192) { col = 2048 + g * 128 + (task - 64); dst = sB + (task - 64); }
    else { col = 2560 + g * 128 + (task - 192); dst = sC + (task - 192); }
    const int dstride = (task < 64) ? 64 : 128;
    const float w0 = p.ssm_conv_w[col], w1 = p.ssm_conv_w[3072 + col], w2 = p.ssm_conv_w[2 * 3072 + col], w3 = p.ssm_conv_w[3 * 3072 + col];
    const float bias = p.ssm_conv_b[col];
    float x0 = p.state_conv[(size_t)(b * 3 + 0) * 3072 + col];
    float x1 = p.state_conv[(size_t)(b * 3 + 1) * 3072 + col];
    float x2 = p.state_conv[(size_t)(b * 3 + 2) * 3072 + col];
#pragma unroll
    for (int t = 0; t < 8; ++t) {
      const float cur = bf2f(p.XBC[(row0 + t) * 3072 + col]);
      const float v = bias + w0 * x0 + w1 * x1 + w2 * x2 + w3 * cur;
      dst[t * dstride] = silu_f(v);
      x0 = x1; x1 = x2; x2 = cur;
    }
  }
  if (tid < 8) {
    const float dt = p.DT[(row0 + tid) * 32 + head];
    sdt[tid] = dt;
    sdA[tid] = __expf(dt * Aneg);
  }
  __syncthreads();
  const int pp = tid >> 2, nq = tid & 3;
  const size_t sbase = ((size_t)(b * 32 + head) * 64 + pp) * 128 + nq * 4;
  float4 h[8];
#pragma unroll
  for (int i = 0; i < 8; ++i) h[i] = *(const float4*)(p.state_ssm + sbase + i * 16);
  const float Dh = p.ssm_D[head];
#pragma unroll 1
  for (int t = 0; t < 8; ++t) {
    const float dA = sdA[t];
    const float xv = sx[t * 64 + pp];
    const float dtx = sdt[t] * xv;
    float y = 0.f;
#pragma unroll
    for (int i = 0; i < 8; ++i) {
      const float4 Bv = *(const float4*)(sB + t * 128 + i * 16 + nq * 4);
      const float4 Cv = *(const float4*)(sC + t * 128 + i * 16 + nq * 4);
      h[i].x = h[i].x * dA + dtx * Bv.x; h[i].y = h[i].y * dA + dtx * Bv.y;
      h[i].z = h[i].z * dA + dtx * Bv.z; h[i].w = h[i].w * dA + dtx * Bv.w;
      y += h[i].x * Cv.x + h[i].y * Cv.y + h[i].z * Cv.z + h[i].w * Cv.w;
    }
    y = sum4(y);
    if (nq == 0) {
      const float z = bf2f(p.Z[(row0 + t) * 2048 + head * 64 + pp]);
      const float yg = (y + Dh * xv) * silu_f(z);
      p.YG[(row0 + t) * 2048 + head * 64 + pp] = f2bf(yg);
      sy2[t * 64 + pp] = yg * yg;
    }
  }
  float* od = p.out + O_SSMS + sbase;
#pragma unroll
  for (int i = 0; i < 8; ++i) *(float4*)(od + i * 16) = h[i];
  __syncthreads();
  if (tid < 8) {
    float s = 0.f;
    for (int i = 0; i < 64; ++i) s += sy2[tid * 64 + i];
    p.SSQ[(row0 + tid) * 32 + head] = s;
  }
  __syncthreads();
}

DI int ssd_item_of(int round) {
  const int x = blockIdx.x & 7, jj = (blockIdx.x >> 3) * 2 + (opaque_tid() >> 8);
  return ((round * 64 + (jj >> 3) * 8 + x) << 3) + (jj & 7);
}
DI void phase_states(const Params& p, char* smem_raw) {
  constexpr int NP = 4096, NS = 1024;
  for (int it = VBID; it < NS; it += VGRID) ssm_sample_item(p, it, smem_raw);
  if (gridDim.x == 256) { for (int r = 0; r < 8; ++r) ssd_states_item(p, ssd_item_of(r), smem_raw); }
  else for (int it = VBID; it < NP; it += VGRID) ssd_states_item(p, it, smem_raw);
}

DI void phase_scan(const Params& p) {
  for (int task = VBID * 256 + VTID; task < 131072; task += VGRID * 256) {
    const int n8 = task & 15, pp = (task >> 4) & 63, head = (task >> 10) & 31, b = task >> 15;
    float h[8];
#pragma unroll
    for (int e = 0; e < 8; ++e) h[e] = 0.f;
#pragma unroll 8
    for (int c = 0; c < 32; ++c) {
      const int item = (b * 32 + c) * 32 + head;
      uint4* sp = (uint4*)(p.STATES + ((size_t)item * 64 + pp) * 128 + n8 * 8);
      const uint4 sv = *sp;
      const float d = p.CD[item];
      *sp = pack8(h);
      float sf[8];
      unpack8(sv, sf);
#pragma unroll
      for (int e = 0; e < 8; ++e) h[e] = h[e] * d + sf[e];
    }
    float* od = p.out + O_SSMP + ((size_t)(b * 32 + head) * 64 + pp) * 128 + n8 * 8;
    *(float4*)od = (float4){h[0], h[1], h[2], h[3]};
    *(float4*)(od + 4) = (float4){h[4], h[5], h[6], h[7]};
  }
}

#define SSD_L0(w, sub) (((sub) ? 7 - (w) : (w)) * 16)
DI void ssd_out_item(const Params& p, int item, char* smem_raw) {
  const int tid = VTID, lane = tid & 63, w = tid >> 6, l15 = lane & 15, G = lane >> 4;
  const int head = item & 31, c = (item >> 5) & 31, b = item >> 10, g = head >> 3;
  u16* Bs = (u16*)(smem_raw + SS_B);
  u16* Xs = (u16*)(smem_raw + SS_R2);
  u16* Hs = (u16*)(smem_raw + SS_H);
  float* s_acs = (float*)(smem_raw + SS_F);
  float* s_dt = s_acs + 128;
  const size_t row0 = (size_t)b * 4096 + c * 128;
  if (tid < 128) {
    s_acs[tid] = p.ACS[(row0 + tid) * 32 + head];
    s_dt[tid] = p.DT[(row0 + tid) * 32 + head];
  }
#pragma unroll
  for (int i = 0; i < 8; ++i) {
    const int idx = tid + 256 * i, row = idx >> 4, ch = idx & 15;
    *(uint4*)(Bs + row * LDW + ch * 8) = *(const uint4*)(p.XBCC + (row0 + row) * 3072 + 2048 + g * 128 + ch * 8);
  }
#pragma unroll
  for (int i = 0; i < 4; ++i) {
    const int row = (tid >> 3) + 32 * i, ch = tid & 7;
    *(uint4*)(Xs + row * LDT + ch * 8) = *(const uint4*)(p.XBCC + (row0 + row) * 3072 + head * 64 + ch * 8);
  }
  {
    const u16* hp = p.STATES + (size_t)item * 64 * 128;
#pragma unroll
    for (int i = 0; i < 4; ++i) {
      const int idx = tid + 256 * i, pp = idx >> 4, ch = idx & 15;
      *(uint4*)(Hs + pp * LDW + ch * 8) = *(const uint4*)(hp + pp * 128 + ch * 8);
    }
  }
  bf16x8 cf[2][4];
#pragma unroll
  for (int sub = 0; sub < 2; ++sub)
#pragma unroll
    for (int ks = 0; ks < 4; ++ks)
      cf[sub][ks] = *(const bf16x8*)(p.XBCC + (row0 + SSD_L0(w, sub) + l15) * 3072 + 2560 + g * 128 + ks * 32 + G * 8);
  uint2 zpre[2][4];
#pragma unroll
  for (int sub = 0; sub < 2; ++sub)
#pragma unroll
    for (int m = 0; m < 4; ++m)
      zpre[sub][m] = *(const uint2*)(p.Z + (row0 + SSD_L0(w, sub) + l15) * 2048 + head * 64 + 16 * m + 4 * G);
  __syncthreads();
  const float Dh = p.ssm_D[head];
#pragma unroll
  for (int sub = 0; sub < 2; ++sub) {
    const int l0 = SSD_L0(w, sub), lq = l0 + l15;
    const float acs_q = s_acs[lq];
    f32x4 yo[4];
#pragma unroll
    for (int m = 0; m < 4; ++m) {
      f32x4 z = {0.f, 0.f, 0.f, 0.f};
#pragma unroll
      for (int ks = 0; ks < 4; ++ks) z = MFMA16(*(const bf16x8*)(Hs + (16 * m + l15) * LDW + ks * 32 + G * 8), cf[sub][ks], z);
      yo[m] = z;
    }
    {
      const float ea = __expf(acs_q);
#pragma unroll
      for (int m = 0; m < 4; ++m) { yo[m][0] *= ea; yo[m][1] *= ea; yo[m][2] *= ea; yo[m][3] *= ea; }
    }
    const int ns = (l0 >> 4) + 1, nsteps = (ns + 1) >> 1;
#pragma unroll 1
    for (int step = 0; step < nsteps; ++step) {
      unsigned pw[4];
#pragma unroll
      for (int h2 = 0; h2 < 2; ++h2) {
        const int ss = 2 * step + h2;
        f32x4 st = {0.f, 0.f, 0.f, 0.f};
#pragma unroll
        for (int ks = 0; ks < 4; ++ks) st = MFMA16(*(const bf16x8*)(Bs + (16 * ss + l15) * LDW + ks * 32 + G * 8), cf[sub][ks], st);
        float mv[4];
#pragma unroll
        for (int j = 0; j < 4; ++j) {
          const int s = 16 * ss + 4 * G + j;
          const float dec = __expf(fminf(acs_q - s_acs[s], 0.f)) * s_dt[s];
          mv[j] = (s <= lq) ? st[j] * dec : 0.f;
        }
        pw[2 * h2] = pack2(mv[0], mv[1]);
        pw[2 * h2 + 1] = pack2(mv[2], mv[3]);
      }
      const bf16x8 pb = words_to_frag(pw[0], pw[1], pw[2], pw[3]);
      const u16* xa = Xs + (32 * step + 4 * G + (l15 >> 2)) * LDT + (l15 & 3) * 4;
#pragma unroll
      for (int m = 0; m < 4; ++m) yo[m] = MFMA16(cat4(tr_read(xa + 16 * m), tr_read(xa + 16 * LDT + 16 * m)), pb, yo[m]);
    }
    const size_t rowg = (size_t)b * 4096 + c * 128 + lq;
    float ssq = 0.f;
#pragma unroll
    for (int m = 0; m < 4; ++m) {
      const uint2 xv = *(const uint2*)(Xs + lq * LDT + 16 * m + 4 * G);
      const uint2 zv = zpre[sub][m];
      const float xf[4] = {lo_f(xv.x), hi_f(xv.x), lo_f(xv.y), hi_f(xv.y)};
      const float zf[4] = {lo_f(zv.x), hi_f(zv.x), lo_f(zv.y), hi_f(zv.y)};
      float y[4];
#pragma unroll
      for (int j = 0; j < 4; ++j) {
        y[j] = (yo[m][j] + Dh * xf[j]) * silu_f(zf[j]);
        ssq += y[j] * y[j];
      }
      uint2 ov; ov.x = pack2(y[0], y[1]); ov.y = pack2(y[2], y[3]);
      *(uint2*)(p.YG + rowg * 2048 + head * 64 + 16 * m + 4 * G) = ov;
    }
    ssq += __shfl_xor(ssq, 16);
    ssq += __shfl_xor(ssq, 32);
    if (G == 0) p.SSQ[rowg * 32 + head] = ssq;
  }
  __syncthreads();
}

DI void idle_transposes(const Params& p, int idle_idx, int n_idle, int first, int count, u16* smem) {
  const int vb = idle_idx * 2 + (opaque_tid() >> 8), vg = n_idle * 2;
  for (int it = vb; it < count; it += vg) late_transpose_task(p, first + it, smem);
}

#define XB_TMO      128
#define XB_XCNT(j)  (256  + 64 * (j))
#define XB_XSUB(j)  (1280 + 64 * (j))
#define XB_XGEN(j)  (2304 + 64 * (j))
#define XB_TOP      3328
#define XB_TOPGEN   3392
#define XCD_BAR_WORDS 3456
#define XB_SPIN_CAP (1u << 20)
#define LAS __attribute__((address_space(3)))
DI unsigned xb_ld(unsigned* p) { return __hip_atomic_load(p, __ATOMIC_RELAXED, __HIP_MEMORY_SCOPE_AGENT); }
DI unsigned xb_add(unsigned* p, unsigned v) { return __hip_atomic_fetch_add(p, v, __ATOMIC_RELAXED, __HIP_MEMORY_SCOPE_AGENT); }
DI unsigned xb_xcc_id() { return (unsigned)__builtin_amdgcn_s_getreg((3 << 11) | 20) & 0xFu; }
#define XB_SPIN(cond, bar) do { unsigned _sp = 0; while (cond) { __builtin_amdgcn_s_sleep(1); \
    if ((++_sp & 255u) == 0u) { if (xb_ld(&(bar)[XB_TMO])) break; if (_sp > XB_SPIN_CAP) { atomicAdd(&(bar)[XB_TMO], 1u); break; } } } } while (0)
struct XcdBarrier { unsigned* bar; unsigned x; volatile LAS unsigned* st; };
DI XcdBarrier xcd_barrier_post(unsigned* bar, volatile LAS unsigned* st) {
  XcdBarrier b; b.bar = bar; b.x = xb_xcc_id(); b.st = st;
  if (threadIdx.x == 0) (void)xb_add(&bar[XB_XCNT(b.x)], 1u);
  return b;
}
DI void xcd_barrier_complete(unsigned* bar, unsigned x, unsigned& nloc, unsigned& nx) {
  const unsigned Gn = gridDim.x * gridDim.y * gridDim.z;
  unsigned sum, cnt, mine, sp = 0u;
  for (;;) {
    sum = 0u; cnt = 0u; mine = 0u;
#pragma unroll
    for (unsigned j = 0; j < 16; ++j) { const unsigned c = xb_ld(&bar[XB_XCNT(j)]); sum += c; cnt += (c > 0u) ? 1u : 0u; mine = (j == x) ? c : mine; }
    if (sum == Gn) break;
    __builtin_amdgcn_s_sleep(1);
    if ((++sp & 255u) == 0u) { if (xb_ld(&bar[XB_TMO])) break; if (sp > XB_SPIN_CAP) { atomicAdd(&bar[XB_TMO], 1u); break; } }
  }
  nloc = mine > 0u ? mine : 1u; nx = cnt > 0u ? cnt : 1u;
}
DI void xcd_barrier(const XcdBarrier& b) {
  asm volatile("s_waitcnt vmcnt(0)" ::: "memory");
  __syncthreads();
  if (threadIdx.x == 0) {
    unsigned* bar = b.bar;
    __builtin_amdgcn_s_waitcnt(0);
    unsigned nloc = b.st[0], nx = b.st[1];
    if (nloc == 0u) { xcd_barrier_complete(bar, b.x, nloc, nx); b.st[0] = nloc; b.st[1] = nx; }
    const unsigned old = xb_add(&bar[XB_XSUB(b.x)], 1u);
    const unsigned gen = old / nloc;
    if (old + 1u == (gen + 1u) * nloc) {
      __builtin_amdgcn_fence(__ATOMIC_RELEASE, "agent");
      asm volatile("s_waitcnt vmcnt(0)" ::: "memory");
      const unsigned og = xb_add(&bar[XB_TOP], 1u);
      const unsigned tg = og / nx;
      if (og + 1u == (tg + 1u) * nx) xb_add(&bar[XB_TOPGEN], 1u);
      else XB_SPIN(xb_ld(&bar[XB_TOPGEN]) == tg, bar);
      __builtin_amdgcn_fence(__ATOMIC_ACQUIRE, "agent");
      xb_add(&bar[XB_XGEN(b.x)], 1u);
      asm volatile("s_waitcnt vmcnt(0)" ::: "memory");
    } else {
      XB_SPIN(xb_ld(&bar[XB_XGEN(b.x)]) == gen, bar);
      __builtin_amdgcn_fence(__ATOMIC_ACQUIRE, "agent");
      asm volatile("s_waitcnt vmcnt(0)" ::: "memory");
    }
  }
  __syncthreads();
}

constexpr int NPHASE = 13;
#ifndef PH_MASK
#define PH_MASK 0x1fff
#endif
#define PH_ON(k) (((PH_MASK) >> (k)) & 1)
#ifndef PH_REPEAT
#define PH_REPEAT 0
#endif
#define PH_REP(k) (((PH_REPEAT) >> (k)) & 1)

template <bool COOP>
__global__ void __launch_bounds__(512, 2) mega(Params p, int ph0, int ph1) {
  extern __shared__ __attribute__((aligned(16))) char smem_all[];
  char* smem_raw = smem_all + (threadIdx.x >> 8) * LDS_HALF;
  u16* smem = (u16*)smem_raw;
#define PHASE_BODY(k)                                                                                                   \
  do {                                                                                                                  \
    if (k == 0) { if (PH_ON(0)) phase_prep(p, smem); }                                                                  \
    else if (k == 1) { if (PH_ON(1)) { gemm_phase_big(p.H, p.Wt1, 1024, MROWS / 256, ATT_IN / 256, Ep1{p}, smem_all); \
      const int x_ = blockIdx.x & 7, j_ = blockIdx.x >> 3; const bool busy_ = (x_ == 0) || (x_ == 1 && j_ < 8); \
      if (gridDim.x != 256) idle_transposes(p, blockIdx.x, gridDim.x, 0, TR2 + TR3, smem); \
      else if (!busy_) idle_transposes(p, (x_ >= 2) ? (x_ - 2) * 32 + j_ : 192 + (j_ - 8), 216, 0, TR2 + TR3, smem); } }  \
    else if (k == 2) { if (PH_ON(2)) phase_attn(p, smem); }                                                             \
    else if (k == 3) { if (PH_ON(3)) phase_merge(p); }                                                                  \
    else if (k == 4) { if (PH_ON(4)) { gemm_phase_big(p.H, p.Wt2, 1024, PROWS / 256, 4, Ep2{p}, smem_all); \
      gemm_sample_splitk(p.H, p.Wt2, 1024, 4, 4, EpAtomic{p.X1}, smem_all); \
      if (gridDim.x != 256) idle_transposes(p, blockIdx.x, gridDim.x, TR2 + TR3, TR4, smem); \
      else if (blockIdx.x >= 16) idle_transposes(p, blockIdx.x - 16, 240, TR2 + TR3, TR4, smem); } } \
    else if (k == 5) { if (PH_ON(5)) phase_norm2(p); }                                                                  \
    else if (k == 6) { if (PH_ON(6)) gemm_phase_big(p.H, p.Wt3, 1024, MROWS / 256, SSM_IN_PAD / 256, Ep3{p}, smem_all); } \
    else if (k == 7) { if (PH_ON(7)) phase_convpass(p); }                                                               \
    else if (k == 8) { if (PH_ON(8)) phase_states(p, smem_raw); }                                                       \
    else if (k == 9) { if (PH_ON(9)) phase_scan(p); }                                                                   \
    else if (k == 10) { if (PH_ON(10)) { if (gridDim.x == 256) { for (int r = 0; r < 8; ++r) ssd_out_item(p, ssd_item_of(r), smem_raw); } \
      else for (int it = VBID; it < 4096; it += VGRID) ssd_out_item(p, it, smem_raw); } } \
    else if (k == 11) { if (PH_ON(11)) phase_gatenorm(p); }                                                             \
    else if (k == 12) { if (PH_ON(12)) { gemm_phase_big(p.YG, p.Wt4, 2048, PROWS / 256, 4, Ep4{p}, smem_all); \
      gemm_sample_splitk(p.YG, p.Wt4, 2048, 4, 8, EpAtomic{p.out + O_Y}, smem_all); } }          \
  } while (0)
#define PHASE_STEP(k) PHASE_BODY(k); if (PH_REP(k)) { xcd_barrier(xb); PHASE_BODY(k); }
  if constexpr (COOP) {
    volatile LAS unsigned* xst = (volatile LAS unsigned*)(smem_all + LDS_MAIN);
    if (threadIdx.x == 0) { xst[0] = 0u; xst[1] = 0u; }
    __syncthreads();
    const XcdBarrier xb = xcd_barrier_post(p.bar, xst);
    if (ph0 == 0x7fffffff) cg::this_grid().sync();
    PHASE_STEP(0) xcd_barrier(xb);
    PHASE_STEP(1) xcd_barrier(xb);
    PHASE_STEP(2) xcd_barrier(xb);
    PHASE_STEP(3) xcd_barrier(xb);
    PHASE_STEP(4) xcd_barrier(xb);
    PHASE_STEP(5) xcd_barrier(xb);
    PHASE_STEP(6) xcd_barrier(xb);
    PHASE_STEP(7) xcd_barrier(xb);
    PHASE_STEP(8) xcd_barrier(xb);
    PHASE_STEP(9) xcd_barrier(xb);
    PHASE_STEP(10) xcd_barrier(xb);
    PHASE_STEP(11) xcd_barrier(xb);
    PHASE_STEP(12)
  } else {
    switch (ph0) {
      case 0: PHASE_BODY(0); break;
      case 1: PHASE_BODY(1); break;
      case 2: PHASE_BODY(2); break;
      case 3: PHASE_BODY(3); break;
      case 4: PHASE_BODY(4); break;
      case 5: PHASE_BODY(5); break;
      case 6: PHASE_BODY(6); break;
      case 7: PHASE_BODY(7); break;
      case 8: PHASE_BODY(8); break;
      case 9: PHASE_BODY(9); break;
      case 10: PHASE_BODY(10); break;
      case 11: PHASE_BODY(11); break;
      case 12: PHASE_BODY(12); break;
    }
  }
}

#ifndef MULTI_LAUNCH
#define MULTI_LAUNCH 0
#endif

extern "C" void kernel_launch(void* const* d_in, const int* in_sizes, int n_in, void* d_out, int out_size, void* d_ws, size_t ws_size,
                              hipStream_t stream) {
  static int grid = 0;
  size_t off = 0;
  auto carve = [&](size_t bytes) { size_t o = off; off += (bytes + 255) & ~(size_t)255; return (char*)d_ws + o; };
  Params p{};
  p.x_prompt = (const float*)d_in[0]; p.x_sample = (const float*)d_in[1];
  p.cache0 = (const float*)d_in[2]; p.cache1 = (const float*)d_in[3]; p.cache2 = (const float*)d_in[4];
  p.state_conv = (const float*)d_in[5]; p.state_ssm = (const float*)d_in[6];
  p.attn_norm = (const float*)d_in[7]; p.attn_w_in = (const float*)d_in[8]; p.attn_q_gain = (const float*)d_in[9];
  p.attn_k_gain = (const float*)d_in[10]; p.attn_w_out = (const float*)d_in[11];
  p.ssm_norm = (const float*)d_in[12]; p.ssm_w_in = (const float*)d_in[13]; p.ssm_conv_w = (const float*)d_in[14];
  p.ssm_conv_b = (const float*)d_in[15]; p.ssm_dt_bias = (const float*)d_in[16]; p.ssm_A_log = (const float*)d_in[17];
  p.ssm_D = (const float*)d_in[18]; p.ssm_gate_norm = (const float*)d_in[19]; p.ssm_w_out = (const float*)d_in[20];
  p.out = (float*)d_out;
  p.Wt1 = (u16*)carve((size_t)ATT_IN * 1024 * 2);
  p.Wt2 = (u16*)carve((size_t)1024 * 1024 * 2);
  p.Wt3 = (u16*)carve((size_t)SSM_IN_PAD * 1024 * 2);
  p.Wt4 = (u16*)carve((size_t)1024 * 2048 * 2);
  p.H = (u16*)carve((size_t)MROWS * 1024 * 2);
  p.QKVG = (u16*)carve((size_t)MROWS * ATT_IN * 2);
  p.OG = (u16*)carve((size_t)MROWS * 3072 * 2);
  p.Z = (u16*)carve((size_t)MROWS * 2048 * 2);
  p.XBC = (u16*)carve((size_t)MROWS * 3072 * 2);
  p.YG = (u16*)carve((size_t)MROWS * 2048 * 2);
  p.LSE = (float*)carve((size_t)MROWS * 48 * 4);
  p.X1 = (float*)carve((size_t)MROWS * 1024 * 4);
  p.DT = (float*)carve((size_t)MROWS * 32 * 4);
  p.STATES = (u16*)carve((size_t)4 * 32 * 32 * 64 * 128 * 2);
  p.XBCC = (u16*)carve((size_t)PROWS * 3072 * 2);
  p.ACS = (float*)carve((size_t)PROWS * 32 * 4);
  p.bar = (unsigned*)carve((size_t)XCD_BAR_WORDS * 4);
  p.QKVH = (u16*)carve((size_t)4 * 3 * 3 * 16 * 4096 * 64 * 2);
  p.SSQ = (float*)carve((size_t)MROWS * 32 * 4);
  p.CD = (float*)carve((size_t)4 * 32 * 32 * 4);
  if (grid == 0) {
    if (n_in != 21 || (size_t)out_size != O_END || ws_size < off) {
      fprintf(stderr, "kernel_launch: unexpected shapes: n_in %d out %d (want %zu) ws %zu (need %zu)\n", n_in, out_size, (size_t)O_END, ws_size, off);
      grid = -1; return;
    }
    int dev = 0, cus = 0, per_cu = 0;
    hipGetDevice(&dev);
    hipDeviceGetAttribute(&cus, hipDeviceAttributeMultiprocessorCount, dev);
    hipFuncSetAttribute((const void*)mega<true>, hipFuncAttributeMaxDynamicSharedMemorySize, LDS_BYTES);
    hipFuncSetAttribute((const void*)mega<false>, hipFuncAttributeMaxDynamicSharedMemorySize, LDS_BYTES);
    hipOccupancyMaxActiveBlocksPerMultiprocessor(&per_cu, (const void*)mega<true>, 512, LDS_BYTES);
    if (per_cu < 1) { fprintf(stderr, "kernel_launch: occupancy query returned %d\n", per_cu); grid = -1; return; }
    if (per_cu > 1) per_cu = 1;
    grid = cus * per_cu;
    grid &= ~7;
  }
  if (grid < 0) return;
#if MULTI_LAUNCH
  for (int ph = 0; ph < NPHASE; ++ph) hipLaunchKernelGGL(mega<false>, dim3(grid), dim3(512), LDS_BYTES, stream, p, ph, ph + 1);
#else
  hipMemsetAsync(p.bar, 0, (size_t)XCD_BAR_WORDS * 4, stream);
  int ph0 = 0, ph1 = NPHASE;
  void* args[] = {&p, &ph0, &ph1};
  hipError_t e = hipLaunchCooperativeKernel((const void*)mega<true>, dim3(grid), dim3(512), args, LDS_BYTES, stream);
  if (e != hipSuccess) fprintf(stderr, "cooperative launch failed: %s (grid %d)\n", hipGetErrorString(e), grid);
#endif
}
```

```cpp
#include <hip/hip_runtime.h>
#include <hip/hip_cooperative_groups.h>
#include <cstdio>
#include <cstdint>
namespace cg = cooperative_groups;

typedef unsigned short u16;
typedef short bf16x8 __attribute__((ext_vector_type(8)));
typedef short s16x4 __attribute__((ext_vector_type(4)));
typedef float f32x4 __attribute__((ext_vector_type(4)));

#define DI __device__ __forceinline__
__device__ __forceinline__ int opaque_tid() { int t = threadIdx.x; asm volatile("" : "+v"(t)); return t; }
#define VTID (opaque_tid() & 255)
#define VBID ((int)(blockIdx.x * 2 + (opaque_tid() >> 8)))
#define VGRID ((int)(gridDim.x * 2))
#define MFMA16(a, b, c) __builtin_amdgcn_mfma_f32_16x16x32_bf16((a), (b), (c), 0, 0, 0)

constexpr int MROWS = 16384 + 256;
constexpr int PROWS = 16384;
constexpr int ATT_IN = 10240;
constexpr int SSM_IN = 5152;
constexpr int SSM_IN_PAD = 5376;
constexpr int LDS_HALF = 73728;
constexpr int LDS_MAIN = 2 * LDS_HALF;
constexpr int LDS_BYTES = LDS_MAIN + 16;
constexpr int LDT = 72;
constexpr int LDW = 136;
constexpr int TILE_ELEMS = 128 * LDT;

constexpr size_t O_Y = 0;
constexpr size_t O_KVP0 = (size_t)MROWS * 1024;
constexpr size_t O_KVP1 = O_KVP0 + (size_t)4 * 128 * 2048;
constexpr size_t O_KVP2 = O_KVP1 + (size_t)4 * 512 * 2048;
constexpr size_t O_KVS0 = O_KVP2 + (size_t)4 * 2048 * 2048;
constexpr size_t O_KVS1 = O_KVS0 + (size_t)256 * 2048;
constexpr size_t O_KVS2 = O_KVS1 + (size_t)256 * 2048;
constexpr size_t O_CONVP = O_KVS2 + (size_t)256 * 2048;
constexpr size_t O_CONVS = O_CONVP + (size_t)4 * 3 * 3072;
constexpr size_t O_SSMP = O_CONVS + (size_t)32 * 3 * 3072;
constexpr size_t O_SSMS = O_SSMP + (size_t)4 * 32 * 64 * 128;
constexpr size_t O_END = O_SSMS + (size_t)32 * 32 * 64 * 128;

struct Params {
  const float *x_prompt, *x_sample, *cache0, *cache1, *cache2, *state_conv, *state_ssm;
  const float *attn_norm, *attn_w_in, *attn_q_gain, *attn_k_gain, *attn_w_out;
  const float *ssm_norm, *ssm_w_in, *ssm_conv_w, *ssm_conv_b, *ssm_dt_bias, *ssm_A_log, *ssm_D, *ssm_gate_norm, *ssm_w_out;
  float* out;
  u16 *Wt1, *Wt2, *Wt3, *Wt4, *H, *QKVG, *OG, *Z, *XBC, *YG, *XBCC, *STATES, *QKVH;
  float *LSE, *X1, *DT, *SSQ, *CD, *ACS;
  unsigned* bar;
};

typedef __bf16 bf16v2 __attribute__((ext_vector_type(2)));
DI u16 f2bf(float x) { return __builtin_bit_cast(u16, (__bf16)x); }
DI float bf2f(u16 h) { return __uint_as_float(((unsigned)h) << 16); }
DI unsigned pack2(float a, float b) { bf16v2 v; v[0] = (__bf16)a; v[1] = (__bf16)b; return __builtin_bit_cast(unsigned, v); }
DI float lo_f(unsigned w) { return __uint_as_float(w << 16); }
DI float hi_f(unsigned w) { return __uint_as_float(w & 0xffff0000u); }
DI void unpack8(const uint4& v, float* f) {
  f[0] = lo_f(v.x); f[1] = hi_f(v.x); f[2] = lo_f(v.y); f[3] = hi_f(v.y);
  f[4] = lo_f(v.z); f[5] = hi_f(v.z); f[6] = lo_f(v.w); f[7] = hi_f(v.w);
}
DI uint4 pack8(const float* f) {
  uint4 v; v.x = pack2(f[0], f[1]); v.y = pack2(f[2], f[3]); v.z = pack2(f[4], f[5]); v.w = pack2(f[6], f[7]); return v;
}
DI float sum16(float v) {
  v += __builtin_bit_cast(float, __builtin_amdgcn_update_dpp(0, __builtin_bit_cast(int, v), 0xB1, 0xf, 0xf, true));
  v += __builtin_bit_cast(float, __builtin_amdgcn_update_dpp(0, __builtin_bit_cast(int, v), 0x4E, 0xf, 0xf, true));
  v += __builtin_bit_cast(float, __builtin_amdgcn_update_dpp(0, __builtin_bit_cast(int, v), 0x141, 0xf, 0xf, true));
  v += __builtin_bit_cast(float, __builtin_amdgcn_update_dpp(0, __builtin_bit_cast(int, v), 0x140, 0xf, 0xf, true));
  return v;
}
DI float sum4(float v) {
  v += __builtin_bit_cast(float, __builtin_amdgcn_update_dpp(0, __builtin_bit_cast(int, v), 0xB1, 0xf, 0xf, true));
  v += __builtin_bit_cast(float, __builtin_amdgcn_update_dpp(0, __builtin_bit_cast(int, v), 0x4E, 0xf, 0xf, true));
  return v;
}
DI float silu_f(float x) { return x / (1.f + __expf(-x)); }
DI s16x4 tr_read(const u16* ptr) {
  return __builtin_amdgcn_ds_read_tr16_b64_v4i16((s16x4 __attribute__((address_space(3)))*)(ptr));
}
DI bf16x8 cat4(s16x4 lo, s16x4 hi) { return __builtin_shufflevector(lo, hi, 0, 1, 2, 3, 4, 5, 6, 7); }
DI bf16x8 words_to_frag(unsigned a, unsigned b, unsigned c, unsigned d) {
  uint4 v; v.x = a; v.y = b; v.z = c; v.w = d; return __builtin_bit_cast(bf16x8, v);
}

constexpr int G8_HT = 128 * 64;
DI int g8_lds_byte(int r, int c) {
  const int st = (r >> 4) * 2 + (c >> 5), rr = r & 15, cc = c & 31, ob = rr * 64 + cc * 2;
  return st * 1024 + (ob ^ (((ob >> 9) & 1) << 5));
}
DI void g8_stage_rc(int b, int& R, int& C) {
  const int st = b / 1024, sb = b % 1024, swz = sb ^ (((sb >> 9) & 1) << 5);
  R = (st >> 1) * 16 + swz / 64; C = (st & 1) * 32 + (swz % 64) / 2;
}
template <class EP>
DI void gemm_tile_big(const u16* __restrict__ A, const u16* __restrict__ Bt, int K, int klen, int brow, int bcol, const EP& ep, char* smem) {
  u16* shm = (u16*)smem;
  const int rtid = opaque_tid();
#define SA(b, h) (shm + ((b) * 2 + (h)) * G8_HT)
#define SB(b, h) (shm + (4 + (b) * 2 + (h)) * G8_HT)
  unsigned offA[2], offB[2];
#pragma unroll
  for (int _i = 0; _i < 2; ++_i) {
    int _r, _c; g8_stage_rc(rtid * 16 + _i * 8192, _r, _c);
    offA[_i] = (unsigned)((_r * K + _c) * 2);
    offB[_i] = (unsigned)((((_r >> 5) * 64 + (_r & 31)) * K + _c) * 2);
  }
#define STAGE_A(P, br, kt) do { const char* _gb = (const char*)A + ((size_t)(br) * K + (size_t)(kt) * 64) * 2;          \
    _Pragma("unroll") for (int _i = 0; _i < 2; ++_i)                                                                    \
      __builtin_amdgcn_global_load_lds((const unsigned*)(_gb + offA[_i]), (unsigned*)((char*)(P) + rtid * 16 + _i * 8192), 16, 0, 0); } while (0)
#define STAGE_B(P, h, kt) do { const char* _gb = (const char*)Bt + ((size_t)(bcol + (h) * 32) * K + (size_t)(kt) * 64) * 2; \
    _Pragma("unroll") for (int _i = 0; _i < 2; ++_i)                                                                    \
      __builtin_amdgcn_global_load_lds((const unsigned*)(_gb + offB[_i]), (unsigned*)((char*)(P) + rtid * 16 + _i * 8192), 16, 0, 0); } while (0)
#define LDA(dst, b, h) _Pragma("unroll") for (int m = 0; m < 4; ++m) _Pragma("unroll") for (int k = 0; k < 2; ++k) \
    dst[m][k] = *reinterpret_cast<const bf16x8*>(a_rd + ((b) * 2 + (h)) * 16384 + m * 2048 + k * 1024)
#define LDB(dst, b, h) _Pragma("unroll") for (int n = 0; n < 2; ++n) _Pragma("unroll") for (int k = 0; k < 2; ++k) \
    dst[n][k] = *reinterpret_cast<const bf16x8*>(b_rd + ((b) * 2 + (h)) * 16384 + n * 2048 + k * 1024)
#define MMA(ai, bj, At, Bx) do { __builtin_amdgcn_s_setprio(1);                                                         \
    for (int m = 0; m < 4; ++m) for (int n = 0; n < 2; ++n) for (int k = 0; k < 2; ++k)                                 \
      acc[ai][m][(bj) * 2 + n] = MFMA16(At[m][k], Bx[n][k], acc[ai][m][(bj) * 2 + n]);                                 \
    __builtin_amdgcn_s_setprio(0); } while (0)
#define WAIT_V(n) asm volatile("s_waitcnt vmcnt(" #n ")" ::: "memory")
#define WAIT_L(n) asm volatile("s_waitcnt lgkmcnt(" #n ")" ::: "memory")
#define BAR __builtin_amdgcn_s_barrier()
#define SCHED __builtin_amdgcn_sched_barrier(0)
  const int wid = rtid >> 6, lane = rtid & 63, wr = wid >> 2, wc = wid & 3, fr = lane & 15, fq = lane >> 4;
  const int l0 = g8_lds_byte(fr, fq * 8);
  const char* a_rd = smem + wr * 8192 + l0;
  const char* b_rd = smem + 4 * 16384 + wc * 4096 + l0;
  f32x4 acc[2][4][4];
#pragma unroll
  for (int ai = 0; ai < 2; ++ai)
#pragma unroll
    for (int m = 0; m < 4; ++m)
#pragma unroll
      for (int n = 0; n < 4; ++n) acc[ai][m][n] = (f32x4){0.f, 0.f, 0.f, 0.f};
  bf16x8 At[4][2], B0[2][2], B1[2][2];
  const int nt = klen / 64;
  STAGE_B(SB(0, 0), 0, 0); STAGE_A(SA(0, 0), brow, 0);
  STAGE_B(SB(0, 1), 1, 0); STAGE_A(SA(0, 1), brow + 128, 0);
  if (wr == 1) BAR;
  WAIT_V(4); BAR;
  STAGE_B(SB(1, 0), 0, 1); STAGE_A(SA(1, 0), brow, 1); STAGE_B(SB(1, 1), 1, 1);
  WAIT_V(6); BAR;
  for (int t = 0; t < nt - 2; t += 2) {
    LDB(B0, 0, 0); SCHED; LDA(At, 0, 0); STAGE_A(SA(1, 1), brow + 128, t + 1);
    WAIT_L(8); BAR; WAIT_L(0); MMA(0, 0, At, B0); BAR; SCHED;
    LDB(B1, 0, 1); STAGE_B(SB(0, 0), 0, t + 2);
    BAR; WAIT_L(0); MMA(0, 1, At, B1); BAR;
    LDA(At, 0, 1); STAGE_A(SA(0, 0), brow, t + 2);
    BAR; WAIT_L(0); MMA(1, 0, At, B0); BAR; SCHED;
    STAGE_B(SB(0, 1), 1, t + 2);
    WAIT_V(6); BAR; MMA(1, 1, At, B1); BAR;
    LDB(B0, 1, 0); SCHED; LDA(At, 1, 0); STAGE_A(SA(0, 1), brow + 128, t + 2);
    WAIT_L(8); BAR; WAIT_L(0); MMA(0, 0, At, B0); BAR; SCHED;
    LDB(B1, 1, 1); STAGE_B(SB(1, 0), 0, t + 3);
    BAR; WAIT_L(0); MMA(0, 1, At, B1); BAR;
    LDA(At, 1, 1); STAGE_A(SA(1, 0), brow, t + 3);
    BAR; WAIT_L(0); MMA(1, 0, At, B0); BAR; SCHED;
    STAGE_B(SB(1, 1), 1, t + 3);
    WAIT_V(6); BAR; MMA(1, 1, At, B1); BAR;
  }
  { LDB(B0, 0, 0); LDA(At, 0, 0); STAGE_A(SA(1, 1), brow + 128, nt - 1);
    BAR; WAIT_L(0); MMA(0, 0, At, B0); BAR;
    LDB(B1, 0, 1); BAR; WAIT_L(0); MMA(0, 1, At, B1); BAR;
    LDA(At, 0, 1); WAIT_V(4); BAR; WAIT_L(0); MMA(1, 0, At, B0); MMA(1, 1, At, B1); BAR; }
  { LDB(B0, 1, 0); LDA(At, 1, 0); WAIT_V(2); BAR; WAIT_L(0); MMA(0, 0, At, B0); BAR;
    LDB(B1, 1, 1); WAIT_V(0); BAR; WAIT_L(0); MMA(0, 1, At, B1); BAR;
    LDA(At, 1, 1); BAR; WAIT_L(0); MMA(1, 0, At, B0); MMA(1, 1, At, B1); BAR; }
  if (wr == 0) BAR;
#undef SA
#undef SB
#undef STAGE_A
#undef STAGE_B
#undef LDA
#undef LDB
#undef MMA
#undef WAIT_V
#undef WAIT_L
#undef BAR
#undef SCHED
  int late = 0;
  asm volatile("" : "+v"(late));
  ep(acc[0], brow + wr * 64 + late, bcol + wc * 64, lane + late);
  ep(acc[1], brow + 128 + wr * 64 + late, bcol + wc * 64, lane + late);
  __syncthreads();
}

template <class EP>
DI void gemm_phase_big(const u16* A, const u16* Bt, int K, int MT, int NT, const EP& ep, char* smem) {
  const int x = blockIdx.x & 7, j = blockIdx.x >> 3, per = gridDim.x >> 3;
  const int T = MT * NT, fullT = (MT >> 3) * 8 * NT, hlast = MT & 7;
  for (int v = j;; v += per) {
    const int chunk = x + 8 * (v >> 5);
    if (chunk * 32 >= T) break;
    const int s = chunk * 32 + (v & 31);
    if (s >= T) continue;
    int mt, nt;
    if (s < fullT) { const int band = s / (8 * NT), within = s - band * 8 * NT; nt = within >> 3; mt = band * 8 + (within & 7); }
    else { const int sp = s - fullT; nt = sp / hlast; mt = (MT >> 3) * 8 + (sp - nt * hlast); }
    gemm_tile_big(A, Bt, K, K, mt * 256, nt * 256, ep, smem);
  }
}

template <class EP>
DI void gemm_sample_splitk(const u16* A, const u16* Bt, int K, int NT, int S, const EP& ep, char* smem) {
  const int i = blockIdx.x;
  if (i < NT * S) {
    const int nt = i / S, ks = i - nt * S, klen = K / S;
    gemm_tile_big(A + ks * klen, Bt + ks * klen, K, klen, PROWS, nt * 256, ep, smem);
  }
}

DI unsigned merge_word(unsigned a, unsigned b, unsigned c, unsigned g, float e0, float e1, float e2) {
  const float lo = (e0 * lo_f(a) + e1 * lo_f(b) + e2 * lo_f(c)) * silu_f(lo_f(g));
  const float hi = (e0 * hi_f(a) + e1 * hi_f(b) + e2 * hi_f(c)) * silu_f(hi_f(g));
  return pack2(lo, hi);
}
DI void phase_merge(const Params& p) {
  const int lane = VTID & 63;
  for (int it = VBID; it < MROWS / 4; it += VGRID) {
    const size_t row = (size_t)it * 4 + (VTID >> 6);
    const int k = lane * 16, head = lane >> 2;
    const float* lp = p.LSE + row * 48 + head;
    const float l0 = lp[0], l1 = lp[16], l2 = lp[32];
    const u16* op = p.OG + row * 3072 + k;
    const u16* gp = p.QKVG + row * ATT_IN + 9216 + k;
    uint4 a[2], b[2], c[2], g[2];
#pragma unroll
    for (int h = 0; h < 2; ++h) {
      a[h] = *(const uint4*)(op + h * 8); b[h] = *(const uint4*)(op + 1024 + h * 8); c[h] = *(const uint4*)(op + 2048 + h * 8);
      g[h] = *(const uint4*)(gp + h * 8);
    }
    const float mx = fmaxf(l0, fmaxf(l1, l2));
    float e0 = __expf(l0 - mx), e1 = __expf(l1 - mx), e2 = __expf(l2 - mx);
    const float inv = 1.f / (e0 + e1 + e2);
    e0 *= inv; e1 *= inv; e2 *= inv;
#pragma unroll
    for (int h = 0; h < 2; ++h) {
      uint4 o;
      o.x = merge_word(a[h].x, b[h].x, c[h].x, g[h].x, e0, e1, e2);
      o.y = merge_word(a[h].y, b[h].y, c[h].y, g[h].y, e0, e1, e2);
      o.z = merge_word(a[h].z, b[h].z, c[h].z, g[h].z, e0, e1, e2);
      o.w = merge_word(a[h].w, b[h].w, c[h].w, g[h].w, e0, e1, e2);
      *(uint4*)(p.H + row * 1024 + k + h * 8) = o;
    }
    if (row >= PROWS) {
      const float* xs = p.x_sample + (row - PROWS) * 1024 + k;
      float* xd = p.X1 + row * 1024 + k;
#pragma unroll
      for (int h = 0; h < 4; ++h) *(float4*)(xd + h * 4) = *(const float4*)(xs + h * 4);
    }
  }
}
DI void phase_gatenorm(const Params& p) {
  const int lane = VTID & 63;
  for (int it = VBID; it < MROWS / 4; it += VGRID) {
    const size_t row = (size_t)it * 4 + (VTID >> 6);
    const int k = lane * 32;
    const float* sp = p.SSQ + row * 32 + (lane >> 4) * 8;
    const float4 s0 = *(const float4*)sp, s1 = *(const float4*)(sp + 4);
    const float ss = (s0.x + s0.y) + (s0.z + s0.w) + (s1.x + s1.y) + (s1.z + s1.w);
    const float rstd = rsqrtf(ss * (1.f / 512.f) + 1e-5f);
    u16* yp = p.YG + row * 2048 + k;
    uint4 y[4];
#pragma unroll
    for (int h = 0; h < 4; ++h) y[h] = *(const uint4*)(yp + h * 8);
#pragma unroll
    for (int h = 0; h < 4; ++h) {
      const float4 g0 = *(const float4*)(p.ssm_gate_norm + k + h * 8), g1 = *(const float4*)(p.ssm_gate_norm + k + h * 8 + 4);
      uint4 o;
      o.x = pack2(lo_f(y[h].x) * rstd * g0.x, hi_f(y[h].x) * rstd * g0.y);
      o.y = pack2(lo_f(y[h].y) * rstd * g0.z, hi_f(y[h].y) * rstd * g0.w);
      o.z = pack2(lo_f(y[h].z) * rstd * g1.x, hi_f(y[h].z) * rstd * g1.y);
      o.w = pack2(lo_f(y[h].w) * rstd * g1.z, hi_f(y[h].w) * rstd * g1.w);
      *(uint4*)(yp + h * 8) = o;
    }
    if (row >= PROWS) {
      const float* xs = p.X1 + row * 1024 + lane * 16;
      float* xd = p.out + O_Y + row * 1024 + lane * 16;
#pragma unroll
      for (int h = 0; h < 4; ++h) *(float4*)(xd + h * 4) = *(const float4*)(xs + h * 4);
    }
  }
}

struct Ep1 {
  const Params& p;
  DI void operator()(f32x4 (&acc)[4][4], int r0, int c0, int lane) const {
    const int l15 = lane & 15, G = lane >> 4;
    int kind, g = 0, head;
    if (c0 >= 9216) { kind = 3; head = (c0 - 9216) >> 6; }
    else { g = c0 / 3072; const int rem = c0 - g * 3072; kind = rem >> 10; head = (rem & 1023) >> 6; }
    if (kind < 2) {
      const float* gp = (kind == 0 ? p.attn_q_gain : p.attn_k_gain) + g * 64;
      float gain[4];
#pragma unroll
      for (int n = 0; n < 4; ++n) gain[n] = gp[n * 16 + l15];
      const float post = (kind == 0) ? 0.125f : 1.f;
#pragma unroll
      for (int m = 0; m < 4; ++m)
#pragma unroll
        for (int j = 0; j < 4; ++j) {
          float ss = 0.f;
#pragma unroll
          for (int n = 0; n < 4; ++n) ss += acc[m][n][j] * acc[m][n][j];
          ss = sum16(ss);
          const float sc = rsqrtf(ss * (1.f / 64.f) + 1e-6f) * post;
#pragma unroll
          for (int n = 0; n < 4; ++n) acc[m][n][j] *= sc * gain[n];
        }
    }
    if (kind < 3 && r0 < PROWS) {
      const int dsh = 2 * g;
      const size_t hb = ((size_t)(((r0 >> 12) * 3 + g) * 3 + kind) * 16 + head) * 4096;
#pragma unroll
      for (int m = 0; m < 4; ++m)
#pragma unroll
        for (int j = 0; j < 4; ++j) {
          const int t = (r0 + m * 16 + G * 4 + j) & 4095;
          const int pos = (t & ((1 << dsh) - 1)) * (4096 >> dsh) + (t >> dsh);
          u16* dst = p.QKVH + (hb + pos) * 64 + l15;
#pragma unroll
          for (int n = 0; n < 4; ++n) dst[n * 16] = f2bf(acc[m][n][j]);
        }
    } else {
#pragma unroll
      for (int m = 0; m < 4; ++m)
#pragma unroll
        for (int j = 0; j < 4; ++j) {
          const int row = r0 + m * 16 + G * 4 + j;
          u16* dst = p.QKVG + (size_t)row * ATT_IN + c0 + l15;
#pragma unroll
          for (int n = 0; n < 4; ++n) dst[n * 16] = f2bf(acc[m][n][j]);
        }
    }
    if (kind == 1 || kind == 2) {
      const int keep = 128 << (2 * g);
      const size_t okp = (g == 0) ? O_KVP0 : (g == 1) ? O_KVP1 : O_KVP2;
      const size_t oks = (g == 0) ? O_KVS0 : (g == 1) ? O_KVS1 : O_KVS2;
#pragma unroll
      for (int m = 0; m < 4; ++m)
#pragma unroll
        for (int j = 0; j < 4; ++j) {
          const int row = r0 + m * 16 + G * 4 + j;
          float* dst = nullptr;
          if (row < PROWS) {
            const int b = row >> 12, s = row & 4095;
            if (s >= 4096 - keep) dst = p.out + okp + ((size_t)(b * keep + s - (4096 - keep)) * 2 + (kind - 1)) * 1024 + head * 64 + l15;
          } else {
            dst = p.out + oks + ((size_t)(row - PROWS) * 2 + (kind - 1)) * 1024 + head * 64 + l15;
          }
          if (dst) {
#pragma unroll
            for (int n = 0; n < 4; ++n) dst[n * 16] = acc[m][n][j];
          }
        }
    }
  }
};
struct Ep2 {
  const Params& p;
  DI void operator()(f32x4 (&acc)[4][4], int r0, int c0, int lane) const {
    const int l15 = lane & 15, G = lane >> 4;
#pragma unroll
    for (int m = 0; m < 4; ++m)
#pragma unroll
      for (int j = 0; j < 4; ++j) {
        const int row = r0 + m * 16 + G * 4 + j;
        const float* xin = (row < PROWS) ? p.x_prompt + (size_t)row * 1024 : p.x_sample + (size_t)(row - PROWS) * 1024;
        float* dst = p.X1 + (size_t)row * 1024 + c0 + l15;
#pragma unroll
        for (int n = 0; n < 4; ++n) dst[n * 16] = xin[c0 + l15 + n * 16] + acc[m][n][j];
      }
  }
};
struct EpAtomic {
  float* dst;
  DI void operator()(f32x4 (&acc)[4][4], int r0, int c0, int lane) const {
    const int l15 = lane & 15, G = lane >> 4;
#pragma unroll
    for (int m = 0; m < 4; ++m)
#pragma unroll
      for (int j = 0; j < 4; ++j) {
        float* d = dst + (size_t)(r0 + m * 16 + G * 4 + j) * 1024 + c0 + l15;
#pragma unroll
        for (int n = 0; n < 4; ++n) unsafeAtomicAdd(d + n * 16, acc[m][n][j]);
      }
  }
};
struct Ep3 {
  const Params& p;
  DI void operator()(f32x4 (&acc)[4][4], int r0, int c0, int lane) const {
    const int l15 = lane & 15, G = lane >> 4;
    if (c0 >= SSM_IN) return;
    if (c0 < 2048) {
#pragma unroll
      for (int m = 0; m < 4; ++m)
#pragma unroll
        for (int j = 0; j < 4; ++j) {
          const int row = r0 + m * 16 + G * 4 + j;
          u16* dst = p.Z + (size_t)row * 2048 + c0 + l15;
#pragma unroll
          for (int n = 0; n < 4; ++n) dst[n * 16] = f2bf(acc[m][n][j]);
        }
    } else if (c0 < 5120) {
      const int cc = c0 - 2048 + l15;
#pragma unroll
      for (int m = 0; m < 4; ++m)
#pragma unroll
        for (int j = 0; j < 4; ++j) {
          const int row = r0 + m * 16 + G * 4 + j;
          u16* dst = p.XBC + (size_t)row * 3072 + cc;
#pragma unroll
          for (int n = 0; n < 4; ++n) dst[n * 16] = f2bf(acc[m][n][j]);
          float* od = nullptr;
          if (row < PROWS) {
            const int b = row >> 12, s = row & 4095;
            if (s >= 4093) od = p.out + O_CONVP + (size_t)(b * 3 + s - 4093) * 3072 + cc;
          } else {
            const int rr = row - PROWS, b = rr >> 3, t = rr & 7;
            if (t >= 5) od = p.out + O_CONVS + (size_t)(b * 3 + t - 5) * 3072 + cc;
          }
          if (od) {
#pragma unroll
            for (int n = 0; n < 4; ++n) od[n * 16] = acc[m][n][j];
          }
        }
    } else {
#pragma unroll
      for (int m = 0; m < 4; ++m)
#pragma unroll
        for (int j = 0; j < 4; ++j) {
          const int row = r0 + m * 16 + G * 4 + j;
#pragma unroll
          for (int n = 0; n < 2; ++n) {
            const int h = n * 16 + l15;
            const float xv = acc[m][n][j] + p.ssm_dt_bias[h];
            p.DT[(size_t)row * 32 + h] = fmaxf(xv, 0.f) + log1pf(__expf(-fabsf(xv)));
          }
        }
    }
  }
};
struct Ep4 {
  const Params& p;
  DI void operator()(f32x4 (&acc)[4][4], int r0, int c0, int lane) const {
    const int l15 = lane & 15, G = lane >> 4;
#pragma unroll
    for (int m = 0; m < 4; ++m)
#pragma unroll
      for (int j = 0; j < 4; ++j) {
        const int row = r0 + m * 16 + G * 4 + j;
        const float* xin = p.X1 + (size_t)row * 1024 + c0 + l15;
        float* dst = p.out + O_Y + (size_t)row * 1024 + c0 + l15;
#pragma unroll
        for (int n = 0; n < 4; ++n) dst[n * 16] = xin[n * 16] + acc[m][n][j];
      }
  }
};

DI void transpose_task(const float* __restrict__ W, u16* __restrict__ Wt, int K, int N, int NTN, int tile, u16* smem) {
  const int tid = VTID;
  const int ktile = tile / NTN, ntile = tile % NTN;
  const int k0 = ktile * 64, n0 = ntile * 64;
#pragma unroll
  for (int i = 0; i < 4; ++i) {
    const int idx = tid + 256 * i;
    const int kk = idx >> 4, nq = idx & 15;
    const int n = n0 + nq * 4;
    float4 v = {0.f, 0.f, 0.f, 0.f};
    if (n < N) v = *(const float4*)(W + (size_t)(k0 + kk) * N + n);
    smem[(nq * 4 + 0) * LDT + kk] = f2bf(v.x);
    smem[(nq * 4 + 1) * LDT + kk] = f2bf(v.y);
    smem[(nq * 4 + 2) * LDT + kk] = f2bf(v.z);
    smem[(nq * 4 + 3) * LDT + kk] = f2bf(v.w);
  }
  __syncthreads();
#pragma unroll
  for (int i = 0; i < 2; ++i) {
    const int idx = tid + 256 * i;
    const int n = idx >> 3, kc = idx & 7;
    *(uint4*)(Wt + (size_t)(n0 + n) * K + k0 + kc * 8) = *(const uint4*)(smem + n * LDT + kc * 8);
  }
  __syncthreads();
}

DI void rmsnorm_row(const float* __restrict__ src, const float* __restrict__ wgt, u16* __restrict__ dst, int lane) {
  float4 v[4];
  float ss = 0.f;
#pragma unroll
  for (int i = 0; i < 4; ++i) {
    v[i] = *(const float4*)(src + lane * 4 + 256 * i);
    ss += v[i].x * v[i].x + v[i].y * v[i].y + v[i].z * v[i].z + v[i].w * v[i].w;
  }
  ss = sum16(ss);
  ss += __shfl_xor(ss, 16);
  ss += __shfl_xor(ss, 32);
  const float rstd = rsqrtf(ss * (1.f / 1024.f) + 1e-6f);
#pragma unroll
  for (int i = 0; i < 4; ++i) {
    const float4 g = *(const float4*)(wgt + lane * 4 + 256 * i);
    uint2 o;
    o.x = pack2(v[i].x * rstd * g.x, v[i].y * rstd * g.y);
    o.y = pack2(v[i].z * rstd * g.z, v[i].w * rstd * g.w);
    *(uint2*)(dst + lane * 4 + 256 * i) = o;
  }
}

constexpr int TR1 = 16 * 160, TR2 = 16 * 16, TR3 = 16 * 84, TR4 = 32 * 16;
DI void phase_prep(const Params& p, u16* smem) {
  constexpr int RT = MROWS / 4;
  for (int it = VBID; it < TR1 + RT; it += VGRID) {
    if (it < TR1) transpose_task(p.attn_w_in, p.Wt1, 1024, ATT_IN, 160, it, smem);
    else {
      const int row = (it - TR1) * 4 + (VTID >> 6);
      const float* src = (row < PROWS) ? p.x_prompt + (size_t)row * 1024 : p.x_sample + (size_t)(row - PROWS) * 1024;
      rmsnorm_row(src, p.attn_norm, p.H + (size_t)row * 1024, VTID & 63);
    }
  }
}
DI void late_transpose_task(const Params& p, int it, u16* smem) {
  if (it < TR2) transpose_task(p.attn_w_out, p.Wt2, 1024, 1024, 16, it, smem);
  else if (it < TR2 + TR3) transpose_task(p.ssm_w_in, p.Wt3, 1024, SSM_IN, 84, it - TR2, smem);
  else transpose_task(p.ssm_w_out, p.Wt4, 2048, 1024, 16, it - TR2 - TR3, smem);
}

DI void phase_norm2(const Params& p) {
  for (int it = VBID; it < MROWS / 4; it += VGRID) {
    const int row = it * 4 + (VTID >> 6);
    rmsnorm_row(p.X1 + (size_t)row * 1024, p.ssm_norm, p.H + (size_t)row * 1024, VTID & 63);
  }
}

struct PromptRegs { uint4 k[8], v[8]; bf16x8 q[2][2]; };
DI void attn_prompt_load(const Params& p, int item, PromptRegs& R) {
  const int tid = VTID, lane = tid & 63, w = tid >> 6, l15 = lane & 15, G = lane >> 4;
  const int rn = item & 31, head = (item >> 5) & 15, b = (item >> 9) & 3, g = item >> 11;
  const int dsh = 2 * g, dil = 1 << dsh, nbg = 32 >> dsh;
  const int r = rn / nbg, n = rn % nbg;
  const size_t hq = ((size_t)((b * 3 + g) * 3 + 0) * 16 + head) * 4096 + (size_t)r * (4096 >> dsh);
  const size_t hk = hq + (size_t)16 * 4096, hv = hq + (size_t)32 * 4096;
  (void)dil;
#pragma unroll
  for (int i = 0; i < 8; ++i) {
    const int c = tid + 256 * i;
    const int kj = c >> 3, ch = c & 7;
    const int u = (n - 1) * 128 + kj;
    R.k[i] = (uint4){0u, 0u, 0u, 0u}; R.v[i] = (uint4){0u, 0u, 0u, 0u};
    if (u >= 0) {
      R.k[i] = *(const uint4*)(p.QKVH + (hk + u) * 64 + ch * 8);
      R.v[i] = *(const uint4*)(p.QKVH + (hv + u) * 64 + ch * 8);
    }
  }
#pragma unroll
  for (int sub = 0; sub < 2; ++sub) {
    const u16* qp = p.QKVH + (hq + n * 128 + w * 32 + sub * 16 + l15) * 64 + G * 8;
    R.q[sub][0] = *(const bf16x8*)qp;
    R.q[sub][1] = *(const bf16x8*)(qp + 32);
  }
}
DI void attn_prompt_stage(const PromptRegs& R, u16* smem) {
  const int tid = VTID;
  u16* Ks = smem;
  u16* Vs = smem + 256 * LDT;
#pragma unroll
  for (int i = 0; i < 8; ++i) {
    const int c = tid + 256 * i;
    const int kj = c >> 3, ch = c & 7;
    *(uint4*)(Ks + kj * LDT + ch * 8) = R.k[i];
    *(uint4*)(Vs + kj * LDT + ch * 8) = R.v[i];
  }
}
DI void attn_prompt_compute(const Params& p, int item, const bf16x8 (&qpre)[2][2], u16* smem) {
  const int tid = VTID, lane = tid & 63, w = tid >> 6, l15 = lane & 15, G = lane >> 4;
  const int rn = item & 31, head = (item >> 5) & 15, b = (item >> 9) & 3, g = item >> 11;
  const int dsh = 2 * g, dil = 1 << dsh, nbg = 32 >> dsh;
  const int r = rn / nbg, n = rn % nbg;
  u16* Ks = smem;
  u16* Vs = smem + 256 * LDT;
#pragma unroll 1
  for (int sub = 0; sub < 2; ++sub) {
    const int q0 = w * 32 + sub * 16;
    const int qi = q0 + l15;
    const size_t rowq = (size_t)b * 4096 + (size_t)(n * 128 + qi) * dil + r;
    const bf16x8 qf0 = sub ? qpre[1][0] : qpre[0][0], qf1 = sub ? qpre[1][1] : qpre[0][1];
    f32x4 st[9];
#pragma unroll
    for (int s = 0; s < 9; ++s) {
      const u16* kp = Ks + (q0 + 16 * s + l15) * LDT + G * 8;
      const bf16x8 a0 = *(const bf16x8*)kp, a1 = *(const bf16x8*)(kp + 32);
      f32x4 z = {0.f, 0.f, 0.f, 0.f};
      z = MFMA16(a0, qf0, z);
      st[s] = MFMA16(a1, qf1, z);
    }
    float mx = -INFINITY;
#pragma unroll
    for (int s = 0; s < 9; ++s)
#pragma unroll
      for (int j = 0; j < 4; ++j) {
        const int kk = 16 * s + 4 * G + j;
        const bool valid = (kk >= l15) && (kk <= l15 + 128) && (n > 0 || q0 + kk >= 128);
        const float v = valid ? st[s][j] : -INFINITY;
        st[s][j] = v;
        mx = fmaxf(mx, v);
      }
    mx = fmaxf(mx, __shfl_xor(mx, 16));
    mx = fmaxf(mx, __shfl_xor(mx, 32));
    float sum = 0.f;
#pragma unroll
    for (int s = 0; s < 9; ++s)
#pragma unroll
      for (int j = 0; j < 4; ++j) {
        const float e = __expf(st[s][j] - mx);
        st[s][j] = e;
        sum += e;
      }
    sum += __shfl_xor(sum, 16);
    sum += __shfl_xor(sum, 32);
    const float inv = 1.f / sum;
    f32x4 o[4];
#pragma unroll
    for (int m = 0; m < 4; ++m) o[m] = (f32x4){0.f, 0.f, 0.f, 0.f};
#pragma unroll
    for (int t = 0; t < 5; ++t) {
      const int sA = 2 * t, sB = 2 * t + 1;
      bf16x8 pb;
      if (t < 4) pb = words_to_frag(pack2(st[sA][0], st[sA][1]), pack2(st[sA][2], st[sA][3]), pack2(st[sB < 9 ? sB : 8][0], st[sB < 9 ? sB : 8][1]), pack2(st[sB < 9 ? sB : 8][2], st[sB < 9 ? sB : 8][3]));
      else pb = words_to_frag(pack2(st[sA][0], st[sA][1]), pack2(st[sA][2], st[sA][3]), 0u, 0u);
      const u16* vA = Vs + (q0 + 16 * sA + 4 * G + (l15 >> 2)) * LDT + (l15 & 3) * 4;
      const u16* vB = Vs + (q0 + 16 * sB + 4 * G + (l15 >> 2)) * LDT + (l15 & 3) * 4;
#pragma unroll
      for (int m = 0; m < 4; ++m) {
        const s16x4 lo = tr_read(vA + 16 * m);
        s16x4 hi = {0, 0, 0, 0};
        if (t < 4) hi = tr_read(vB + 16 * m);
        o[m] = MFMA16(cat4(lo, hi), pb, o[m]);
      }
    }
    u16* op = p.OG + rowq * 3072 + g * 1024 + head * 64 + 4 * G;
#pragma unroll
    for (int m = 0; m < 4; ++m) {
      uint2 ov;
      ov.x = pack2(o[m][0] * inv, o[m][1] * inv);
      ov.y = pack2(o[m][2] * inv, o[m][3] * inv);
      *(uint2*)(op + 16 * m) = ov;
    }
    if (G == 0) p.LSE[rowq * 48 + g * 16 + head] = mx + __logf(sum);
  }
}

DI void attn_sample_task(const Params& p, int id) {
  const int lane = VTID & 63, l15 = lane & 15, G = lane >> 4;
  const int t = id & 7, head = (id >> 3) & 15, b = (id >> 7) & 31, g = id >> 12;
  const int L = 128 << (2 * g), dil = 1 << (2 * g);
  const float* cache = (g == 0) ? p.cache0 : (g == 1) ? p.cache1 : p.cache2;
  const float* newkv = p.out + ((g == 0) ? O_KVS0 : (g == 1) ? O_KVS1 : O_KVS2);
  const size_t rowq = (size_t)PROWS + b * 8 + t;
  const uint2 qq = *(const uint2*)(p.QKVG + rowq * ATT_IN + g * 3072 + head * 64 + 4 * l15);
  const float q0 = lo_f(qq.x), q1 = hi_f(qq.x), q2 = lo_f(qq.y), q3 = hi_f(qq.y);
  const int coff = head * 64 + 4 * l15;
  float mx = -INFINITY, sum = 0.f, a0 = 0.f, a1 = 0.f, a2 = 0.f, a3 = 0.f;
#pragma unroll 1
  for (int bt = 0; bt < 2; ++bt) {
    float4 kb[17], vb[17];
#pragma unroll
    for (int u = 0; u < 17; ++u) {
      const int j = 4 * (bt * 17 + u) + G;
      const int jc = j < 128 ? j : 128;
      const int idx = L + t - dil * jc;
      const float* kp = ((idx < L) ? cache + (size_t)(b * L + idx) * 2048 : newkv + (size_t)(b * 8 + idx - L) * 2048) + coff + 512;
      kb[u] = *(const float4*)(kp - 512);
      vb[u] = *(const float4*)(kp + 512);
    }
    float scb[17];
    float bm = -INFINITY;
#pragma unroll
    for (int u = 0; u < 17; ++u) {
      const int j = 4 * (bt * 17 + u) + G;
      float sv = q0 * kb[u].x + q1 * kb[u].y + q2 * kb[u].z + q3 * kb[u].w;
      sv = sum16(sv);
      sv = (j <= 128) ? sv : -INFINITY;
      scb[u] = sv;
      bm = fmaxf(bm, sv);
    }
    const float mn = fmaxf(mx, bm);
    const float corr = __expf(mx - mn);
    sum *= corr; a0 *= corr; a1 *= corr; a2 *= corr; a3 *= corr;
#pragma unroll
    for (int u = 0; u < 17; ++u) {
      const float pe = __expf(scb[u] - mn);
      sum += pe;
      a0 += pe * vb[u].x; a1 += pe * vb[u].y; a2 += pe * vb[u].z; a3 += pe * vb[u].w;
    }
    mx = mn;
  }
  {
    float M = fmaxf(mx, __shfl_xor(mx, 16));
    M = fmaxf(M, __shfl_xor(M, 32));
    const float f = __expf(mx - M);
    sum *= f; a0 *= f; a1 *= f; a2 *= f; a3 *= f;
    mx = M;
  }
  sum += __shfl_xor(sum, 16); sum += __shfl_xor(sum, 32);
  a0 += __shfl_xor(a0, 16); a0 += __shfl_xor(a0, 32);
  a1 += __shfl_xor(a1, 16); a1 += __shfl_xor(a1, 32);
  a2 += __shfl_xor(a2, 16); a2 += __shfl_xor(a2, 32);
  a3 += __shfl_xor(a3, 16); a3 += __shfl_xor(a3, 32);
  const float inv = 1.f / sum;
  if (G == 0) {
    uint2 ov;
    ov.x = pack2(a0 * inv, a1 * inv);
    ov.y = pack2(a2 * inv, a3 * inv);
    *(uint2*)(p.OG + rowq * 3072 + g * 1024 + coff) = ov;
    if (l15 == 0) p.LSE[rowq * 48 + g * 16 + head] = mx + __logf(sum);
  }
}

DI int attn_item_of(int round) {
  if (gridDim.x != 256) return VBID + round * VGRID;
  const int x = blockIdx.x & 7, jj = (blockIdx.x >> 3) * 2 + (opaque_tid() >> 8);
  return ((round * 64 + (jj >> 3) * 8 + x) << 3) + (jj & 7);
}
DI void attn_prompt_stream(const Params& p, u16* smem) {
  constexpr int NP = 6144;
  int round = 0;
  int item = attn_item_of(0);
  PromptRegs R;
  if (item < NP) attn_prompt_load(p, item, R);
  while (item < NP) {
    attn_prompt_stage(R, smem);
    bf16x8 qc[2][2];
    qc[0][0] = R.q[0][0]; qc[0][1] = R.q[0][1]; qc[1][0] = R.q[1][0]; qc[1][1] = R.q[1][1];
    __syncthreads();
    const int next = attn_item_of(++round);
    if (next < NP) attn_prompt_load(p, next, R);
    attn_prompt_compute(p, item, qc, smem);
    __syncthreads();
    item = next;
  }
}
DI void phase_attn(const Params& p, u16* smem) {
  constexpr int NS = 3072;
  const bool sample_first = false;
  if (!sample_first) attn_prompt_stream(p, smem);
  for (int it = VBID; it < NS; it += VGRID) attn_sample_task(p, it * 4 + (VTID >> 6));
  if (sample_first) attn_prompt_stream(p, smem);
}

DI void conv_pass_task(const Params& p, int bt) {
  const int id = bt * 256 + VTID;
  const int ch = id % 384, seg = id / 384;
  const int col = ch * 8, row0 = seg * 8, t0 = row0 & 4095;
  const u16* src = p.XBC + (size_t)row0 * 3072 + col;
  uint4 raw[11];
#pragma unroll
  for (int j = 0; j < 3; ++j) {
    raw[j] = (uint4){0u, 0u, 0u, 0u};
    if (t0 > 0) raw[j] = *(const uint4*)(src - (ptrdiff_t)(3 - j) * 3072);
  }
#pragma unroll
  for (int j = 0; j < 8; ++j) raw[3 + j] = *(const uint4*)(src + (size_t)j * 3072);
  float wgt[4][8], bias[8];
#pragma unroll
  for (int j = 0; j < 4; ++j) {
    const float4 w0 = *(const float4*)(p.ssm_conv_w + j * 3072 + col), w1 = *(const float4*)(p.ssm_conv_w + j * 3072 + col + 4);
    wgt[j][0] = w0.x; wgt[j][1] = w0.y; wgt[j][2] = w0.z; wgt[j][3] = w0.w;
    wgt[j][4] = w1.x; wgt[j][5] = w1.y; wgt[j][6] = w1.z; wgt[j][7] = w1.w;
  }
  {
    const float4 b0 = *(const float4*)(p.ssm_conv_b + col), b1 = *(const float4*)(p.ssm_conv_b + col + 4);
    bias[0] = b0.x; bias[1] = b0.y; bias[2] = b0.z; bias[3] = b0.w;
    bias[4] = b1.x; bias[5] = b1.y; bias[6] = b1.z; bias[7] = b1.w;
  }
  float win[3][8];
  unpack8(raw[0], win[0]); unpack8(raw[1], win[1]); unpack8(raw[2], win[2]);
  u16* dst = p.XBCC + (size_t)row0 * 3072 + col;
#pragma unroll
  for (int i = 0; i < 8; ++i) {
    float cur[8], r[8];
    unpack8(raw[3 + i], cur);
#pragma unroll
    for (int e = 0; e < 8; ++e) {
      const float v = bias[e] + wgt[0][e] * win[0][e] + wgt[1][e] * win[1][e] + wgt[2][e] * win[2][e] + wgt[3][e] * cur[e];
      r[e] = silu_f(v);
      win[0][e] = win[1][e]; win[1][e] = win[2][e]; win[2][e] = cur[e];
    }
    *(uint4*)(dst + (size_t)i * 3072) = pack8(r);
  }
}

DI void acs_task(const Params& p, int bc) {
  const int lane = VTID & 63, head = lane & 31, half = lane >> 5;
  const float Aneg = -__expf(p.ssm_A_log[head]);
  const size_t rb = (size_t)bc * 128 + half * 64;
  float run = 0.f;
#pragma unroll 8
  for (int i = 0; i < 64; ++i) run += p.DT[(rb + i) * 32 + head] * Aneg;
  const float tot0 = __shfl(run, head);
  run = half ? tot0 : 0.f;
#pragma unroll 8
  for (int i = 0; i < 64; ++i) {
    run += p.DT[(rb + i) * 32 + head] * Aneg;
    p.ACS[(rb + i) * 32 + head] = run;
  }
}

DI void phase_convpass(const Params& p) {
  constexpr int NC = PROWS / 8 * 384 / 256;
  for (int it = VBID; it < NC + 32; it += VGRID) {
    if (it < NC) conv_pass_task(p, it);
    else acs_task(p, (it - NC) * 4 + (VTID >> 6));
  }
}

constexpr int SS_B = 0;
constexpr int SS_R2 = 34816;
constexpr int SS_H = 34816 + 18432;
constexpr int SS_F = 70656;

DI void ssd_states_item(const Params& p, int item, char* smem_raw) {
  const int tid = VTID, lane = tid & 63, w = tid >> 6, l15 = lane & 15, G = lane >> 4;
  const int head = item & 31, c = (item >> 5) & 31, b = item >> 10, g = head >> 3;
  u16* Bs = (u16*)(smem_raw + SS_B);
  u16* Xs = (u16*)(smem_raw + SS_R2);
  const size_t row0 = (size_t)b * 4096 + c * 128;
  const float a_end = p.ACS[(row0 + 127) * 32 + head];
#pragma unroll
  for (int i = 0; i < 4; ++i) {
    const int row = (tid >> 3) + 32 * i, ch = tid & 7;
    const float wl = p.DT[(row0 + row) * 32 + head] * __expf(a_end - p.ACS[(row0 + row) * 32 + head]);
    const uint4 v = *(const uint4*)(p.XBCC + (row0 + row) * 3072 + head * 64 + ch * 8);
    uint4 o;
    o.x = pack2(lo_f(v.x) * wl, hi_f(v.x) * wl); o.y = pack2(lo_f(v.y) * wl, hi_f(v.y) * wl);
    o.z = pack2(lo_f(v.z) * wl, hi_f(v.z) * wl); o.w = pack2(lo_f(v.w) * wl, hi_f(v.w) * wl);
    *(uint4*)(Xs + row * LDT + ch * 8) = o;
  }
#pragma unroll
  for (int i = 0; i < 8; ++i) {
    const int idx = tid + 256 * i, row = idx >> 4, ch = idx & 15;
    *(uint4*)(Bs + row * LDW + ch * 8) = *(const uint4*)(p.XBCC + (row0 + row) * 3072 + 2048 + g * 128 + ch * 8);
  }
  __syncthreads();
  f32x4 acc[4][2];
#pragma unroll
  for (int m = 0; m < 4; ++m) { acc[m][0] = (f32x4){0.f, 0.f, 0.f, 0.f}; acc[m][1] = (f32x4){0.f, 0.f, 0.f, 0.f}; }
#pragma unroll
  for (int k = 0; k < 4; ++k) {
    const int rowA = 32 * k + 8 * G + (l15 >> 2);
    bf16x8 a[4], bb[2];
#pragma unroll
    for (int m = 0; m < 4; ++m) {
      const u16* ap = Xs + rowA * LDT + 16 * m + (l15 & 3) * 4;
      a[m] = cat4(tr_read(ap), tr_read(ap + 4 * LDT));
    }
#pragma unroll
    for (int nn = 0; nn < 2; ++nn) {
      const u16* bp = Bs + rowA * LDW + 32 * w + 16 * nn + (l15 & 3) * 4;
      bb[nn] = cat4(tr_read(bp), tr_read(bp + 4 * LDW));
    }
#pragma unroll
    for (int m = 0; m < 4; ++m)
#pragma unroll
      for (int nn = 0; nn < 2; ++nn) acc[m][nn] = MFMA16(a[m], bb[nn], acc[m][nn]);
  }
  u16* sp = p.STATES + (size_t)item * 64 * 128;
#pragma unroll
  for (int m = 0; m < 4; ++m)
#pragma unroll
    for (int nn = 0; nn < 2; ++nn)
#pragma unroll
      for (int j = 0; j < 4; ++j) sp[(16 * m + 4 * G + j) * 128 + 32 * w + 16 * nn + l15] = f2bf(acc[m][nn][j]);
  if (tid == 0) p.CD[item] = __expf(a_end);
  __syncthreads();
}

DI void ssm_sample_item(const Params& p, int item, char* smem_raw) {
  const int tid = VTID;
  const int head = item & 31, b = item >> 5, g = head >> 3;
  float* sx = (float*)smem_raw;
  float* sB = sx + 512;
  float* sC = sB + 1024;
  float* sdt = sC + 1024;
  float* sdA = sdt + 8;
  float* sy2 = sdA + 8;
  const size_t row0 = (size_t)PROWS + b * 8;
  const float Aneg = -__expf(p.ssm_A_log[head]);
  for (int task = tid; task < 320; task += 256) {
    int col; float* dst;
    if (task < 64) { col = head * 64 + task; dst = sx + task; }
    else if (task < 192) { col = 2048 + g * 128 + (task - 64); dst = sB + (task - 64); }
    else { col = 2560 + g * 128 + (task - 192); dst = sC + (task - 192); }
    const int dstride = (task < 64) ? 64 : 128;
    const float w0 = p.ssm_conv_w[col], w1 = p.ssm_conv_w[3072 + col], w2 = p.ssm_conv_w[2 * 3072 + col], w3 = p.ssm_conv_w[3 * 3072 + col];
    const float bias = p.ssm_conv_b[col];
    float x0 = p.state_conv[(size_t)(b * 3 + 0) * 3072 + col];
    float x1 = p.state_conv[(size_t)(b * 3 + 1) * 3072 + col];
    float x2 = p.state_conv[(size_t)(b * 3 + 2) * 3072 + col];
#pragma unroll
    for (int t = 0; t < 8; ++t) {
      const float cur = bf2f(p.XBC[(row0 + t) * 3072 + col]);
      const float v = bias + w0 * x0 + w1 * x1 + w2 * x2 + w3 * cur;
      dst[t * dstride] = silu_f(v);
      x0 = x1; x1 = x2; x2 = cur;
    }
  }
  if (tid < 8) {
    const float dt = p.DT[(row0 + tid) * 32 + head];
    sdt[tid] = dt;
    sdA[tid] = __expf(dt * Aneg);
  }
  __syncthreads();
  const int pp = tid >> 2, nq = tid & 3;
  const size_t sbase = ((size_t)(b * 32 + head) * 64 + pp) * 128 + nq * 4;
  float4 h[8];
#pragma unroll
  for (int i = 0; i < 8; ++i) h[i] = *(const float4*)(p.state_ssm + sbase + i * 16);
  const float Dh = p.ssm_D[head];
#pragma unroll 1
  for (int t = 0; t < 8; ++t) {
    const float dA = sdA[t];
    const float xv = sx[t * 64 + pp];
    const float dtx = sdt[t] * xv;
    float y = 0.f;
#pragma unroll
    for (int i = 0; i < 8; ++i) {
      const float4 Bv = *(const float4*)(sB + t * 128 + i * 16 + nq * 4);
      const float4 Cv = *(const float4*)(sC + t * 128 + i * 16 + nq * 4);
      h[i].x = h[i].x * dA + dtx * Bv.x; h[i].y = h[i].y * dA + dtx * Bv.y;
      h[i].z = h[i].z * dA + dtx * Bv.z; h[i].w = h[i].w * dA + dtx * Bv.w;
      y += h[i].x * Cv.x + h[i].y * Cv.y + h[i].z * Cv.z + h[i].w * Cv.w;
    }
    y = sum4(y);
    if (nq == 0) {
      const float z = bf2f(p.Z[(row0 + t) * 2048 + head * 64 + pp]);
      const float yg = (y + Dh * xv) * silu_f(z);
      p.YG[(row0 + t) * 2048 + head * 64 + pp] = f2bf(yg);
      sy2[t * 64 + pp] = yg * yg;
    }
  }
  float* od = p.out + O_SSMS + sbase;
#pragma unroll
  for (int i = 0; i < 8; ++i) *(float4*)(od + i * 16) = h[i];
  __syncthreads();
  if (tid < 8) {
    float s = 0.f;
    for (int i = 0; i < 64; ++i) s += sy2[tid * 64 + i];
    p.SSQ[(row0 + tid) * 32 + head] = s;
  }
  __syncthreads();
}

DI int ssd_item_of(int round) {
  const int x = blockIdx.x & 7, jj = (blockIdx.x >> 3) * 2 + (opaque_tid() >> 8);
  return ((round * 64 + (jj >> 3) * 8 + x) << 3) + (jj & 7);
}
DI void phase_states(const Params& p, char* smem_raw) {
  constexpr int NP = 4096, NS = 1024;
  for (int it = VBID; it < NS; it += VGRID) ssm_sample_item(p, it, smem_raw);
  if (gridDim.x == 256) { for (int r = 0; r < 8; ++r) ssd_states_item(p, ssd_item_of(r), smem_raw); }
  else for (int it = VBID; it < NP; it += VGRID) ssd_states_item(p, it, smem_raw);
}

DI void phase_scan(const Params& p) {
  for (int task = VBID * 256 + VTID; task < 131072; task += VGRID * 256) {
    const int n8 = task & 15, pp = (task >> 4) & 63, head = (task >> 10) & 31, b = task >> 15;
    float h[8];
#pragma unroll
    for (int e = 0; e < 8; ++e) h[e] = 0.f;
#pragma unroll 8
    for (int c = 0; c < 32; ++c) {
      const int item = (b * 32 + c) * 32 + head;
      uint4* sp = (uint4*)(p.STATES + ((size_t)item * 64 + pp) * 128 + n8 * 8);
      const uint4 sv = *sp;
      const float d = p.CD[item];
      *sp = pack8(h);
      float sf[8];
      unpack8(sv, sf);
#pragma unroll
      for (int e = 0; e < 8; ++e) h[e] = h[e] * d + sf[e];
    }
    float* od = p.out + O_SSMP + ((size_t)(b * 32 + head) * 64 + pp) * 128 + n8 * 8;
    *(float4*)od = (float4){h[0], h[1], h[2], h[3]};
    *(float4*)(od + 4) = (float4){h[4], h[5], h[6], h[7]};
  }
}

#define SSD_L0(w, sub) (((sub) ? 7 - (w) : (w)) * 16)
DI void ssd_out_item(const Params& p, int item, char* smem_raw) {
  const int tid = VTID, lane = tid & 63, w = tid >> 6, l15 = lane & 15, G = lane >> 4;
  const int head = item & 31, c = (item >> 5) & 31, b = item >> 10, g = head >> 3;
  u16* Bs = (u16*)(smem_raw + SS_B);
  u16* Xs = (u16*)(smem_raw + SS_R2);
  u16* Hs = (u16*)(smem_raw + SS_H);
  float* s_acs = (float*)(smem_raw + SS_F);
  float* s_dt = s_acs + 128;
  const size_t row0 = (size_t)b * 4096 + c * 128;
  if (tid < 128) {
    s_acs[tid] = p.ACS[(row0 + tid) * 32 + head];
    s_dt[tid] = p.DT[(row0 + tid) * 32 + head];
  }
#pragma unroll
  for (int i = 0; i < 8; ++i) {
    const int idx = tid + 256 * i, row = idx >> 4, ch = idx & 15;
    *(uint4*)(Bs + row * LDW + ch * 8) = *(const uint4*)(p.XBCC + (row0 + row) * 3072 + 2048 + g * 128 + ch * 8);
  }
#pragma unroll
  for (int i = 0; i < 4; ++i) {
    const int row = (tid >> 3) + 32 * i, ch = tid & 7;
    *(uint4*)(Xs + row * LDT + ch * 8) = *(const uint4*)(p.XBCC + (row0 + row) * 3072 + head * 64 + ch * 8);
  }
  {
    const u16* hp = p.STATES + (size_t)item * 64 * 128;
#pragma unroll
    for (int i = 0; i < 4; ++i) {
      const int idx = tid + 256 * i, pp = idx >> 4, ch = idx & 15;
      *(uint4*)(Hs + pp * LDW + ch * 8) = *(const uint4*)(hp + pp * 128 + ch * 8);
    }
  }
  bf16x8 cf[2][4];
#pragma unroll
  for (int sub = 0; sub < 2; ++sub)
#pragma unroll
    for (int ks = 0; ks < 4; ++ks)
      cf[sub][ks] = *(const bf16x8*)(p.XBCC + (row0 + SSD_L0(w, sub) + l15) * 3072 + 2560 + g * 128 + ks * 32 + G * 8);
  uint2 zpre[2][4];
#pragma unroll
  for (int sub = 0; sub < 2; ++sub)
#pragma unroll
    for (int m = 0; m < 4; ++m)
      zpre[sub][m] = *(const uint2*)(p.Z + (row0 + SSD_L0(w, sub) + l15) * 2048 + head * 64 + 16 * m + 4 * G);
  __syncthreads();
  const float Dh = p.ssm_D[head];
#pragma unroll
  for (int sub = 0; sub < 2; ++sub) {
    const int l0 = SSD_L0(w, sub), lq = l0 + l15;
    const float acs_q = s_acs[lq];
    f32x4 yo[4];
#pragma unroll
    for (int m = 0; m < 4; ++m) {
      f32x4 z = {0.f, 0.f, 0.f, 0.f};
#pragma unroll
      for (int ks = 0; ks < 4; ++ks) z = MFMA16(*(const bf16x8*)(Hs + (16 * m + l15) * LDW + ks * 32 + G * 8), cf[sub][ks], z);
      yo[m] = z;
    }
    {
      const float ea = __expf(acs_q);
#pragma unroll
      for (int m = 0; m < 4; ++m) { yo[m][0] *= ea; yo[m][1] *= ea; yo[m][2] *= ea; yo[m][3] *= ea; }
    }
    const int ns = (l0 >> 4) + 1, nsteps = (ns + 1) >> 1;
#pragma unroll 2
    for (int step = 0; step < nsteps; ++step) {
      unsigned pw[4];
#pragma unroll
      for (int h2 = 0; h2 < 2; ++h2) {
        const int ss = 2 * step + h2;
        f32x4 st = {0.f, 0.f, 0.f, 0.f};
#pragma unroll
        for (int ks = 0; ks < 4; ++ks) st = MFMA16(*(const bf16x8*)(Bs + (16 * ss + l15) * LDW + ks * 32 + G * 8), cf[sub][ks], st);
        float mv[4];
#pragma unroll
        for (int j = 0; j < 4; ++j) {
          const int s = 16 * ss + 4 * G + j;
          const float dec = __expf(fminf(acs_q - s_acs[s], 0.f)) * s_dt[s];
          mv[j] = (s <= lq) ? st[j] * dec : 0.f;
        }
        pw[2 * h2] = pack2(mv[0], mv[1]);
        pw[2 * h2 + 1] = pack2(mv[2], mv[3]);
      }
      const bf16x8 pb = words_to_frag(pw[0], pw[1], pw[2], pw[3]);
      const u16* xa = Xs + (32 * step + 4 * G + (l15 >> 2)) * LDT + (l15 & 3) * 4;
#pragma unroll
      for (int m = 0; m < 4; ++m) yo[m] = MFMA16(cat4(tr_read(xa + 16 * m), tr_read(xa + 16 * LDT + 16 * m)), pb, yo[m]);
    }
    const size_t rowg = (size_t)b * 4096 + c * 128 + lq;
    float ssq = 0.f;
#pragma unroll
    for (int m = 0; m < 4; ++m) {
      const uint2 xv = *(const uint2*)(Xs + lq * LDT + 16 * m + 4 * G);
      const uint2 zv = zpre[sub][m];
      const float xf[4] = {lo_f(xv.x), hi_f(xv.x), lo_f(xv.y), hi_f(xv.y)};
      const float zf[4] = {lo_f(zv.x), hi_f(zv.x), lo_f(zv.y), hi_f(zv.y)};
      float y[4];
#pragma unroll
      for (int j = 0; j < 4; ++j) {
        y[j] = (yo[m][j] + Dh * xf[j]) * silu_f(zf[j]);
        ssq += y[j] * y[j];
      }
      uint2 ov; ov.x = pack2(y[0], y[1]); ov.y = pack2(y[2], y[3]);
      *(uint2*)(p.YG + rowg * 2048 + head * 64 + 16 * m + 4 * G) = ov;
    }
    ssq += __shfl_xor(ssq, 16);
    ssq += __shfl_xor(ssq, 32);
    if (G == 0) p.SSQ[rowg * 32 + head] = ssq;
  }
  __syncthreads();
}

DI void idle_transposes(const Params& p, int idle_idx, int n_idle, int first, int count, u16* smem) {
  const int vb = idle_idx * 2 + (opaque_tid() >> 8), vg = n_idle * 2;
  for (int it = vb; it < count; it += vg) late_transpose_task(p, first + it, smem);
}

#define XB_TMO      128
#define XB_XCNT(j)  (256  + 64 * (j))
#define XB_XSUB(j)  (1280 + 64 * (j))
#define XB_XGEN(j)  (2304 + 64 * (j))
#define XB_TOP      3328
#define XB_TOPGEN   3392
#define XCD_BAR_WORDS 3456
#define XB_SPIN_CAP (1u << 20)
#define LAS __attribute__((address_space(3)))
DI unsigned xb_ld(unsigned* p) { return __hip_atomic_load(p, __ATOMIC_RELAXED, __HIP_MEMORY_SCOPE_AGENT); }
DI unsigned xb_add(unsigned* p, unsigned v) { return __hip_atomic_fetch_add(p, v, __ATOMIC_RELAXED, __HIP_MEMORY_SCOPE_AGENT); }
DI unsigned xb_xcc_id() { return (unsigned)__builtin_amdgcn_s_getreg((3 << 11) | 20) & 0xFu; }
#define XB_SPIN(cond, bar) do { unsigned _sp = 0; while (cond) { __builtin_amdgcn_s_sleep(1); \
    if ((++_sp & 255u) == 0u) { if (xb_ld(&(bar)[XB_TMO])) break; if (_sp > XB_SPIN_CAP) { atomicAdd(&(bar)[XB_TMO], 1u); break; } } } } while (0)
struct XcdBarrier { unsigned* bar; unsigned x; volatile LAS unsigned* st; };
DI XcdBarrier xcd_barrier_post(unsigned* bar, volatile LAS unsigned* st) {
  XcdBarrier b; b.bar = bar; b.x = xb_xcc_id(); b.st = st;
  if (threadIdx.x == 0) (void)xb_add(&bar[XB_XCNT(b.x)], 1u);
  return b;
}
DI void xcd_barrier_complete(unsigned* bar, unsigned x, unsigned& nloc, unsigned& nx) {
  const unsigned Gn = gridDim.x * gridDim.y * gridDim.z;
  unsigned sum, cnt, mine, sp = 0u;
  for (;;) {
    sum = 0u; cnt = 0u; mine = 0u;
#pragma unroll
    for (unsigned j = 0; j < 16; ++j) { const unsigned c = xb_ld(&bar[XB_XCNT(j)]); sum += c; cnt += (c > 0u) ? 1u : 0u; mine = (j == x) ? c : mine; }
    if (sum == Gn) break;
    __builtin_amdgcn_s_sleep(1);
    if ((++sp & 255u) == 0u) { if (xb_ld(&bar[XB_TMO])) break; if (sp > XB_SPIN_CAP) { atomicAdd(&bar[XB_TMO], 1u); break; } }
  }
  nloc = mine > 0u ? mine : 1u; nx = cnt > 0u ? cnt : 1u;
}
DI void xcd_barrier(const XcdBarrier& b) {
  asm volatile("s_waitcnt vmcnt(0)" ::: "memory");
  __syncthreads();
  if (threadIdx.x == 0) {
    unsigned* bar = b.bar;
    __builtin_amdgcn_s_waitcnt(0);
    unsigned nloc = b.st[0], nx = b.st[1];
    if (nloc == 0u) { xcd_barrier_complete(bar, b.x, nloc, nx); b.st[0] = nloc; b.st[1] = nx; }
    const unsigned old = xb_add(&bar[XB_XSUB(b.x)], 1u);
    const unsigned gen = old / nloc;
    if (old + 1u == (gen + 1u) * nloc) {
      __builtin_amdgcn_fence(__ATOMIC_RELEASE, "agent");
      asm volatile("s_waitcnt vmcnt(0)" ::: "memory");
      const unsigned og = xb_add(&bar[XB_TOP], 1u);
      const unsigned tg = og / nx;
      if (og + 1u == (tg + 1u) * nx) xb_add(&bar[XB_TOPGEN], 1u);
      else XB_SPIN(xb_ld(&bar[XB_TOPGEN]) == tg, bar);
      __builtin_amdgcn_fence(__ATOMIC_ACQUIRE, "agent");
      xb_add(&bar[XB_XGEN(b.x)], 1u);
      asm volatile("s_waitcnt vmcnt(0)" ::: "memory");
    } else {
      XB_SPIN(xb_ld(&bar[XB_XGEN(b.x)]) == gen, bar);
      __builtin_amdgcn_fence(__ATOMIC_ACQUIRE, "agent");
      asm volatile("s_waitcnt vmcnt(0)" ::: "memory");
    }
  }
  __syncthreads();
}

constexpr int NPHASE = 13;
#ifndef PH_MASK
#define PH_MASK 0x1fff
#endif
#define PH_ON(k) (((PH_MASK) >> (k)) & 1)
#ifndef PH_REPEAT
#define PH_REPEAT 0
#endif
#define PH_REP(k) (((PH_REPEAT) >> (k)) & 1)

template <bool COOP>
__global__ void __launch_bounds__(512, 2) mega(Params p, int ph0, int ph1) {
  extern __shared__ __attribute__((aligned(16))) char smem_all[];
  char* smem_raw = smem_all + (threadIdx.x >> 8) * LDS_HALF;
  u16* smem = (u16*)smem_raw;
#define PHASE_BODY(k)                                                                                                   \
  do {                                                                                                                  \
    if (k == 0) { if (PH_ON(0)) phase_prep(p, smem); }                                                                  \
    else if (k == 1) { if (PH_ON(1)) { gemm_phase_big(p.H, p.Wt1, 1024, MROWS / 256, ATT_IN / 256, Ep1{p}, smem_all); \
      const int x_ = blockIdx.x & 7, j_ = blockIdx.x >> 3; const bool busy_ = (x_ == 0) || (x_ == 1 && j_ < 8); \
      if (gridDim.x != 256) idle_transposes(p, blockIdx.x, gridDim.x, 0, TR2 + TR3, smem); \
      else if (!busy_) idle_transposes(p, (x_ >= 2) ? (x_ - 2) * 32 + j_ : 192 + (j_ - 8), 216, 0, TR2 + TR3, smem); } }  \
    else if (k == 2) { if (PH_ON(2)) phase_attn(p, smem); }                                                             \
    else if (k == 3) { if (PH_ON(3)) phase_merge(p); }                                                                  \
    else if (k == 4) { if (PH_ON(4)) { gemm_phase_big(p.H, p.Wt2, 1024, PROWS / 256, 4, Ep2{p}, smem_all); \
      gemm_sample_splitk(p.H, p.Wt2, 1024, 4, 4, EpAtomic{p.X1}, smem_all); \
      if (gridDim.x != 256) idle_transposes(p, blockIdx.x, gridDim.x, TR2 + TR3, TR4, smem); \
      else if (blockIdx.x >= 16) idle_transposes(p, blockIdx.x - 16, 240, TR2 + TR3, TR4, smem); } } \
    else if (k == 5) { if (PH_ON(5)) phase_norm2(p); }                                                                  \
    else if (k == 6) { if (PH_ON(6)) gemm_phase_big(p.H, p.Wt3, 1024, MROWS / 256, SSM_IN_PAD / 256, Ep3{p}, smem_all); } \
    else if (k == 7) { if (PH_ON(7)) phase_convpass(p); }                                                               \
    else if (k == 8) { if (PH_ON(8)) phase_states(p, smem_raw); }                                                       \
    else if (k == 9) { if (PH_ON(9)) phase_scan(p); }                                                                   \
    else if (k == 10) { if (PH_ON(10)) { if (gridDim.x == 256) { for (int r = 0; r < 8; ++r) ssd_out_item(p, ssd_item_of(r), smem_raw); } \
      else for (int it = VBID; it < 4096; it += VGRID) ssd_out_item(p, it, smem_raw); } } \
    else if (k == 11) { if (PH_ON(11)) phase_gatenorm(p); }                                                             \
    else if (k == 12) { if (PH_ON(12)) { gemm_phase_big(p.YG, p.Wt4, 2048, PROWS / 256, 4, Ep4{p}, smem_all); \
      gemm_sample_splitk(p.YG, p.Wt4, 2048, 4, 8, EpAtomic{p.out + O_Y}, smem_all); } }          \
  } while (0)
#define PHASE_STEP(k) PHASE_BODY(k); if (PH_REP(k)) { xcd_barrier(xb); PHASE_BODY(k); }
  if constexpr (COOP) {
    volatile LAS unsigned* xst = (volatile LAS unsigned*)(smem_all + LDS_MAIN);
    if (threadIdx.x == 0) { xst[0] = 0u; xst[1] = 0u; }
    __syncthreads();
    const XcdBarrier xb = xcd_barrier_post(p.bar, xst);
    if (ph0 == 0x7fffffff) cg::this_grid().sync();
    PHASE_STEP(0) xcd_barrier(xb);
    PHASE_STEP(1) xcd_barrier(xb);
    PHASE_STEP(2) xcd_barrier(xb);
    PHASE_STEP(3) xcd_barrier(xb);
    PHASE_STEP(4) xcd_barrier(xb);
    PHASE_STEP(5) xcd_barrier(xb);
    PHASE_STEP(6) xcd_barrier(xb);
    PHASE_STEP(7) xcd_barrier(xb);
    PHASE_STEP(8) xcd_barrier(xb);
    PHASE_STEP(9) xcd_barrier(xb);
    PHASE_STEP(10) xcd_barrier(xb);
    PHASE_STEP(11) xcd_barrier(xb);
    PHASE_STEP(12)
  } else {
    switch (ph0) {
      case 0: PHASE_BODY(0); break;
      case 1: PHASE_BODY(1); break;
      case 2: PHASE_BODY(2); break;
      case 3: PHASE_BODY(3); break;
      case 4: PHASE_BODY(4); break;
      case 5: PHASE_BODY(5); break;
      case 6: PHASE_BODY(6); break;
      case 7: PHASE_BODY(7); break;
      case 8: PHASE_BODY(8); break;
      case 9: PHASE_BODY(9); break;
      case 10: PHASE_BODY(10); break;
      case 11: PHASE_BODY(11); break;
      case 12: PHASE_BODY(12); break;
    }
  }
}

#ifndef MULTI_LAUNCH
#define MULTI_LAUNCH 0
#endif

extern "C" void kernel_launch(void* const* d_in, const int* in_sizes, int n_in, void* d_out, int out_size, void* d_ws, size_t ws_size,
                              hipStream_t stream) {
  static int grid = 0;
  size_t off = 0;
  auto carve = [&](size_t bytes) { size_t o = off; off += (bytes + 255) & ~(size_t)255; return (char*)d_ws + o; };
  Params p{};
  p.x_prompt = (const float*)d_in[0]; p.x_sample = (const float*)d_in[1];
  p.cache0 = (const float*)d_in[2]; p.cache1 = (const float*)d_in[3]; p.cache2 = (const float*)d_in[4];
  p.state_conv = (const float*)d_in[5]; p.state_ssm = (const float*)d_in[6];
  p.attn_norm = (const float*)d_in[7]; p.attn_w_in = (const float*)d_in[8]; p.attn_q_gain = (const float*)d_in[9];
  p.attn_k_gain = (const float*)d_in[10]; p.attn_w_out = (const float*)d_in[11];
  p.ssm_norm = (const float*)d_in[12]; p.ssm_w_in = (const float*)d_in[13]; p.ssm_conv_w = (const float*)d_in[14];
  p.ssm_conv_b = (const float*)d_in[15]; p.ssm_dt_bias = (const float*)d_in[16]; p.ssm_A_log = (const float*)d_in[17];
  p.ssm_D = (const float*)d_in[18]; p.ssm_gate_norm = (const float*)d_in[19]; p.ssm_w_out = (const float*)d_in[20];
  p.out = (float*)d_out;
  p.Wt1 = (u16*)carve((size_t)ATT_IN * 1024 * 2);
  p.Wt2 = (u16*)carve((size_t)1024 * 1024 * 2);
  p.Wt3 = (u16*)carve((size_t)SSM_IN_PAD * 1024 * 2);
  p.Wt4 = (u16*)carve((size_t)1024 * 2048 * 2);
  p.H = (u16*)carve((size_t)MROWS * 1024 * 2);
  p.QKVG = (u16*)carve((size_t)MROWS * ATT_IN * 2);
  p.OG = (u16*)carve((size_t)MROWS * 3072 * 2);
  p.Z = (u16*)carve((size_t)MROWS * 2048 * 2);
  p.XBC = (u16*)carve((size_t)MROWS * 3072 * 2);
  p.YG = (u16*)carve((size_t)MROWS * 2048 * 2);
  p.LSE = (float*)carve((size_t)MROWS * 48 * 4);
  p.X1 = (float*)carve((size_t)MROWS * 1024 * 4);
  p.DT = (float*)carve((size_t)MROWS * 32 * 4);
  p.STATES = (u16*)carve((size_t)4 * 32 * 32 * 64 * 128 * 2);
  p.XBCC = (u16*)carve((size_t)PROWS * 3072 * 2);
  p.ACS = (float*)carve((size_t)PROWS * 32 * 4);
  p.bar = (unsigned*)carve((size_t)XCD_BAR_WORDS * 4);
  p.QKVH = (u16*)carve((size_t)4 * 3 * 3 * 16 * 4096 * 64 * 2);
  p.SSQ = (float*)carve((size_t)MROWS * 32 * 4);
  p.CD = (float*)carve((size_t)4 * 32 * 32 * 4);
  if (grid == 0) {
    if (n_in != 21 || (size_t)out_size != O_END || ws_size < off) {
      fprintf(stderr, "kernel_launch: unexpected shapes: n_in %d out %d (want %zu) ws %zu (need %zu)\n", n_in, out_size, (size_t)O_END, ws_size, off);
      grid = -1; return;
    }
    int dev = 0, cus = 0, per_cu = 0;
    hipGetDevice(&dev);
    hipDeviceGetAttribute(&cus, hipDeviceAttributeMultiprocessorCount, dev);
    hipFuncSetAttribute((const void*)mega<true>, hipFuncAttributeMaxDynamicSharedMemorySize, LDS_BYTES);
    hipFuncSetAttribute((const void*)mega<false>, hipFuncAttributeMaxDynamicSharedMemorySize, LDS_BYTES);
    hipOccupancyMaxActiveBlocksPerMultiprocessor(&per_cu, (const void*)mega<true>, 512, LDS_BYTES);
    if (per_cu < 1) { fprintf(stderr, "kernel_launch: occupancy query returned %d\n", per_cu); grid = -1; return; }
    if (per_cu > 1) per_cu = 1;
    grid = cus * per_cu;
    grid &= ~7;
  }
  if (grid < 0) return;
#if MULTI_LAUNCH
  for (int ph = 0; ph < NPHASE; ++ph) hipLaunchKernelGGL(mega<false>, dim3(grid), dim3(512), LDS_BYTES, stream, p, ph, ph + 1);
#else
  hipMemsetAsync(p.bar, 0, (size_t)XCD_BAR_WORDS * 4, stream);
  int ph0 = 0, ph1 = NPHASE;
  void* args[] = {&p, &ph0, &ph1};
  hipError_t e = hipLaunchCooperativeKernel((const void*)mega<true>, dim3(grid), dim3(512), args, LDS_BYTES, stream);
  if (e != hipSuccess) fprintf(stderr, "cooperative launch failed: %s (grid %d)\n", hipGetErrorString(e), grid);
#endif
}
```
